# Optimizing an MI355X kernel written in HIP

```python
import math
import jax, jax.numpy as jnp
from jax import lax
import numpy as np

D_MODEL = 1024
BATCH = 4
SEQ = 8192
DEPTH = 4

D_MIX = D_MODEL
CONV_DIM = D_MIX // 2
CONV_GROUPS = 8
CONV_WIDTH = 31
GLA_HEADS = 4
GLA_VAL_DIM = D_MIX // 2
GLA_HEAD_V = GLA_VAL_DIM // GLA_HEADS
GLA_KEY_DIM = GLA_VAL_DIM // 2
GLA_HEAD_K = GLA_KEY_DIM // GLA_HEADS
GATE_RANK = 16
GATE_TAU = 16.0
GLA_CHUNK = 64
IN_COLS = 2 * CONV_DIM + 2 * GLA_KEY_DIM + 2 * GLA_VAL_DIM + GATE_RANK
MEM_LEN = 256
X_HEADS = 4
X_HEAD_DIM = D_MODEL // X_HEADS
D_FF = int(math.ceil(8 * D_MODEL / 3 / 256) * 256)
DEEPNORM_ALPHA = (2 * DEPTH) ** 0.25
DEEPNORM_BETA = (8 * DEPTH) ** -0.25
LN_EPS = 1e-5

kernel_name = "hybrid_conv_gla_deepnorm_trunk"


def layer_norm(x, g, b):
    xf = x.astype(jnp.float32)
    mu = jnp.mean(xf, axis=-1, keepdims=True)
    xc = xf - mu
    var = jnp.mean(xc * xc, axis=-1, keepdims=True)
    return (xc * lax.rsqrt(var + LN_EPS) * g.astype(jnp.float32) + b.astype(jnp.float32)).astype(x.dtype)


def rms_norm(x, g):
    xf = x.astype(jnp.float32)
    ms = jnp.mean(xf * xf, axis=-1, keepdims=True)
    return (xf * lax.rsqrt(ms + LN_EPS) * g.astype(jnp.float32)).astype(x.dtype)


def causal_depthwise_conv(u, w, b):
    c = u.shape[-1]
    y = lax.conv_general_dilated(
        u, w[:, None, :].astype(u.dtype), window_strides=(1,),
        padding=[(w.shape[0] - 1, 0)],
        dimension_numbers=("NWC", "WIO", "NWC"),
        feature_group_count=c)
    return y + b


def gla_chunked(q, k, v, log_a):
    out_dtype = v.dtype
    bsz, t, h, dk = q.shape
    dv = v.shape[-1]
    n = t // GLA_CHUNK

    def to_chunks(z):
        return z.astype(jnp.float32).reshape(bsz, n, GLA_CHUNK, h, z.shape[-1]).transpose(0, 3, 1, 2, 4)

    qc = to_chunks(q) * (dk ** -0.5)
    kc, vc, gc = to_chunks(k), to_chunks(v), to_chunks(log_a)
    bcum = jnp.cumsum(gc, axis=3)
    b_last = bcum[:, :, :, -1:, :]
    qe = qc * jnp.exp(bcum)
    ke = kc * jnp.exp(-bcum)
    kd = kc * jnp.exp(b_last - bcum)
    causal = jnp.tril(jnp.ones((GLA_CHUNK, GLA_CHUNK), dtype=bool))
    att = jnp.einsum("bhncd,bhnsd->bhncs", qe, ke)
    att = jnp.where(causal, att, 0.0)
    o_intra = jnp.einsum("bhncs,bhnse->bhnce", att, vc)
    upd = jnp.einsum("bhncd,bhnce->bhnde", kd, vc)
    decay = jnp.exp(b_last[:, :, :, 0, :])

    def step(state, inp):
        dec, u = inp
        return dec[..., None] * state + u, state

    s0 = jnp.zeros((bsz, h, dk, dv), jnp.float32)
    _, s_prev = lax.scan(step, s0, (jnp.moveaxis(decay, 2, 0), jnp.moveaxis(upd, 2, 0)))
    s_prev = jnp.moveaxis(s_prev, 0, 2)
    o_inter = jnp.einsum("bhncd,bhnde->bhnce", qe, s_prev)
    o = (o_intra + o_inter).transpose(0, 2, 3, 1, 4).reshape(bsz, t, h, dv)
    return o.astype(out_dtype)


def hybrid_mixer(h, w_in, w_a2, b_a, conv_w, conv_b, conv_ln_g, conv_ln_b, gla_norm_g, w_out):
    bsz, t, _ = h.shape
    proj = h @ w_in
    cuts = np.cumsum([CONV_DIM, CONV_DIM, GLA_KEY_DIM, GLA_KEY_DIM, GLA_VAL_DIM, GLA_VAL_DIM]).tolist()
    c_a, c_g, q, k, v, r, a_low = jnp.split(proj, cuts, axis=-1)
    u = c_a * jax.nn.sigmoid(c_g)
    u = causal_depthwise_conv(u, conv_w, conv_b)
    u = jax.nn.silu(layer_norm(u, conv_ln_g, conv_ln_b))
    z = a_low @ w_a2 + b_a
    log_a = jax.nn.log_sigmoid(z.astype(jnp.float32)) / GATE_TAU
    heads = lambda y, d: y.reshape(bsz, t, GLA_HEADS, d)
    o = gla_chunked(heads(q, GLA_HEAD_K), heads(k, GLA_HEAD_K), heads(v, GLA_HEAD_V),
                    heads(log_a, GLA_HEAD_K))
    o = rms_norm(o, gla_norm_g) * jax.nn.silu(heads(r, GLA_HEAD_V))
    o = o.reshape(bsz, t, GLA_VAL_DIM)
    return jnp.concatenate([u, o], axis=-1) @ w_out


def memory_cross_attention(x, mem, w_q, w_kv, w_o):
    bsz, t, _ = x.shape
    q = (x @ w_q).reshape(bsz, t, X_HEADS, X_HEAD_DIM)
    kv = mem @ w_kv
    k, v = jnp.split(kv, 2, axis=-1)
    k = k.reshape(bsz, MEM_LEN, X_HEADS, X_HEAD_DIM)
    v = v.reshape(bsz, MEM_LEN, X_HEADS, X_HEAD_DIM)
    s = jnp.einsum("bthd,bmhd->bhtm", q.astype(jnp.float32), k.astype(jnp.float32)) * (X_HEAD_DIM ** -0.5)
    p = jax.nn.softmax(s, axis=-1).astype(v.dtype)
    o = jnp.einsum("bhtm,bmhd->bthd", p, v).reshape(bsz, t, D_MODEL)
    return o @ w_o


def swiglu(x, w_in, w_out):
    g, u = jnp.split(x @ w_in, 2, axis=-1)
    return (jax.nn.silu(g) * u) @ w_out


def setup_inputs(seed: int = 0) -> dict:
    key = jax.random.key(seed)
    ks = jax.random.split(key, 24)
    nrm = lambda k, shape, scale: jax.random.normal(k, shape, jnp.float32) * scale
    gain = lambda k, shape: 1.0 + nrm(k, shape, 0.02)
    L = DEPTH
    return {
        "x": nrm(ks[0], (BATCH, SEQ, D_MODEL), 1.0),
        "mem": nrm(ks[1], (BATCH, MEM_LEN, D_MODEL), 1.0),
        "ln0_g": gain(ks[2], (D_MODEL,)),
        "ln0_b": nrm(ks[3], (D_MODEL,), 0.02),
        "w_in": nrm(ks[4], (L, D_MODEL, IN_COLS), D_MODEL ** -0.5),
        "w_a2": nrm(ks[5], (L, GATE_RANK, GLA_KEY_DIM), GATE_RANK ** -0.5),
        "b_a": nrm(ks[6], (L, GLA_KEY_DIM), 0.01),
        "conv_w": nrm(ks[7], (L, CONV_WIDTH, CONV_DIM), CONV_WIDTH ** -0.5),
        "conv_b": nrm(ks[8], (L, CONV_DIM), 0.02),
        "conv_ln_g": gain(ks[9], (L, CONV_DIM)),
        "conv_ln_b": nrm(ks[10], (L, CONV_DIM), 0.02),
        "gla_norm_g": gain(ks[11], (L, GLA_HEAD_V)),
        "w_mix_out": nrm(ks[12], (L, D_MIX, D_MODEL), DEEPNORM_BETA * D_MIX ** -0.5),
        "ln1_g": gain(ks[13], (L, D_MODEL)),
        "ln1_b": nrm(ks[14], (L, D_MODEL), 0.02),
        "w_xq": nrm(ks[15], (L, D_MODEL, D_MODEL), D_MODEL ** -0.5),
        "w_xkv": jnp.concatenate([
            nrm(ks[16], (L, D_MODEL, D_MODEL), D_MODEL ** -0.5),
            nrm(jax.random.fold_in(ks[16], 1), (L, D_MODEL, D_MODEL), DEEPNORM_BETA * D_MODEL ** -0.5)], axis=-1),
        "w_xo": nrm(ks[17], (L, D_MODEL, D_MODEL), DEEPNORM_BETA * D_MODEL ** -0.5),
        "ln2_g": gain(ks[18], (L, D_MODEL)),
        "ln2_b": nrm(ks[19], (L, D_MODEL), 0.02),
        "w_ffn_in": nrm(ks[20], (L, D_MODEL, 2 * D_FF), D_MODEL ** -0.5),
        "w_ffn_out": nrm(ks[21], (L, D_FF, D_MODEL), DEEPNORM_BETA * D_FF ** -0.5),
        "ln3_g": gain(ks[22], (L, D_MODEL)),
        "ln3_b": nrm(ks[23], (L, D_MODEL), 0.02),
    }


def reference(x, mem, ln0_g, ln0_b, w_in, w_a2, b_a, conv_w, conv_b, conv_ln_g, conv_ln_b,
              gla_norm_g, w_mix_out, ln1_g, ln1_b, w_xq, w_xkv, w_xo, ln2_g, ln2_b,
              w_ffn_in, w_ffn_out, ln3_g, ln3_b):
    h = layer_norm(x, ln0_g, ln0_b)
    for l in range(DEPTH):
        mix = hybrid_mixer(h, w_in[l], w_a2[l], b_a[l], conv_w[l], conv_b[l], conv_ln_g[l],
                           conv_ln_b[l], gla_norm_g[l], w_mix_out[l])
        h = layer_norm(DEEPNORM_ALPHA * h + mix, ln1_g[l], ln1_b[l])
        xa = memory_cross_attention(h, mem, w_xq[l], w_xkv[l], w_xo[l])
        h = layer_norm(DEEPNORM_ALPHA * h + xa, ln2_g[l], ln2_b[l])
        ff = swiglu(h, w_ffn_in[l], w_ffn_out[l])
        h = layer_norm(DEEPNORM_ALPHA * h + ff, ln3_g[l], ln3_b[l])
    return h
```

```cpp
#include <hip/hip_runtime.h>
#include <cstdio>
#include <cstdint>

typedef unsigned short bf16_t;
typedef unsigned u32x4 __attribute__((ext_vector_type(4)));
typedef float f32x4 __attribute__((ext_vector_type(4)));

constexpr int D = 1024, BATCH = 4, SEQ = 8192, DEPTH = 4, M = BATCH * SEQ;
constexpr int IN_COLS = 2576, PROJ_LD = 2560, MEM_LEN = 256, D_FF = 2816;
constexpr int C_CA = 0, C_CG = 512, C_Q = 1024, C_K = 1280, C_V = 1536, C_R = 2048, C_AL = 2560;
constexpr float LN_EPS = 1e-5f;
constexpr float ALPHA = 1.681792830507429f;

constexpr size_t MiB = 1u << 20;
constexpr size_t WS_CTL = 0;
constexpr size_t WS_K = 8 * MiB;
constexpr size_t WS_VT = 16 * MiB;
constexpr size_t WS_MEMB = 24 * MiB;
constexpr size_t WS_MEMP = 26 * MiB;
constexpr size_t WS_ALOW = 28 * MiB;
constexpr size_t WS_DEC = 29 * MiB;
constexpr size_t WS_WT = 32 * MiB;
constexpr size_t WS_HB = 160 * MiB;
constexpr size_t WS_PROJ = 224 * MiB;
constexpr size_t WS_Q = 224 * MiB;
constexpr size_t WS_ACT = 224 * MiB;
constexpr size_t WS_UPD = 384 * MiB;
constexpr size_t WS_MIXIN = 448 * MiB;
constexpr size_t WS_END = 512 * MiB;

__host__ __device__ __forceinline__ int key_of_slot(int p) { const int e = p & 7; return (p & ~15) + (e & 3) + 8 * (e >> 2) + 4 * ((p >> 3) & 1); }
__host__ __device__ __forceinline__ int slot_of_key(int k) { const int w = k & 15; return (k & ~15) + 8 * ((w >> 2) & 1) + (w & 3) + 4 * (w >> 3); }

__device__ __forceinline__ float bf2f(bf16_t b) { return __uint_as_float(((unsigned)b) << 16); }
__device__ __forceinline__ bf16_t f2bf(float f) { unsigned u = __float_as_uint(f); return (bf16_t)((u + 0x7fffu + ((u >> 16) & 1u)) >> 16); }
__device__ __forceinline__ float ldf(const float* p) { return *p; }
__device__ __forceinline__ float ldf(const bf16_t* p) { return bf2f(*p); }
__device__ __forceinline__ float sigmoidf_(float x) { return 1.f / (1.f + __expf(-x)); }
__device__ __forceinline__ float siluf_(float x) { return x / (1.f + __expf(-x)); }
__device__ __forceinline__ float wave_sum(float v) {
#pragma unroll
    for (int o = 1; o < 64; o <<= 1) v += __shfl_xor(v, o);
    return v;
}
__device__ __forceinline__ float wave_max(float v) {
#pragma unroll
    for (int o = 1; o < 64; o <<= 1) v = fmaxf(v, __shfl_xor(v, o));
    return v;
}

__global__ void __launch_bounds__(256) n_ln(const float* in, float* outf, bf16_t* outb, const float* g, const float* b, int rows) {
    const int lane = threadIdx.x & 63, row = blockIdx.x * 4 + (threadIdx.x >> 6);
    if (row >= rows) return;
    const f32x4* xr = (const f32x4*)(in + (size_t)row * D) + lane;
    f32x4 v[4]; float s = 0.f;
#pragma unroll
    for (int j = 0; j < 4; ++j) { v[j] = xr[64 * j]; s += (v[j].x + v[j].y) + (v[j].z + v[j].w); }
    const float mean = wave_sum(s) * (1.f / D); float s2 = 0.f;
#pragma unroll
    for (int j = 0; j < 4; ++j) { v[j] = v[j] - mean; s2 += (v[j].x * v[j].x + v[j].y * v[j].y) + (v[j].z * v[j].z + v[j].w * v[j].w); }
    const float rstd = rsqrtf(wave_sum(s2) * (1.f / D) + LN_EPS);
#pragma unroll
    for (int j = 0; j < 4; ++j) {
        const int c = (64 * j + lane) * 4;
        const f32x4 gg = *(const f32x4*)(g + c), bb = *(const f32x4*)(b + c);
        f32x4 o = v[j] * rstd * gg + bb;
        *((f32x4*)(outf + (size_t)row * D) + 64 * j + lane) = o;
        bf16_t* ob = outb + (size_t)row * D + c;
        ob[0] = f2bf(o.x); ob[1] = f2bf(o.y); ob[2] = f2bf(o.z); ob[3] = f2bf(o.w);
    }
}
__global__ void n_memcvt(const float* mem, bf16_t* mb, bf16_t* mp) {
    const int i = blockIdx.x * 256 + threadIdx.x;
    const int row = i >> 10, c = i & 1023, b = row >> 8, key = row & 255;
    const bf16_t v = f2bf(mem[i]);
    mb[i] = v; mp[(size_t)(b * 256 + slot_of_key(key)) * 1024 + c] = v;
}
template <int MODE, typename TA>
__global__ void __launch_bounds__(256) n_gemm(const TA* A, int lda, const float* W, int ldw, int col0, void* Cv, int ldc, int N, int K, int ucol) {
    __shared__ float As[16][68], Bs[16][64], Bu[MODE == 2 ? 16 : 1][64];
    const int tid = threadIdx.x, tx = tid & 15, ty = tid >> 4, m0 = blockIdx.y * 64, n0 = blockIdx.x * 64;
    float acc[4][4] = {}, acu[4][4] = {};
    for (int k0 = 0; k0 < K; k0 += 16) {
        { const int r = tid >> 2, k4 = (tid & 3) * 4;
#pragma unroll
          for (int i = 0; i < 4; ++i) As[k4 + i][r] = ldf(A + (size_t)(m0 + r) * lda + k0 + k4 + i); }
        { const int k = tid >> 4, n4 = (tid & 15) * 4;
#pragma unroll
          for (int i = 0; i < 4; ++i) { const int n = n0 + n4 + i; Bs[k][n4 + i] = n < N ? W[(size_t)(k0 + k) * ldw + col0 + n] : 0.f;
              if (MODE == 2) Bu[k][n4 + i] = n < N ? W[(size_t)(k0 + k) * ldw + col0 + ucol + n] : 0.f; } }
        __syncthreads();
#pragma unroll
        for (int kk = 0; kk < 16; ++kk) {
            float a[4], b[4], u[4];
#pragma unroll
            for (int i = 0; i < 4; ++i) { a[i] = As[kk][ty * 4 + i]; b[i] = Bs[kk][tx * 4 + i]; if (MODE == 2) u[i] = Bu[kk][tx * 4 + i]; }
#pragma unroll
            for (int i = 0; i < 4; ++i)
#pragma unroll
                for (int j = 0; j < 4; ++j) { acc[i][j] += a[i] * b[j]; if (MODE == 2) acu[i][j] += a[i] * u[j]; }
        }
        __syncthreads();
    }
#pragma unroll
    for (int i = 0; i < 4; ++i)
#pragma unroll
        for (int j = 0; j < 4; ++j) {
            const int row = m0 + ty * 4 + i, col = n0 + tx * 4 + j;
            if (col >= N) continue;
            if (MODE == 0) ((bf16_t*)Cv)[(size_t)row * ldc + col] = f2bf(acc[i][j]);
            else if (MODE == 1) { float* p = (float*)Cv + (size_t)row * ldc + col; *p = ALPHA * *p + acc[i][j]; }
            else if (MODE == 2) ((bf16_t*)Cv)[(size_t)row * ldc + col] = f2bf(siluf_(acc[i][j]) * acu[i][j]);
            else ((bf16_t*)Cv)[(size_t)col * ldc + row] = f2bf(acc[i][j]);
        }
}
__global__ void __launch_bounds__(512) n_conv(const bf16_t* PROJ, const float* cw, const float* cb, const float* lg, const float* lb, bf16_t* MIXIN) {
    __shared__ float red[16];
    const int row = blockIdx.x, t = row % SEQ, c = threadIdx.x, lane = c & 63, w = c >> 6;
    float acc = cb[c];
    for (int k = 0; k < 31; ++k) { const int tt = t - 30 + k; if (tt < 0) continue;
        const bf16_t* pr = PROJ + (size_t)(row - 30 + k) * PROJ_LD;
        acc += cw[k * 512 + c] * bf2f(pr[C_CA + c]) * sigmoidf_(bf2f(pr[C_CG + c])); }
    float s = wave_sum(acc); if (lane == 0) red[w] = s; __syncthreads();
    float mean = 0.f; for (int i = 0; i < 8; ++i) mean += red[i]; mean *= (1.f / 512.f);
    const float dlt = acc - mean; float q = wave_sum(dlt * dlt); if (lane == 0) red[8 + w] = q; __syncthreads();
    float var = 0.f; for (int i = 0; i < 8; ++i) var += red[8 + i]; var *= (1.f / 512.f);
    const float y = dlt * rsqrtf(var + LN_EPS) * lg[c] + lb[c];
    MIXIN[(size_t)row * D + c] = f2bf(siluf_(y));
}
__global__ void __launch_bounds__(128) n_gla(const bf16_t* PROJ, const bf16_t* ALOW, const float* wa2, const float* ba, float* OG) {
    __shared__ float sa[64], sq[64], sk[64];
    const int bh = blockIdx.x, b = bh >> 2, h = bh & 3, e = threadIdx.x;
    float S[64];
#pragma unroll
    for (int d = 0; d < 64; ++d) S[d] = 0.f;
    float wcol[16]; float bcol = 0.f;
    if (e < 64) { bcol = ba[h * 64 + e];
#pragma unroll
        for (int i = 0; i < 16; ++i) wcol[i] = wa2[i * 256 + h * 64 + e]; }
    else {
#pragma unroll
        for (int i = 0; i < 16; ++i) wcol[i] = 0.f; }
    for (int t = 0; t < SEQ; ++t) {
        const size_t row = (size_t)b * SEQ + t; const bf16_t* pr = PROJ + row * PROJ_LD;
        if (e < 64) { float z = bcol;
#pragma unroll
            for (int i = 0; i < 16; ++i) z += bf2f(ALOW[row * 16 + i]) * wcol[i];
            const float ls = fminf(z, 0.f) - log1pf(__expf(-fabsf(z)));
            sa[e] = __expf(ls * (1.f / 16.f)); sq[e] = bf2f(pr[C_Q + h * 64 + e]); sk[e] = bf2f(pr[C_K + h * 64 + e]); }
        __syncthreads();
        const float v = bf2f(pr[C_V + h * 128 + e]); float o = 0.f;
#pragma unroll
        for (int d = 0; d < 64; ++d) { S[d] = sa[d] * S[d] + sk[d] * v; o += sq[d] * S[d]; }
        OG[row * 512 + h * 128 + e] = o * 0.125f;
        __syncthreads();
    }
}
__global__ void __launch_bounds__(512) n_glanorm(const float* OG, const bf16_t* PROJ, const float* g, bf16_t* MIXIN) {
    __shared__ float red[8];
    const int row = blockIdx.x, c = threadIdx.x, lane = c & 63, w = c >> 6, h = c >> 7, e = c & 127;
    const float o = OG[(size_t)row * 512 + c];
    const float s = wave_sum(o * o); if (lane == 0) red[w] = s; __syncthreads();
    const float ms = (red[2 * h] + red[2 * h + 1]) * (1.f / 128.f);
    const float r = bf2f(PROJ[(size_t)row * PROJ_LD + C_R + c]);
    MIXIN[(size_t)row * D + 512 + c] = f2bf(o * rsqrtf(ms + LN_EPS) * g[e] * siluf_(r));
}
__global__ void __launch_bounds__(256) n_attn(bf16_t* Q, const bf16_t* Kb, const bf16_t* Vt) {
    __shared__ float sq[1024], sp[256], red[8];
    const int row = blockIdx.x, b = row / SEQ, tid = threadIdx.x, lane = tid & 63, w = tid >> 6;
    for (int i = tid; i < 1024; i += 256) sq[i] = bf2f(Q[(size_t)row * D + i]);
    __syncthreads();
    for (int h = 0; h < 4; ++h) {
        const bf16_t* kr = Kb + (size_t)(b * 256 + tid) * 1024 + h * 256; float s = 0.f;
        for (int d = 0; d < 256; ++d) s += sq[h * 256 + d] * bf2f(kr[d]);
        s *= (1.f / 16.f);
        float mx = wave_max(s); if (lane == 0) red[w] = mx; __syncthreads();
        mx = fmaxf(fmaxf(red[0], red[1]), fmaxf(red[2], red[3]));
        const float ex = __expf(s - mx); float sm = wave_sum(ex); if (lane == 0) red[4 + w] = sm; __syncthreads();
        sm = (red[4] + red[5]) + (red[6] + red[7]);
        sp[tid] = ex / sm; __syncthreads();
        const bf16_t* vr = Vt + (size_t)(h * 256 + tid) * 1024 + b * 256; float o = 0.f;
        for (int p = 0; p < 256; ++p) o += sp[key_of_slot(p)] * bf2f(vr[p]);
        Q[(size_t)row * D + h * 256 + tid] = f2bf(o);
        __syncthreads();
    }
}

extern "C" void kernel_launch(void* const* d_in, const int* in_sizes, int n_in, void* d_out, int out_size, void* d_ws, size_t ws_size, hipStream_t stream) {
    if (n_in != 24 || out_size != M * D || ws_size < WS_END) { fprintf(stderr, "kernel_launch: unexpected shapes (n_in %d out %d ws %zu)\n", n_in, out_size, ws_size); return; }
    const float* x = (const float*)d_in[0]; const float* mem = (const float*)d_in[1];
    const float* ln0_g = (const float*)d_in[2]; const float* ln0_b = (const float*)d_in[3];
    const float* w_in = (const float*)d_in[4]; const float* w_a2 = (const float*)d_in[5]; const float* b_a = (const float*)d_in[6];
    const float* conv_w = (const float*)d_in[7]; const float* conv_b = (const float*)d_in[8];
    const float* conv_ln_g = (const float*)d_in[9]; const float* conv_ln_b = (const float*)d_in[10];
    const float* gla_norm_g = (const float*)d_in[11]; const float* w_mix_out = (const float*)d_in[12];
    const float* ln1_g = (const float*)d_in[13]; const float* ln1_b = (const float*)d_in[14];
    const float* w_xq = (const float*)d_in[15]; const float* w_xkv = (const float*)d_in[16]; const float* w_xo = (const float*)d_in[17];
    const float* ln2_g = (const float*)d_in[18]; const float* ln2_b = (const float*)d_in[19];
    const float* w_ffn_in = (const float*)d_in[20]; const float* w_ffn_out = (const float*)d_in[21];
    const float* ln3_g = (const float*)d_in[22]; const float* ln3_b = (const float*)d_in[23];
    unsigned char* ws = (unsigned char*)d_ws;
    float* HF = (float*)d_out;
    bf16_t* HB = (bf16_t*)(ws + WS_HB); bf16_t* PROJ = (bf16_t*)(ws + WS_PROJ); bf16_t* ALOW = (bf16_t*)(ws + WS_ALOW);
    bf16_t* MIXIN = (bf16_t*)(ws + WS_MIXIN); bf16_t* Qb = (bf16_t*)(ws + WS_Q); bf16_t* ACT = (bf16_t*)(ws + WS_ACT);
    bf16_t* Kb = (bf16_t*)(ws + WS_K); bf16_t* Vt = (bf16_t*)(ws + WS_VT); bf16_t* MEMB = (bf16_t*)(ws + WS_MEMB); bf16_t* MEMP = (bf16_t*)(ws + WS_MEMP);
    float* OG = (float*)(ws + WS_UPD);

    n_ln<<<M / 4, 256, 0, stream>>>(x, HF, HB, ln0_g, ln0_b, M);
    n_memcvt<<<4096, 256, 0, stream>>>(mem, MEMB, MEMP);
    for (int l = 0; l < DEPTH; ++l) {
        n_gemm<0, bf16_t><<<dim3(16, 16), 256, 0, stream>>>(MEMB, 1024, w_xkv + (size_t)l * 1024 * 2048, 2048, 0, Kb + (size_t)l * 1024 * 1024, 1024, 1024, 1024, 0);
        n_gemm<3, bf16_t><<<dim3(16, 16), 256, 0, stream>>>(MEMP, 1024, w_xkv + (size_t)l * 1024 * 2048, 2048, 1024, Vt + (size_t)l * 1024 * 1024, 1024, 1024, 1024, 0);
    }
    for (int l = 0; l < DEPTH; ++l) {
        const float* wl = w_in + (size_t)l * 1024 * IN_COLS;
        n_gemm<0, bf16_t><<<dim3(PROJ_LD / 64, M / 64), 256, 0, stream>>>(HB, D, wl, IN_COLS, 0, PROJ, PROJ_LD, PROJ_LD, D, 0);
        n_gemm<0, bf16_t><<<dim3(1, M / 64), 256, 0, stream>>>(HB, D, wl, IN_COLS, C_AL, ALOW, 16, 16, D, 0);
        n_conv<<<M, 512, 0, stream>>>(PROJ, conv_w + l * 31 * 512, conv_b + l * 512, conv_ln_g + l * 512, conv_ln_b + l * 512, MIXIN);
        n_gla<<<16, 128, 0, stream>>>(PROJ, ALOW, w_a2 + l * 16 * 256, b_a + l * 256, OG);
        n_glanorm<<<M, 512, 0, stream>>>(OG, PROJ, gla_norm_g + l * 128, MIXIN);
        n_gemm<1, bf16_t><<<dim3(D / 64, M / 64), 256, 0, stream>>>(MIXIN, D, w_mix_out + (size_t)l * D * D, D, 0, HF, D, D, D, 0);
        n_ln<<<M / 4, 256, 0, stream>>>(HF, HF, HB, ln1_g + l * D, ln1_b + l * D, M);
        n_gemm<0, bf16_t><<<dim3(D / 64, M / 64), 256, 0, stream>>>(HB, D, w_xq + (size_t)l * D * D, D, 0, Qb, D, D, D, 0);
        n_attn<<<M, 256, 0, stream>>>(Qb, Kb + (size_t)l * 1024 * 1024, Vt + (size_t)l * 1024 * 1024);
        n_gemm<1, bf16_t><<<dim3(D / 64, M / 64), 256, 0, stream>>>(Qb, D, w_xo + (size_t)l * D * D, D, 0, HF, D, D, D, 0);
        n_ln<<<M / 4, 256, 0, stream>>>(HF, HF, HB, ln2_g + l * D, ln2_b + l * D, M);
        n_gemm<2, bf16_t><<<dim3(D_FF / 64, M / 64), 256, 0, stream>>>(HB, D, w_ffn_in + (size_t)l * D * 2 * D_FF, 2 * D_FF, 0, ACT, D_FF, D_FF, D, D_FF);
        n_gemm<1, bf16_t><<<dim3(D / 64, M / 64), 256, 0, stream>>>(ACT, D_FF, w_ffn_out + (size_t)l * D_FF * D, D, 0, HF, D, D, D_FF, 0);
        n_ln<<<M / 4, 256, 0, stream>>>(HF, HF, HB, ln3_g + l * D, ln3_b + l * D, M);
    }
}
```

```cpp
#include <hip/hip_runtime.h>
#include <hip/hip_cooperative_groups.h>
#include <cstdio>
#include <cstdint>

typedef unsigned short bf16_t;
typedef unsigned u32x4 __attribute__((ext_vector_type(4)));
typedef float f32x4 __attribute__((ext_vector_type(4)));

constexpr int D = 1024, BATCH = 4, SEQ = 8192, DEPTH = 4, M = BATCH * SEQ;
constexpr int IN_COLS = 2576, PROJ_LD = 2560, MEM_LEN = 256, D_FF = 2816;
constexpr int C_CA = 0, C_CG = 512, C_Q = 1024, C_K = 1280, C_V = 1536, C_R = 2048, C_AL = 2560;
constexpr float LN_EPS = 1e-5f;
constexpr float ALPHA = 1.681792830507429f;

constexpr size_t MiB = 1u << 20;
constexpr size_t WS_CTL = 0;
constexpr size_t WS_K = 8 * MiB;
constexpr size_t WS_VT = 16 * MiB;
constexpr size_t WS_MEMB = 24 * MiB;
constexpr size_t WS_MEMP = 26 * MiB;
constexpr size_t WS_ALOW = 28 * MiB;
constexpr size_t WS_DEC = 29 * MiB;
constexpr size_t WS_WT = 32 * MiB;
constexpr size_t WS_HB = 160 * MiB;
constexpr size_t WS_PROJ = 224 * MiB;
constexpr size_t WS_Q = 224 * MiB;
constexpr size_t WS_ACT = 224 * MiB;
constexpr size_t WS_UPD = 384 * MiB;
constexpr size_t WS_MIXIN = 448 * MiB;
constexpr size_t WS_END = 512 * MiB;

__host__ __device__ __forceinline__ int key_of_slot(int p) { const int e = p & 7, kg = (p >> 3) & 3; return (p & ~31) + 16 * (e >> 2) + 4 * kg + (e & 3); }
__host__ __device__ __forceinline__ int slot_of_key(int k) { const int w = k & 31; return (k & ~31) + 8 * ((w >> 2) & 3) + 4 * (w >> 4) + (w & 3); }

__device__ __forceinline__ float bf2f(bf16_t b) { return __uint_as_float(((unsigned)b) << 16); }
__device__ __forceinline__ bf16_t f2bf(float f) { unsigned u = __float_as_uint(f); return (bf16_t)((u + 0x7fffu + ((u >> 16) & 1u)) >> 16); }
__device__ __forceinline__ float ldf(const float* p) { return *p; }
__device__ __forceinline__ float ldf(const bf16_t* p) { return bf2f(*p); }
__device__ __forceinline__ float sigmoidf_(float x) { return 1.f / (1.f + __expf(-x)); }
__device__ __forceinline__ float siluf_(float x) { return x / (1.f + __expf(-x)); }
__device__ __forceinline__ float wave_sum(float v) {
#pragma unroll
    for (int o = 1; o < 64; o <<= 1) v += __shfl_xor(v, o);
    return v;
}
__device__ __forceinline__ float wave_max(float v) {
#pragma unroll
    for (int o = 1; o < 64; o <<= 1) v = fmaxf(v, __shfl_xor(v, o));
    return v;
}

__global__ void __launch_bounds__(256) n_ln(const float* in, float* outf, bf16_t* outb, const float* g, const float* b, int rows) {
    const int lane = threadIdx.x & 63, row = blockIdx.x * 4 + (threadIdx.x >> 6);
    if (row >= rows) return;
    const f32x4* xr = (const f32x4*)(in + (size_t)row * D) + lane;
    f32x4 v[4]; float s = 0.f;
#pragma unroll
    for (int j = 0; j < 4; ++j) { v[j] = xr[64 * j]; s += (v[j].x + v[j].y) + (v[j].z + v[j].w); }
    const float mean = wave_sum(s) * (1.f / D); float s2 = 0.f;
#pragma unroll
    for (int j = 0; j < 4; ++j) { v[j] = v[j] - mean; s2 += (v[j].x * v[j].x + v[j].y * v[j].y) + (v[j].z * v[j].z + v[j].w * v[j].w); }
    const float rstd = rsqrtf(wave_sum(s2) * (1.f / D) + LN_EPS);
#pragma unroll
    for (int j = 0; j < 4; ++j) {
        const int c = (64 * j + lane) * 4;
        const f32x4 gg = *(const f32x4*)(g + c), bb = *(const f32x4*)(b + c);
        f32x4 o = v[j] * rstd * gg + bb;
        *((f32x4*)(outf + (size_t)row * D) + 64 * j + lane) = o;
        bf16_t* ob = outb + (size_t)row * D + c;
        ob[0] = f2bf(o.x); ob[1] = f2bf(o.y); ob[2] = f2bf(o.z); ob[3] = f2bf(o.w);
    }
}
__global__ void n_memcvt(const float* mem, bf16_t* mb, bf16_t* mp) {
    const int i = blockIdx.x * 256 + threadIdx.x;
    const int row = i >> 10, c = i & 1023, b = row >> 8, key = row & 255;
    const bf16_t v = f2bf(mem[i]);
    mb[i] = v; mp[(size_t)(b * 256 + slot_of_key(key)) * 1024 + c] = v;
}
template <int MODE, typename TA>
__global__ void __launch_bounds__(256) n_gemm(const TA* A, int lda, const float* W, int ldw, int col0, void* Cv, int ldc, int N, int K, int ucol) {
    __shared__ float As[16][68], Bs[16][64], Bu[MODE == 2 ? 16 : 1][64];
    const int tid = threadIdx.x, tx = tid & 15, ty = tid >> 4, m0 = blockIdx.y * 64, n0 = blockIdx.x * 64;
    float acc[4][4] = {}, acu[4][4] = {};
    for (int k0 = 0; k0 < K; k0 += 16) {
        { const int r = tid >> 2, k4 = (tid & 3) * 4;
#pragma unroll
          for (int i = 0; i < 4; ++i) As[k4 + i][r] = ldf(A + (size_t)(m0 + r) * lda + k0 + k4 + i); }
        { const int k = tid >> 4, n4 = (tid & 15) * 4;
#pragma unroll
          for (int i = 0; i < 4; ++i) { const int n = n0 + n4 + i; Bs[k][n4 + i] = n < N ? W[(size_t)(k0 + k) * ldw + col0 + n] : 0.f;
              if (MODE == 2) Bu[k][n4 + i] = n < N ? W[(size_t)(k0 + k) * ldw + col0 + ucol + n] : 0.f; } }
        __syncthreads();
#pragma unroll
        for (int kk = 0; kk < 16; ++kk) {
            float a[4], b[4], u[4];
#pragma unroll
            for (int i = 0; i < 4; ++i) { a[i] = As[kk][ty * 4 + i]; b[i] = Bs[kk][tx * 4 + i]; if (MODE == 2) u[i] = Bu[kk][tx * 4 + i]; }
#pragma unroll
            for (int i = 0; i < 4; ++i)
#pragma unroll
                for (int j = 0; j < 4; ++j) { acc[i][j] += a[i] * b[j]; if (MODE == 2) acu[i][j] += a[i] * u[j]; }
        }
        __syncthreads();
    }
#pragma unroll
    for (int i = 0; i < 4; ++i)
#pragma unroll
        for (int j = 0; j < 4; ++j) {
            const int row = m0 + ty * 4 + i, col = n0 + tx * 4 + j;
            if (col >= N) continue;
            if (MODE == 0) ((bf16_t*)Cv)[(size_t)row * ldc + col] = f2bf(acc[i][j]);
            else if (MODE == 1) { float* p = (float*)Cv + (size_t)row * ldc + col; *p = ALPHA * *p + acc[i][j]; }
            else if (MODE == 2) ((bf16_t*)Cv)[(size_t)row * ldc + col] = f2bf(siluf_(acc[i][j]) * acu[i][j]);
            else ((bf16_t*)Cv)[(size_t)col * ldc + row] = f2bf(acc[i][j]);
        }
}
__global__ void __launch_bounds__(512) n_conv(const bf16_t* PROJ, const float* cw, const float* cb, const float* lg, const float* lb, bf16_t* MIXIN) {
    __shared__ float red[16];
    const int row = blockIdx.x, t = row % SEQ, c = threadIdx.x, lane = c & 63, w = c >> 6;
    float acc = cb[c];
    for (int k = 0; k < 31; ++k) { const int tt = t - 30 + k; if (tt < 0) continue;
        const bf16_t* pr = PROJ + (size_t)(row - 30 + k) * PROJ_LD;
        acc += cw[k * 512 + c] * bf2f(pr[C_CA + c]) * sigmoidf_(bf2f(pr[C_CG + c])); }
    float s = wave_sum(acc); if (lane == 0) red[w] = s; __syncthreads();
    float mean = 0.f; for (int i = 0; i < 8; ++i) mean += red[i]; mean *= (1.f / 512.f);
    const float dlt = acc - mean; float q = wave_sum(dlt * dlt); if (lane == 0) red[8 + w] = q; __syncthreads();
    float var = 0.f; for (int i = 0; i < 8; ++i) var += red[8 + i]; var *= (1.f / 512.f);
    const float y = dlt * rsqrtf(var + LN_EPS) * lg[c] + lb[c];
    MIXIN[(size_t)row * D + c] = f2bf(siluf_(y));
}
__global__ void __launch_bounds__(128) n_gla(const bf16_t* PROJ, const bf16_t* ALOW, const float* wa2, const float* ba, float* OG) {
    __shared__ float sa[64], sq[64], sk[64];
    const int bh = blockIdx.x, b = bh >> 2, h = bh & 3, e = threadIdx.x;
    float S[64];
#pragma unroll
    for (int d = 0; d < 64; ++d) S[d] = 0.f;
    float wcol[16]; float bcol = 0.f;
    if (e < 64) { bcol = ba[h * 64 + e];
#pragma unroll
        for (int i = 0; i < 16; ++i) wcol[i] = wa2[i * 256 + h * 64 + e]; }
    else {
#pragma unroll
        for (int i = 0; i < 16; ++i) wcol[i] = 0.f; }
    for (int t = 0; t < SEQ; ++t) {
        const size_t row = (size_t)b * SEQ + t; const bf16_t* pr = PROJ + row * PROJ_LD;
        if (e < 64) { float z = bcol;
#pragma unroll
            for (int i = 0; i < 16; ++i) z += bf2f(ALOW[row * 16 + i]) * wcol[i];
            const float ls = fminf(z, 0.f) - log1pf(__expf(-fabsf(z)));
            sa[e] = __expf(ls * (1.f / 16.f)); sq[e] = bf2f(pr[C_Q + h * 64 + e]); sk[e] = bf2f(pr[C_K + h * 64 + e]); }
        __syncthreads();
        const float v = bf2f(pr[C_V + h * 128 + e]); float o = 0.f;
#pragma unroll
        for (int d = 0; d < 64; ++d) { S[d] = sa[d] * S[d] + sk[d] * v; o += sq[d] * S[d]; }
        OG[row * 512 + h * 128 + e] = o * 0.125f;
        __syncthreads();
    }
}
__global__ void __launch_bounds__(512) n_glanorm(const float* OG, const bf16_t* PROJ, const float* g, bf16_t* MIXIN) {
    __shared__ float red[8];
    const int row = blockIdx.x, c = threadIdx.x, lane = c & 63, w = c >> 6, h = c >> 7, e = c & 127;
    const float o = OG[(size_t)row * 512 + c];
    const float s = wave_sum(o * o); if (lane == 0) red[w] = s; __syncthreads();
    const float ms = (red[2 * h] + red[2 * h + 1]) * (1.f / 128.f);
    const float r = bf2f(PROJ[(size_t)row * PROJ_LD + C_R + c]);
    MIXIN[(size_t)row * D + 512 + c] = f2bf(o * rsqrtf(ms + LN_EPS) * g[e] * siluf_(r));
}
__global__ void __launch_bounds__(256) n_attn(bf16_t* Q, const bf16_t* Kb, int kld, const bf16_t* Vt) {
    __shared__ float sq[1024], sp[256], red[8];
    const int row = blockIdx.x, b = row / SEQ, tid = threadIdx.x, lane = tid & 63, w = tid >> 6;
    for (int i = tid; i < 1024; i += 256) sq[i] = bf2f(Q[(size_t)row * D + i]);
    __syncthreads();
    for (int h = 0; h < 4; ++h) {
        const bf16_t* kr = Kb + (size_t)(b * 256 + tid) * kld + h * 256; float s = 0.f;
        for (int d = 0; d < 256; ++d) s += sq[h * 256 + d] * bf2f(kr[d]);
        s *= (1.f / 16.f);
        float mx = wave_max(s); if (lane == 0) red[w] = mx; __syncthreads();
        mx = fmaxf(fmaxf(red[0], red[1]), fmaxf(red[2], red[3]));
        const float ex = __expf(s - mx); float sm = wave_sum(ex); if (lane == 0) red[4 + w] = sm; __syncthreads();
        sm = (red[4] + red[5]) + (red[6] + red[7]);
        sp[tid] = ex / sm; __syncthreads();
        const bf16_t* vr = Vt + (size_t)(h * 256 + tid) * 1024 + b * 256; float o = 0.f;
        for (int p = 0; p < 256; ++p) o += sp[key_of_slot(p)] * bf2f(vr[p]);
        Q[(size_t)row * D + h * 256 + tid] = f2bf(o);
        __syncthreads();
    }
}

namespace pg8 {
#define PG8_LAS __attribute__((address_space(3)))
typedef unsigned short bf16_t;
typedef short bf16x8 __attribute__((ext_vector_type(8)));
typedef float f32x4 __attribute__((ext_vector_type(4)));
typedef unsigned u32x4 __attribute__((ext_vector_type(4)));
constexpr int BM = 256, BK = 64, HALF = 128, HTB = HALF * BK * 2  , STAGE_BYTES = 8 * HTB, NXCD = 8, WGM = 8;

__host__ __device__ __forceinline__ int lds_byte(int r, int c) { const int st = (r >> 4) * 2 + (c >> 5), rr = r & 15, cc = c & 31, ob = rr * 64 + cc * 2; return st * 1024 + (ob ^ (((ob >> 9) & 1) << 5)); }
__host__ __device__ __forceinline__ void stage_rc(int b, int& R, int& C) { const int st = b / 1024, sb = b % 1024, swz = sb ^ (((sb >> 9) & 1) << 5); R = (st >> 1) * 16 + swz / 64; C = (st & 1) * 32 + (swz % 64) / 2; }
__host__ __device__ __forceinline__ int perm32(int rho) { const int n = rho >> 4, i = rho & 15; return 8 * (i >> 2) + 4 * n + (i & 3); }

struct Unit { int pm, pn; };
struct Gemm { const bf16_t* A; const bf16_t* Bt; int M, N, K; };

struct StaticOrder {
    int nM, nN, nwg, G, c;
    __host__ __device__ void init(int M, int N, int G_, int c_) { nM = M / BM; nN = N / BM; nwg = nM * nN; G = G_; c = c_; }
    __host__ __device__ bool next(int i, Unit& u) const {
        const long L = (long)i * G + c; if (L >= nwg) return false;
        int wgid = (int)L; { const int q = nwg / NXCD, r = nwg % NXCD, xcd = wgid % NXCD, off = wgid / NXCD; wgid = (xcd < r ? xcd * (q + 1) : r * (q + 1) + (xcd - r) * q) + off; }
        const int nig = WGM * nN, gid = wgid / nig, fm = gid * WGM, gsz = (nM - fm) < WGM ? (nM - fm) : WGM;
        u.pm = fm + ((wgid % nig) % gsz); u.pn = (wgid % nig) / gsz; return true;
    }
    __device__ __forceinline__ void a_ready(const Unit&) const {}
    __device__ __forceinline__ void done(const Unit&) const {}
};


template <int MM, int NN> struct StaticOrderT {
    static constexpr int nM = MM / BM, nN = NN / BM, nwg = nM * nN;
    int G, c;
    __host__ __device__ void init(int G_, int c_) { G = G_; c = c_; }
    __host__ __device__ bool next(int i, Unit& u) const {
        const long L = (long)i * G + c; if (L >= nwg) return false;
        int wgid = (int)L; { constexpr int q = nwg / NXCD, r = nwg % NXCD; const int xcd = wgid % NXCD, off = wgid / NXCD; wgid = (xcd < r ? xcd * (q + 1) : r * (q + 1) + (xcd - r) * q) + off; }
        constexpr int nig = WGM * nN; const int gid = wgid / nig, fm = gid * WGM, gsz = (nM - fm) < WGM ? (nM - fm) : WGM;
        u.pm = fm + ((wgid % nig) % gsz); u.pn = (wgid % nig) / gsz; return true;
    }
    __device__ __forceinline__ void a_ready(const Unit&) const {}
    __device__ __forceinline__ void done(const Unit&) const {}
};
__device__ __forceinline__ unsigned cvt_pk_bf16(float lo, float hi) { unsigned r; asm volatile("v_cvt_pk_bf16_f32 %0, %1, %2" : "=v"(r) : "v"(lo), "v"(hi)); return r; }
__device__ __forceinline__ u32x4 pack8(const f32x4 v0, const f32x4 v1) { u32x4 w; w.x = cvt_pk_bf16(v0[0], v0[1]); w.y = cvt_pk_bf16(v0[2], v0[3]); w.z = cvt_pk_bf16(v1[0], v1[1]); w.w = cvt_pk_bf16(v1[2], v1[3]); return w; }
__device__ __forceinline__ float silu_fast(float x) { return x * __builtin_amdgcn_rcpf(1.f + __expf(-x)); }
struct EpiBf16 {
    static constexpr bool PERM = true, AFTER_DRAIN = false;
    bf16_t* O; int ldc;
    __device__ __forceinline__ void operator()(const f32x4 (&acc)[2][2][4][2], const Unit& u, int wr, int wc, int fr, int fq) const {
        const int row0 = u.pm * BM + wr * 64 + fr, col0 = u.pn * BM + wc * 32 + 8 * fq;
#pragma unroll
        for (int ai = 0; ai < 2; ++ai)
#pragma unroll
            for (int m = 0; m < 4; ++m) { bf16_t* rowp = O + (size_t)(row0 + ai * HALF + m * 16) * ldc + col0;
#pragma unroll
                for (int bj = 0; bj < 2; ++bj) *(u32x4*)(rowp + bj * HALF) = pack8(acc[ai][bj][m][0], acc[ai][bj][m][1]); }
    }
};
struct EpiProj {
    static constexpr bool PERM = true, AFTER_DRAIN = false;
    bf16_t* O; bf16_t* AL;
    __device__ __forceinline__ void operator()(const f32x4 (&acc)[2][2][4][2], const Unit& u, int wr, int wc, int fr, int fq) const {
        const int row0 = u.pm * BM + wr * 64 + fr, col0 = u.pn * BM + wc * 32 + 8 * fq;
        if (u.pn < 10) {
#pragma unroll
            for (int ai = 0; ai < 2; ++ai)
#pragma unroll
                for (int m = 0; m < 4; ++m) { bf16_t* rowp = O + (size_t)(row0 + ai * HALF + m * 16) * 2560 + col0;
#pragma unroll
                    for (int bj = 0; bj < 2; ++bj) *(u32x4*)(rowp + bj * HALF) = pack8(acc[ai][bj][m][0], acc[ai][bj][m][1]); }
        } else if (wc == 0 && fq < 2) {
#pragma unroll
            for (int ai = 0; ai < 2; ++ai)
#pragma unroll
                for (int m = 0; m < 4; ++m) *(u32x4*)(AL + (size_t)(row0 + ai * HALF + m * 16) * 16 + 8 * fq) = pack8(acc[ai][0][m][0], acc[ai][0][m][1]);
        }
    }
};
struct EpiRes {
    static constexpr bool PERM = false, AFTER_DRAIN = false;
    float* HF; float alpha; static constexpr int ldc = 1024;
    __device__ __forceinline__ void operator()(const f32x4 (&acc)[2][2][4][2], const Unit& u, int wr, int wc, int fr, int fq) const {
        const int row0 = u.pm * BM + wr * 64 + fr, col0 = u.pn * BM + wc * 32 + 4 * fq;
#pragma unroll
        for (int ai = 0; ai < 2; ++ai)
#pragma unroll
            for (int m = 0; m < 4; ++m) { float* rowp = HF + (size_t)(row0 + ai * HALF + m * 16) * ldc + col0;
#pragma unroll
                for (int bj = 0; bj < 2; ++bj)
#pragma unroll
                    for (int n = 0; n < 2; ++n) { f32x4* p = (f32x4*)(rowp + bj * HALF + n * 16); const f32x4 h = *p; *p = h * alpha + acc[ai][bj][m][n]; } }
    }
};
struct EpiSwiglu {
    static constexpr bool PERM = true, AFTER_DRAIN = false;
    bf16_t* O; static constexpr int ldc = 2816;
    __device__ __forceinline__ void operator()(const f32x4 (&acc)[2][2][4][2], const Unit& u, int wr, int wc, int fr, int fq) const {
        const int row0 = u.pm * BM + wr * 64 + fr, col0 = u.pn * HALF + wc * 32 + 8 * fq;
#pragma unroll
        for (int ai = 0; ai < 2; ++ai)
#pragma unroll
            for (int m = 0; m < 4; ++m) { f32x4 a0, a1;
#pragma unroll
                for (int j = 0; j < 4; ++j) { a0[j] = silu_fast(acc[ai][0][m][0][j]) * acc[ai][1][m][0][j]; a1[j] = silu_fast(acc[ai][0][m][1][j]) * acc[ai][1][m][1][j]; }
                *(u32x4*)(O + (size_t)(row0 + ai * HALF + m * 16) * ldc + col0) = pack8(a0, a1); }
    }
};

template <class Epi, class Sched, bool ALIGN_EPI, bool SP2, int KC>
__device__ __forceinline__ void gemm_phase(PG8_LAS unsigned char* lds, const Gemm g, const Sched& S, const Epi& E, const int tid) {
    const int wid = __builtin_amdgcn_readfirstlane(tid >> 6), lane = tid & 63, wr = wid >> 2, wc = wid & 3, fr = lane & 15, fq = lane >> 4;
    constexpr int K = KC, nt = K / BK;
    unsigned voffA[2], voffB[2];
#pragma unroll
    for (int i = 0; i < 2; ++i) { int R, C; stage_rc(tid * 16 + i * 8192, R, C); const int Rb = Epi::PERM ? ((R & ~31) + perm32(R & 31)) : R;
        voffA[i] = (unsigned)(R * K + C) * 2u; voffB[i] = (unsigned)(Rb * K + C) * 2u; }
    const size_t kstep = (size_t)(BK * 2);
    const size_t hstep = (size_t)HALF * K * 2;
    const size_t tstep = 2 * hstep;
    const unsigned ldsw = (unsigned)wid * 1024u;
    const int aoff = lds_byte(wr * 64 + fr, fq * 8), boff = lds_byte(wc * 32 + fr, fq * 8);
#define PG8_SA(b, h) (((b) * 2 + (h)) * HTB)
#define PG8_SB(b, h) ((4 + (b) * 2 + (h)) * HTB)
#define PG8_STAGE(bufoff, gbase, voff) do { _Pragma("unroll") for (int _i = 0; _i < 2; ++_i) \
        __builtin_amdgcn_global_load_lds((const unsigned*)((const char*)(gbase) + (voff)[_i]), (PG8_LAS unsigned*)(lds + (bufoff) + ldsw + _i * 8192), 16, 0, 0); } while (0)
#define PG8_LDA(dst, b, h) do { _Pragma("unroll") for (int m = 0; m < 4; ++m) _Pragma("unroll") for (int k = 0; k < 2; ++k) dst[m][k] = *(const PG8_LAS bf16x8*)(lds + PG8_SA(b, h) + aoff + m * 2048 + k * 1024); } while (0)
#define PG8_LDB(dst, b, h) do { _Pragma("unroll") for (int n = 0; n < 2; ++n) _Pragma("unroll") for (int k = 0; k < 2; ++k) dst[n][k] = *(const PG8_LAS bf16x8*)(lds + PG8_SB(b, h) + boff + n * 2048 + k * 1024); } while (0)
#define PG8_MMA(ai, bj, At, Bt) do { __builtin_amdgcn_s_setprio(1); _Pragma("unroll") for (int m = 0; m < 4; ++m) _Pragma("unroll") for (int n = 0; n < 2; ++n) _Pragma("unroll") for (int k = 0; k < 2; ++k) \
        acc[ai][bj][m][n] = __builtin_amdgcn_mfma_f32_16x16x32_bf16(Bt[n][k], At[m][k], acc[ai][bj][m][n], 0, 0, 0); __builtin_amdgcn_s_setprio(0); } while (0)
#define PG8_WAIT_V(n) asm volatile("s_waitcnt vmcnt(" #n ")" ::: "memory")
#define PG8_WAIT_L(n) asm volatile("s_waitcnt lgkmcnt(" #n ")" ::: "memory")
#define PG8_BAR __builtin_amdgcn_s_barrier()
#define PG8_SCHED __builtin_amdgcn_sched_barrier(0)
    Unit cur, nxt; int ui = 0;
    if (!S.next(0, cur)) return;
    f32x4 acc[2][2][4][2];
#pragma unroll
    for (int a = 0; a < 2; ++a)
#pragma unroll
        for (int b = 0; b < 2; ++b)
#pragma unroll
            for (int m = 0; m < 4; ++m)
#pragma unroll
                for (int n = 0; n < 2; ++n) acc[a][b][m][n] = (f32x4){0.f, 0.f, 0.f, 0.f};
    bf16x8 At[4][2], B0[2][2], B1[2][2];
    const char* cA = (const char*)g.A + (size_t)cur.pm * tstep; const char* cB = (const char*)g.Bt + (size_t)cur.pn * tstep;
    S.a_ready(cur);
    if constexpr (SP2) {
        PG8_STAGE(PG8_SB(0, 0), cB, voffB); PG8_STAGE(PG8_SB(0, 1), cB + hstep, voffB); PG8_STAGE(PG8_SA(0, 0), cA, voffA); PG8_STAGE(PG8_SA(0, 1), cA + hstep, voffA);
        if (wr == 1) PG8_BAR;
        PG8_WAIT_V(2); PG8_BAR;
        PG8_STAGE(PG8_SB(1, 0), cB + kstep, voffB); PG8_STAGE(PG8_SA(1, 0), cA + kstep, voffA); PG8_STAGE(PG8_SB(1, 1), cB + hstep + kstep, voffB);
        PG8_WAIT_V(6); PG8_BAR;
    } else {
        PG8_STAGE(PG8_SB(0, 0), cB, voffB); PG8_STAGE(PG8_SA(0, 0), cA, voffA); PG8_STAGE(PG8_SB(0, 1), cB + hstep, voffB); PG8_STAGE(PG8_SA(0, 1), cA + hstep, voffA);
        if (wr == 1) PG8_BAR;
        PG8_WAIT_V(4); PG8_BAR;
        PG8_STAGE(PG8_SB(1, 0), cB + kstep, voffB); PG8_STAGE(PG8_SA(1, 0), cA + kstep, voffA); PG8_STAGE(PG8_SB(1, 1), cB + hstep + kstep, voffB);
        PG8_WAIT_V(6); PG8_BAR;
    }
    for (;;) {
        const bool has_next = S.next(ui + 1, nxt);
        const char* nA = has_next ? (const char*)g.A + (size_t)nxt.pm * tstep : cA; const char* nB = has_next ? (const char*)g.Bt + (size_t)nxt.pn * tstep : cB;
        for (int t = 0; t < nt; t += 2) {
            const bool last = (t == nt - 2);
            const char* a1 = cA + (size_t)(t + 1) * kstep;
            const char* a2 = last ? nA : cA + (size_t)(t + 2) * kstep; const char* b2 = last ? nB : cB + (size_t)(t + 2) * kstep;
            const char* a3 = a2 + kstep; const char* b3 = b2 + kstep;
            if (last && has_next) S.a_ready(nxt);
            if constexpr (SP2) {
            PG8_LDB(B0, 0, 0); PG8_LDB(B1, 0, 1); PG8_SCHED; PG8_LDA(At, 0, 0); PG8_STAGE(PG8_SA(1, 1), a1 + hstep, voffA);
            PG8_WAIT_V(8); PG8_WAIT_L(0); PG8_BAR; PG8_MMA(0, 0, At, B0); PG8_MMA(0, 1, At, B1); PG8_BAR; PG8_SCHED;
            PG8_LDA(At, 0, 1); PG8_STAGE(PG8_SB(0, 0), b2, voffB); PG8_STAGE(PG8_SB(0, 1), b2 + hstep, voffB); PG8_STAGE(PG8_SA(0, 0), a2, voffA);
            PG8_WAIT_V(8); PG8_WAIT_L(0); PG8_BAR; PG8_MMA(1, 0, At, B0); PG8_MMA(1, 1, At, B1); PG8_BAR; PG8_SCHED;
            PG8_LDB(B0, 1, 0); PG8_LDB(B1, 1, 1); PG8_SCHED; PG8_LDA(At, 1, 0); PG8_STAGE(PG8_SA(0, 1), a2 + hstep, voffA);
            PG8_WAIT_V(8); PG8_WAIT_L(0); PG8_BAR; PG8_MMA(0, 0, At, B0); PG8_MMA(0, 1, At, B1); PG8_BAR; PG8_SCHED;
            PG8_LDA(At, 1, 1); PG8_STAGE(PG8_SB(1, 0), b3, voffB); PG8_STAGE(PG8_SB(1, 1), b3 + hstep, voffB); PG8_STAGE(PG8_SA(1, 0), a3, voffA);
            PG8_WAIT_V(8); PG8_WAIT_L(0); PG8_BAR; PG8_MMA(1, 0, At, B0); PG8_MMA(1, 1, At, B1); PG8_BAR; PG8_SCHED;
            } else {
            PG8_LDB(B0, 0, 0); PG8_SCHED; PG8_LDA(At, 0, 0); PG8_STAGE(PG8_SA(1, 1), a1 + hstep, voffA);
            PG8_WAIT_L(8); PG8_BAR; PG8_WAIT_L(0); PG8_MMA(0, 0, At, B0); PG8_BAR; PG8_SCHED;
            PG8_LDB(B1, 0, 1); PG8_STAGE(PG8_SB(0, 0), b2, voffB);
            PG8_BAR; PG8_WAIT_L(0); PG8_MMA(0, 1, At, B1); PG8_BAR;
            PG8_LDA(At, 0, 1); PG8_STAGE(PG8_SA(0, 0), a2, voffA);
            PG8_BAR; PG8_WAIT_L(0); PG8_MMA(1, 0, At, B0); PG8_BAR; PG8_SCHED;
            PG8_STAGE(PG8_SB(0, 1), b2 + hstep, voffB);
            PG8_WAIT_V(6); PG8_BAR; PG8_MMA(1, 1, At, B1); PG8_BAR;
            PG8_LDB(B0, 1, 0); PG8_SCHED; PG8_LDA(At, 1, 0); PG8_STAGE(PG8_SA(0, 1), a2 + hstep, voffA);
            PG8_WAIT_L(8); PG8_BAR; PG8_WAIT_L(0); PG8_MMA(0, 0, At, B0); PG8_BAR; PG8_SCHED;
            PG8_LDB(B1, 1, 1); PG8_STAGE(PG8_SB(1, 0), b3, voffB);
            PG8_BAR; PG8_WAIT_L(0); PG8_MMA(0, 1, At, B1); PG8_BAR;
            PG8_LDA(At, 1, 1); PG8_STAGE(PG8_SA(1, 0), a3, voffA);
            PG8_BAR; PG8_WAIT_L(0); PG8_MMA(1, 0, At, B0); PG8_BAR; PG8_SCHED;
            PG8_STAGE(PG8_SB(1, 1), b3 + hstep, voffB);
            PG8_WAIT_V(6); PG8_BAR; PG8_MMA(1, 1, At, B1); PG8_BAR;
            }
        }
        if constexpr (ALIGN_EPI) { if (wr == 0) PG8_BAR; }
        if constexpr (!Epi::AFTER_DRAIN) { E(acc, cur, wr, wc, fr, fq); S.done(cur); }
        if (!has_next) break;
#pragma unroll
        for (int a = 0; a < 2; ++a)
#pragma unroll
            for (int b = 0; b < 2; ++b)
#pragma unroll
                for (int m = 0; m < 4; ++m)
#pragma unroll
                    for (int n = 0; n < 2; ++n) acc[a][b][m][n] = (f32x4){0.f, 0.f, 0.f, 0.f};
        cur = nxt; cA = nA; cB = nB; ++ui;
        if constexpr (ALIGN_EPI) { if (wr == 1) PG8_BAR; }
    }
    PG8_WAIT_V(0);
    if constexpr (!ALIGN_EPI) { if (wr == 0) PG8_BAR; }
    PG8_BAR;
    if constexpr (Epi::AFTER_DRAIN) { E.fused(acc, cur, wr, wc, fr, fq, lds, wid, lane); S.done(cur); }
#undef PG8_SA
#undef PG8_SB
#undef PG8_STAGE
#undef PG8_LDA
#undef PG8_LDB
#undef PG8_MMA
#undef PG8_WAIT_V
#undef PG8_WAIT_L
#undef PG8_BAR
#undef PG8_SCHED
}
}
namespace cg = cooperative_groups;
#define LAS __attribute__((address_space(3)))
#define LDS_WAIT() asm volatile("s_waitcnt lgkmcnt(0)" ::: "memory")
constexpr int NWAVES = 8, LDS_BYTES = 147456;
constexpr int NPL = 13, NPH = 2 + NPL * DEPTH;
enum { PK_IN = 0, PK_CG1, PK_G2, PK_G3, PK_MIX, PK_LN1, PK_Q, PK_ATT, PK_XO, PK_LN2, PK_FF1, PK_FF2, PK_LN3 };
constexpr size_t WT_XK = 0, WT_XV = (size_t)4096 * 1024, WT_L0 = (size_t)2 * 4096 * 1024, WT_LSTRIDE = 14680064;
constexpr size_t WO_IN = 0, WO_MIX = 2883584, WO_XQ = WO_MIX + 1048576, WO_XO = WO_XQ + 1048576, WO_FF1 = WO_XO + 1048576, WO_FF2 = WO_FF1 + 5767168;
static_assert(WO_FF2 + 2883584 == WT_LSTRIDE && (WT_L0 + 4 * WT_LSTRIDE) * 2 == 128 * MiB, "weight map");
constexpr int I_IN = 16 * 81, I_SQ = 512, I_XKV = 1024, I_FF1 = 16 * 176, I_FF2 = 44 * 32, I_LAYER = I_IN + 3 * I_SQ + I_XKV + I_FF1 + I_FF2;

struct Args { const float* in[24]; float* out; unsigned char* ws; int ph_lo, ph_hi, sub, pad; };

__device__ __forceinline__ unsigned pk2(float lo, float hi) { return (unsigned)f2bf(lo) | ((unsigned)f2bf(hi) << 16); }
__device__ __forceinline__ void cvt_item(const float* W, int K, int N, int k0, int n0, bf16_t* dst, LAS float* scr, int lane) {
#pragma unroll 8
    for (int i = 0; i < 32; ++i) { const int kk = 2 * i + (lane >> 5), n = n0 + (lane & 31); scr[kk * 33 + (lane & 31)] = n < N ? W[(size_t)(k0 + kk) * N + n] : 0.f; }
    LDS_WAIT(); asm volatile("" ::: "memory");
    const int c = lane & 7;
#pragma unroll
    for (int j = 0; j < 4; ++j) { const int n = (lane >> 3) + 8 * j; const LAS float* s = scr + (8 * c) * 33 + n;
        u32x4 o; o.x = pk2(s[0 * 33], s[1 * 33]); o.y = pk2(s[2 * 33], s[3 * 33]); o.z = pk2(s[4 * 33], s[5 * 33]); o.w = pk2(s[6 * 33], s[7 * 33]);
        *(u32x4*)(dst + (size_t)n * K + k0 + 8 * c) = o; }
    LDS_WAIT(); asm volatile("" ::: "memory");
}
__device__ __forceinline__ void ln_row(const float* in, float* outf, bf16_t* outb, const float* g, const float* b, int lane) {
    const f32x4* xr = (const f32x4*)in + lane;
    f32x4 v[4]; float s = 0.f;
#pragma unroll
    for (int j = 0; j < 4; ++j) { v[j] = xr[64 * j]; s += (v[j].x + v[j].y) + (v[j].z + v[j].w); }
    const float mean = wave_sum(s) * (1.f / D); float s2 = 0.f;
#pragma unroll
    for (int j = 0; j < 4; ++j) { v[j] = v[j] - mean; s2 += (v[j].x * v[j].x + v[j].y * v[j].y) + (v[j].z * v[j].z + v[j].w * v[j].w); }
    const float rstd = rsqrtf(wave_sum(s2) * (1.f / D) + LN_EPS);
#pragma unroll
    for (int j = 0; j < 4; ++j) {
        const int c = (64 * j + lane) * 4;
        const f32x4 o = v[j] * rstd * *(const f32x4*)(g + c) + *(const f32x4*)(b + c);
        *((f32x4*)outf + 64 * j + lane) = o;
        *(unsigned long long*)(outb + c) = (unsigned long long)pk2(o.x, o.y) | ((unsigned long long)pk2(o.z, o.w) << 32);
    }
}

typedef short bf16x8_t __attribute__((ext_vector_type(8)));
typedef unsigned u32x2_t __attribute__((ext_vector_type(2)));
__device__ __forceinline__ unsigned cvtpk(float lo, float hi) { unsigned r; asm volatile("v_cvt_pk_bf16_f32 %0, %1, %2" : "=v"(r) : "v"(lo), "v"(hi)); return r; }
__device__ __forceinline__ void att_stage(LAS unsigned char* lds, const bf16_t* src, int pitch, int tid) {
    const int r0 = tid >> 5, ch = tid & 31;
    const bf16_t* g0 = src + (size_t)r0 * pitch + ch * 8;
    LAS unsigned char* l0 = lds + r0 * 512 + ((ch ^ r0) << 4);
    u32x4 v[16];
#pragma unroll
    for (int x = 0; x < 16; ++x) v[x] = *(const u32x4*)(g0 + (size_t)(16 * x) * pitch);
#pragma unroll
    for (int x = 0; x < 16; ++x) *(LAS u32x4*)(l0 + x * 8192) = v[x];
}
__device__ __forceinline__ void att_phase(LAS unsigned char* lds, const bf16_t* Kl, const bf16_t* Vl, bf16_t* Qb, int G, int tid) {
    for (int u = blockIdx.x; u < (M / 128) * 4; u += G) {
        asm volatile("" : "+v"(tid));
        const int lane = tid & 63, wave = __builtin_amdgcn_readfirstlane(tid >> 6), j = lane & 15, kg = lane >> 4;
        const int h = u & 3, pm = u >> 2, b = pm >> 6;
        att_stage(lds, Kl + (size_t)(b * 256) * 4096 + h * 256, 4096, tid);
        bf16_t* qrow = Qb + (size_t)(pm * 128 + 16 * wave + j) * 1024 + h * 256;
        bf16x8_t qf[8];
#pragma unroll
        for (int s = 0; s < 8; ++s) qf[s] = *(const bf16x8_t*)(qrow + 32 * s + 8 * kg);
        __syncthreads();
        f32x4 acc[16];
#pragma unroll
        for (int kb = 0; kb < 16; ++kb) acc[kb] = (f32x4){0.f, 0.f, 0.f, 0.f};
        const LAS unsigned char* fbase = lds + j * 512;
#pragma unroll
        for (int s = 0; s < 8; ++s)
#pragma unroll
            for (int kb = 0; kb < 16; ++kb) { const bf16x8_t af = *(const LAS bf16x8_t*)(fbase + kb * 8192 + (((4 * s + kg) ^ j) << 4));
                acc[kb] = __builtin_amdgcn_mfma_f32_16x16x32_bf16(af, qf[s], acc[kb], 0, 0, 0); }
        float mx = acc[0][0];
#pragma unroll
        for (int kb = 0; kb < 16; ++kb) mx = fmaxf(fmaxf(mx, fmaxf(acc[kb][0], acc[kb][1])), fmaxf(acc[kb][2], acc[kb][3]));
        mx = fmaxf(mx, __shfl_xor(mx, 16)); mx = fmaxf(mx, __shfl_xor(mx, 32));
        const float cs = 0.0625f * 1.4426950408889634f, mxc = mx * cs; float sum = 0.f;
        bf16x8_t pf[8];
#pragma unroll
        for (int t = 0; t < 8; ++t) { f32x4 p0, p1;
#pragma unroll
            for (int e = 0; e < 4; ++e) { p0[e] = __builtin_amdgcn_exp2f(acc[2 * t][e] * cs - mxc); p1[e] = __builtin_amdgcn_exp2f(acc[2 * t + 1][e] * cs - mxc); }
            sum += (p0[0] + p0[1]) + (p0[2] + p0[3]) + (p1[0] + p1[1]) + (p1[2] + p1[3]);
            u32x4 w; w.x = cvtpk(p0[0], p0[1]); w.y = cvtpk(p0[2], p0[3]); w.z = cvtpk(p1[0], p1[1]); w.w = cvtpk(p1[2], p1[3]); pf[t] = __builtin_bit_cast(bf16x8_t, w); }
        sum += __shfl_xor(sum, 16); sum += __shfl_xor(sum, 32);
        const float inv = 1.f / sum;
        __syncthreads();
        att_stage(lds, Vl + (size_t)(h * 256) * 1024 + b * 256, 1024, tid);
        __syncthreads();
#pragma unroll
        for (int db = 0; db < 16; ++db) {
            f32x4 o = (f32x4){0.f, 0.f, 0.f, 0.f};
#pragma unroll
            for (int t = 0; t < 8; ++t) { const bf16x8_t af = *(const LAS bf16x8_t*)(fbase + db * 8192 + (((4 * t + kg) ^ j) << 4));
                o = __builtin_amdgcn_mfma_f32_16x16x32_bf16(af, pf[t], o, 0, 0, 0); }
            u32x2_t w; w.x = cvtpk(o[0] * inv, o[1] * inv); w.y = cvtpk(o[2] * inv, o[3] * inv);
            *(u32x2_t*)(qrow + 16 * db + 4 * kg) = w;
        }
        __syncthreads();
    }
}

__device__ __forceinline__ void conv_phase(LAS unsigned char* lds, const bf16_t* PROJ, const float* cw, const float* cb, const float* lg, const float* lb, bf16_t* MIXIN, int G, int tid) {
    LAS float* U = (LAS float*)lds;
    for (int u = blockIdx.x; u < M / 32; u += G) {
        asm volatile("" : "+v"(tid));
        const int lane = tid & 63, wave = __builtin_amdgcn_readfirstlane(tid >> 6);
        const int row0 = u * 32, t0 = row0 % SEQ;
#pragma unroll
        for (int pass = 0; pass < 8; ++pass) { const int rr = pass * 8 + wave;
            if (rr < 62) { f32x4 o0 = (f32x4){0.f, 0.f, 0.f, 0.f}, o1 = o0;
                if (t0 - 30 + rr >= 0) { const bf16_t* pr = PROJ + (size_t)(row0 - 30 + rr) * PROJ_LD + 8 * lane;
                    const u32x4 a = *(const u32x4*)(pr + C_CA), g = *(const u32x4*)(pr + C_CG);
#pragma unroll
                    for (int x = 0; x < 4; ++x) { const float a0 = __uint_as_float(a[x] << 16), a1 = __uint_as_float(a[x] & 0xffff0000u), g0 = __uint_as_float(g[x] << 16), g1 = __uint_as_float(g[x] & 0xffff0000u);
                        const float u0 = a0 * __builtin_amdgcn_rcpf(1.f + __expf(-g0)), u1 = a1 * __builtin_amdgcn_rcpf(1.f + __expf(-g1));
                        if (x < 2) { o0[2 * x] = u0; o0[2 * x + 1] = u1; } else { o1[2 * x - 4] = u0; o1[2 * x - 3] = u1; } } }
                *(LAS f32x4*)(U + rr * 512 + 8 * lane) = o0; *(LAS f32x4*)(U + rr * 512 + 8 * lane + 4) = o1; } }
        __syncthreads();
        const int c = tid;
        float w[31];
#pragma unroll
        for (int k = 0; k < 31; ++k) w[k] = cw[k * 512 + c];
        const float bias = cb[c];
        float y[32];
#pragma unroll
        for (int blk = 0; blk < 4; ++blk) { float win[38];
#pragma unroll
            for (int x = 0; x < 38; ++x) win[x] = U[(8 * blk + x) * 512 + c];
#pragma unroll
            for (int o = 0; o < 8; ++o) { float acc = bias;
#pragma unroll
                for (int k = 0; k < 31; ++k) acc += w[k] * win[o + k];
                y[8 * blk + o] = acc; } }
        __syncthreads();
#pragma unroll
        for (int tt = 0; tt < 32; ++tt) U[tt * 512 + c] = y[tt];
        __syncthreads();
#pragma unroll
        for (int q = 0; q < 4; ++q) { const int tt = 4 * wave + q;
            f32x4 a = *(const LAS f32x4*)(U + tt * 512 + 8 * lane), b = *(const LAS f32x4*)(U + tt * 512 + 8 * lane + 4);
            const float mean = wave_sum((a[0] + a[1]) + (a[2] + a[3]) + (b[0] + b[1]) + (b[2] + b[3])) * (1.f / 512.f);
            a = a - mean; b = b - mean;
            const float var = wave_sum((a[0] * a[0] + a[1] * a[1]) + (a[2] * a[2] + a[3] * a[3]) + (b[0] * b[0] + b[1] * b[1]) + (b[2] * b[2] + b[3] * b[3])) * (1.f / 512.f);
            const float rstd = rsqrtf(var + LN_EPS);
            a = a * rstd * *(const f32x4*)(lg + 8 * lane) + *(const f32x4*)(lb + 8 * lane); b = b * rstd * *(const f32x4*)(lg + 8 * lane + 4) + *(const f32x4*)(lb + 8 * lane + 4);
#pragma unroll
            for (int x = 0; x < 4; ++x) { a[x] = pg8::silu_fast(a[x]); b[x] = pg8::silu_fast(b[x]); }
            *(u32x4*)(MIXIN + (size_t)(row0 + tt) * D + 8 * lane) = pg8::pack8(a, b); }
        __syncthreads();
    }
}

typedef float f32x16_t __attribute__((ext_vector_type(16)));
constexpr int GP = 72;
__device__ __forceinline__ int slot32(int c) { const int w = c & 15; return (c & ~15) + 8 * ((w >> 2) & 1) + (w & 3) + 4 * (w >> 3); }
__device__ __forceinline__ void gla_bcum(const bf16_t* ALOW, const float* wa2, const float* ba, int row0, int h, int lane, int wave, float (&bc)[8], float (&bl)[8]) {
    const u32x4 a0 = *(const u32x4*)(ALOW + (size_t)(row0 + lane) * 16), a1 = *(const u32x4*)(ALOW + (size_t)(row0 + lane) * 16 + 8);
    float al[16];
#pragma unroll
    for (int x = 0; x < 4; ++x) { al[2 * x] = __uint_as_float(a0[x] << 16); al[2 * x + 1] = __uint_as_float(a0[x] & 0xffff0000u); al[8 + 2 * x] = __uint_as_float(a1[x] << 16); al[8 + 2 * x + 1] = __uint_as_float(a1[x] & 0xffff0000u); }
#pragma unroll
    for (int x = 0; x < 8; ++x) { const int col = h * 64 + 8 * wave + x; float z = ba[col];
#pragma unroll
        for (int i = 0; i < 16; ++i) z += al[i] * wa2[i * 256 + col];
        float la = (fminf(z, 0.f) - log1pf(__expf(-fabsf(z)))) * (1.f / 16.f);
#pragma unroll
        for (int off = 1; off < 64; off <<= 1) { const float t = __shfl_up(la, off); if (lane >= off) la += t; }
        bc[x] = la; bl[x] = __shfl(la, 63); }
}
__device__ __forceinline__ void unpack8(const u32x4 v, float (&f)[8]) {
#pragma unroll
    for (int x = 0; x < 4; ++x) { f[2 * x] = __uint_as_float(v[x] << 16); f[2 * x + 1] = __uint_as_float(v[x] & 0xffff0000u); }
}
__device__ __forceinline__ void gla_g1_phase(LAS unsigned char* lds, const bf16_t* PROJ, const bf16_t* ALOW, const float* wa2, const float* ba, float* UPD, float* DEC, int G, int tid) {
    LAS bf16_t* KD = (LAS bf16_t*)lds; LAS bf16_t* VT = (LAS bf16_t*)(lds + 18432);
    for (int u = blockIdx.x; u < 2048; u += G) {
        asm volatile("" : "+v"(tid));
        const int lane = tid & 63, wave = __builtin_amdgcn_readfirstlane(tid >> 6);
        const int bh = u >> 7, n = u & 127, b = bh >> 2, h = bh & 3, row0 = b * SEQ + n * 64;
        float bc[8], bl[8];
        gla_bcum(ALOW, wa2, ba, row0, h, lane, wave, bc, bl);
        const bf16_t* pr = PROJ + (size_t)(row0 + lane) * PROJ_LD;
        float kf[8]; unpack8(*(const u32x4*)(pr + C_K + h * 64 + 8 * wave), kf);
#pragma unroll
        for (int x = 0; x < 8; ++x) KD[(8 * wave + x) * GP + lane] = f2bf(kf[x] * __expf(bl[x] - bc[x]));
        if (lane == 63) {
#pragma unroll
            for (int x = 0; x < 8; ++x) DEC[u * 64 + 8 * wave + x] = __expf(bl[x]); }
#pragma unroll
        for (int pc = 0; pc < 2; ++pc) { const int e0 = 64 * pc + 8 * wave; const u32x4 v = *(const u32x4*)(pr + C_V + h * 128 + e0);
#pragma unroll
            for (int x = 0; x < 4; ++x) { VT[(e0 + 2 * x) * GP + lane] = (bf16_t)(v[x] & 0xffffu); VT[(e0 + 2 * x + 1) * GP + lane] = (bf16_t)(v[x] >> 16); } }
        __syncthreads();
        const int eb = wave >> 1, dbk = wave & 1, i = lane & 31, kg = lane >> 5;
        f32x16_t acc;
#pragma unroll
        for (int r = 0; r < 16; ++r) acc[r] = 0.f;
#pragma unroll
        for (int s = 0; s < 4; ++s) { const bf16x8_t af = *(const LAS bf16x8_t*)(VT + (32 * eb + i) * GP + 16 * s + 8 * kg), bfr = *(const LAS bf16x8_t*)(KD + (32 * dbk + i) * GP + 16 * s + 8 * kg);
            acc = __builtin_amdgcn_mfma_f32_32x32x16_bf16(af, bfr, acc, 0, 0, 0); }
        float* up = UPD + ((size_t)u * 128 + 32 * eb + 4 * kg) * 64 + 32 * dbk + i;
#pragma unroll
        for (int r = 0; r < 16; ++r) up[((r & 3) + 8 * (r >> 2)) * 64] = acc[r];
        __syncthreads();
    }
}
__device__ __forceinline__ void gla_g2_phase(float* UPD, const float* DEC, int G, int tid) {
    for (int g = blockIdx.x * 512 + tid; g < 16 * 8192; g += G * 512) {
        const int bh = g >> 13, ed = g & 8191, d = g & 63;
        float* p = UPD + (size_t)bh * 128 * 8192 + ed; const float* dc = DEC + bh * 128 * 64 + d;
        float S = 0.f;
        for (int n0 = 0; n0 < 128; n0 += 16) { float uu[16], dd[16];
#pragma unroll
            for (int x = 0; x < 16; ++x) { uu[x] = p[(size_t)(n0 + x) * 8192]; dd[x] = dc[(n0 + x) * 64]; }
#pragma unroll
            for (int x = 0; x < 16; ++x) { p[(size_t)(n0 + x) * 8192] = S; S = dd[x] * S + uu[x]; } }
    }
}
__device__ __forceinline__ void gla_g3_phase(LAS unsigned char* lds, const bf16_t* PROJ, const bf16_t* ALOW, const float* wa2, const float* ba, const float* gn, const float* UPD, bf16_t* MIXIN, int G, int tid) {
    LAS bf16_t* KE = (LAS bf16_t*)lds; LAS bf16_t* QE = (LAS bf16_t*)(lds + 9216); LAS bf16_t* VT = (LAS bf16_t*)(lds + 18432); LAS float* RED = (LAS float*)(lds + 36864);
    for (int u = blockIdx.x; u < 2048; u += G) {
        asm volatile("" : "+v"(tid));
        const int lane = tid & 63, wave = __builtin_amdgcn_readfirstlane(tid >> 6);
        const int bh = u >> 7, n = u & 127, b = bh >> 2, h = bh & 3, row0 = b * SEQ + n * 64;
        { float bc[8], bl[8];
          gla_bcum(ALOW, wa2, ba, row0, h, lane, wave, bc, bl);
          const bf16_t* pr = PROJ + (size_t)(row0 + lane) * PROJ_LD;
          float qf[8], kf[8]; unpack8(*(const u32x4*)(pr + C_Q + h * 64 + 8 * wave), qf); unpack8(*(const u32x4*)(pr + C_K + h * 64 + 8 * wave), kf);
          f32x4 q0, q1, k0, k1;
#pragma unroll
          for (int x = 0; x < 4; ++x) { q0[x] = qf[x] * 0.125f * __expf(bc[x]); q1[x] = qf[4 + x] * 0.125f * __expf(bc[4 + x]); k0[x] = kf[x] * __expf(-bc[x]); k1[x] = kf[4 + x] * __expf(-bc[4 + x]); }
          *(LAS u32x4*)(QE + lane * GP + 8 * wave) = pg8::pack8(q0, q1); *(LAS u32x4*)(KE + lane * GP + 8 * wave) = pg8::pack8(k0, k1);
          const int pcol = slot32(lane);
#pragma unroll
          for (int pc = 0; pc < 2; ++pc) { const int e0 = 64 * pc + 8 * wave; const u32x4 v = *(const u32x4*)(pr + C_V + h * 128 + e0);
#pragma unroll
              for (int x = 0; x < 4; ++x) { VT[(e0 + 2 * x) * GP + pcol] = (bf16_t)(v[x] & 0xffffu); VT[(e0 + 2 * x + 1) * GP + pcol] = (bf16_t)(v[x] >> 16); } } }
        __syncthreads();
        const int eb = wave >> 1, cb = wave & 1, i = lane & 31, kg = lane >> 5;
        bf16x8_t qb[4];
#pragma unroll
        for (int s = 0; s < 4; ++s) qb[s] = *(const LAS bf16x8_t*)(QE + (32 * cb + i) * GP + 16 * s + 8 * kg);
        f32x16_t o;
#pragma unroll
        for (int r = 0; r < 16; ++r) o[r] = 0.f;
#pragma unroll
        for (int sb = 0; sb < 2; ++sb) if (sb <= cb) {
            f32x16_t at;
#pragma unroll
            for (int r = 0; r < 16; ++r) at[r] = 0.f;
#pragma unroll
            for (int s = 0; s < 4; ++s) { const bf16x8_t af = *(const LAS bf16x8_t*)(KE + (32 * sb + i) * GP + 16 * s + 8 * kg); at = __builtin_amdgcn_mfma_f32_32x32x16_bf16(af, qb[s], at, 0, 0, 0); }
            if (sb == cb) {
#pragma unroll
                for (int r = 0; r < 16; ++r) if ((r & 3) + 8 * (r >> 2) + 4 * kg > i) at[r] = 0.f; }
#pragma unroll
            for (int sp = 0; sp < 2; ++sp) { u32x4 w; w.x = cvtpk(at[8 * sp + 0], at[8 * sp + 1]); w.y = cvtpk(at[8 * sp + 2], at[8 * sp + 3]); w.z = cvtpk(at[8 * sp + 4], at[8 * sp + 5]); w.w = cvtpk(at[8 * sp + 6], at[8 * sp + 7]);
                const bf16x8_t af = *(const LAS bf16x8_t*)(VT + (32 * eb + i) * GP + 32 * sb + 16 * sp + 8 * kg);
                o = __builtin_amdgcn_mfma_f32_32x32x16_bf16(af, __builtin_bit_cast(bf16x8_t, w), o, 0, 0, 0); }
        }
        { const float* sp = UPD + ((size_t)u * 128 + 32 * eb + i) * 64 + 8 * kg;
#pragma unroll
          for (int s = 0; s < 4; ++s) { const f32x4 x0 = *(const f32x4*)(sp + 16 * s), x1 = *(const f32x4*)(sp + 16 * s + 4);
              o = __builtin_amdgcn_mfma_f32_32x32x16_bf16(__builtin_bit_cast(bf16x8_t, pg8::pack8(x0, x1)), qb[s], o, 0, 0, 0); } }
        float ss = 0.f;
#pragma unroll
        for (int r = 0; r < 16; ++r) ss += o[r] * o[r];
        ss += __shfl_xor(ss, 32);
        if (kg == 0) RED[eb * 64 + 32 * cb + i] = ss;
        __syncthreads();
        const float tot = (RED[32 * cb + i] + RED[64 + 32 * cb + i]) + (RED[128 + 32 * cb + i] + RED[192 + 32 * cb + i]);
        const float rstd = rsqrtf(tot * (1.f / 128.f) + LN_EPS);
        const size_t row = (size_t)(row0 + 32 * cb + i);
#pragma unroll
        for (int rg = 0; rg < 4; ++rg) { const int e = 32 * eb + 8 * rg + 4 * kg;
            const f32x4 g4 = *(const f32x4*)(gn + e); const u32x2_t rr = *(const u32x2_t*)(PROJ + row * PROJ_LD + C_R + h * 128 + e);
            const float r0 = __uint_as_float(rr.x << 16), r1 = __uint_as_float(rr.x & 0xffff0000u), r2 = __uint_as_float(rr.y << 16), r3 = __uint_as_float(rr.y & 0xffff0000u);
            u32x2_t w; w.x = cvtpk(o[4 * rg] * rstd * g4[0] * pg8::silu_fast(r0), o[4 * rg + 1] * rstd * g4[1] * pg8::silu_fast(r1));
            w.y = cvtpk(o[4 * rg + 2] * rstd * g4[2] * pg8::silu_fast(r2), o[4 * rg + 3] * rstd * g4[3] * pg8::silu_fast(r3));
            *(u32x2_t*)(MIXIN + row * D + 512 + h * 128 + e) = w; }
        __syncthreads();
    }
}

#ifndef PHASE_CG1
#define PHASE_CG1
#endif
#ifndef PHASE_G2
#define PHASE_G2
#endif
#ifndef PHASE_G3
#define PHASE_G3
#endif
#ifndef PHASE_ATT
#define PHASE_ATT
#endif
__global__ void __launch_bounds__(NWAVES * 64) mega(Args a) {
    extern __shared__ __attribute__((aligned(16))) unsigned char lds_raw[];
    LAS unsigned char* lds = (LAS unsigned char*)lds_raw;
    const int wave = __builtin_amdgcn_readfirstlane(threadIdx.x >> 6);
    const int G = gridDim.x, gw = blockIdx.x * NWAVES + wave, NGW = G * NWAVES;
    unsigned char* ws = a.ws;
    float* HF = a.out;
    bf16_t* WT = (bf16_t*)(ws + WS_WT); bf16_t* HB = (bf16_t*)(ws + WS_HB); bf16_t* PROJ = (bf16_t*)(ws + WS_PROJ); bf16_t* ALOW = (bf16_t*)(ws + WS_ALOW);
    bf16_t* MIXIN = (bf16_t*)(ws + WS_MIXIN); bf16_t* Qb = (bf16_t*)(ws + WS_Q); bf16_t* ACT = (bf16_t*)(ws + WS_ACT);
    bf16_t* Kb = (bf16_t*)(ws + WS_K); bf16_t* Vt = (bf16_t*)(ws + WS_VT); bf16_t* MEMB = (bf16_t*)(ws + WS_MEMB); bf16_t* MEMP = (bf16_t*)(ws + WS_MEMP);
    float* UPD = (float*)(ws + WS_UPD); float* DEC = (float*)(ws + WS_DEC);

    for (int p = a.ph_lo; p < a.ph_hi; ++p) {
        int tid = threadIdx.x; asm volatile("" : "+v"(tid));
        const int lane = tid & 63;
        if (p == 0) {
            LAS float* scr = (LAS float*)(lds + wave * 16384);
            for (int it = gw; it < DEPTH * I_LAYER; it += NGW) {
                const int l = it / I_LAYER; int r = it % I_LAYER;
                bf16_t* WL = WT + WT_L0 + (size_t)l * WT_LSTRIDE;
                if (r < I_IN) { const int kb = r / 81, nb = r % 81; cvt_item(a.in[4] + (size_t)l * 1024 * IN_COLS, 1024, IN_COLS, 64 * kb, 32 * nb, WL + WO_IN + (size_t)(32 * nb) * 1024, scr, lane); continue; } r -= I_IN;
                if (r < I_SQ) { const int kb = r / 32, nb = r % 32; cvt_item(a.in[12] + (size_t)l * 1024 * 1024, 1024, 1024, 64 * kb, 32 * nb, WL + WO_MIX + (size_t)(32 * nb) * 1024, scr, lane); continue; } r -= I_SQ;
                if (r < I_SQ) { const int kb = r / 32, nb = r % 32; cvt_item(a.in[15] + (size_t)l * 1024 * 1024, 1024, 1024, 64 * kb, 32 * nb, WL + WO_XQ + (size_t)(32 * nb) * 1024, scr, lane); continue; } r -= I_SQ;
                if (r < I_SQ) { const int kb = r / 32, nb = r % 32; cvt_item(a.in[17] + (size_t)l * 1024 * 1024, 1024, 1024, 64 * kb, 32 * nb, WL + WO_XO + (size_t)(32 * nb) * 1024, scr, lane); continue; } r -= I_SQ;
                if (r < I_XKV) { const int kb = r / 64, n0 = 32 * (r % 64);
                    bf16_t* dst = n0 < 1024 ? WT + WT_XK + (size_t)(l * 1024 + n0) * 1024 : WT + WT_XV + (size_t)(l * 1024 + n0 - 1024) * 1024;
                    cvt_item(a.in[16] + (size_t)l * 1024 * 2048, 1024, 2048, 64 * kb, n0, dst, scr, lane); continue; } r -= I_XKV;
                if (r < I_FF1) { const int kb = r / 176, n0 = 32 * (r % 176);
                    const int drow = n0 < D_FF ? 256 * (n0 / 128) + n0 % 128 : 256 * ((n0 - D_FF) / 128) + 128 + (n0 - D_FF) % 128;
                    cvt_item(a.in[20] + (size_t)l * 1024 * 2 * D_FF, 1024, 2 * D_FF, 64 * kb, n0, WL + WO_FF1 + (size_t)drow * 1024, scr, lane); continue; } r -= I_FF1;
                { const int kb = r / 32, nb = r % 32; cvt_item(a.in[21] + (size_t)l * D_FF * 1024, D_FF, 1024, 64 * kb, 32 * nb, WL + WO_FF2 + (size_t)(32 * nb) * D_FF, scr, lane); }
            }
            for (int i = blockIdx.x * 512 + tid; i < 1024 * 1024; i += G * 512) {
                const int row = i >> 10, c = i & 1023, b = row >> 8, key = row & 255; const bf16_t v = f2bf(a.in[1][i]);
                MEMB[i] = v; MEMP[(size_t)(b * 256 + slot_of_key(key)) * 1024 + c] = v; }
            for (int m = gw; m < M; m += NGW) ln_row(a.in[0] + (size_t)m * D, HF + (size_t)m * D, HB + (size_t)m * D, a.in[2], a.in[3], lane);
        } else if (p == 1) {
            const int half = G / 2;
            if ((int)blockIdx.x < half) { pg8::Gemm g{MEMB, WT + WT_XK, 1024, 4096, 1024}; pg8::StaticOrderT<1024, 4096> S; S.init(half, (int)blockIdx.x);
                pg8::EpiBf16 E{Kb, 4096}; pg8::gemm_phase<pg8::EpiBf16, pg8::StaticOrderT<1024, 4096>, true, true, 1024>(lds, g, S, E, tid); }
            else { pg8::Gemm g{WT + WT_XV, MEMP, 4096, 1024, 1024}; pg8::StaticOrderT<4096, 1024> S; S.init(G - half, (int)blockIdx.x - half);
                pg8::EpiBf16 E{Vt, 1024}; pg8::gemm_phase<pg8::EpiBf16, pg8::StaticOrderT<4096, 1024>, true, true, 1024>(lds, g, S, E, tid); }
        } else {
            const int l = (p - 2) / NPL, kind = (p - 2) % NPL;
            const bf16_t* WL = WT + WT_L0 + (size_t)l * WT_LSTRIDE;
            if (kind == PK_IN) { pg8::Gemm g{HB, WL + WO_IN, M, 2816, 1024}; pg8::StaticOrderT<M, 2816> S; S.init(G, (int)blockIdx.x);
                pg8::EpiProj E{PROJ, ALOW}; pg8::gemm_phase<pg8::EpiProj, pg8::StaticOrderT<M, 2816>, true, true, 1024>(lds, g, S, E, tid); }
            else if (kind == PK_CG1) {
                if (a.sub & 1) conv_phase(lds, PROJ, a.in[7] + l * 31 * 512, a.in[8] + l * 512, a.in[9] + l * 512, a.in[10] + l * 512, MIXIN, G, tid);
                if (a.sub & 2) gla_g1_phase(lds, PROJ, ALOW, a.in[5] + l * 16 * 256, a.in[6] + l * 256, UPD, DEC, G, tid); }
            else if (kind == PK_G2) { gla_g2_phase(UPD, DEC, G, tid); }
            else if (kind == PK_G3) { gla_g3_phase(lds, PROJ, ALOW, a.in[5] + l * 16 * 256, a.in[6] + l * 256, a.in[11] + l * 128, UPD, MIXIN, G, tid); }
            else if (kind == PK_MIX || kind == PK_XO) { pg8::Gemm g{kind == PK_MIX ? MIXIN : Qb, WL + (kind == PK_MIX ? WO_MIX : WO_XO), M, 1024, 1024}; pg8::StaticOrderT<M, 1024> S; S.init(G, (int)blockIdx.x);
                pg8::EpiRes E{HF, ALPHA}; pg8::gemm_phase<pg8::EpiRes, pg8::StaticOrderT<M, 1024>, true, true, 1024>(lds, g, S, E, tid); }
            else if (kind == PK_Q) { pg8::Gemm g{HB, WL + WO_XQ, M, 1024, 1024}; pg8::StaticOrderT<M, 1024> S; S.init(G, (int)blockIdx.x);
                pg8::EpiBf16 E{Qb, 1024}; pg8::gemm_phase<pg8::EpiBf16, pg8::StaticOrderT<M, 1024>, true, true, 1024>(lds, g, S, E, tid); }
            else if (kind == PK_ATT) { att_phase(lds, Kb + l * 1024, Vt + (size_t)l * 1024 * 1024, Qb, G, tid); }
            else if (kind == PK_FF1) { pg8::Gemm g{HB, WL + WO_FF1, M, 2 * D_FF, 1024}; pg8::StaticOrderT<M, 2 * D_FF> S; S.init(G, (int)blockIdx.x);
                pg8::EpiSwiglu E{ACT}; pg8::gemm_phase<pg8::EpiSwiglu, pg8::StaticOrderT<M, 2 * D_FF>, true, true, 1024>(lds, g, S, E, tid); }
            else if (kind == PK_FF2) { pg8::Gemm g{ACT, WL + WO_FF2, M, 1024, D_FF}; pg8::StaticOrderT<M, 1024> S; S.init(G, (int)blockIdx.x);
                pg8::EpiRes E{HF, ALPHA}; pg8::gemm_phase<pg8::EpiRes, pg8::StaticOrderT<M, 1024>, true, true, D_FF>(lds, g, S, E, tid); }
            else {
                const int gi = kind == PK_LN1 ? 13 : kind == PK_LN2 ? 18 : 22;
                const float* gg = a.in[gi] + l * D; const float* bb = a.in[gi + 1] + l * D;
                for (int m = gw; m < M; m += NGW) ln_row(HF + (size_t)m * D, HF + (size_t)m * D, HB + (size_t)m * D, gg, bb, lane);
            }
        }
        if (p + 1 < a.ph_hi) cg::this_grid().sync();
    }
}

#ifndef MEGA_ATT
#define MEGA_ATT 1
#endif
#ifndef MEGA_CONV
#define MEGA_CONV 1
#endif
#ifndef MEGA_GLA
#define MEGA_GLA 1
#endif
#ifndef ONE_LAUNCH
#define ONE_LAUNCH 1
#endif
extern "C" void kernel_launch(void* const* d_in, const int* in_sizes, int n_in, void* d_out, int out_size, void* d_ws, size_t ws_size, hipStream_t stream) {
    if (n_in != 24 || out_size != M * D || ws_size < WS_END) { fprintf(stderr, "kernel_launch: unexpected shapes (n_in %d out %d ws %zu)\n", n_in, out_size, ws_size); return; }
    static int grid = 0;
    if (grid == 0) {
        int dev = 0, cus = 0, per_cu = 0;
        hipGetDevice(&dev); hipDeviceGetAttribute(&cus, hipDeviceAttributeMultiprocessorCount, dev);
        if (hipFuncSetAttribute((const void*)mega, hipFuncAttributeMaxDynamicSharedMemorySize, LDS_BYTES) != hipSuccess) { fprintf(stderr, "kernel_launch: hipFuncSetAttribute failed\n"); grid = -1; return; }
        if (hipOccupancyMaxActiveBlocksPerMultiprocessor(&per_cu, (const void*)mega, NWAVES * 64, LDS_BYTES) != hipSuccess || per_cu < 1) { fprintf(stderr, "kernel_launch: occupancy query says %d\n", per_cu); per_cu = 1; }
        (void)hipGetLastError();
        grid = cus;
        fprintf(stderr, "kernel_launch: grid %d (cus %d per_cu %d)\n", grid, cus, per_cu);
    }
    if (grid < 0) return;
    Args a{};
    for (int i = 0; i < 24; ++i) a.in[i] = (const float*)d_in[i];
    a.out = (float*)d_out; a.ws = (unsigned char*)d_ws;
    unsigned char* ws = (unsigned char*)d_ws;
    float* HF = (float*)d_out;
    bf16_t* PROJ = (bf16_t*)(ws + WS_PROJ); bf16_t* ALOW = (bf16_t*)(ws + WS_ALOW);
    bf16_t* MIXIN = (bf16_t*)(ws + WS_MIXIN); bf16_t* Qb = (bf16_t*)(ws + WS_Q);
    bf16_t* Kb = (bf16_t*)(ws + WS_K); bf16_t* Vt = (bf16_t*)(ws + WS_VT);
    float* OG = (float*)(ws + WS_UPD);
    (void)HF;
#if ONE_LAUNCH
    a.ph_lo = 0; a.ph_hi = NPH; a.sub = 3;
    void* kargs[] = {&a};
    hipError_t e = hipLaunchCooperativeKernel((const void*)mega, dim3(grid), dim3(NWAVES * 64), kargs, LDS_BYTES, stream);
    if (e != hipSuccess) fprintf(stderr, "kernel_launch: cooperative launch failed: %s\n", hipGetErrorString(e));
#else
    for (int p = 0; p < NPH; ++p) {
        const int l = p < 2 ? 0 : (p - 2) / NPL, kind = p < 2 ? -1 : (p - 2) % NPL;
        bool use_mega = true; int sub = 3;
        if (kind == PK_ATT && !MEGA_ATT) use_mega = false;
        if ((kind == PK_G2 || kind == PK_G3) && !MEGA_GLA) continue;
        if (kind == PK_CG1) { sub = (MEGA_CONV ? 1 : 0) | (MEGA_GLA ? 2 : 0); use_mega = sub != 0; }
        if (use_mega) { a.ph_lo = p; a.ph_hi = p + 1; a.sub = sub; hipLaunchKernelGGL(mega, dim3(grid), dim3(NWAVES * 64), LDS_BYTES, stream, a); }
        if (kind == PK_ATT && !MEGA_ATT) n_attn<<<M, 256, 0, stream>>>(Qb, Kb + l * 1024, 4096, Vt + (size_t)l * 1024 * 1024);
        if (kind == PK_CG1) {
            if (!MEGA_CONV) n_conv<<<M, 512, 0, stream>>>(PROJ, a.in[7] + l * 31 * 512, a.in[8] + l * 512, a.in[9] + l * 512, a.in[10] + l * 512, MIXIN);
            if (!MEGA_GLA) { n_gla<<<16, 128, 0, stream>>>(PROJ, ALOW, a.in[5] + l * 16 * 256, a.in[6] + l * 256, OG);
                             n_glanorm<<<M, 512, 0, stream>>>(OG, PROJ, a.in[11] + l * 128, MIXIN); }
        }
    }
#endif
}
```

```cpp
#include <hip/hip_runtime.h>
#include <hip/hip_cooperative_groups.h>
#include <cstdio>
#include <cstdint>

typedef unsigned short bf16_t;
typedef unsigned u32x4 __attribute__((ext_vector_type(4)));
typedef float f32x4 __attribute__((ext_vector_type(4)));

constexpr int D = 1024, BATCH = 4, SEQ = 8192, DEPTH = 4, M = BATCH * SEQ;
constexpr int IN_COLS = 2576, PROJ_LD = 2560, MEM_LEN = 256, D_FF = 2816;
constexpr int C_CA = 0, C_CG = 512, C_Q = 1024, C_K = 1280, C_V = 1536, C_R = 2048, C_AL = 2560;
constexpr float LN_EPS = 1e-5f;
constexpr float ALPHA = 1.681792830507429f;

constexpr size_t MiB = 1u << 20;
constexpr size_t WS_CTL = 0;
constexpr size_t WS_K = 8 * MiB;
constexpr size_t WS_VT = 16 * MiB;
constexpr size_t WS_MEMB = 24 * MiB;
constexpr size_t WS_MEMP = 26 * MiB;
constexpr size_t WS_ALOW = 28 * MiB;
constexpr size_t WS_DEC = 29 * MiB;
constexpr size_t WS_CNT = 0;
constexpr size_t WS_CSP = 1 * MiB;
constexpr size_t WS_CS = 6 * MiB;
constexpr size_t WS_SLOTS = 30 * MiB;
constexpr size_t WS_MUR = 31 * MiB;
constexpr size_t WS_WT = 32 * MiB;
constexpr size_t WS_HB = 160 * MiB;
constexpr size_t WS_PROJ = 224 * MiB;
constexpr size_t WS_Q = 224 * MiB;
constexpr size_t WS_ACT = 224 * MiB;
constexpr size_t WS_UPD = 384 * MiB;
constexpr size_t WS_MIXIN = 448 * MiB;
constexpr size_t WS_END = 512 * MiB;

__host__ __device__ __forceinline__ int key_of_slot(int p) { const int e = p & 7, kg = (p >> 3) & 3; return (p & ~31) + 16 * (e >> 2) + 4 * kg + (e & 3); }
__host__ __device__ __forceinline__ int slot_of_key(int k) { const int w = k & 31; return (k & ~31) + 8 * ((w >> 2) & 3) + 4 * (w >> 4) + (w & 3); }

__device__ __forceinline__ float bf2f(bf16_t b) { return __uint_as_float(((unsigned)b) << 16); }
__device__ __forceinline__ bf16_t f2bf(float f) { unsigned u = __float_as_uint(f); return (bf16_t)((u + 0x7fffu + ((u >> 16) & 1u)) >> 16); }
__device__ __forceinline__ float ldf(const float* p) { return *p; }
__device__ __forceinline__ float ldf(const bf16_t* p) { return bf2f(*p); }
__device__ __forceinline__ float sigmoidf_(float x) { return 1.f / (1.f + __expf(-x)); }
__device__ __forceinline__ float siluf_(float x) { return x / (1.f + __expf(-x)); }
__device__ __forceinline__ float wave_sum(float v) {
#pragma unroll
    for (int o = 1; o < 64; o <<= 1) v += __shfl_xor(v, o);
    return v;
}
__device__ __forceinline__ float wave_max(float v) {
#pragma unroll
    for (int o = 1; o < 64; o <<= 1) v = fmaxf(v, __shfl_xor(v, o));
    return v;
}

namespace pg8 {
#define PG8_LAS __attribute__((address_space(3)))
typedef unsigned short bf16_t;
typedef short bf16x8 __attribute__((ext_vector_type(8)));
typedef float f32x4 __attribute__((ext_vector_type(4)));
typedef unsigned u32x4 __attribute__((ext_vector_type(4)));
constexpr int BM = 256, BK = 64, HALF = 128, HTB = HALF * BK * 2  , STAGE_BYTES = 8 * HTB, NXCD = 8, WGM = 8;

__host__ __device__ __forceinline__ int lds_byte(int r, int c) { const int st = (r >> 4) * 2 + (c >> 5), rr = r & 15, cc = c & 31, ob = rr * 64 + cc * 2; return st * 1024 + (ob ^ (((ob >> 9) & 1) << 5)); }
__host__ __device__ __forceinline__ void stage_rc(int b, int& R, int& C) { const int st = b / 1024, sb = b % 1024, swz = sb ^ (((sb >> 9) & 1) << 5); R = (st >> 1) * 16 + swz / 64; C = (st & 1) * 32 + (swz % 64) / 2; }
__host__ __device__ __forceinline__ int perm32(int rho) { const int n = rho >> 4, i = rho & 15; return 8 * (i >> 2) + 4 * n + (i & 3); }

struct Unit { int pm, pn; };
struct Gemm { const bf16_t* A; const bf16_t* Bt; int M, N, K; };

struct StaticOrder {
    int nM, nN, nwg, G, c;
    __host__ __device__ void init(int M, int N, int G_, int c_) { nM = M / BM; nN = N / BM; nwg = nM * nN; G = G_; c = c_; }
    __host__ __device__ bool next(int i, Unit& u) const {
        const long L = (long)i * G + c; if (L >= nwg) return false;
        int wgid = (int)L; { const int q = nwg / NXCD, r = nwg % NXCD, xcd = wgid % NXCD, off = wgid / NXCD; wgid = (xcd < r ? xcd * (q + 1) : r * (q + 1) + (xcd - r) * q) + off; }
        const int nig = WGM * nN, gid = wgid / nig, fm = gid * WGM, gsz = (nM - fm) < WGM ? (nM - fm) : WGM;
        u.pm = fm + ((wgid % nig) % gsz); u.pn = (wgid % nig) / gsz; return true;
    }
    __device__ __forceinline__ void a_ready(const Unit&) const {}
    __device__ __forceinline__ void done(const Unit&) const {}
};


template <int MM, int NN> struct StaticOrderT {
    static constexpr int nM = MM / BM, nN = NN / BM, nwg = nM * nN;
    int G, c;
    __host__ __device__ void init(int G_, int c_) { G = G_; c = c_; }
    __host__ __device__ bool next(int i, Unit& u) const {
        const long L = (long)i * G + c; if (L >= nwg) return false;
        int wgid = (int)L; { constexpr int q = nwg / NXCD, r = nwg % NXCD; const int xcd = wgid % NXCD, off = wgid / NXCD; wgid = (xcd < r ? xcd * (q + 1) : r * (q + 1) + (xcd - r) * q) + off; }
        constexpr int nig = WGM * nN; const int gid = wgid / nig, fm = gid * WGM, gsz = (nM - fm) < WGM ? (nM - fm) : WGM;
        u.pm = fm + ((wgid % nig) % gsz); u.pn = (wgid % nig) / gsz; return true;
    }
    __device__ __forceinline__ void a_ready(const Unit&) const {}
    __device__ __forceinline__ void done(const Unit&) const {}
};
typedef float f32x2 __attribute__((ext_vector_type(2)));
__device__ __forceinline__ unsigned cvt_pk_bf16(float lo, float hi) { unsigned r; asm volatile("v_cvt_pk_bf16_f32 %0, %1, %2" : "=v"(r) : "v"(lo), "v"(hi)); return r; }
__device__ __forceinline__ u32x4 pack8(const f32x4 v0, const f32x4 v1) { u32x4 w; w.x = cvt_pk_bf16(v0[0], v0[1]); w.y = cvt_pk_bf16(v0[2], v0[3]); w.z = cvt_pk_bf16(v1[0], v1[1]); w.w = cvt_pk_bf16(v1[2], v1[3]); return w; }
__device__ __forceinline__ float silu_fast(float x) { return x * __builtin_amdgcn_rcpf(1.f + __expf(-x)); }
struct EpiBf16 {
    static constexpr bool PERM = true, AFTER_DRAIN = false;
    bf16_t* O; int ldc;
    __device__ __forceinline__ void operator()(const f32x4 (&acc)[2][2][4][2], const Unit& u, int wr, int wc, int fr, int fq) const {
        const int row0 = u.pm * BM + wr * 64 + fr, col0 = u.pn * BM + wc * 32 + 8 * fq;
#pragma unroll
        for (int ai = 0; ai < 2; ++ai)
#pragma unroll
            for (int m = 0; m < 4; ++m) { bf16_t* rowp = O + (size_t)(row0 + ai * HALF + m * 16) * ldc + col0;
#pragma unroll
                for (int bj = 0; bj < 2; ++bj) *(u32x4*)(rowp + bj * HALF) = pack8(acc[ai][bj][m][0], acc[ai][bj][m][1]); }
    }
};
struct EpiProj {
    static constexpr bool PERM = true, AFTER_DRAIN = false;
    bf16_t* O; bf16_t* AL;
    __device__ __forceinline__ void operator()(const f32x4 (&acc)[2][2][4][2], const Unit& u, int wr, int wc, int fr, int fq) const {
        const int row0 = u.pm * BM + wr * 64 + fr, col0 = u.pn * BM + wc * 32 + 8 * fq;
        if (u.pn < 10) {
#pragma unroll
            for (int ai = 0; ai < 2; ++ai)
#pragma unroll
                for (int m = 0; m < 4; ++m) { bf16_t* rowp = O + (size_t)(row0 + ai * HALF + m * 16) * 2560 + col0;
#pragma unroll
                    for (int bj = 0; bj < 2; ++bj) *(u32x4*)(rowp + bj * HALF) = pack8(acc[ai][bj][m][0], acc[ai][bj][m][1]); }
        } else if (wc == 0 && fq < 2) {
#pragma unroll
            for (int ai = 0; ai < 2; ++ai)
#pragma unroll
                for (int m = 0; m < 4; ++m) *(u32x4*)(AL + (size_t)(row0 + ai * HALF + m * 16) * 16 + 8 * fq) = pack8(acc[ai][0][m][0], acc[ai][0][m][1]);
        }
    }
};
struct EpiRes {
    static constexpr bool PERM = false, AFTER_DRAIN = false;
    float* HF; float alpha; static constexpr int ldc = 1024;
    __device__ __forceinline__ void operator()(const f32x4 (&acc)[2][2][4][2], const Unit& u, int wr, int wc, int fr, int fq) const {
        const int row0 = u.pm * BM + wr * 64 + fr, col0 = u.pn * BM + wc * 32 + 4 * fq;
#pragma unroll
        for (int ai = 0; ai < 2; ++ai)
#pragma unroll
            for (int m = 0; m < 4; ++m) { float* rowp = HF + (size_t)(row0 + ai * HALF + m * 16) * ldc + col0;
#pragma unroll
                for (int bj = 0; bj < 2; ++bj)
#pragma unroll
                    for (int n = 0; n < 2; ++n) { f32x4* p = (f32x4*)(rowp + bj * HALF + n * 16); const f32x4 h = *p; *p = h * alpha + acc[ai][bj][m][n]; } }
    }
};
struct EpiSwiglu {
    static constexpr bool PERM = true, AFTER_DRAIN = false;
    bf16_t* O; static constexpr int ldc = 2816;
    __device__ __forceinline__ void operator()(const f32x4 (&acc)[2][2][4][2], const Unit& u, int wr, int wc, int fr, int fq) const {
        const int row0 = u.pm * BM + wr * 64 + fr, col0 = u.pn * HALF + wc * 32 + 8 * fq;
#pragma unroll
        for (int ai = 0; ai < 2; ++ai)
#pragma unroll
            for (int m = 0; m < 4; ++m) { f32x4 a0, a1;
#pragma unroll
                for (int j = 0; j < 4; ++j) { a0[j] = silu_fast(acc[ai][0][m][0][j]) * acc[ai][1][m][0][j]; a1[j] = silu_fast(acc[ai][0][m][1][j]) * acc[ai][1][m][1][j]; }
                *(u32x4*)(O + (size_t)(row0 + ai * HALF + m * 16) * ldc + col0) = pack8(a0, a1); }
    }
};

__device__ __forceinline__ void row_stats8(const float* MUR, int row0, float (&mu)[2][4], float (&rs)[2][4]) {
#pragma unroll
    for (int ai = 0; ai < 2; ++ai)
#pragma unroll
        for (int m = 0; m < 4; ++m) { const f32x2 t = *(const f32x2*)(MUR + 2 * (size_t)(row0 + ai * HALF + m * 16)); mu[ai][m] = t.x; rs[ai][m] = t.y; }
}
struct EpiBf16LN {
    static constexpr bool PERM = true, AFTER_DRAIN = false;
    bf16_t* O; int ldc; const float* MUR; const float* cs; const float* cb;
    __device__ __forceinline__ void operator()(const f32x4 (&acc)[2][2][4][2], const Unit& u, int wr, int wc, int fr, int fq) const {
        const int row0 = u.pm * BM + wr * 64 + fr, col0 = u.pn * BM + wc * 32 + 8 * fq;
        float mu[2][4], rs[2][4]; row_stats8(MUR, row0, mu, rs);
#pragma unroll
        for (int bj = 0; bj < 2; ++bj) { const f32x4 s0 = *(const f32x4*)(cs + col0 + bj * HALF), s1 = *(const f32x4*)(cs + col0 + bj * HALF + 4), b0 = *(const f32x4*)(cb + col0 + bj * HALF), b1 = *(const f32x4*)(cb + col0 + bj * HALF + 4);
#pragma unroll
            for (int ai = 0; ai < 2; ++ai)
#pragma unroll
                for (int m = 0; m < 4; ++m) { const f32x4 v0 = (acc[ai][bj][m][0] - s0 * mu[ai][m]) * rs[ai][m] + b0, v1 = (acc[ai][bj][m][1] - s1 * mu[ai][m]) * rs[ai][m] + b1;
                    *(u32x4*)(O + (size_t)(row0 + ai * HALF + m * 16) * ldc + col0 + bj * HALF) = pack8(v0, v1); } }
    }
};
struct EpiProjLN {
    static constexpr bool PERM = true, AFTER_DRAIN = false;
    bf16_t* O; bf16_t* AL; const float* MUR; const float* cs; const float* cb;
    __device__ __forceinline__ void operator()(const f32x4 (&acc)[2][2][4][2], const Unit& u, int wr, int wc, int fr, int fq) const {
        const int row0 = u.pm * BM + wr * 64 + fr, col0 = u.pn * BM + wc * 32 + 8 * fq;
        float mu[2][4], rs[2][4]; row_stats8(MUR, row0, mu, rs);
        if (u.pn < 10) {
#pragma unroll
            for (int bj = 0; bj < 2; ++bj) { const f32x4 s0 = *(const f32x4*)(cs + col0 + bj * HALF), s1 = *(const f32x4*)(cs + col0 + bj * HALF + 4), b0 = *(const f32x4*)(cb + col0 + bj * HALF), b1 = *(const f32x4*)(cb + col0 + bj * HALF + 4);
#pragma unroll
                for (int ai = 0; ai < 2; ++ai)
#pragma unroll
                    for (int m = 0; m < 4; ++m) { const f32x4 v0 = (acc[ai][bj][m][0] - s0 * mu[ai][m]) * rs[ai][m] + b0, v1 = (acc[ai][bj][m][1] - s1 * mu[ai][m]) * rs[ai][m] + b1;
                        *(u32x4*)(O + (size_t)(row0 + ai * HALF + m * 16) * 2560 + col0 + bj * HALF) = pack8(v0, v1); } }
        } else if (wc == 0 && fq < 2) {
            const f32x4 s0 = *(const f32x4*)(cs + col0), s1 = *(const f32x4*)(cs + col0 + 4), b0 = *(const f32x4*)(cb + col0), b1 = *(const f32x4*)(cb + col0 + 4);
#pragma unroll
            for (int ai = 0; ai < 2; ++ai)
#pragma unroll
                for (int m = 0; m < 4; ++m) { const f32x4 v0 = (acc[ai][0][m][0] - s0 * mu[ai][m]) * rs[ai][m] + b0, v1 = (acc[ai][0][m][1] - s1 * mu[ai][m]) * rs[ai][m] + b1;
                    *(u32x4*)(AL + (size_t)(row0 + ai * HALF + m * 16) * 16 + 8 * fq) = pack8(v0, v1); }
        }
    }
};
struct EpiSwigluLN {
    static constexpr bool PERM = true, AFTER_DRAIN = false;
    bf16_t* O; const float* MUR; const float* cs; const float* cb; static constexpr int ldc = 2816;
    __device__ __forceinline__ void operator()(const f32x4 (&acc)[2][2][4][2], const Unit& u, int wr, int wc, int fr, int fq) const {
        const int row0 = u.pm * BM + wr * 64 + fr, wrow = u.pn * BM + wc * 32 + 8 * fq, col0 = u.pn * HALF + wc * 32 + 8 * fq;
        float mu[2][4], rs[2][4]; row_stats8(MUR, row0, mu, rs);
        const f32x4 sg0 = *(const f32x4*)(cs + wrow), sg1 = *(const f32x4*)(cs + wrow + 4), bg0 = *(const f32x4*)(cb + wrow), bg1 = *(const f32x4*)(cb + wrow + 4);
        const f32x4 su0 = *(const f32x4*)(cs + wrow + HALF), su1 = *(const f32x4*)(cs + wrow + HALF + 4), bu0 = *(const f32x4*)(cb + wrow + HALF), bu1 = *(const f32x4*)(cb + wrow + HALF + 4);
#pragma unroll
        for (int ai = 0; ai < 2; ++ai)
#pragma unroll
            for (int m = 0; m < 4; ++m) {
                const f32x4 g0 = (acc[ai][0][m][0] - sg0 * mu[ai][m]) * rs[ai][m] + bg0, g1 = (acc[ai][0][m][1] - sg1 * mu[ai][m]) * rs[ai][m] + bg1;
                const f32x4 u0 = (acc[ai][1][m][0] - su0 * mu[ai][m]) * rs[ai][m] + bu0, u1 = (acc[ai][1][m][1] - su1 * mu[ai][m]) * rs[ai][m] + bu1;
                f32x4 a0, a1;
#pragma unroll
                for (int j = 0; j < 4; ++j) { a0[j] = silu_fast(g0[j]) * u0[j]; a1[j] = silu_fast(g1[j]) * u1[j]; }
                *(u32x4*)(O + (size_t)(row0 + ai * HALF + m * 16) * ldc + col0) = pack8(a0, a1); }
    }
};
struct EpiResLN {
    static constexpr bool PERM = false, AFTER_DRAIN = false;
    const float* Xin; float* Yout; bf16_t* YB; float* MUR; const float* gp; const float* bp; unsigned long long* slots; unsigned* cnt; float alpha; PG8_LAS unsigned char* lds;
    __device__ __forceinline__ void operator()(f32x4 (&acc)[2][2][4][2], const Unit& u, int wr, int wc, int fr, int fq) const {
        typedef unsigned u32x2 __attribute__((ext_vector_type(2)));
        const int row0 = u.pm * BM + wr * 64 + fr, col0 = u.pn * BM + wc * 32 + 4 * fq;
        float mu[2][4], rs[2][4]; row_stats8(MUR, row0, mu, rs);
#pragma unroll
        for (int bj = 0; bj < 2; ++bj)
#pragma unroll
            for (int n = 0; n < 2; ++n) { const f32x4 g4 = *(const f32x4*)(gp + col0 + bj * HALF + n * 16), b4 = *(const f32x4*)(bp + col0 + bj * HALF + n * 16);
#pragma unroll
                for (int ai = 0; ai < 2; ++ai)
#pragma unroll
                    for (int m = 0; m < 4; ++m) { const size_t off = (size_t)(row0 + ai * HALF + m * 16) * 1024 + col0 + bj * HALF + n * 16;
                        f32x4 yo;
                        if (Xin) yo = *(const f32x4*)(Xin + off);
                        else { const u32x2 t = *(const u32x2*)(YB + off); yo = (f32x4){__uint_as_float(t.x << 16), __uint_as_float(t.x & 0xffff0000u), __uint_as_float(t.y << 16), __uint_as_float(t.y & 0xffff0000u)}; }
                        const f32x4 yn = ((yo - mu[ai][m]) * rs[ai][m] * g4 + b4) * alpha + acc[ai][bj][m][n];
                        acc[ai][bj][m][n] = yn; if (Yout) *(f32x4*)(Yout + off) = yn;
                        u32x2 w; w.x = cvt_pk_bf16(yn[0], yn[1]); w.y = cvt_pk_bf16(yn[2], yn[3]); *(u32x2*)(YB + off) = w; } }
        PG8_LAS f32x2* P = (PG8_LAS f32x2*)(lds + 131072);
#pragma unroll
        for (int ai = 0; ai < 2; ++ai)
#pragma unroll
            for (int m = 0; m < 4; ++m) {
                float s = 0.f;
#pragma unroll
                for (int bj = 0; bj < 2; ++bj)
#pragma unroll
                    for (int n = 0; n < 2; ++n) { const f32x4 x = acc[ai][bj][m][n]; s += (x[0] + x[1]) + (x[2] + x[3]); }
                s += __shfl_xor(s, 16); s += __shfl_xor(s, 32);
                const float mw = s * (1.0f / 64.0f); float q = 0.f;
#pragma unroll
                for (int bj = 0; bj < 2; ++bj)
#pragma unroll
                    for (int n = 0; n < 2; ++n) { const f32x4 d = acc[ai][bj][m][n] - mw; q += (d[0] * d[0] + d[1] * d[1]) + (d[2] * d[2] + d[3] * d[3]); }
                q += __shfl_xor(q, 16); q += __shfl_xor(q, 32);
                if (fq == 0) P[(ai * HALF + wr * 64 + m * 16 + fr) * 4 + wc] = (f32x2){mw, q};
            }
        asm volatile("s_waitcnt lgkmcnt(0)" ::: "memory"); __builtin_amdgcn_s_barrier(); asm volatile("" ::: "memory");
        const int wid = wr * 4 + wc, lane = fq * 16 + fr, row = wid * 32 + (lane & 31);
        if (lane < 32) {
            const f32x2 a = P[row * 4 + 0], b = P[row * 4 + 1], c = P[row * 4 + 2], d = P[row * 4 + 3];
            const float mt = (a.x + b.x + c.x + d.x) * 0.25f;
            const float da = a.x - mt, db = b.x - mt, dc = c.x - mt, dd = d.x - mt;
            const float m2 = (a.y + b.y) + (c.y + d.y) + 64.0f * ((da * da + db * db) + (dc * dc + dd * dd));
            __hip_atomic_store(slots + ((size_t)(u.pm * BM + row) * 4 + u.pn), ((unsigned long long)__float_as_uint(m2) << 32) | __float_as_uint(mt), __ATOMIC_RELAXED, __HIP_MEMORY_SCOPE_AGENT);
        }
        asm volatile("s_waitcnt vmcnt(0)" ::: "memory");
        unsigned old = 0u;
        if (lane == 0) old = __hip_atomic_fetch_add(cnt + u.pm, 1u, __ATOMIC_RELAXED, __HIP_MEMORY_SCOPE_AGENT);
        old = (unsigned)__builtin_amdgcn_readfirstlane((int)old);
        if (old == 31u) {
            __builtin_amdgcn_fence(__ATOMIC_ACQUIRE, "agent");
#pragma unroll
            for (int rr = 0; rr < 4; ++rr) { const int r = lane * 4 + rr; const unsigned long long* sl = slots + (size_t)(u.pm * BM + r) * 4; float mt[4], m2[4], ms = 0.f;
#pragma unroll
                for (int t = 0; t < 4; ++t) { const unsigned long long w = __hip_atomic_load(sl + t, __ATOMIC_RELAXED, __HIP_MEMORY_SCOPE_AGENT); mt[t] = __uint_as_float((unsigned)w); m2[t] = __uint_as_float((unsigned)(w >> 32)); ms += mt[t]; }
                const float mean = ms * 0.25f; float q = 0.f;
#pragma unroll
                for (int t = 0; t < 4; ++t) { const float dm = mt[t] - mean; q += m2[t] + 256.0f * dm * dm; }
                *(f32x2*)(MUR + 2 * (size_t)(u.pm * BM + r)) = (f32x2){mean, 1.0f / sqrtf(q * (1.0f / 1024.0f) + 1e-5f)}; }
        }
    }
};

template <class Epi, class Sched, bool ALIGN_EPI, bool SP2, int KC>
__device__ __forceinline__ void gemm_phase(PG8_LAS unsigned char* lds, const Gemm g, const Sched& S, const Epi& E, const int tid) {
    const int wid = __builtin_amdgcn_readfirstlane(tid >> 6), lane = tid & 63, wr = wid >> 2, wc = wid & 3, fr = lane & 15, fq = lane >> 4;
    constexpr int K = KC, nt = K / BK;
    unsigned voffA[2], voffB[2];
#pragma unroll
    for (int i = 0; i < 2; ++i) { int R, C; stage_rc(tid * 16 + i * 8192, R, C); const int Rb = Epi::PERM ? ((R & ~31) + perm32(R & 31)) : R;
        voffA[i] = (unsigned)(R * K + C) * 2u; voffB[i] = (unsigned)(Rb * K + C) * 2u; }
    const size_t kstep = (size_t)(BK * 2);
    const size_t hstep = (size_t)HALF * K * 2;
    const size_t tstep = 2 * hstep;
    const unsigned ldsw = (unsigned)wid * 1024u;
    const int aoff = lds_byte(wr * 64 + fr, fq * 8), boff = lds_byte(wc * 32 + fr, fq * 8);
#define PG8_SA(b, h) (((b) * 2 + (h)) * HTB)
#define PG8_SB(b, h) ((4 + (b) * 2 + (h)) * HTB)
#define PG8_STAGE(bufoff, gbase, voff) do { _Pragma("unroll") for (int _i = 0; _i < 2; ++_i) \
        __builtin_amdgcn_global_load_lds((const unsigned*)((const char*)(gbase) + (voff)[_i]), (PG8_LAS unsigned*)(lds + (bufoff) + ldsw + _i * 8192), 16, 0, 0); } while (0)
#define PG8_LDA(dst, b, h) do { _Pragma("unroll") for (int m = 0; m < 4; ++m) _Pragma("unroll") for (int k = 0; k < 2; ++k) dst[m][k] = *(const PG8_LAS bf16x8*)(lds + PG8_SA(b, h) + aoff + m * 2048 + k * 1024); } while (0)
#define PG8_LDB(dst, b, h) do { _Pragma("unroll") for (int n = 0; n < 2; ++n) _Pragma("unroll") for (int k = 0; k < 2; ++k) dst[n][k] = *(const PG8_LAS bf16x8*)(lds + PG8_SB(b, h) + boff + n * 2048 + k * 1024); } while (0)
#define PG8_MMA(ai, bj, At, Bt) do { __builtin_amdgcn_s_setprio(1); _Pragma("unroll") for (int m = 0; m < 4; ++m) _Pragma("unroll") for (int n = 0; n < 2; ++n) _Pragma("unroll") for (int k = 0; k < 2; ++k) \
        acc[ai][bj][m][n] = __builtin_amdgcn_mfma_f32_16x16x32_bf16(Bt[n][k], At[m][k], acc[ai][bj][m][n], 0, 0, 0); __builtin_amdgcn_s_setprio(0); } while (0)
#define PG8_WAIT_V(n) asm volatile("s_waitcnt vmcnt(" #n ")" ::: "memory")
#define PG8_WAIT_L(n) asm volatile("s_waitcnt lgkmcnt(" #n ")" ::: "memory")
#define PG8_BAR __builtin_amdgcn_s_barrier()
#define PG8_SCHED __builtin_amdgcn_sched_barrier(0)
    Unit cur, nxt; int ui = 0;
    if (!S.next(0, cur)) return;
    f32x4 acc[2][2][4][2];
#pragma unroll
    for (int a = 0; a < 2; ++a)
#pragma unroll
        for (int b = 0; b < 2; ++b)
#pragma unroll
            for (int m = 0; m < 4; ++m)
#pragma unroll
                for (int n = 0; n < 2; ++n) acc[a][b][m][n] = (f32x4){0.f, 0.f, 0.f, 0.f};
    bf16x8 At[4][2], B0[2][2], B1[2][2];
    const char* cA = (const char*)g.A + (size_t)cur.pm * tstep; const char* cB = (const char*)g.Bt + (size_t)cur.pn * tstep;
    S.a_ready(cur);
    if constexpr (SP2) {
        PG8_STAGE(PG8_SB(0, 0), cB, voffB); PG8_STAGE(PG8_SB(0, 1), cB + hstep, voffB); PG8_STAGE(PG8_SA(0, 0), cA, voffA); PG8_STAGE(PG8_SA(0, 1), cA + hstep, voffA);
        if (wr == 1) PG8_BAR;
        PG8_WAIT_V(2); PG8_BAR;
        PG8_STAGE(PG8_SB(1, 0), cB + kstep, voffB); PG8_STAGE(PG8_SA(1, 0), cA + kstep, voffA); PG8_STAGE(PG8_SB(1, 1), cB + hstep + kstep, voffB);
        PG8_WAIT_V(6); PG8_BAR;
    } else {
        PG8_STAGE(PG8_SB(0, 0), cB, voffB); PG8_STAGE(PG8_SA(0, 0), cA, voffA); PG8_STAGE(PG8_SB(0, 1), cB + hstep, voffB); PG8_STAGE(PG8_SA(0, 1), cA + hstep, voffA);
        if (wr == 1) PG8_BAR;
        PG8_WAIT_V(4); PG8_BAR;
        PG8_STAGE(PG8_SB(1, 0), cB + kstep, voffB); PG8_STAGE(PG8_SA(1, 0), cA + kstep, voffA); PG8_STAGE(PG8_SB(1, 1), cB + hstep + kstep, voffB);
        PG8_WAIT_V(6); PG8_BAR;
    }
    for (;;) {
        const bool has_next = S.next(ui + 1, nxt);
        const char* nA = has_next ? (const char*)g.A + (size_t)nxt.pm * tstep : cA; const char* nB = has_next ? (const char*)g.Bt + (size_t)nxt.pn * tstep : cB;
        for (int t = 0; t < nt; t += 2) {
            const bool last = (t == nt - 2);
            const char* a1 = cA + (size_t)(t + 1) * kstep;
            const char* a2 = last ? nA : cA + (size_t)(t + 2) * kstep; const char* b2 = last ? nB : cB + (size_t)(t + 2) * kstep;
            const char* a3 = a2 + kstep; const char* b3 = b2 + kstep;
            if (last && has_next) S.a_ready(nxt);
            if constexpr (SP2) {
            PG8_LDB(B0, 0, 0); PG8_LDB(B1, 0, 1); PG8_SCHED; PG8_LDA(At, 0, 0); PG8_STAGE(PG8_SA(1, 1), a1 + hstep, voffA);
            PG8_WAIT_V(8); PG8_WAIT_L(0); PG8_BAR; PG8_MMA(0, 0, At, B0); PG8_MMA(0, 1, At, B1); PG8_BAR; PG8_SCHED;
            PG8_LDA(At, 0, 1); PG8_STAGE(PG8_SB(0, 0), b2, voffB); PG8_STAGE(PG8_SB(0, 1), b2 + hstep, voffB); PG8_STAGE(PG8_SA(0, 0), a2, voffA);
            PG8_WAIT_V(8); PG8_WAIT_L(0); PG8_BAR; PG8_MMA(1, 0, At, B0); PG8_MMA(1, 1, At, B1); PG8_BAR; PG8_SCHED;
            PG8_LDB(B0, 1, 0); PG8_LDB(B1, 1, 1); PG8_SCHED; PG8_LDA(At, 1, 0); PG8_STAGE(PG8_SA(0, 1), a2 + hstep, voffA);
            PG8_WAIT_V(8); PG8_WAIT_L(0); PG8_BAR; PG8_MMA(0, 0, At, B0); PG8_MMA(0, 1, At, B1); PG8_BAR; PG8_SCHED;
            PG8_LDA(At, 1, 1); PG8_STAGE(PG8_SB(1, 0), b3, voffB); PG8_STAGE(PG8_SB(1, 1), b3 + hstep, voffB); PG8_STAGE(PG8_SA(1, 0), a3, voffA);
            PG8_WAIT_V(8); PG8_WAIT_L(0); PG8_BAR; PG8_MMA(1, 0, At, B0); PG8_MMA(1, 1, At, B1); PG8_BAR; PG8_SCHED;
            } else {
            PG8_LDB(B0, 0, 0); PG8_SCHED; PG8_LDA(At, 0, 0); PG8_STAGE(PG8_SA(1, 1), a1 + hstep, voffA);
            PG8_WAIT_L(8); PG8_BAR; PG8_WAIT_L(0); PG8_MMA(0, 0, At, B0); PG8_BAR; PG8_SCHED;
            PG8_LDB(B1, 0, 1); PG8_STAGE(PG8_SB(0, 0), b2, voffB);
            PG8_BAR; PG8_WAIT_L(0); PG8_MMA(0, 1, At, B1); PG8_BAR;
            PG8_LDA(At, 0, 1); PG8_STAGE(PG8_SA(0, 0), a2, voffA);
            PG8_BAR; PG8_WAIT_L(0); PG8_MMA(1, 0, At, B0); PG8_BAR; PG8_SCHED;
            PG8_STAGE(PG8_SB(0, 1), b2 + hstep, voffB);
            PG8_WAIT_V(6); PG8_BAR; PG8_MMA(1, 1, At, B1); PG8_BAR;
            PG8_LDB(B0, 1, 0); PG8_SCHED; PG8_LDA(At, 1, 0); PG8_STAGE(PG8_SA(0, 1), a2 + hstep, voffA);
            PG8_WAIT_L(8); PG8_BAR; PG8_WAIT_L(0); PG8_MMA(0, 0, At, B0); PG8_BAR; PG8_SCHED;
            PG8_LDB(B1, 1, 1); PG8_STAGE(PG8_SB(1, 0), b3, voffB);
            PG8_BAR; PG8_WAIT_L(0); PG8_MMA(0, 1, At, B1); PG8_BAR;
            PG8_LDA(At, 1, 1); PG8_STAGE(PG8_SA(1, 0), a3, voffA);
            PG8_BAR; PG8_WAIT_L(0); PG8_MMA(1, 0, At, B0); PG8_BAR; PG8_SCHED;
            PG8_STAGE(PG8_SB(1, 1), b3 + hstep, voffB);
            PG8_WAIT_V(6); PG8_BAR; PG8_MMA(1, 1, At, B1); PG8_BAR;
            }
        }
        if constexpr (ALIGN_EPI) { if (wr == 0) PG8_BAR; }
        if constexpr (!Epi::AFTER_DRAIN) { E(acc, cur, wr, wc, fr, fq); S.done(cur); }
        if (!has_next) break;
#pragma unroll
        for (int a = 0; a < 2; ++a)
#pragma unroll
            for (int b = 0; b < 2; ++b)
#pragma unroll
                for (int m = 0; m < 4; ++m)
#pragma unroll
                    for (int n = 0; n < 2; ++n) acc[a][b][m][n] = (f32x4){0.f, 0.f, 0.f, 0.f};
        cur = nxt; cA = nA; cB = nB; ++ui;
        if constexpr (ALIGN_EPI) { if (wr == 1) PG8_BAR; }
    }
    PG8_WAIT_V(0);
    if constexpr (!ALIGN_EPI) { if (wr == 0) PG8_BAR; }
    PG8_BAR;
    if constexpr (Epi::AFTER_DRAIN) { E.fused(acc, cur, wr, wc, fr, fq, lds, wid, lane); S.done(cur); }
#undef PG8_SA
#undef PG8_SB
#undef PG8_STAGE
#undef PG8_LDA
#undef PG8_LDB
#undef PG8_MMA
#undef PG8_WAIT_V
#undef PG8_WAIT_L
#undef PG8_BAR
#undef PG8_SCHED
}
}
namespace cg = cooperative_groups;
#define LAS __attribute__((address_space(3)))
#define LDS_WAIT() asm volatile("s_waitcnt lgkmcnt(0)" ::: "memory")
constexpr int NWAVES = 8, LDS_BYTES = 147456;
constexpr size_t WT_XK = 0, WT_XV = (size_t)4096 * 1024, WT_L0 = (size_t)2 * 4096 * 1024, WT_LSTRIDE = 14680064;
constexpr size_t WO_IN = 0, WO_MIX = 2883584, WO_XQ = WO_MIX + 1048576, WO_XO = WO_XQ + 1048576, WO_FF1 = WO_XO + 1048576, WO_FF2 = WO_FF1 + 5767168;
static_assert(WO_FF2 + 2883584 == WT_LSTRIDE && (WT_L0 + 4 * WT_LSTRIDE) * 2 == 128 * MiB, "weight map");
constexpr int I_IN = 16 * 81, I_SQ = 512, I_XKV = 1024, I_FF1 = 16 * 176, I_FF2 = 44 * 32, I_LAYER = I_IN + 3 * I_SQ + I_XKV + I_FF1 + I_FF2;

struct Args { const float* in[24]; float* out; unsigned char* ws; int ph_lo, ph_hi, sub, pad; };

__device__ __forceinline__ unsigned pk2(float lo, float hi) { return (unsigned)f2bf(lo) | ((unsigned)f2bf(hi) << 16); }
__device__ __forceinline__ void cvt_item(const float* W, int K, int N, int k0, int n0, bf16_t* dst, LAS float* scr, int lane) {
#pragma unroll 8
    for (int i = 0; i < 32; ++i) { const int kk = 2 * i + (lane >> 5), n = n0 + (lane & 31); scr[kk * 33 + (lane & 31)] = n < N ? W[(size_t)(k0 + kk) * N + n] : 0.f; }
    LDS_WAIT(); asm volatile("" ::: "memory");
    const int c = lane & 7;
#pragma unroll
    for (int j = 0; j < 4; ++j) { const int n = (lane >> 3) + 8 * j; const LAS float* s = scr + (8 * c) * 33 + n;
        u32x4 o; o.x = pk2(s[0 * 33], s[1 * 33]); o.y = pk2(s[2 * 33], s[3 * 33]); o.z = pk2(s[4 * 33], s[5 * 33]); o.w = pk2(s[6 * 33], s[7 * 33]);
        *(u32x4*)(dst + (size_t)n * K + k0 + 8 * c) = o; }
    LDS_WAIT(); asm volatile("" ::: "memory");
}
__device__ __forceinline__ void ln_row(const float* in, float* outf, bf16_t* outb, const float* g, const float* b, int lane) {
    const f32x4* xr = (const f32x4*)in + lane;
    f32x4 v[4]; float s = 0.f;
#pragma unroll
    for (int j = 0; j < 4; ++j) { v[j] = xr[64 * j]; s += (v[j].x + v[j].y) + (v[j].z + v[j].w); }
    const float mean = wave_sum(s) * (1.f / D); float s2 = 0.f;
#pragma unroll
    for (int j = 0; j < 4; ++j) { v[j] = v[j] - mean; s2 += (v[j].x * v[j].x + v[j].y * v[j].y) + (v[j].z * v[j].z + v[j].w * v[j].w); }
    const float rstd = rsqrtf(wave_sum(s2) * (1.f / D) + LN_EPS);
#pragma unroll
    for (int j = 0; j < 4; ++j) {
        const int c = (64 * j + lane) * 4;
        const f32x4 o = v[j] * rstd * *(const f32x4*)(g + c) + *(const f32x4*)(b + c);
        *((f32x4*)outf + 64 * j + lane) = o;
        *(unsigned long long*)(outb + c) = (unsigned long long)pk2(o.x, o.y) | ((unsigned long long)pk2(o.z, o.w) << 32);
    }
}


__device__ __forceinline__ void cvt_item_ln(const float* W, int K, int N, int k0, int n0, bf16_t* dst, LAS float* scr, int lane, const float* g, const float* b, float* csp, float* cbp) {
    float cs = 0.f, cb = 0.f;
#pragma unroll 8
    for (int i = 0; i < 32; ++i) { const int kk = 2 * i + (lane >> 5), n = n0 + (lane & 31); const float w = n < N ? W[(size_t)(k0 + kk) * N + n] : 0.f; const float wg = w * g[k0 + kk];
        scr[kk * 33 + (lane & 31)] = wg; cs += bf2f(f2bf(wg)); cb += b[k0 + kk] * w; }
    cs += __shfl_xor(cs, 32); cb += __shfl_xor(cb, 32);
    if (lane < 32) { csp[lane] = cs; cbp[lane] = cb; }
    LDS_WAIT(); asm volatile("" ::: "memory");
    const int c = lane & 7;
#pragma unroll
    for (int j = 0; j < 4; ++j) { const int n = (lane >> 3) + 8 * j; const LAS float* s = scr + (8 * c) * 33 + n;
        u32x4 o; o.x = pk2(s[0 * 33], s[1 * 33]); o.y = pk2(s[2 * 33], s[3 * 33]); o.z = pk2(s[4 * 33], s[5 * 33]); o.w = pk2(s[6 * 33], s[7 * 33]);
        *(u32x4*)(dst + (size_t)n * K + k0 + 8 * c) = o; }
    LDS_WAIT(); asm volatile("" ::: "memory");
}
__device__ __forceinline__ void x_row(const float* in, bf16_t* outb, float* mur, int lane) {
    const f32x4* xr = (const f32x4*)in + lane;
    f32x4 v[4]; float s = 0.f;
#pragma unroll
    for (int j = 0; j < 4; ++j) { v[j] = xr[64 * j]; s += (v[j].x + v[j].y) + (v[j].z + v[j].w);
        *(unsigned long long*)(outb + (64 * j + lane) * 4) = (unsigned long long)pk2(v[j].x, v[j].y) | ((unsigned long long)pk2(v[j].z, v[j].w) << 32); }
    const float mean = wave_sum(s) * (1.f / D); float s2 = 0.f;
#pragma unroll
    for (int j = 0; j < 4; ++j) { const f32x4 d = v[j] - mean; s2 += (d.x * d.x + d.y * d.y) + (d.z * d.z + d.w * d.w); }
    const float rstd = rsqrtf(wave_sum(s2) * (1.f / D) + LN_EPS);
    if (lane == 0) { mur[0] = mean; mur[1] = rstd; }
}
__device__ __forceinline__ void ln_row_f32(float* io, const float* g, const float* b, int lane) {
    f32x4* xr = (f32x4*)io + lane;
    f32x4 v[4]; float s = 0.f;
#pragma unroll
    for (int j = 0; j < 4; ++j) { v[j] = xr[64 * j]; s += (v[j].x + v[j].y) + (v[j].z + v[j].w); }
    const float mean = wave_sum(s) * (1.f / D); float s2 = 0.f;
#pragma unroll
    for (int j = 0; j < 4; ++j) { v[j] = v[j] - mean; s2 += (v[j].x * v[j].x + v[j].y * v[j].y) + (v[j].z * v[j].z + v[j].w * v[j].w); }
    const float rstd = rsqrtf(wave_sum(s2) * (1.f / D) + LN_EPS);
#pragma unroll
    for (int j = 0; j < 4; ++j) { const int c = (64 * j + lane) * 4; xr[64 * j] = v[j] * rstd * *(const f32x4*)(g + c) + *(const f32x4*)(b + c); }
}
typedef short bf16x8_t __attribute__((ext_vector_type(8)));
typedef unsigned u32x2_t __attribute__((ext_vector_type(2)));
__device__ __forceinline__ unsigned cvtpk(float lo, float hi) { unsigned r; asm volatile("v_cvt_pk_bf16_f32 %0, %1, %2" : "=v"(r) : "v"(lo), "v"(hi)); return r; }
__device__ __forceinline__ void att_stage(LAS unsigned char* lds, const bf16_t* src, int pitch, int tid) {
    const int r0 = tid >> 5, ch = tid & 31;
    const bf16_t* g0 = src + (size_t)r0 * pitch + ch * 8;
    LAS unsigned char* l0 = lds + r0 * 512 + ((ch ^ r0) << 4);
    u32x4 v[16];
#pragma unroll
    for (int x = 0; x < 16; ++x) v[x] = *(const u32x4*)(g0 + (size_t)(16 * x) * pitch);
#pragma unroll
    for (int x = 0; x < 16; ++x) *(LAS u32x4*)(l0 + x * 8192) = v[x];
}
__device__ __forceinline__ void att_phase(LAS unsigned char* lds, const bf16_t* Kl, const bf16_t* Vl, const bf16_t* Qb, bf16_t* Ob, int G, int tid) {
    for (int u = blockIdx.x; u < (M / 128) * 4; u += G) {
        asm volatile("" : "+v"(tid));
        const int lane = tid & 63, wave = __builtin_amdgcn_readfirstlane(tid >> 6), j = lane & 15, kg = lane >> 4;
        const int h = u & 3, pm = u >> 2, b = pm >> 6;
        att_stage(lds, Kl + (size_t)(b * 256) * 4096 + h * 256, 4096, tid);
        const bf16_t* qrow = Qb + (size_t)(pm * 128 + 16 * wave + j) * 1024 + h * 256;
        bf16_t* orow = Ob + (size_t)(pm * 128 + 16 * wave + j) * 1024 + h * 256;
        bf16x8_t qf[8];
#pragma unroll
        for (int s = 0; s < 8; ++s) qf[s] = *(const bf16x8_t*)(qrow + 32 * s + 8 * kg);
        __syncthreads();
        f32x4 acc[16];
#pragma unroll
        for (int kb = 0; kb < 16; ++kb) acc[kb] = (f32x4){0.f, 0.f, 0.f, 0.f};
        const LAS unsigned char* fbase = lds + j * 512;
#pragma unroll
        for (int s = 0; s < 8; ++s)
#pragma unroll
            for (int kb = 0; kb < 16; ++kb) { const bf16x8_t af = *(const LAS bf16x8_t*)(fbase + kb * 8192 + (((4 * s + kg) ^ j) << 4));
                acc[kb] = __builtin_amdgcn_mfma_f32_16x16x32_bf16(af, qf[s], acc[kb], 0, 0, 0); }
        float mx = acc[0][0];
#pragma unroll
        for (int kb = 0; kb < 16; ++kb) mx = fmaxf(fmaxf(mx, fmaxf(acc[kb][0], acc[kb][1])), fmaxf(acc[kb][2], acc[kb][3]));
        mx = fmaxf(mx, __shfl_xor(mx, 16)); mx = fmaxf(mx, __shfl_xor(mx, 32));
        const float cs = 0.0625f * 1.4426950408889634f, mxc = mx * cs; float sum = 0.f;
        bf16x8_t pf[8];
#pragma unroll
        for (int t = 0; t < 8; ++t) { f32x4 p0, p1;
#pragma unroll
            for (int e = 0; e < 4; ++e) { p0[e] = __builtin_amdgcn_exp2f(acc[2 * t][e] * cs - mxc); p1[e] = __builtin_amdgcn_exp2f(acc[2 * t + 1][e] * cs - mxc); }
            sum += (p0[0] + p0[1]) + (p0[2] + p0[3]) + (p1[0] + p1[1]) + (p1[2] + p1[3]);
            u32x4 w; w.x = cvtpk(p0[0], p0[1]); w.y = cvtpk(p0[2], p0[3]); w.z = cvtpk(p1[0], p1[1]); w.w = cvtpk(p1[2], p1[3]); pf[t] = __builtin_bit_cast(bf16x8_t, w); }
        sum += __shfl_xor(sum, 16); sum += __shfl_xor(sum, 32);
        const float inv = 1.f / sum;
        __syncthreads();
        att_stage(lds, Vl + (size_t)(h * 256) * 1024 + b * 256, 1024, tid);
        __syncthreads();
#pragma unroll
        for (int db = 0; db < 16; ++db) {
            f32x4 o = (f32x4){0.f, 0.f, 0.f, 0.f};
#pragma unroll
            for (int t = 0; t < 8; ++t) { const bf16x8_t af = *(const LAS bf16x8_t*)(fbase + db * 8192 + (((4 * t + kg) ^ j) << 4));
                o = __builtin_amdgcn_mfma_f32_16x16x32_bf16(af, pf[t], o, 0, 0, 0); }
            u32x2_t w; w.x = cvtpk(o[0] * inv, o[1] * inv); w.y = cvtpk(o[2] * inv, o[3] * inv);
            *(u32x2_t*)(orow + 16 * db + 4 * kg) = w;
        }
        __syncthreads();
    }
}

__device__ __forceinline__ void conv_phase(LAS unsigned char* lds, const bf16_t* PROJ, const float* cw, const float* cb, const float* lg, const float* lb, bf16_t* MIXIN, int G, int tid) {
    LAS float* U = (LAS float*)lds;
    for (int u = blockIdx.x; u < M / 32; u += G) {
        asm volatile("" : "+v"(tid));
        const int lane = tid & 63, wave = __builtin_amdgcn_readfirstlane(tid >> 6);
        const int row0 = u * 32, t0 = row0 % SEQ;
#pragma unroll
        for (int pass = 0; pass < 8; ++pass) { const int rr = pass * 8 + wave;
            if (rr < 62) { f32x4 o0 = (f32x4){0.f, 0.f, 0.f, 0.f}, o1 = o0;
                if (t0 - 30 + rr >= 0) { const bf16_t* pr = PROJ + (size_t)(row0 - 30 + rr) * PROJ_LD + 8 * lane;
                    const u32x4 a = *(const u32x4*)(pr + C_CA), g = *(const u32x4*)(pr + C_CG);
#pragma unroll
                    for (int x = 0; x < 4; ++x) { const float a0 = __uint_as_float(a[x] << 16), a1 = __uint_as_float(a[x] & 0xffff0000u), g0 = __uint_as_float(g[x] << 16), g1 = __uint_as_float(g[x] & 0xffff0000u);
                        const float u0 = a0 * __builtin_amdgcn_rcpf(1.f + __expf(-g0)), u1 = a1 * __builtin_amdgcn_rcpf(1.f + __expf(-g1));
                        if (x < 2) { o0[2 * x] = u0; o0[2 * x + 1] = u1; } else { o1[2 * x - 4] = u0; o1[2 * x - 3] = u1; } } }
                *(LAS f32x4*)(U + rr * 512 + 8 * lane) = o0; *(LAS f32x4*)(U + rr * 512 + 8 * lane + 4) = o1; } }
        __syncthreads();
        const int c = tid;
        float w[31];
#pragma unroll
        for (int k = 0; k < 31; ++k) w[k] = cw[k * 512 + c];
        const float bias = cb[c];
        float y[32];
#pragma unroll
        for (int blk = 0; blk < 4; ++blk) { float win[38];
#pragma unroll
            for (int x = 0; x < 38; ++x) win[x] = U[(8 * blk + x) * 512 + c];
#pragma unroll
            for (int o = 0; o < 8; ++o) { float acc = bias;
#pragma unroll
                for (int k = 0; k < 31; ++k) acc += w[k] * win[o + k];
                y[8 * blk + o] = acc; } }
        __syncthreads();
#pragma unroll
        for (int tt = 0; tt < 32; ++tt) U[tt * 512 + c] = y[tt];
        __syncthreads();
#pragma unroll
        for (int q = 0; q < 4; ++q) { const int tt = 4 * wave + q;
            f32x4 a = *(const LAS f32x4*)(U + tt * 512 + 8 * lane), b = *(const LAS f32x4*)(U + tt * 512 + 8 * lane + 4);
            const float mean = wave_sum((a[0] + a[1]) + (a[2] + a[3]) + (b[0] + b[1]) + (b[2] + b[3])) * (1.f / 512.f);
            a = a - mean; b = b - mean;
            const float var = wave_sum((a[0] * a[0] + a[1] * a[1]) + (a[2] * a[2] + a[3] * a[3]) + (b[0] * b[0] + b[1] * b[1]) + (b[2] * b[2] + b[3] * b[3])) * (1.f / 512.f);
            const float rstd = rsqrtf(var + LN_EPS);
            a = a * rstd * *(const f32x4*)(lg + 8 * lane) + *(const f32x4*)(lb + 8 * lane); b = b * rstd * *(const f32x4*)(lg + 8 * lane + 4) + *(const f32x4*)(lb + 8 * lane + 4);
#pragma unroll
            for (int x = 0; x < 4; ++x) { a[x] = pg8::silu_fast(a[x]); b[x] = pg8::silu_fast(b[x]); }
            *(u32x4*)(MIXIN + (size_t)(row0 + tt) * D + 8 * lane) = pg8::pack8(a, b); }
        __syncthreads();
    }
}

typedef float f32x16_t __attribute__((ext_vector_type(16)));
constexpr int GP = 72;
__device__ __forceinline__ int slot32(int c) { const int w = c & 15; return (c & ~15) + 8 * ((w >> 2) & 1) + (w & 3) + 4 * (w >> 3); }
__device__ __forceinline__ void gla_bcum(const bf16_t* ALOW, const float* wa2, const float* ba, int row0, int h, int lane, int wave, float (&bc)[8], float (&bl)[8]) {
    const u32x4 a0 = *(const u32x4*)(ALOW + (size_t)(row0 + lane) * 16), a1 = *(const u32x4*)(ALOW + (size_t)(row0 + lane) * 16 + 8);
    float al[16];
#pragma unroll
    for (int x = 0; x < 4; ++x) { al[2 * x] = __uint_as_float(a0[x] << 16); al[2 * x + 1] = __uint_as_float(a0[x] & 0xffff0000u); al[8 + 2 * x] = __uint_as_float(a1[x] << 16); al[8 + 2 * x + 1] = __uint_as_float(a1[x] & 0xffff0000u); }
#pragma unroll
    for (int x = 0; x < 8; ++x) { const int col = h * 64 + 8 * wave + x; float z = ba[col];
#pragma unroll
        for (int i = 0; i < 16; ++i) z += al[i] * wa2[i * 256 + col];
        float la = (fminf(z, 0.f) - log1pf(__expf(-fabsf(z)))) * (1.f / 16.f);
#pragma unroll
        for (int off = 1; off < 64; off <<= 1) { const float t = __shfl_up(la, off); if (lane >= off) la += t; }
        bc[x] = la; bl[x] = __shfl(la, 63); }
}
__device__ __forceinline__ void unpack8(const u32x4 v, float (&f)[8]) {
#pragma unroll
    for (int x = 0; x < 4; ++x) { f[2 * x] = __uint_as_float(v[x] << 16); f[2 * x + 1] = __uint_as_float(v[x] & 0xffff0000u); }
}
__device__ __forceinline__ void gla_g1_phase(LAS unsigned char* lds, const bf16_t* PROJ, const bf16_t* ALOW, const float* wa2, const float* ba, float* UPD, float* DEC, int G, int tid) {
    LAS bf16_t* KD = (LAS bf16_t*)lds; LAS bf16_t* VT = (LAS bf16_t*)(lds + 18432);
    for (int u = blockIdx.x; u < 2048; u += G) {
        asm volatile("" : "+v"(tid));
        const int lane = tid & 63, wave = __builtin_amdgcn_readfirstlane(tid >> 6);
        const int bh = u >> 7, n = u & 127, b = bh >> 2, h = bh & 3, row0 = b * SEQ + n * 64;
        float bc[8], bl[8];
        gla_bcum(ALOW, wa2, ba, row0, h, lane, wave, bc, bl);
        const bf16_t* pr = PROJ + (size_t)(row0 + lane) * PROJ_LD;
        float kf[8]; unpack8(*(const u32x4*)(pr + C_K + h * 64 + 8 * wave), kf);
#pragma unroll
        for (int x = 0; x < 8; ++x) KD[(8 * wave + x) * GP + lane] = f2bf(kf[x] * __expf(bl[x] - bc[x]));
        if (lane == 63) {
#pragma unroll
            for (int x = 0; x < 8; ++x) DEC[u * 64 + 8 * wave + x] = __expf(bl[x]); }
#pragma unroll
        for (int pc = 0; pc < 2; ++pc) { const int e0 = 64 * pc + 8 * wave; const u32x4 v = *(const u32x4*)(pr + C_V + h * 128 + e0);
#pragma unroll
            for (int x = 0; x < 4; ++x) { VT[(e0 + 2 * x) * GP + lane] = (bf16_t)(v[x] & 0xffffu); VT[(e0 + 2 * x + 1) * GP + lane] = (bf16_t)(v[x] >> 16); } }
        __syncthreads();
        const int eb = wave >> 1, dbk = wave & 1, i = lane & 31, kg = lane >> 5;
        f32x16_t acc;
#pragma unroll
        for (int r = 0; r < 16; ++r) acc[r] = 0.f;
#pragma unroll
        for (int s = 0; s < 4; ++s) { const bf16x8_t af = *(const LAS bf16x8_t*)(VT + (32 * eb + i) * GP + 16 * s + 8 * kg), bfr = *(const LAS bf16x8_t*)(KD + (32 * dbk + i) * GP + 16 * s + 8 * kg);
            acc = __builtin_amdgcn_mfma_f32_32x32x16_bf16(af, bfr, acc, 0, 0, 0); }
        float* up = UPD + ((size_t)u * 128 + 32 * eb + 4 * kg) * 64 + 32 * dbk + i;
#pragma unroll
        for (int r = 0; r < 16; ++r) up[((r & 3) + 8 * (r >> 2)) * 64] = acc[r];
        __syncthreads();
    }
}
__device__ __forceinline__ void gla_g2_phase(float* UPD, const float* DEC, int G, int tid) {
    for (int g = blockIdx.x * 512 + tid; g < 16 * 8192; g += G * 512) {
        const int bh = g >> 13, ed = g & 8191, d = g & 63;
        float* p = UPD + (size_t)bh * 128 * 8192 + ed; const float* dc = DEC + bh * 128 * 64 + d;
        float S = 0.f;
        for (int n0 = 0; n0 < 128; n0 += 16) { float uu[16], dd[16];
#pragma unroll
            for (int x = 0; x < 16; ++x) { uu[x] = p[(size_t)(n0 + x) * 8192]; dd[x] = dc[(n0 + x) * 64]; }
#pragma unroll
            for (int x = 0; x < 16; ++x) { p[(size_t)(n0 + x) * 8192] = S; S = dd[x] * S + uu[x]; } }
    }
}
__device__ __forceinline__ void gla_g3_phase(LAS unsigned char* lds, const bf16_t* PROJ, const bf16_t* ALOW, const float* wa2, const float* ba, const float* gn, const float* UPD, bf16_t* MIXIN, int G, int tid) {
    LAS bf16_t* KE = (LAS bf16_t*)lds; LAS bf16_t* QE = (LAS bf16_t*)(lds + 9216); LAS bf16_t* VT = (LAS bf16_t*)(lds + 18432); LAS float* RED = (LAS float*)(lds + 36864);
    for (int u = blockIdx.x; u < 2048; u += G) {
        asm volatile("" : "+v"(tid));
        const int lane = tid & 63, wave = __builtin_amdgcn_readfirstlane(tid >> 6);
        const int bh = u >> 7, n = u & 127, b = bh >> 2, h = bh & 3, row0 = b * SEQ + n * 64;
        { float bc[8], bl[8];
          gla_bcum(ALOW, wa2, ba, row0, h, lane, wave, bc, bl);
          const bf16_t* pr = PROJ + (size_t)(row0 + lane) * PROJ_LD;
          float qf[8], kf[8]; unpack8(*(const u32x4*)(pr + C_Q + h * 64 + 8 * wave), qf); unpack8(*(const u32x4*)(pr + C_K + h * 64 + 8 * wave), kf);
          f32x4 q0, q1, k0, k1;
#pragma unroll
          for (int x = 0; x < 4; ++x) { q0[x] = qf[x] * 0.125f * __expf(bc[x]); q1[x] = qf[4 + x] * 0.125f * __expf(bc[4 + x]); k0[x] = kf[x] * __expf(-bc[x]); k1[x] = kf[4 + x] * __expf(-bc[4 + x]); }
          *(LAS u32x4*)(QE + lane * GP + 8 * wave) = pg8::pack8(q0, q1); *(LAS u32x4*)(KE + lane * GP + 8 * wave) = pg8::pack8(k0, k1);
          const int pcol = slot32(lane);
#pragma unroll
          for (int pc = 0; pc < 2; ++pc) { const int e0 = 64 * pc + 8 * wave; const u32x4 v = *(const u32x4*)(pr + C_V + h * 128 + e0);
#pragma unroll
              for (int x = 0; x < 4; ++x) { VT[(e0 + 2 * x) * GP + pcol] = (bf16_t)(v[x] & 0xffffu); VT[(e0 + 2 * x + 1) * GP + pcol] = (bf16_t)(v[x] >> 16); } } }
        __syncthreads();
        const int eb = wave >> 1, cb = wave & 1, i = lane & 31, kg = lane >> 5;
        bf16x8_t qb[4];
#pragma unroll
        for (int s = 0; s < 4; ++s) qb[s] = *(const LAS bf16x8_t*)(QE + (32 * cb + i) * GP + 16 * s + 8 * kg);
        f32x16_t o;
#pragma unroll
        for (int r = 0; r < 16; ++r) o[r] = 0.f;
#pragma unroll
        for (int sb = 0; sb < 2; ++sb) if (sb <= cb) {
            f32x16_t at;
#pragma unroll
            for (int r = 0; r < 16; ++r) at[r] = 0.f;
#pragma unroll
            for (int s = 0; s < 4; ++s) { const bf16x8_t af = *(const LAS bf16x8_t*)(KE + (32 * sb + i) * GP + 16 * s + 8 * kg); at = __builtin_amdgcn_mfma_f32_32x32x16_bf16(af, qb[s], at, 0, 0, 0); }
            if (sb == cb) {
#pragma unroll
                for (int r = 0; r < 16; ++r) if ((r & 3) + 8 * (r >> 2) + 4 * kg > i) at[r] = 0.f; }
#pragma unroll
            for (int sp = 0; sp < 2; ++sp) { u32x4 w; w.x = cvtpk(at[8 * sp + 0], at[8 * sp + 1]); w.y = cvtpk(at[8 * sp + 2], at[8 * sp + 3]); w.z = cvtpk(at[8 * sp + 4], at[8 * sp + 5]); w.w = cvtpk(at[8 * sp + 6], at[8 * sp + 7]);
                const bf16x8_t af = *(const LAS bf16x8_t*)(VT + (32 * eb + i) * GP + 32 * sb + 16 * sp + 8 * kg);
                o = __builtin_amdgcn_mfma_f32_32x32x16_bf16(af, __builtin_bit_cast(bf16x8_t, w), o, 0, 0, 0); }
        }
        { const float* sp = UPD + ((size_t)u * 128 + 32 * eb + i) * 64 + 8 * kg;
#pragma unroll
          for (int s = 0; s < 4; ++s) { const f32x4 x0 = *(const f32x4*)(sp + 16 * s), x1 = *(const f32x4*)(sp + 16 * s + 4);
              o = __builtin_amdgcn_mfma_f32_32x32x16_bf16(__builtin_bit_cast(bf16x8_t, pg8::pack8(x0, x1)), qb[s], o, 0, 0, 0); } }
        float ss = 0.f;
#pragma unroll
        for (int r = 0; r < 16; ++r) ss += o[r] * o[r];
        ss += __shfl_xor(ss, 32);
        if (kg == 0) RED[eb * 64 + 32 * cb + i] = ss;
        __syncthreads();
        const float tot = (RED[32 * cb + i] + RED[64 + 32 * cb + i]) + (RED[128 + 32 * cb + i] + RED[192 + 32 * cb + i]);
        const float rstd = rsqrtf(tot * (1.f / 128.f) + LN_EPS);
        const size_t row = (size_t)(row0 + 32 * cb + i);
#pragma unroll
        for (int rg = 0; rg < 4; ++rg) { const int e = 32 * eb + 8 * rg + 4 * kg;
            const f32x4 g4 = *(const f32x4*)(gn + e); const u32x2_t rr = *(const u32x2_t*)(PROJ + row * PROJ_LD + C_R + h * 128 + e);
            const float r0 = __uint_as_float(rr.x << 16), r1 = __uint_as_float(rr.x & 0xffff0000u), r2 = __uint_as_float(rr.y << 16), r3 = __uint_as_float(rr.y & 0xffff0000u);
            u32x2_t w; w.x = cvtpk(o[4 * rg] * rstd * g4[0] * pg8::silu_fast(r0), o[4 * rg + 1] * rstd * g4[1] * pg8::silu_fast(r1));
            w.y = cvtpk(o[4 * rg + 2] * rstd * g4[2] * pg8::silu_fast(r2), o[4 * rg + 3] * rstd * g4[3] * pg8::silu_fast(r3));
            *(u32x2_t*)(MIXIN + row * D + 512 + h * 128 + e) = w; }
        __syncthreads();
    }
}

#ifndef PROBE_MASK
#define PROBE_MASK 0
#endif
#ifndef ONE_LAUNCH
#define ONE_LAUNCH 1
#endif
constexpr int NPL = 10, NPH = 2 + NPL * DEPTH + 1;
enum { PK_IN = 0, PK_CG1, PK_G2, PK_G3, PK_MIX, PK_Q, PK_ATT, PK_XO, PK_FF1, PK_FF2 };
constexpr int CSN = 9472, CS_IN = 0, CS_Q = 2816, CS_FF1 = 3840;

__global__ void __launch_bounds__(NWAVES * 64) mega(Args a) {
    extern __shared__ __attribute__((aligned(16))) unsigned char lds_raw[];
    LAS unsigned char* lds = (LAS unsigned char*)lds_raw;
    const int wave = __builtin_amdgcn_readfirstlane(threadIdx.x >> 6);
    const int G = gridDim.x, gw = blockIdx.x * NWAVES + wave, NGW = G * NWAVES;
    unsigned char* ws = a.ws;
#define INP(k) ({ int k_ = (k); asm volatile("" : "+s"(k_)); a.in[k_]; })
    float* Y = a.out;
    bf16_t* WT = (bf16_t*)(ws + WS_WT); bf16_t* YB = (bf16_t*)(ws + WS_HB); bf16_t* PROJ = (bf16_t*)(ws + WS_PROJ); bf16_t* ALOW = (bf16_t*)(ws + WS_ALOW);
    bf16_t* MIXIN = (bf16_t*)(ws + WS_MIXIN); bf16_t* Qb = (bf16_t*)(ws + WS_Q); bf16_t* ACT = (bf16_t*)(ws + WS_ACT);
    bf16_t* Kb = (bf16_t*)(ws + WS_K); bf16_t* Vt = (bf16_t*)(ws + WS_VT); bf16_t* MEMB = (bf16_t*)(ws + WS_MEMB); bf16_t* MEMP = (bf16_t*)(ws + WS_MEMP);
    float* UPD = (float*)(ws + WS_UPD); float* DEC = (float*)(ws + WS_DEC);
    float* CSP = (float*)(ws + WS_CSP); float* CS = (float*)(ws + WS_CS); float* MUR = (float*)(ws + WS_MUR);
    unsigned long long* SLOTS = (unsigned long long*)(ws + WS_SLOTS); unsigned* CNT = (unsigned*)(ws + WS_CNT);

    for (int p = a.ph_lo; p < a.ph_hi; ++p) {
      const int pkind = (p < 2 || p == NPH - 1) ? -1 : (p - 2) % NPL;
      int nrep = 1;
      if ((a.sub & 4) && (pkind == PK_IN || pkind == PK_Q || pkind == PK_FF1)) nrep = 2;
      if ((a.sub & 8) && (pkind == PK_CG1 || pkind == PK_G3)) nrep = 2;
      if ((a.sub & 16) && pkind == PK_ATT) nrep = 2;
      for (int rep = 0; rep < nrep; ++rep) {
        const bool dummy = rep + 1 < nrep;
        int tid; asm volatile("v_mbcnt_lo_u32_b32 %0, -1, 0\n\tv_mbcnt_hi_u32_b32 %0, -1, %0\n\tv_lshl_or_b32 %0, %1, 6, %0" : "=&v"(tid) : "s"(wave));
        const int lane = tid & 63;
        if (p == 0) {
            LAS float* scr = (LAS float*)(lds + wave * 16384);
            if (blockIdx.x == 0) { CNT[tid] = 0u; CNT[512 + tid] = 0u; CNT[1024 + tid] = 0u; }
            for (int it = gw; it < DEPTH * I_LAYER; it += NGW) {
                const int l = it / I_LAYER; int r = it % I_LAYER;
                bf16_t* WL = WT + WT_L0 + (size_t)l * WT_LSTRIDE;
                float* cspl = CSP + (size_t)l * 2 * 16 * CSN;
                if (r < I_IN) { const int kb = r / 81, nb = r % 81; const float* gg = l == 0 ? INP(2) : INP(22) + (l - 1) * D; const float* bb = l == 0 ? INP(3) : INP(23) + (l - 1) * D;
                    cvt_item_ln(INP(4) + (size_t)l * 1024 * IN_COLS, 1024, IN_COLS, 64 * kb, 32 * nb, WL + WO_IN + (size_t)(32 * nb) * 1024, scr, lane, gg, bb, cspl + kb * CSN + CS_IN + 32 * nb, cspl + (16 + kb) * CSN + CS_IN + 32 * nb); continue; } r -= I_IN;
                if (r < I_SQ) { const int kb = r / 32, nb = r % 32; cvt_item(INP(12) + (size_t)l * 1024 * 1024, 1024, 1024, 64 * kb, 32 * nb, WL + WO_MIX + (size_t)(32 * nb) * 1024, scr, lane); continue; } r -= I_SQ;
                if (r < I_SQ) { const int kb = r / 32, nb = r % 32;
                    cvt_item_ln(INP(15) + (size_t)l * 1024 * 1024, 1024, 1024, 64 * kb, 32 * nb, WL + WO_XQ + (size_t)(32 * nb) * 1024, scr, lane, INP(13) + l * D, INP(14) + l * D, cspl + kb * CSN + CS_Q + 32 * nb, cspl + (16 + kb) * CSN + CS_Q + 32 * nb); continue; } r -= I_SQ;
                if (r < I_SQ) { const int kb = r / 32, nb = r % 32; cvt_item(INP(17) + (size_t)l * 1024 * 1024, 1024, 1024, 64 * kb, 32 * nb, WL + WO_XO + (size_t)(32 * nb) * 1024, scr, lane); continue; } r -= I_SQ;
                if (r < I_XKV) { const int kb = r / 64, n0 = 32 * (r % 64);
                    bf16_t* dst = n0 < 1024 ? WT + WT_XK + (size_t)(l * 1024 + n0) * 1024 : WT + WT_XV + (size_t)(l * 1024 + n0 - 1024) * 1024;
                    cvt_item(INP(16) + (size_t)l * 1024 * 2048, 1024, 2048, 64 * kb, n0, dst, scr, lane); continue; } r -= I_XKV;
                if (r < I_FF1) { const int kb = r / 176, n0 = 32 * (r % 176);
                    const int drow = n0 < D_FF ? 256 * (n0 / 128) + n0 % 128 : 256 * ((n0 - D_FF) / 128) + 128 + (n0 - D_FF) % 128;
                    cvt_item_ln(INP(20) + (size_t)l * 1024 * 2 * D_FF, 1024, 2 * D_FF, 64 * kb, n0, WL + WO_FF1 + (size_t)drow * 1024, scr, lane, INP(18) + l * D, INP(19) + l * D, cspl + kb * CSN + CS_FF1 + drow, cspl + (16 + kb) * CSN + CS_FF1 + drow); continue; } r -= I_FF1;
                { const int kb = r / 32, nb = r % 32; cvt_item(INP(21) + (size_t)l * D_FF * 1024, D_FF, 1024, 64 * kb, 32 * nb, WL + WO_FF2 + (size_t)(32 * nb) * D_FF, scr, lane); }
            }
            for (int i = blockIdx.x * 512 + tid; i < 1024 * 1024; i += G * 512) {
                const int row = i >> 10, c = i & 1023, b = row >> 8, key = row & 255; const bf16_t v = f2bf(INP(1)[i]);
                MEMB[i] = v; MEMP[(size_t)(b * 256 + slot_of_key(key)) * 1024 + c] = v; }
            for (int m = gw; m < M; m += NGW) x_row(INP(0) + (size_t)m * D, YB + (size_t)m * D, MUR + 2 * (size_t)m, lane);
        } else if (p == 1) {
            for (int i = blockIdx.x * 512 + tid; i < DEPTH * 2 * CSN; i += G * 512) { const int lc = i / CSN, c = i % CSN; const float* pp = CSP + (size_t)lc * 16 * CSN + c; float s = 0.f;
#pragma unroll
                for (int kb = 0; kb < 16; ++kb) s += pp[kb * CSN];
                CS[i] = s; }
            const int half = G / 2;
            if ((int)blockIdx.x < half) { pg8::Gemm g{MEMB, WT + WT_XK, 1024, 4096, 1024}; pg8::StaticOrderT<1024, 4096> S; S.init(half, (int)blockIdx.x);
                pg8::EpiBf16 E{Kb, 4096}; pg8::gemm_phase<pg8::EpiBf16, pg8::StaticOrderT<1024, 4096>, true, true, 1024>(lds, g, S, E, tid); }
            else { pg8::Gemm g{WT + WT_XV, MEMP, 4096, 1024, 1024}; pg8::StaticOrderT<4096, 1024> S; S.init(G - half, (int)blockIdx.x - half);
                pg8::EpiBf16 E{Vt, 1024}; pg8::gemm_phase<pg8::EpiBf16, pg8::StaticOrderT<4096, 1024>, true, true, 1024>(lds, g, S, E, tid); }
        } else if (p == NPH - 1) {
            const float* gg = INP(22) + (DEPTH - 1) * D; const float* bb = INP(23) + (DEPTH - 1) * D;
            for (int m = gw; m < M; m += NGW) ln_row_f32(Y + (size_t)m * D, gg, bb, lane);
        } else {
            const int l = (p - 2) / NPL, kind = (p - 2) % NPL;
            const bf16_t* WL = WT + WT_L0 + (size_t)l * WT_LSTRIDE;
            const float* csl = CS + (size_t)l * 2 * CSN; const float* cbl = csl + CSN;
            if (kind == PK_IN) { pg8::Gemm g{YB, WL + WO_IN, M, 2816, 1024}; pg8::StaticOrderT<M, 2816> S; S.init(G, (int)blockIdx.x);
                pg8::EpiProjLN E{PROJ, ALOW, MUR, csl + CS_IN, cbl + CS_IN}; pg8::gemm_phase<pg8::EpiProjLN, pg8::StaticOrderT<M, 2816>, true, true, 1024>(lds, g, S, E, tid); }
            else if (kind == PK_CG1) {
                if (a.sub & 1) conv_phase(lds, PROJ, INP(7) + l * 31 * 512, INP(8) + l * 512, INP(9) + l * 512, INP(10) + l * 512, MIXIN, G, tid);
                if (a.sub & 2) gla_g1_phase(lds, PROJ, ALOW, INP(5) + l * 16 * 256, INP(6) + l * 256, UPD, DEC, G, tid); }
            else if (kind == PK_G2) { gla_g2_phase(UPD, DEC, G, tid); }
            else if (kind == PK_G3) { gla_g3_phase(lds, PROJ, ALOW, INP(5) + l * 16 * 256, INP(6) + l * 256, INP(11) + l * 128, UPD, MIXIN, G, tid); }
            else if (kind == PK_MIX || kind == PK_XO) {
                const bool mix = kind == PK_MIX;
                pg8::Gemm g{mix ? MIXIN : Qb, WL + (mix ? WO_MIX : WO_XO), M, 1024, 1024}; pg8::StaticOrderT<M, 1024> S; S.init(G, (int)blockIdx.x);
                const float* gp = mix ? (l == 0 ? INP(2) : INP(22) + (l - 1) * D) : INP(13) + l * D; const float* bp = mix ? (l == 0 ? INP(3) : INP(23) + (l - 1) * D) : INP(14) + l * D;
                pg8::EpiResLN E{(mix && l == 0) ? INP(0) : nullptr, nullptr, YB, MUR, gp, bp, SLOTS, CNT + (3 * l + (mix ? 0 : 1)) * 128, ALPHA, lds};
                pg8::gemm_phase<pg8::EpiResLN, pg8::StaticOrderT<M, 1024>, true, true, 1024>(lds, g, S, E, tid); }
            else if (kind == PK_Q) { pg8::Gemm g{YB, WL + WO_XQ, M, 1024, 1024}; pg8::StaticOrderT<M, 1024> S; S.init(G, (int)blockIdx.x);
                pg8::EpiBf16LN E{Qb, 1024, MUR, csl + CS_Q, cbl + CS_Q}; pg8::gemm_phase<pg8::EpiBf16LN, pg8::StaticOrderT<M, 1024>, true, true, 1024>(lds, g, S, E, tid); }
            else if (kind == PK_ATT) { att_phase(lds, Kb + l * 1024, Vt + (size_t)l * 1024 * 1024, Qb, dummy ? MIXIN : Qb, G, tid); }
            else if (kind == PK_FF1) { pg8::Gemm g{YB, WL + WO_FF1, M, 2 * D_FF, 1024}; pg8::StaticOrderT<M, 2 * D_FF> S; S.init(G, (int)blockIdx.x);
                pg8::EpiSwigluLN E{ACT, MUR, csl + CS_FF1, cbl + CS_FF1}; pg8::gemm_phase<pg8::EpiSwigluLN, pg8::StaticOrderT<M, 2 * D_FF>, true, true, 1024>(lds, g, S, E, tid); }
            else { pg8::Gemm g{ACT, WL + WO_FF2, M, 1024, D_FF}; pg8::StaticOrderT<M, 1024> S; S.init(G, (int)blockIdx.x);
                pg8::EpiResLN E{nullptr, l == DEPTH - 1 ? Y : nullptr, YB, MUR, INP(18) + l * D, INP(19) + l * D, SLOTS, CNT + (3 * l + 2) * 128, ALPHA, lds};
                pg8::gemm_phase<pg8::EpiResLN, pg8::StaticOrderT<M, 1024>, true, true, D_FF>(lds, g, S, E, tid); }
        }
      }
        if (p + 1 < a.ph_hi) cg::this_grid().sync();
    }
}

#undef INP
extern "C" void kernel_launch(void* const* d_in, const int* in_sizes, int n_in, void* d_out, int out_size, void* d_ws, size_t ws_size, hipStream_t stream) {
    if (n_in != 24 || out_size != M * D || ws_size < WS_END) { fprintf(stderr, "kernel_launch: unexpected shapes (n_in %d out %d ws %zu)\n", n_in, out_size, ws_size); return; }
    static int grid = 0;
    if (grid == 0) {
        int dev = 0, cus = 0, per_cu = 0;
        (void)hipGetDevice(&dev); (void)hipDeviceGetAttribute(&cus, hipDeviceAttributeMultiprocessorCount, dev);
        if (hipFuncSetAttribute((const void*)mega, hipFuncAttributeMaxDynamicSharedMemorySize, LDS_BYTES) != hipSuccess) { fprintf(stderr, "kernel_launch: hipFuncSetAttribute failed\n"); grid = -1; return; }
        if (hipOccupancyMaxActiveBlocksPerMultiprocessor(&per_cu, (const void*)mega, NWAVES * 64, LDS_BYTES) != hipSuccess || per_cu < 1) { fprintf(stderr, "kernel_launch: occupancy query says %d\n", per_cu); per_cu = 1; }
        (void)hipGetLastError();
        grid = cus;
    }
    if (grid < 0) return;
    Args a{};
    for (int i = 0; i < 24; ++i) a.in[i] = (const float*)d_in[i];
    a.out = (float*)d_out; a.ws = (unsigned char*)d_ws;
#if ONE_LAUNCH
    a.ph_lo = 0; a.ph_hi = NPH; a.sub = 3 | PROBE_MASK;
    void* kargs[] = {&a};
    hipError_t e = hipLaunchCooperativeKernel((const void*)mega, dim3(grid), dim3(NWAVES * 64), kargs, LDS_BYTES, stream);
    if (e != hipSuccess) fprintf(stderr, "kernel_launch: cooperative launch failed: %s\n", hipGetErrorString(e));
#else
    for (int p = 0; p < NPH; ++p) { a.ph_lo = p; a.ph_hi = p + 1; a.sub = 3; hipLaunchKernelGGL(mega, dim3(grid), dim3(NWAVES * 64), LDS_BYTES, stream, a); }
#endif
}
```

```cpp
#include <hip/hip_runtime.h>
#include <hip/hip_cooperative_groups.h>
#include <cstdio>
#include <cstdint>

typedef unsigned short bf16_t;
typedef unsigned u32x4 __attribute__((ext_vector_type(4)));
typedef float f32x4 __attribute__((ext_vector_type(4)));

constexpr int D = 1024, BATCH = 4, SEQ = 8192, DEPTH = 4, M = BATCH * SEQ;
constexpr int IN_COLS = 2576, PROJ_LD = 2560, MEM_LEN = 256, D_FF = 2816;
constexpr int C_CA = 0, C_CG = 512, C_Q = 1024, C_K = 1280, C_V = 1536, C_R = 2048, C_AL = 2560;
constexpr float LN_EPS = 1e-5f;
constexpr float ALPHA = 1.681792830507429f;

constexpr size_t MiB = 1u << 20;
constexpr size_t WS_CTL = 0;
constexpr size_t WS_K = 8 * MiB;
constexpr size_t WS_VT = 16 * MiB;
constexpr size_t WS_MEMB = 24 * MiB;
constexpr size_t WS_MEMP = 26 * MiB;
constexpr size_t WS_ALOW = 28 * MiB;
constexpr size_t WS_DEC = 29 * MiB;
constexpr size_t WS_CNT = 0;
constexpr size_t WS_BAR = 65536;
constexpr size_t WS_CSP = 1 * MiB;
constexpr size_t WS_CS = 6 * MiB;
constexpr size_t WS_SLOTS = 30 * MiB;
constexpr size_t WS_MUR = 31 * MiB;
constexpr size_t WS_WT = 32 * MiB;
constexpr size_t WS_HB = 160 * MiB;
constexpr size_t WS_PROJ = 224 * MiB;
constexpr size_t WS_Q = 224 * MiB;
constexpr size_t WS_ACT = 224 * MiB;
constexpr size_t WS_UPD = 384 * MiB;
constexpr size_t WS_MIXIN = 448 * MiB;
constexpr size_t WS_END = 512 * MiB;

__host__ __device__ __forceinline__ int key_of_slot(int p) { const int e = p & 7, kg = (p >> 3) & 3; return (p & ~31) + 16 * (e >> 2) + 4 * kg + (e & 3); }
__host__ __device__ __forceinline__ int slot_of_key(int k) { const int w = k & 31; return (k & ~31) + 8 * ((w >> 2) & 3) + 4 * (w >> 4) + (w & 3); }

__device__ __forceinline__ float bf2f(bf16_t b) { return __uint_as_float(((unsigned)b) << 16); }
__device__ __forceinline__ bf16_t f2bf(float f) { unsigned u = __float_as_uint(f); return (bf16_t)((u + 0x7fffu + ((u >> 16) & 1u)) >> 16); }
__device__ __forceinline__ float ldf(const float* p) { return *p; }
__device__ __forceinline__ float ldf(const bf16_t* p) { return bf2f(*p); }
__device__ __forceinline__ float sigmoidf_(float x) { return 1.f / (1.f + __expf(-x)); }
__device__ __forceinline__ float siluf_(float x) { return x / (1.f + __expf(-x)); }
__device__ __forceinline__ float wave_sum(float v) {
#pragma unroll
    for (int o = 1; o < 64; o <<= 1) v += __shfl_xor(v, o);
    return v;
}
__device__ __forceinline__ float wave_max(float v) {
#pragma unroll
    for (int o = 1; o < 64; o <<= 1) v = fmaxf(v, __shfl_xor(v, o));
    return v;
}

namespace pg8 {
#define PG8_LAS __attribute__((address_space(3)))
typedef unsigned short bf16_t;
typedef short bf16x8 __attribute__((ext_vector_type(8)));
typedef float f32x4 __attribute__((ext_vector_type(4)));
typedef unsigned u32x4 __attribute__((ext_vector_type(4)));
constexpr int BM = 256, BK = 64, HALF = 128, HTB = HALF * BK * 2  , STAGE_BYTES = 8 * HTB, NXCD = 8, WGM = 8;

__host__ __device__ __forceinline__ int lds_byte(int r, int c) { const int st = (r >> 4) * 2 + (c >> 5), rr = r & 15, cc = c & 31, ob = rr * 64 + cc * 2; return st * 1024 + (ob ^ (((ob >> 9) & 1) << 5)); }
__host__ __device__ __forceinline__ void stage_rc(int b, int& R, int& C) { const int st = b / 1024, sb = b % 1024, swz = sb ^ (((sb >> 9) & 1) << 5); R = (st >> 1) * 16 + swz / 64; C = (st & 1) * 32 + (swz % 64) / 2; }
__host__ __device__ __forceinline__ int perm32(int rho) { const int n = rho >> 4, i = rho & 15; return 8 * (i >> 2) + 4 * n + (i & 3); }

struct Unit { int pm, pn; };
struct Gemm { const bf16_t* A; const bf16_t* Bt; int M, N, K; };

struct StaticOrder {
    int nM, nN, nwg, G, c;
    __host__ __device__ void init(int M, int N, int G_, int c_) { nM = M / BM; nN = N / BM; nwg = nM * nN; G = G_; c = c_; }
    __host__ __device__ bool next(int i, Unit& u) const {
        const long L = (long)i * G + c; if (L >= nwg) return false;
        int wgid = (int)L; { const int q = nwg / NXCD, r = nwg % NXCD, xcd = wgid % NXCD, off = wgid / NXCD; wgid = (xcd < r ? xcd * (q + 1) : r * (q + 1) + (xcd - r) * q) + off; }
        const int nig = WGM * nN, gid = wgid / nig, fm = gid * WGM, gsz = (nM - fm) < WGM ? (nM - fm) : WGM;
        u.pm = fm + ((wgid % nig) % gsz); u.pn = (wgid % nig) / gsz; return true;
    }
    __device__ __forceinline__ void a_ready(const Unit&) const {}
    __device__ __forceinline__ void done(const Unit&) const {}
};


template <int MM, int NN> struct StaticOrderT {
    static constexpr int nM = MM / BM, nN = NN / BM, nwg = nM * nN;
    int G, c;
    __host__ __device__ void init(int G_, int c_) { G = G_; c = c_; }
    __host__ __device__ bool next(int i, Unit& u) const {
        const long L = (long)i * G + c; if (L >= nwg) return false;
        int wgid = (int)L; { constexpr int q = nwg / NXCD, r = nwg % NXCD; const int xcd = wgid % NXCD, off = wgid / NXCD; wgid = (xcd < r ? xcd * (q + 1) : r * (q + 1) + (xcd - r) * q) + off; }
        constexpr int nig = WGM * nN; const int gid = wgid / nig, fm = gid * WGM, gsz = (nM - fm) < WGM ? (nM - fm) : WGM;
        u.pm = fm + ((wgid % nig) % gsz); u.pn = (wgid % nig) / gsz; return true;
    }
    __device__ __forceinline__ void a_ready(const Unit&) const {}
    __device__ __forceinline__ void done(const Unit&) const {}
};
typedef float f32x2 __attribute__((ext_vector_type(2)));
__device__ __forceinline__ unsigned cvt_pk_bf16(float lo, float hi) { unsigned r; asm volatile("v_cvt_pk_bf16_f32 %0, %1, %2" : "=v"(r) : "v"(lo), "v"(hi)); return r; }
__device__ __forceinline__ u32x4 pack8(const f32x4 v0, const f32x4 v1) { u32x4 w; w.x = cvt_pk_bf16(v0[0], v0[1]); w.y = cvt_pk_bf16(v0[2], v0[3]); w.z = cvt_pk_bf16(v1[0], v1[1]); w.w = cvt_pk_bf16(v1[2], v1[3]); return w; }
__device__ __forceinline__ float silu_fast(float x) { return x * __builtin_amdgcn_rcpf(1.f + __expf(-x)); }
struct EpiBf16 {
    static constexpr bool PERM = true, AFTER_DRAIN = false;
    bf16_t* O; int ldc;
    __device__ __forceinline__ void operator()(const f32x4 (&acc)[2][2][4][2], const Unit& u, int wr, int wc, int fr, int fq) const {
        const int row0 = u.pm * BM + wr * 64 + fr, col0 = u.pn * BM + wc * 32 + 8 * fq;
#pragma unroll
        for (int ai = 0; ai < 2; ++ai)
#pragma unroll
            for (int m = 0; m < 4; ++m) { bf16_t* rowp = O + (size_t)(row0 + ai * HALF + m * 16) * ldc + col0;
#pragma unroll
                for (int bj = 0; bj < 2; ++bj) *(u32x4*)(rowp + bj * HALF) = pack8(acc[ai][bj][m][0], acc[ai][bj][m][1]); }
    }
};
struct EpiProj {
    static constexpr bool PERM = true, AFTER_DRAIN = false;
    bf16_t* O; bf16_t* AL;
    __device__ __forceinline__ void operator()(const f32x4 (&acc)[2][2][4][2], const Unit& u, int wr, int wc, int fr, int fq) const {
        const int row0 = u.pm * BM + wr * 64 + fr, col0 = u.pn * BM + wc * 32 + 8 * fq;
        if (u.pn < 10) {
#pragma unroll
            for (int ai = 0; ai < 2; ++ai)
#pragma unroll
                for (int m = 0; m < 4; ++m) { bf16_t* rowp = O + (size_t)(row0 + ai * HALF + m * 16) * 2560 + col0;
#pragma unroll
                    for (int bj = 0; bj < 2; ++bj) *(u32x4*)(rowp + bj * HALF) = pack8(acc[ai][bj][m][0], acc[ai][bj][m][1]); }
        } else if (wc == 0 && fq < 2) {
#pragma unroll
            for (int ai = 0; ai < 2; ++ai)
#pragma unroll
                for (int m = 0; m < 4; ++m) *(u32x4*)(AL + (size_t)(row0 + ai * HALF + m * 16) * 16 + 8 * fq) = pack8(acc[ai][0][m][0], acc[ai][0][m][1]);
        }
    }
};
struct EpiRes {
    static constexpr bool PERM = false, AFTER_DRAIN = false;
    float* HF; float alpha; static constexpr int ldc = 1024;
    __device__ __forceinline__ void operator()(const f32x4 (&acc)[2][2][4][2], const Unit& u, int wr, int wc, int fr, int fq) const {
        const int row0 = u.pm * BM + wr * 64 + fr, col0 = u.pn * BM + wc * 32 + 4 * fq;
#pragma unroll
        for (int ai = 0; ai < 2; ++ai)
#pragma unroll
            for (int m = 0; m < 4; ++m) { float* rowp = HF + (size_t)(row0 + ai * HALF + m * 16) * ldc + col0;
#pragma unroll
                for (int bj = 0; bj < 2; ++bj)
#pragma unroll
                    for (int n = 0; n < 2; ++n) { f32x4* p = (f32x4*)(rowp + bj * HALF + n * 16); const f32x4 h = *p; *p = h * alpha + acc[ai][bj][m][n]; } }
    }
};
struct EpiSwiglu {
    static constexpr bool PERM = true, AFTER_DRAIN = false;
    bf16_t* O; static constexpr int ldc = 2816;
    __device__ __forceinline__ void operator()(const f32x4 (&acc)[2][2][4][2], const Unit& u, int wr, int wc, int fr, int fq) const {
        const int row0 = u.pm * BM + wr * 64 + fr, col0 = u.pn * HALF + wc * 32 + 8 * fq;
#pragma unroll
        for (int ai = 0; ai < 2; ++ai)
#pragma unroll
            for (int m = 0; m < 4; ++m) { f32x4 a0, a1;
#pragma unroll
                for (int j = 0; j < 4; ++j) { a0[j] = silu_fast(acc[ai][0][m][0][j]) * acc[ai][1][m][0][j]; a1[j] = silu_fast(acc[ai][0][m][1][j]) * acc[ai][1][m][1][j]; }
                *(u32x4*)(O + (size_t)(row0 + ai * HALF + m * 16) * ldc + col0) = pack8(a0, a1); }
    }
};

__device__ __forceinline__ void row_stats8(const float* MUR, int row0, float (&mu)[2][4], float (&rs)[2][4]) {
#pragma unroll
    for (int ai = 0; ai < 2; ++ai)
#pragma unroll
        for (int m = 0; m < 4; ++m) { const f32x2 t = *(const f32x2*)(MUR + 2 * (size_t)(row0 + ai * HALF + m * 16)); mu[ai][m] = t.x; rs[ai][m] = t.y; }
}
struct EpiBf16LN {
    static constexpr bool PERM = true, AFTER_DRAIN = false;
    bf16_t* O; int ldc; const float* MUR; const float* cs; const float* cb;
    __device__ __forceinline__ void operator()(const f32x4 (&acc)[2][2][4][2], const Unit& u, int wr, int wc, int fr, int fq) const {
        const int row0 = u.pm * BM + wr * 64 + fr, col0 = u.pn * BM + wc * 32 + 8 * fq;
        float mu[2][4], rs[2][4]; row_stats8(MUR, row0, mu, rs);
#pragma unroll
        for (int bj = 0; bj < 2; ++bj) { const f32x4 s0 = *(const f32x4*)(cs + col0 + bj * HALF), s1 = *(const f32x4*)(cs + col0 + bj * HALF + 4), b0 = *(const f32x4*)(cb + col0 + bj * HALF), b1 = *(const f32x4*)(cb + col0 + bj * HALF + 4);
#pragma unroll
            for (int ai = 0; ai < 2; ++ai)
#pragma unroll
                for (int m = 0; m < 4; ++m) { const f32x4 v0 = (acc[ai][bj][m][0] - s0 * mu[ai][m]) * rs[ai][m] + b0, v1 = (acc[ai][bj][m][1] - s1 * mu[ai][m]) * rs[ai][m] + b1;
                    *(u32x4*)(O + (size_t)(row0 + ai * HALF + m * 16) * ldc + col0 + bj * HALF) = pack8(v0, v1); } }
    }
};
struct EpiProjLN {
    static constexpr bool PERM = true, AFTER_DRAIN = false;
    bf16_t* O; bf16_t* AL; const float* MUR; const float* cs; const float* cb;
    __device__ __forceinline__ void operator()(const f32x4 (&acc)[2][2][4][2], const Unit& u, int wr, int wc, int fr, int fq) const {
        const int row0 = u.pm * BM + wr * 64 + fr, col0 = u.pn * BM + wc * 32 + 8 * fq;
        float mu[2][4], rs[2][4]; row_stats8(MUR, row0, mu, rs);
        if (u.pn < 10) {
#pragma unroll
            for (int bj = 0; bj < 2; ++bj) { const f32x4 s0 = *(const f32x4*)(cs + col0 + bj * HALF), s1 = *(const f32x4*)(cs + col0 + bj * HALF + 4), b0 = *(const f32x4*)(cb + col0 + bj * HALF), b1 = *(const f32x4*)(cb + col0 + bj * HALF + 4);
#pragma unroll
                for (int ai = 0; ai < 2; ++ai)
#pragma unroll
                    for (int m = 0; m < 4; ++m) { const f32x4 v0 = (acc[ai][bj][m][0] - s0 * mu[ai][m]) * rs[ai][m] + b0, v1 = (acc[ai][bj][m][1] - s1 * mu[ai][m]) * rs[ai][m] + b1;
                        *(u32x4*)(O + (size_t)(row0 + ai * HALF + m * 16) * 2560 + col0 + bj * HALF) = pack8(v0, v1); } }
        } else if (wc == 0 && fq < 2) {
            const f32x4 s0 = *(const f32x4*)(cs + col0), s1 = *(const f32x4*)(cs + col0 + 4), b0 = *(const f32x4*)(cb + col0), b1 = *(const f32x4*)(cb + col0 + 4);
#pragma unroll
            for (int ai = 0; ai < 2; ++ai)
#pragma unroll
                for (int m = 0; m < 4; ++m) { const f32x4 v0 = (acc[ai][0][m][0] - s0 * mu[ai][m]) * rs[ai][m] + b0, v1 = (acc[ai][0][m][1] - s1 * mu[ai][m]) * rs[ai][m] + b1;
                    *(u32x4*)(AL + (size_t)(row0 + ai * HALF + m * 16) * 16 + 8 * fq) = pack8(v0, v1); }
        }
    }
};
struct EpiSwigluLN {
    static constexpr bool PERM = true, AFTER_DRAIN = false;
    bf16_t* O; const float* MUR; const float* cs; const float* cb; static constexpr int ldc = 2816;
    __device__ __forceinline__ void operator()(const f32x4 (&acc)[2][2][4][2], const Unit& u, int wr, int wc, int fr, int fq) const {
        const int row0 = u.pm * BM + wr * 64 + fr, wrow = u.pn * BM + wc * 32 + 8 * fq, col0 = u.pn * HALF + wc * 32 + 8 * fq;
        float mu[2][4], rs[2][4]; row_stats8(MUR, row0, mu, rs);
        const f32x4 sg0 = *(const f32x4*)(cs + wrow), sg1 = *(const f32x4*)(cs + wrow + 4), bg0 = *(const f32x4*)(cb + wrow), bg1 = *(const f32x4*)(cb + wrow + 4);
        const f32x4 su0 = *(const f32x4*)(cs + wrow + HALF), su1 = *(const f32x4*)(cs + wrow + HALF + 4), bu0 = *(const f32x4*)(cb + wrow + HALF), bu1 = *(const f32x4*)(cb + wrow + HALF + 4);
#pragma unroll
        for (int ai = 0; ai < 2; ++ai)
#pragma unroll
            for (int m = 0; m < 4; ++m) {
                const f32x4 g0 = (acc[ai][0][m][0] - sg0 * mu[ai][m]) * rs[ai][m] + bg0, g1 = (acc[ai][0][m][1] - sg1 * mu[ai][m]) * rs[ai][m] + bg1;
                const f32x4 u0 = (acc[ai][1][m][0] - su0 * mu[ai][m]) * rs[ai][m] + bu0, u1 = (acc[ai][1][m][1] - su1 * mu[ai][m]) * rs[ai][m] + bu1;
                f32x4 a0, a1;
#pragma unroll
                for (int j = 0; j < 4; ++j) { a0[j] = silu_fast(g0[j]) * u0[j]; a1[j] = silu_fast(g1[j]) * u1[j]; }
                *(u32x4*)(O + (size_t)(row0 + ai * HALF + m * 16) * ldc + col0) = pack8(a0, a1); }
    }
};
struct EpiResLN {
    static constexpr bool PERM = false, AFTER_DRAIN = false;
    const float* Xin; float* Yout; bf16_t* YB; float* MUR; const float* gp; const float* bp; unsigned long long* slots; unsigned* cnt; float alpha; PG8_LAS unsigned char* lds;
    __device__ __forceinline__ void operator()(f32x4 (&acc)[2][2][4][2], const Unit& u, int wr, int wc, int fr, int fq) const {
        typedef unsigned u32x2 __attribute__((ext_vector_type(2)));
        const int row0 = u.pm * BM + wr * 64 + fr, col0 = u.pn * BM + wc * 32 + 4 * fq;
        float mu[2][4], rs[2][4]; row_stats8(MUR, row0, mu, rs);
#pragma unroll
        for (int bj = 0; bj < 2; ++bj)
#pragma unroll
            for (int n = 0; n < 2; ++n) { const f32x4 g4 = *(const f32x4*)(gp + col0 + bj * HALF + n * 16), b4 = *(const f32x4*)(bp + col0 + bj * HALF + n * 16);
#pragma unroll
                for (int ai = 0; ai < 2; ++ai)
#pragma unroll
                    for (int m = 0; m < 4; ++m) { const size_t off = (size_t)(row0 + ai * HALF + m * 16) * 1024 + col0 + bj * HALF + n * 16;
                        f32x4 yo;
                        if (Xin) yo = *(const f32x4*)(Xin + off);
                        else { const u32x2 t = *(const u32x2*)(YB + off); yo = (f32x4){__uint_as_float(t.x << 16), __uint_as_float(t.x & 0xffff0000u), __uint_as_float(t.y << 16), __uint_as_float(t.y & 0xffff0000u)}; }
                        const f32x4 yn = ((yo - mu[ai][m]) * rs[ai][m] * g4 + b4) * alpha + acc[ai][bj][m][n];
                        acc[ai][bj][m][n] = yn; if (Yout) *(f32x4*)(Yout + off) = yn;
                        u32x2 w; w.x = cvt_pk_bf16(yn[0], yn[1]); w.y = cvt_pk_bf16(yn[2], yn[3]); *(u32x2*)(YB + off) = w; } }
        PG8_LAS f32x2* P = (PG8_LAS f32x2*)(lds + 131072);
#pragma unroll
        for (int ai = 0; ai < 2; ++ai)
#pragma unroll
            for (int m = 0; m < 4; ++m) {
                float s = 0.f;
#pragma unroll
                for (int bj = 0; bj < 2; ++bj)
#pragma unroll
                    for (int n = 0; n < 2; ++n) { const f32x4 x = acc[ai][bj][m][n]; s += (x[0] + x[1]) + (x[2] + x[3]); }
                s += __shfl_xor(s, 16); s += __shfl_xor(s, 32);
                const float mw = s * (1.0f / 64.0f); float q = 0.f;
#pragma unroll
                for (int bj = 0; bj < 2; ++bj)
#pragma unroll
                    for (int n = 0; n < 2; ++n) { const f32x4 d = acc[ai][bj][m][n] - mw; q += (d[0] * d[0] + d[1] * d[1]) + (d[2] * d[2] + d[3] * d[3]); }
                q += __shfl_xor(q, 16); q += __shfl_xor(q, 32);
                if (fq == 0) P[(ai * HALF + wr * 64 + m * 16 + fr) * 4 + wc] = (f32x2){mw, q};
            }
        asm volatile("s_waitcnt lgkmcnt(0)" ::: "memory"); __builtin_amdgcn_s_barrier(); asm volatile("" ::: "memory");
        const int wid = wr * 4 + wc, lane = fq * 16 + fr, row = wid * 32 + (lane & 31);
        if (lane < 32) {
            const f32x2 a = P[row * 4 + 0], b = P[row * 4 + 1], c = P[row * 4 + 2], d = P[row * 4 + 3];
            const float mt = (a.x + b.x + c.x + d.x) * 0.25f;
            const float da = a.x - mt, db = b.x - mt, dc = c.x - mt, dd = d.x - mt;
            const float m2 = (a.y + b.y) + (c.y + d.y) + 64.0f * ((da * da + db * db) + (dc * dc + dd * dd));
            __hip_atomic_store(slots + ((size_t)(u.pm * BM + row) * 4 + u.pn), ((unsigned long long)__float_as_uint(m2) << 32) | __float_as_uint(mt), __ATOMIC_RELAXED, __HIP_MEMORY_SCOPE_AGENT);
        }
        asm volatile("s_waitcnt vmcnt(0)" ::: "memory");
        unsigned old = 0u;
        if (lane == 0) old = __hip_atomic_fetch_add(cnt + u.pm, 1u, __ATOMIC_RELAXED, __HIP_MEMORY_SCOPE_AGENT);
        old = (unsigned)__builtin_amdgcn_readfirstlane((int)old);
        if (old == 31u) {
            __builtin_amdgcn_fence(__ATOMIC_ACQUIRE, "agent");
#pragma unroll
            for (int rr = 0; rr < 4; ++rr) { const int r = lane * 4 + rr; const unsigned long long* sl = slots + (size_t)(u.pm * BM + r) * 4; float mt[4], m2[4], ms = 0.f;
#pragma unroll
                for (int t = 0; t < 4; ++t) { const unsigned long long w = __hip_atomic_load(sl + t, __ATOMIC_RELAXED, __HIP_MEMORY_SCOPE_AGENT); mt[t] = __uint_as_float((unsigned)w); m2[t] = __uint_as_float((unsigned)(w >> 32)); ms += mt[t]; }
                const float mean = ms * 0.25f; float q = 0.f;
#pragma unroll
                for (int t = 0; t < 4; ++t) { const float dm = mt[t] - mean; q += m2[t] + 256.0f * dm * dm; }
                *(f32x2*)(MUR + 2 * (size_t)(u.pm * BM + r)) = (f32x2){mean, 1.0f / sqrtf(q * (1.0f / 1024.0f) + 1e-5f)}; }
        }
    }
};

template <class Epi, class Sched, bool ALIGN_EPI, bool SP2, int KC>
__device__ __forceinline__ void gemm_phase(PG8_LAS unsigned char* lds, const Gemm g, const Sched& S, const Epi& E, const int tid) {
    const int wid = __builtin_amdgcn_readfirstlane(tid >> 6), lane = tid & 63, wr = wid >> 2, wc = wid & 3, fr = lane & 15, fq = lane >> 4;
    constexpr int K = KC, nt = K / BK;
    unsigned voffA[2], voffB[2];
#pragma unroll
    for (int i = 0; i < 2; ++i) { int R, C; stage_rc(tid * 16 + i * 8192, R, C); const int Rb = Epi::PERM ? ((R & ~31) + perm32(R & 31)) : R;
        voffA[i] = (unsigned)(R * K + C) * 2u; voffB[i] = (unsigned)(Rb * K + C) * 2u; }
    const size_t kstep = (size_t)(BK * 2);
    const size_t hstep = (size_t)HALF * K * 2;
    const size_t tstep = 2 * hstep;
    const unsigned ldsw = (unsigned)wid * 1024u;
    const int aoff = lds_byte(wr * 64 + fr, fq * 8), boff = lds_byte(wc * 32 + fr, fq * 8);
#define PG8_SA(b, h) (((b) * 2 + (h)) * HTB)
#define PG8_SB(b, h) ((4 + (b) * 2 + (h)) * HTB)
#define PG8_STAGE(bufoff, gbase, voff) do { _Pragma("unroll") for (int _i = 0; _i < 2; ++_i) \
        __builtin_amdgcn_global_load_lds((const unsigned*)((const char*)(gbase) + (voff)[_i]), (PG8_LAS unsigned*)(lds + (bufoff) + ldsw + _i * 8192), 16, 0, 0); } while (0)
#define PG8_LDA(dst, b, h) do { _Pragma("unroll") for (int m = 0; m < 4; ++m) _Pragma("unroll") for (int k = 0; k < 2; ++k) dst[m][k] = *(const PG8_LAS bf16x8*)(lds + PG8_SA(b, h) + aoff + m * 2048 + k * 1024); } while (0)
#define PG8_LDB(dst, b, h) do { _Pragma("unroll") for (int n = 0; n < 2; ++n) _Pragma("unroll") for (int k = 0; k < 2; ++k) dst[n][k] = *(const PG8_LAS bf16x8*)(lds + PG8_SB(b, h) + boff + n * 2048 + k * 1024); } while (0)
#define PG8_MMA(ai, bj, At, Bt) do { __builtin_amdgcn_s_setprio(1); _Pragma("unroll") for (int m = 0; m < 4; ++m) _Pragma("unroll") for (int n = 0; n < 2; ++n) _Pragma("unroll") for (int k = 0; k < 2; ++k) \
        acc[ai][bj][m][n] = __builtin_amdgcn_mfma_f32_16x16x32_bf16(Bt[n][k], At[m][k], acc[ai][bj][m][n], 0, 0, 0); __builtin_amdgcn_s_setprio(0); } while (0)
#define PG8_WAIT_V(n) asm volatile("s_waitcnt vmcnt(" #n ")" ::: "memory")
#define PG8_WAIT_L(n) asm volatile("s_waitcnt lgkmcnt(" #n ")" ::: "memory")
#define PG8_BAR __builtin_amdgcn_s_barrier()
#define PG8_SCHED __builtin_amdgcn_sched_barrier(0)
    Unit cur, nxt; int ui = 0;
    if (!S.next(0, cur)) return;
    f32x4 acc[2][2][4][2];
#pragma unroll
    for (int a = 0; a < 2; ++a)
#pragma unroll
        for (int b = 0; b < 2; ++b)
#pragma unroll
            for (int m = 0; m < 4; ++m)
#pragma unroll
                for (int n = 0; n < 2; ++n) acc[a][b][m][n] = (f32x4){0.f, 0.f, 0.f, 0.f};
    bf16x8 At[4][2], B0[2][2], B1[2][2];
    const char* cA = (const char*)g.A + (size_t)cur.pm * tstep; const char* cB = (const char*)g.Bt + (size_t)cur.pn * tstep;
    S.a_ready(cur);
    if constexpr (SP2) {
        PG8_STAGE(PG8_SB(0, 0), cB, voffB); PG8_STAGE(PG8_SB(0, 1), cB + hstep, voffB); PG8_STAGE(PG8_SA(0, 0), cA, voffA); PG8_STAGE(PG8_SA(0, 1), cA + hstep, voffA);
        if (wr == 1) PG8_BAR;
        PG8_WAIT_V(2); PG8_BAR;
        PG8_STAGE(PG8_SB(1, 0), cB + kstep, voffB); PG8_STAGE(PG8_SA(1, 0), cA + kstep, voffA); PG8_STAGE(PG8_SB(1, 1), cB + hstep + kstep, voffB);
        PG8_WAIT_V(6); PG8_BAR;
    } else {
        PG8_STAGE(PG8_SB(0, 0), cB, voffB); PG8_STAGE(PG8_SA(0, 0), cA, voffA); PG8_STAGE(PG8_SB(0, 1), cB + hstep, voffB); PG8_STAGE(PG8_SA(0, 1), cA + hstep, voffA);
        if (wr == 1) PG8_BAR;
        PG8_WAIT_V(4); PG8_BAR;
        PG8_STAGE(PG8_SB(1, 0), cB + kstep, voffB); PG8_STAGE(PG8_SA(1, 0), cA + kstep, voffA); PG8_STAGE(PG8_SB(1, 1), cB + hstep + kstep, voffB);
        PG8_WAIT_V(6); PG8_BAR;
    }
    for (;;) {
        const bool has_next = S.next(ui + 1, nxt);
        const char* nA = has_next ? (const char*)g.A + (size_t)nxt.pm * tstep : cA; const char* nB = has_next ? (const char*)g.Bt + (size_t)nxt.pn * tstep : cB;
        for (int t = 0; t < nt; t += 2) {
            const bool last = (t == nt - 2);
            const char* a1 = cA + (size_t)(t + 1) * kstep;
            const char* a2 = last ? nA : cA + (size_t)(t + 2) * kstep; const char* b2 = last ? nB : cB + (size_t)(t + 2) * kstep;
            const char* a3 = a2 + kstep; const char* b3 = b2 + kstep;
            if (last && has_next) S.a_ready(nxt);
            if constexpr (SP2) {
            PG8_LDB(B0, 0, 0); PG8_LDB(B1, 0, 1); PG8_SCHED; PG8_LDA(At, 0, 0); PG8_STAGE(PG8_SA(1, 1), a1 + hstep, voffA);
            PG8_WAIT_V(8); PG8_WAIT_L(0); PG8_BAR; PG8_MMA(0, 0, At, B0); PG8_MMA(0, 1, At, B1); PG8_BAR; PG8_SCHED;
            PG8_LDA(At, 0, 1); PG8_STAGE(PG8_SB(0, 0), b2, voffB); PG8_STAGE(PG8_SB(0, 1), b2 + hstep, voffB); PG8_STAGE(PG8_SA(0, 0), a2, voffA);
            PG8_WAIT_V(8); PG8_WAIT_L(0); PG8_BAR; PG8_MMA(1, 0, At, B0); PG8_MMA(1, 1, At, B1); PG8_BAR; PG8_SCHED;
            PG8_LDB(B0, 1, 0); PG8_LDB(B1, 1, 1); PG8_SCHED; PG8_LDA(At, 1, 0); PG8_STAGE(PG8_SA(0, 1), a2 + hstep, voffA);
            PG8_WAIT_V(8); PG8_WAIT_L(0); PG8_BAR; PG8_MMA(0, 0, At, B0); PG8_MMA(0, 1, At, B1); PG8_BAR; PG8_SCHED;
            PG8_LDA(At, 1, 1); PG8_STAGE(PG8_SB(1, 0), b3, voffB); PG8_STAGE(PG8_SB(1, 1), b3 + hstep, voffB); PG8_STAGE(PG8_SA(1, 0), a3, voffA);
            PG8_WAIT_V(8); PG8_WAIT_L(0); PG8_BAR; PG8_MMA(1, 0, At, B0); PG8_MMA(1, 1, At, B1); PG8_BAR; PG8_SCHED;
            } else {
            PG8_LDB(B0, 0, 0); PG8_SCHED; PG8_LDA(At, 0, 0); PG8_STAGE(PG8_SA(1, 1), a1 + hstep, voffA);
            PG8_WAIT_L(8); PG8_BAR; PG8_WAIT_L(0); PG8_MMA(0, 0, At, B0); PG8_BAR; PG8_SCHED;
            PG8_LDB(B1, 0, 1); PG8_STAGE(PG8_SB(0, 0), b2, voffB);
            PG8_BAR; PG8_WAIT_L(0); PG8_MMA(0, 1, At, B1); PG8_BAR;
            PG8_LDA(At, 0, 1); PG8_STAGE(PG8_SA(0, 0), a2, voffA);
            PG8_BAR; PG8_WAIT_L(0); PG8_MMA(1, 0, At, B0); PG8_BAR; PG8_SCHED;
            PG8_STAGE(PG8_SB(0, 1), b2 + hstep, voffB);
            PG8_WAIT_V(6); PG8_BAR; PG8_MMA(1, 1, At, B1); PG8_BAR;
            PG8_LDB(B0, 1, 0); PG8_SCHED; PG8_LDA(At, 1, 0); PG8_STAGE(PG8_SA(0, 1), a2 + hstep, voffA);
            PG8_WAIT_L(8); PG8_BAR; PG8_WAIT_L(0); PG8_MMA(0, 0, At, B0); PG8_BAR; PG8_SCHED;
            PG8_LDB(B1, 1, 1); PG8_STAGE(PG8_SB(1, 0), b3, voffB);
            PG8_BAR; PG8_WAIT_L(0); PG8_MMA(0, 1, At, B1); PG8_BAR;
            PG8_LDA(At, 1, 1); PG8_STAGE(PG8_SA(1, 0), a3, voffA);
            PG8_BAR; PG8_WAIT_L(0); PG8_MMA(1, 0, At, B0); PG8_BAR; PG8_SCHED;
            PG8_STAGE(PG8_SB(1, 1), b3 + hstep, voffB);
            PG8_WAIT_V(6); PG8_BAR; PG8_MMA(1, 1, At, B1); PG8_BAR;
            }
        }
        if constexpr (ALIGN_EPI) { if (wr == 0) PG8_BAR; }
        if constexpr (!Epi::AFTER_DRAIN) { E(acc, cur, wr, wc, fr, fq); S.done(cur); }
        if (!has_next) break;
#pragma unroll
        for (int a = 0; a < 2; ++a)
#pragma unroll
            for (int b = 0; b < 2; ++b)
#pragma unroll
                for (int m = 0; m < 4; ++m)
#pragma unroll
                    for (int n = 0; n < 2; ++n) acc[a][b][m][n] = (f32x4){0.f, 0.f, 0.f, 0.f};
        cur = nxt; cA = nA; cB = nB; ++ui;
        if constexpr (ALIGN_EPI) { if (wr == 1) PG8_BAR; }
    }
    PG8_WAIT_V(0);
    if constexpr (!ALIGN_EPI) { if (wr == 0) PG8_BAR; }
    PG8_BAR;
    if constexpr (Epi::AFTER_DRAIN) { E.fused(acc, cur, wr, wc, fr, fq, lds, wid, lane); S.done(cur); }
#undef PG8_SA
#undef PG8_SB
#undef PG8_STAGE
#undef PG8_LDA
#undef PG8_LDB
#undef PG8_MMA
#undef PG8_WAIT_V
#undef PG8_WAIT_L
#undef PG8_BAR
#undef PG8_SCHED
}
}
namespace cg = cooperative_groups;
#define LAS __attribute__((address_space(3)))
#define LDS_WAIT() asm volatile("s_waitcnt lgkmcnt(0)" ::: "memory")
constexpr int NWAVES = 8, LDS_BYTES = 147456;
constexpr size_t WT_XK = 0, WT_XV = (size_t)4096 * 1024, WT_L0 = (size_t)2 * 4096 * 1024, WT_LSTRIDE = 14680064;
constexpr size_t WO_IN = 0, WO_MIX = 2883584, WO_XQ = WO_MIX + 1048576, WO_XO = WO_XQ + 1048576, WO_FF1 = WO_XO + 1048576, WO_FF2 = WO_FF1 + 5767168;
static_assert(WO_FF2 + 2883584 == WT_LSTRIDE && (WT_L0 + 4 * WT_LSTRIDE) * 2 == 128 * MiB, "weight map");
constexpr int I_IN = 16 * 81, I_SQ = 512, I_XKV = 1024, I_FF1 = 16 * 176, I_FF2 = 44 * 32, I_LAYER = I_IN + 3 * I_SQ + I_XKV + I_FF1 + I_FF2;

struct Args { const float* in[24]; float* out; unsigned char* ws; int ph_lo, ph_hi, sub, pad; };

__device__ __forceinline__ unsigned pk2(float lo, float hi) { return (unsigned)f2bf(lo) | ((unsigned)f2bf(hi) << 16); }
__device__ __forceinline__ void cvt_item(const float* W, int K, int N, int k0, int n0, bf16_t* dst, LAS float* scr, int lane) {
#pragma unroll 8
    for (int i = 0; i < 32; ++i) { const int kk = 2 * i + (lane >> 5), n = n0 + (lane & 31); scr[kk * 33 + (lane & 31)] = n < N ? W[(size_t)(k0 + kk) * N + n] : 0.f; }
    LDS_WAIT(); asm volatile("" ::: "memory");
    const int c = lane & 7;
#pragma unroll
    for (int j = 0; j < 4; ++j) { const int n = (lane >> 3) + 8 * j; const LAS float* s = scr + (8 * c) * 33 + n;
        u32x4 o; o.x = pk2(s[0 * 33], s[1 * 33]); o.y = pk2(s[2 * 33], s[3 * 33]); o.z = pk2(s[4 * 33], s[5 * 33]); o.w = pk2(s[6 * 33], s[7 * 33]);
        *(u32x4*)(dst + (size_t)n * K + k0 + 8 * c) = o; }
    LDS_WAIT(); asm volatile("" ::: "memory");
}
__device__ __forceinline__ void ln_row(const float* in, float* outf, bf16_t* outb, const float* g, const float* b, int lane) {
    const f32x4* xr = (const f32x4*)in + lane;
    f32x4 v[4]; float s = 0.f;
#pragma unroll
    for (int j = 0; j < 4; ++j) { v[j] = xr[64 * j]; s += (v[j].x + v[j].y) + (v[j].z + v[j].w); }
    const float mean = wave_sum(s) * (1.f / D); float s2 = 0.f;
#pragma unroll
    for (int j = 0; j < 4; ++j) { v[j] = v[j] - mean; s2 += (v[j].x * v[j].x + v[j].y * v[j].y) + (v[j].z * v[j].z + v[j].w * v[j].w); }
    const float rstd = rsqrtf(wave_sum(s2) * (1.f / D) + LN_EPS);
#pragma unroll
    for (int j = 0; j < 4; ++j) {
        const int c = (64 * j + lane) * 4;
        const f32x4 o = v[j] * rstd * *(const f32x4*)(g + c) + *(const f32x4*)(b + c);
        *((f32x4*)outf + 64 * j + lane) = o;
        *(unsigned long long*)(outb + c) = (unsigned long long)pk2(o.x, o.y) | ((unsigned long long)pk2(o.z, o.w) << 32);
    }
}


__device__ __forceinline__ void cvt_item_ln(const float* W, int K, int N, int k0, int n0, bf16_t* dst, LAS float* scr, int lane, const float* g, const float* b, float* csp, float* cbp) {
    float cs = 0.f, cb = 0.f;
#pragma unroll 8
    for (int i = 0; i < 32; ++i) { const int kk = 2 * i + (lane >> 5), n = n0 + (lane & 31); const float w = n < N ? W[(size_t)(k0 + kk) * N + n] : 0.f; const float wg = w * g[k0 + kk];
        scr[kk * 33 + (lane & 31)] = wg; cs += bf2f(f2bf(wg)); cb += b[k0 + kk] * w; }
    cs += __shfl_xor(cs, 32); cb += __shfl_xor(cb, 32);
    if (lane < 32) { csp[lane] = cs; cbp[lane] = cb; }
    LDS_WAIT(); asm volatile("" ::: "memory");
    const int c = lane & 7;
#pragma unroll
    for (int j = 0; j < 4; ++j) { const int n = (lane >> 3) + 8 * j; const LAS float* s = scr + (8 * c) * 33 + n;
        u32x4 o; o.x = pk2(s[0 * 33], s[1 * 33]); o.y = pk2(s[2 * 33], s[3 * 33]); o.z = pk2(s[4 * 33], s[5 * 33]); o.w = pk2(s[6 * 33], s[7 * 33]);
        *(u32x4*)(dst + (size_t)n * K + k0 + 8 * c) = o; }
    LDS_WAIT(); asm volatile("" ::: "memory");
}
__device__ __forceinline__ void x_row(const float* in, bf16_t* outb, float* mur, int lane) {
    const f32x4* xr = (const f32x4*)in + lane;
    f32x4 v[4]; float s = 0.f;
#pragma unroll
    for (int j = 0; j < 4; ++j) { v[j] = xr[64 * j]; s += (v[j].x + v[j].y) + (v[j].z + v[j].w);
        *(unsigned long long*)(outb + (64 * j + lane) * 4) = (unsigned long long)pk2(v[j].x, v[j].y) | ((unsigned long long)pk2(v[j].z, v[j].w) << 32); }
    const float mean = wave_sum(s) * (1.f / D); float s2 = 0.f;
#pragma unroll
    for (int j = 0; j < 4; ++j) { const f32x4 d = v[j] - mean; s2 += (d.x * d.x + d.y * d.y) + (d.z * d.z + d.w * d.w); }
    const float rstd = rsqrtf(wave_sum(s2) * (1.f / D) + LN_EPS);
    if (lane == 0) { mur[0] = mean; mur[1] = rstd; }
}
__device__ __forceinline__ void ln_row_f32(float* io, const float* g, const float* b, int lane) {
    f32x4* xr = (f32x4*)io + lane;
    f32x4 v[4]; float s = 0.f;
#pragma unroll
    for (int j = 0; j < 4; ++j) { v[j] = xr[64 * j]; s += (v[j].x + v[j].y) + (v[j].z + v[j].w); }
    const float mean = wave_sum(s) * (1.f / D); float s2 = 0.f;
#pragma unroll
    for (int j = 0; j < 4; ++j) { v[j] = v[j] - mean; s2 += (v[j].x * v[j].x + v[j].y * v[j].y) + (v[j].z * v[j].z + v[j].w * v[j].w); }
    const float rstd = rsqrtf(wave_sum(s2) * (1.f / D) + LN_EPS);
#pragma unroll
    for (int j = 0; j < 4; ++j) { const int c = (64 * j + lane) * 4; xr[64 * j] = v[j] * rstd * *(const f32x4*)(g + c) + *(const f32x4*)(b + c); }
}
#define XB_TMO      128
#define XB_XCNT(j)  (256  + 64 * (j))
#define XB_XSUB(j)  (1280 + 64 * (j))
#define XB_XGEN(j)  (2304 + 64 * (j))
#define XB_TOP      3328
#define XB_TOPGEN   3392
#define XCD_BAR_WORDS 3456
#define XB_SPIN_CAP (1u << 18)

__device__ __forceinline__ unsigned xb_ld(unsigned* p)              { return __hip_atomic_load(p, __ATOMIC_RELAXED, __HIP_MEMORY_SCOPE_AGENT); }
__device__ __forceinline__ unsigned xb_add(unsigned* p, unsigned v) { return __hip_atomic_fetch_add(p, v, __ATOMIC_RELAXED, __HIP_MEMORY_SCOPE_AGENT); }
__device__ __forceinline__ unsigned xb_xcc_id() { return (unsigned)__builtin_amdgcn_s_getreg((3 << 11) | 20) & 0xFu; }
#define XB_SPIN(cond, bar) do { unsigned _sp = 0; while (cond) { __builtin_amdgcn_s_sleep(1); \
    if ((++_sp & 255u) == 0u) { if (xb_ld(&(bar)[XB_TMO])) break; if (_sp > XB_SPIN_CAP) { atomicAdd(&(bar)[XB_TMO], 1u); break; } } } } while (0)

struct XcdBarrier {
    unsigned* bar; unsigned x;
    volatile LAS unsigned* st;
};

__device__ __forceinline__ XcdBarrier xcd_barrier_post(unsigned* bar, volatile LAS unsigned* st) {
    XcdBarrier b; b.bar = bar; b.x = xb_xcc_id(); b.st = st;
    if (threadIdx.x == 0) (void)xb_add(&bar[XB_XCNT(b.x)], 1u);
    return b;
}
__device__ __forceinline__ void xcd_barrier_complete(unsigned* bar, unsigned x, unsigned& nloc, unsigned& nx) {
    const unsigned G = gridDim.x * gridDim.y * gridDim.z;
    unsigned sum, cnt, mine, sp = 0u;
    for (;;) {
        sum = 0u; cnt = 0u; mine = 0u;
#pragma unroll
        for (unsigned j = 0; j < 16; ++j) { const unsigned c = xb_ld(&bar[XB_XCNT(j)]); sum += c; cnt += (c > 0u) ? 1u : 0u; mine = (j == x) ? c : mine; }
        if (sum == G) break;
        __builtin_amdgcn_s_sleep(1);
        if ((++sp & 255u) == 0u) { if (xb_ld(&bar[XB_TMO])) break; if (sp > XB_SPIN_CAP) { atomicAdd(&bar[XB_TMO], 1u); break; } }
    }
    nloc = mine > 0u ? mine : 1u; nx = cnt > 0u ? cnt : 1u;
}

__device__ __forceinline__ void xcd_barrier(const XcdBarrier& b) {
    asm volatile("s_waitcnt vmcnt(0)" ::: "memory");
    __syncthreads();
    if (threadIdx.x == 0) {
        unsigned* bar = b.bar;
        __builtin_amdgcn_s_waitcnt(0);
        unsigned nloc = b.st[0], nx = b.st[1];
        if (nloc == 0u) { xcd_barrier_complete(bar, b.x, nloc, nx); b.st[0] = nloc; b.st[1] = nx; }
        const unsigned old = xb_add(&bar[XB_XSUB(b.x)], 1u);
        const unsigned gen = old / nloc;
        if (old + 1u == (gen + 1u) * nloc) {
            __builtin_amdgcn_fence(__ATOMIC_RELEASE, "agent");
            asm volatile("s_waitcnt vmcnt(0)" ::: "memory");
            const unsigned og = xb_add(&bar[XB_TOP], 1u);
            const unsigned tg = og / nx;
            if (og + 1u == (tg + 1u) * nx) xb_add(&bar[XB_TOPGEN], 1u);
            else XB_SPIN(xb_ld(&bar[XB_TOPGEN]) == tg, bar);
            __builtin_amdgcn_fence(__ATOMIC_ACQUIRE, "agent");
            xb_add(&bar[XB_XGEN(b.x)], 1u);
            asm volatile("s_waitcnt vmcnt(0)" ::: "memory");
        } else {
            XB_SPIN(xb_ld(&bar[XB_XGEN(b.x)]) == gen, bar);
            __builtin_amdgcn_fence(__ATOMIC_ACQUIRE, "agent");
            asm volatile("s_waitcnt vmcnt(0)" ::: "memory");
        }
    }
    __syncthreads();
}

template <bool REL, bool ACQ> __device__ __forceinline__ void xcd_barrier_v(const XcdBarrier& b) {
    asm volatile("s_waitcnt vmcnt(0)" ::: "memory");
    __syncthreads();
    if (threadIdx.x == 0) {
        unsigned* bar = b.bar;
        __builtin_amdgcn_s_waitcnt(0);
        unsigned nloc = b.st[0], nx = b.st[1];
        if (nloc == 0u) { xcd_barrier_complete(bar, b.x, nloc, nx); b.st[0] = nloc; b.st[1] = nx; }
        const unsigned old = xb_add(&bar[XB_XSUB(b.x)], 1u);
        const unsigned gen = old / nloc;
        if (old + 1u == (gen + 1u) * nloc) {
            if (REL) __builtin_amdgcn_fence(__ATOMIC_RELEASE, "agent");
            asm volatile("s_waitcnt vmcnt(0)" ::: "memory");
            const unsigned og = xb_add(&bar[XB_TOP], 1u);
            const unsigned tg = og / nx;
            if (og + 1u == (tg + 1u) * nx) xb_add(&bar[XB_TOPGEN], 1u);
            else XB_SPIN(xb_ld(&bar[XB_TOPGEN]) == tg, bar);
            if (ACQ) __builtin_amdgcn_fence(__ATOMIC_ACQUIRE, "agent");
            xb_add(&bar[XB_XGEN(b.x)], 1u);
            asm volatile("s_waitcnt vmcnt(0)" ::: "memory");
        } else {
            XB_SPIN(xb_ld(&bar[XB_XGEN(b.x)]) == gen, bar);
            if (ACQ) __builtin_amdgcn_fence(__ATOMIC_ACQUIRE, "agent");
            asm volatile("s_waitcnt vmcnt(0)" ::: "memory");
        }
    }
    __syncthreads();
}
typedef short bf16x8_t __attribute__((ext_vector_type(8)));
typedef unsigned u32x2_t __attribute__((ext_vector_type(2)));
__device__ __forceinline__ unsigned cvtpk(float lo, float hi) { unsigned r; asm volatile("v_cvt_pk_bf16_f32 %0, %1, %2" : "=v"(r) : "v"(lo), "v"(hi)); return r; }
__device__ __forceinline__ void att_stage(LAS unsigned char* lds, const bf16_t* src, int pitch, int tid) {
    const int r0 = tid >> 5, ch = tid & 31;
    const bf16_t* g0 = src + (size_t)r0 * pitch + ch * 8;
    LAS unsigned char* l0 = lds + r0 * 512 + ((ch ^ r0) << 4);
    u32x4 v[16];
#pragma unroll
    for (int x = 0; x < 16; ++x) v[x] = *(const u32x4*)(g0 + (size_t)(16 * x) * pitch);
#pragma unroll
    for (int x = 0; x < 16; ++x) *(LAS u32x4*)(l0 + x * 8192) = v[x];
}
__device__ __forceinline__ void att_phase(LAS unsigned char* lds, const bf16_t* Kl, const bf16_t* Vl, const bf16_t* Qb, bf16_t* Ob, int G, int tid) {
    for (int u = blockIdx.x; u < (M / 128) * 4; u += G) {
        asm volatile("" : "+v"(tid));
        const int lane = tid & 63, wave = __builtin_amdgcn_readfirstlane(tid >> 6), j = lane & 15, kg = lane >> 4;
        const int h = u & 3, pm = u >> 2, b = pm >> 6;
        att_stage(lds, Kl + (size_t)(b * 256) * 4096 + h * 256, 4096, tid);
        const bf16_t* qrow = Qb + (size_t)(pm * 128 + 16 * wave + j) * 1024 + h * 256;
        bf16_t* orow = Ob + (size_t)(pm * 128 + 16 * wave + j) * 1024 + h * 256;
        bf16x8_t qf[8];
#pragma unroll
        for (int s = 0; s < 8; ++s) qf[s] = *(const bf16x8_t*)(qrow + 32 * s + 8 * kg);
        __syncthreads();
        f32x4 acc[16];
#pragma unroll
        for (int kb = 0; kb < 16; ++kb) acc[kb] = (f32x4){0.f, 0.f, 0.f, 0.f};
        const LAS unsigned char* fbase = lds + j * 512;
#pragma unroll
        for (int s = 0; s < 8; ++s)
#pragma unroll
            for (int kb = 0; kb < 16; ++kb) { const bf16x8_t af = *(const LAS bf16x8_t*)(fbase + kb * 8192 + (((4 * s + kg) ^ j) << 4));
                acc[kb] = __builtin_amdgcn_mfma_f32_16x16x32_bf16(af, qf[s], acc[kb], 0, 0, 0); }
        float mx = acc[0][0];
#pragma unroll
        for (int kb = 0; kb < 16; ++kb) mx = fmaxf(fmaxf(mx, fmaxf(acc[kb][0], acc[kb][1])), fmaxf(acc[kb][2], acc[kb][3]));
        mx = fmaxf(mx, __shfl_xor(mx, 16)); mx = fmaxf(mx, __shfl_xor(mx, 32));
        const float cs = 0.0625f * 1.4426950408889634f, mxc = mx * cs; float sum = 0.f;
        bf16x8_t pf[8];
#pragma unroll
        for (int t = 0; t < 8; ++t) { f32x4 p0, p1;
#pragma unroll
            for (int e = 0; e < 4; ++e) { p0[e] = __builtin_amdgcn_exp2f(acc[2 * t][e] * cs - mxc); p1[e] = __builtin_amdgcn_exp2f(acc[2 * t + 1][e] * cs - mxc); }
            sum += (p0[0] + p0[1]) + (p0[2] + p0[3]) + (p1[0] + p1[1]) + (p1[2] + p1[3]);
            u32x4 w; w.x = cvtpk(p0[0], p0[1]); w.y = cvtpk(p0[2], p0[3]); w.z = cvtpk(p1[0], p1[1]); w.w = cvtpk(p1[2], p1[3]); pf[t] = __builtin_bit_cast(bf16x8_t, w); }
        sum += __shfl_xor(sum, 16); sum += __shfl_xor(sum, 32);
        const float inv = 1.f / sum;
        __syncthreads();
        att_stage(lds, Vl + (size_t)(h * 256) * 1024 + b * 256, 1024, tid);
        __syncthreads();
#pragma unroll
        for (int db = 0; db < 16; ++db) {
            f32x4 o = (f32x4){0.f, 0.f, 0.f, 0.f};
#pragma unroll
            for (int t = 0; t < 8; ++t) { const bf16x8_t af = *(const LAS bf16x8_t*)(fbase + db * 8192 + (((4 * t + kg) ^ j) << 4));
                o = __builtin_amdgcn_mfma_f32_16x16x32_bf16(af, pf[t], o, 0, 0, 0); }
            u32x2_t w; w.x = cvtpk(o[0] * inv, o[1] * inv); w.y = cvtpk(o[2] * inv, o[3] * inv);
            *(u32x2_t*)(orow + 16 * db + 4 * kg) = w;
        }
        __syncthreads();
    }
}

__device__ __forceinline__ void conv_phase(LAS unsigned char* lds, const bf16_t* PROJ, const float* cw, const float* cb, const float* lg, const float* lb, bf16_t* MIXIN, int G, int tid) {
    LAS float* U = (LAS float*)lds;
    for (int u = blockIdx.x; u < M / 32; u += G) {
        asm volatile("" : "+v"(tid));
        const int lane = tid & 63, wave = __builtin_amdgcn_readfirstlane(tid >> 6);
        const int row0 = u * 32, t0 = row0 % SEQ;
#pragma unroll
        for (int pass = 0; pass < 8; ++pass) { const int rr = pass * 8 + wave;
            if (rr < 62) { f32x4 o0 = (f32x4){0.f, 0.f, 0.f, 0.f}, o1 = o0;
                if (t0 - 30 + rr >= 0) { const bf16_t* pr = PROJ + (size_t)(row0 - 30 + rr) * PROJ_LD + 8 * lane;
                    const u32x4 a = *(const u32x4*)(pr + C_CA), g = *(const u32x4*)(pr + C_CG);
#pragma unroll
                    for (int x = 0; x < 4; ++x) { const float a0 = __uint_as_float(a[x] << 16), a1 = __uint_as_float(a[x] & 0xffff0000u), g0 = __uint_as_float(g[x] << 16), g1 = __uint_as_float(g[x] & 0xffff0000u);
                        const float u0 = a0 * __builtin_amdgcn_rcpf(1.f + __expf(-g0)), u1 = a1 * __builtin_amdgcn_rcpf(1.f + __expf(-g1));
                        if (x < 2) { o0[2 * x] = u0; o0[2 * x + 1] = u1; } else { o1[2 * x - 4] = u0; o1[2 * x - 3] = u1; } } }
                *(LAS f32x4*)(U + rr * 512 + 8 * lane) = o0; *(LAS f32x4*)(U + rr * 512 + 8 * lane + 4) = o1; } }
        __syncthreads();
        const int c = tid;
        float w[31];
#pragma unroll
        for (int k = 0; k < 31; ++k) w[k] = cw[k * 512 + c];
        const float bias = cb[c];
        float y[32];
#pragma unroll
        for (int blk = 0; blk < 4; ++blk) { float win[38];
#pragma unroll
            for (int x = 0; x < 38; ++x) win[x] = U[(8 * blk + x) * 512 + c];
#pragma unroll
            for (int o = 0; o < 8; ++o) { float acc = bias;
#pragma unroll
                for (int k = 0; k < 31; ++k) acc += w[k] * win[o + k];
                y[8 * blk + o] = acc; } }
        __syncthreads();
#pragma unroll
        for (int tt = 0; tt < 32; ++tt) U[tt * 512 + c] = y[tt];
        __syncthreads();
#pragma unroll
        for (int q = 0; q < 4; ++q) { const int tt = 4 * wave + q;
            f32x4 a = *(const LAS f32x4*)(U + tt * 512 + 8 * lane), b = *(const LAS f32x4*)(U + tt * 512 + 8 * lane + 4);
            const float mean = wave_sum((a[0] + a[1]) + (a[2] + a[3]) + (b[0] + b[1]) + (b[2] + b[3])) * (1.f / 512.f);
            a = a - mean; b = b - mean;
            const float var = wave_sum((a[0] * a[0] + a[1] * a[1]) + (a[2] * a[2] + a[3] * a[3]) + (b[0] * b[0] + b[1] * b[1]) + (b[2] * b[2] + b[3] * b[3])) * (1.f / 512.f);
            const float rstd = rsqrtf(var + LN_EPS);
            a = a * rstd * *(const f32x4*)(lg + 8 * lane) + *(const f32x4*)(lb + 8 * lane); b = b * rstd * *(const f32x4*)(lg + 8 * lane + 4) + *(const f32x4*)(lb + 8 * lane + 4);
#pragma unroll
            for (int x = 0; x < 4; ++x) { a[x] = pg8::silu_fast(a[x]); b[x] = pg8::silu_fast(b[x]); }
            *(u32x4*)(MIXIN + (size_t)(row0 + tt) * D + 8 * lane) = pg8::pack8(a, b); }
        __syncthreads();
    }
}

typedef float f32x16_t __attribute__((ext_vector_type(16)));
constexpr int GP = 72;
__device__ __forceinline__ int slot32(int c) { const int w = c & 15; return (c & ~15) + 8 * ((w >> 2) & 1) + (w & 3) + 4 * (w >> 3); }
__device__ __forceinline__ void gla_bcum(const bf16_t* ALOW, const float* wa2, const float* ba, int row0, int h, int lane, int wave, float (&bc)[8], float (&bl)[8]) {
    const u32x4 a0 = *(const u32x4*)(ALOW + (size_t)(row0 + lane) * 16), a1 = *(const u32x4*)(ALOW + (size_t)(row0 + lane) * 16 + 8);
    float al[16];
#pragma unroll
    for (int x = 0; x < 4; ++x) { al[2 * x] = __uint_as_float(a0[x] << 16); al[2 * x + 1] = __uint_as_float(a0[x] & 0xffff0000u); al[8 + 2 * x] = __uint_as_float(a1[x] << 16); al[8 + 2 * x + 1] = __uint_as_float(a1[x] & 0xffff0000u); }
#pragma unroll
    for (int x = 0; x < 8; ++x) { const int col = h * 64 + 8 * wave + x; float z = ba[col];
#pragma unroll
        for (int i = 0; i < 16; ++i) z += al[i] * wa2[i * 256 + col];
        float la = (fminf(z, 0.f) - log1pf(__expf(-fabsf(z)))) * (1.f / 16.f);
#pragma unroll
        for (int off = 1; off < 64; off <<= 1) { const float t = __shfl_up(la, off); if (lane >= off) la += t; }
        bc[x] = la; bl[x] = __shfl(la, 63); }
}
__device__ __forceinline__ void unpack8(const u32x4 v, float (&f)[8]) {
#pragma unroll
    for (int x = 0; x < 4; ++x) { f[2 * x] = __uint_as_float(v[x] << 16); f[2 * x + 1] = __uint_as_float(v[x] & 0xffff0000u); }
}
__device__ __forceinline__ void gla_g1_phase(LAS unsigned char* lds, const bf16_t* PROJ, const bf16_t* ALOW, const float* wa2, const float* ba, float* UPD, float* DEC, int G, int tid) {
    LAS bf16_t* KD = (LAS bf16_t*)lds; LAS bf16_t* VT = (LAS bf16_t*)(lds + 18432);
    for (int u = blockIdx.x; u < 2048; u += G) {
        asm volatile("" : "+v"(tid));
        const int lane = tid & 63, wave = __builtin_amdgcn_readfirstlane(tid >> 6);
        const int bh = u >> 7, n = u & 127, b = bh >> 2, h = bh & 3, row0 = b * SEQ + n * 64;
        float bc[8], bl[8];
        gla_bcum(ALOW, wa2, ba, row0, h, lane, wave, bc, bl);
        const bf16_t* pr = PROJ + (size_t)(row0 + lane) * PROJ_LD;
        float kf[8]; unpack8(*(const u32x4*)(pr + C_K + h * 64 + 8 * wave), kf);
#pragma unroll
        for (int x = 0; x < 8; ++x) KD[(8 * wave + x) * GP + lane] = f2bf(kf[x] * __expf(bl[x] - bc[x]));
        if (lane == 63) {
#pragma unroll
            for (int x = 0; x < 8; ++x) DEC[u * 64 + 8 * wave + x] = __expf(bl[x]); }
#pragma unroll
        for (int pc = 0; pc < 2; ++pc) { const int e0 = 64 * pc + 8 * wave; const u32x4 v = *(const u32x4*)(pr + C_V + h * 128 + e0);
#pragma unroll
            for (int x = 0; x < 4; ++x) { VT[(e0 + 2 * x) * GP + lane] = (bf16_t)(v[x] & 0xffffu); VT[(e0 + 2 * x + 1) * GP + lane] = (bf16_t)(v[x] >> 16); } }
        __syncthreads();
        const int eb = wave >> 1, dbk = wave & 1, i = lane & 31, kg = lane >> 5;
        f32x16_t acc;
#pragma unroll
        for (int r = 0; r < 16; ++r) acc[r] = 0.f;
#pragma unroll
        for (int s = 0; s < 4; ++s) { const bf16x8_t af = *(const LAS bf16x8_t*)(VT + (32 * eb + i) * GP + 16 * s + 8 * kg), bfr = *(const LAS bf16x8_t*)(KD + (32 * dbk + i) * GP + 16 * s + 8 * kg);
            acc = __builtin_amdgcn_mfma_f32_32x32x16_bf16(af, bfr, acc, 0, 0, 0); }
        float* up = UPD + ((size_t)u * 128 + 32 * eb + 4 * kg) * 64 + 32 * dbk + i;
#pragma unroll
        for (int r = 0; r < 16; ++r) up[((r & 3) + 8 * (r >> 2)) * 64] = acc[r];
        __syncthreads();
    }
}
__device__ __forceinline__ void gla_g2_phase(float* UPD, float* SP, const float* DEC, int G, int tid) {
    for (int g = blockIdx.x * 512 + tid; g < 16 * 8192; g += G * 512) {
        const int bh = g >> 13, ed = g & 8191, d = g & 63;
        const float* p = UPD + (size_t)bh * 128 * 8192 + ed; float* po = SP + (size_t)bh * 128 * 8192 + ed; const float* dc = DEC + bh * 128 * 64 + d;
        float S = 0.f;
        for (int n0 = 0; n0 < 128; n0 += 16) { float uu[16], dd[16];
#pragma unroll
            for (int x = 0; x < 16; ++x) { uu[x] = p[(size_t)(n0 + x) * 8192]; dd[x] = dc[(n0 + x) * 64]; }
#pragma unroll
            for (int x = 0; x < 16; ++x) { po[(size_t)(n0 + x) * 8192] = S; S = dd[x] * S + uu[x]; } }
    }
}
__device__ __forceinline__ void gla_g3_phase(LAS unsigned char* lds, const bf16_t* PROJ, const bf16_t* ALOW, const float* wa2, const float* ba, const float* gn, const float* UPD, bf16_t* MIXIN, int G, int tid) {
    LAS bf16_t* KE = (LAS bf16_t*)lds; LAS bf16_t* QE = (LAS bf16_t*)(lds + 9216); LAS bf16_t* VT = (LAS bf16_t*)(lds + 18432); LAS float* RED = (LAS float*)(lds + 36864);
    for (int u = blockIdx.x; u < 2048; u += G) {
        asm volatile("" : "+v"(tid));
        const int lane = tid & 63, wave = __builtin_amdgcn_readfirstlane(tid >> 6);
        const int bh = u >> 7, n = u & 127, b = bh >> 2, h = bh & 3, row0 = b * SEQ + n * 64;
        { float bc[8], bl[8];
          gla_bcum(ALOW, wa2, ba, row0, h, lane, wave, bc, bl);
          const bf16_t* pr = PROJ + (size_t)(row0 + lane) * PROJ_LD;
          float qf[8], kf[8]; unpack8(*(const u32x4*)(pr + C_Q + h * 64 + 8 * wave), qf); unpack8(*(const u32x4*)(pr + C_K + h * 64 + 8 * wave), kf);
          f32x4 q0, q1, k0, k1;
#pragma unroll
          for (int x = 0; x < 4; ++x) { q0[x] = qf[x] * 0.125f * __expf(bc[x]); q1[x] = qf[4 + x] * 0.125f * __expf(bc[4 + x]); k0[x] = kf[x] * __expf(-bc[x]); k1[x] = kf[4 + x] * __expf(-bc[4 + x]); }
          *(LAS u32x4*)(QE + lane * GP + 8 * wave) = pg8::pack8(q0, q1); *(LAS u32x4*)(KE + lane * GP + 8 * wave) = pg8::pack8(k0, k1);
          const int pcol = slot32(lane);
#pragma unroll
          for (int pc = 0; pc < 2; ++pc) { const int e0 = 64 * pc + 8 * wave; const u32x4 v = *(const u32x4*)(pr + C_V + h * 128 + e0);
#pragma unroll
              for (int x = 0; x < 4; ++x) { VT[(e0 + 2 * x) * GP + pcol] = (bf16_t)(v[x] & 0xffffu); VT[(e0 + 2 * x + 1) * GP + pcol] = (bf16_t)(v[x] >> 16); } } }
        __syncthreads();
        const int eb = wave >> 1, cb = wave & 1, i = lane & 31, kg = lane >> 5;
        bf16x8_t qb[4];
#pragma unroll
        for (int s = 0; s < 4; ++s) qb[s] = *(const LAS bf16x8_t*)(QE + (32 * cb + i) * GP + 16 * s + 8 * kg);
        f32x16_t o;
#pragma unroll
        for (int r = 0; r < 16; ++r) o[r] = 0.f;
#pragma unroll
        for (int sb = 0; sb < 2; ++sb) if (sb <= cb) {
            f32x16_t at;
#pragma unroll
            for (int r = 0; r < 16; ++r) at[r] = 0.f;
#pragma unroll
            for (int s = 0; s < 4; ++s) { const bf16x8_t af = *(const LAS bf16x8_t*)(KE + (32 * sb + i) * GP + 16 * s + 8 * kg); at = __builtin_amdgcn_mfma_f32_32x32x16_bf16(af, qb[s], at, 0, 0, 0); }
            if (sb == cb) {
#pragma unroll
                for (int r = 0; r < 16; ++r) if ((r & 3) + 8 * (r >> 2) + 4 * kg > i) at[r] = 0.f; }
#pragma unroll
            for (int sp = 0; sp < 2; ++sp) { u32x4 w; w.x = cvtpk(at[8 * sp + 0], at[8 * sp + 1]); w.y = cvtpk(at[8 * sp + 2], at[8 * sp + 3]); w.z = cvtpk(at[8 * sp + 4], at[8 * sp + 5]); w.w = cvtpk(at[8 * sp + 6], at[8 * sp + 7]);
                const bf16x8_t af = *(const LAS bf16x8_t*)(VT + (32 * eb + i) * GP + 32 * sb + 16 * sp + 8 * kg);
                o = __builtin_amdgcn_mfma_f32_32x32x16_bf16(af, __builtin_bit_cast(bf16x8_t, w), o, 0, 0, 0); }
        }
        { const float* sp = UPD + ((size_t)u * 128 + 32 * eb + i) * 64 + 8 * kg;
#pragma unroll
          for (int s = 0; s < 4; ++s) { const f32x4 x0 = *(const f32x4*)(sp + 16 * s), x1 = *(const f32x4*)(sp + 16 * s + 4);
              o = __builtin_amdgcn_mfma_f32_32x32x16_bf16(__builtin_bit_cast(bf16x8_t, pg8::pack8(x0, x1)), qb[s], o, 0, 0, 0); } }
        float ss = 0.f;
#pragma unroll
        for (int r = 0; r < 16; ++r) ss += o[r] * o[r];
        ss += __shfl_xor(ss, 32);
        if (kg == 0) RED[eb * 64 + 32 * cb + i] = ss;
        __syncthreads();
        const float tot = (RED[32 * cb + i] + RED[64 + 32 * cb + i]) + (RED[128 + 32 * cb + i] + RED[192 + 32 * cb + i]);
        const float rstd = rsqrtf(tot * (1.f / 128.f) + LN_EPS);
        const size_t row = (size_t)(row0 + 32 * cb + i);
#pragma unroll
        for (int rg = 0; rg < 4; ++rg) { const int e = 32 * eb + 8 * rg + 4 * kg;
            const f32x4 g4 = *(const f32x4*)(gn + e); const u32x2_t rr = *(const u32x2_t*)(PROJ + row * PROJ_LD + C_R + h * 128 + e);
            const float r0 = __uint_as_float(rr.x << 16), r1 = __uint_as_float(rr.x & 0xffff0000u), r2 = __uint_as_float(rr.y << 16), r3 = __uint_as_float(rr.y & 0xffff0000u);
            u32x2_t w; w.x = cvtpk(o[4 * rg] * rstd * g4[0] * pg8::silu_fast(r0), o[4 * rg + 1] * rstd * g4[1] * pg8::silu_fast(r1));
            w.y = cvtpk(o[4 * rg + 2] * rstd * g4[2] * pg8::silu_fast(r2), o[4 * rg + 3] * rstd * g4[3] * pg8::silu_fast(r3));
            *(u32x2_t*)(MIXIN + row * D + 512 + h * 128 + e) = w; }
        __syncthreads();
    }
}

#ifndef PROBE_MASK
#define PROBE_MASK 0
#endif
#ifndef ONE_LAUNCH
#define ONE_LAUNCH 1
#endif
constexpr int NPL = 10, NPH = 2 + NPL * DEPTH + 1;
enum { PK_IN = 0, PK_CG1, PK_G2, PK_G3, PK_MIX, PK_Q, PK_ATT, PK_XO, PK_FF1, PK_FF2 };
constexpr int CSN = 9472, CS_IN = 0, CS_Q = 2816, CS_FF1 = 3840;

__global__ void __launch_bounds__(NWAVES * 64) mega(Args a) {
    extern __shared__ __attribute__((aligned(16))) unsigned char lds_raw[];
    LAS unsigned char* lds = (LAS unsigned char*)lds_raw;
    const int wave = __builtin_amdgcn_readfirstlane(threadIdx.x >> 6);
    const int G = gridDim.x, gw = blockIdx.x * NWAVES + wave, NGW = G * NWAVES;
    unsigned char* ws = a.ws;
#define INP(k) ({ int k_ = (k); asm volatile("" : "+s"(k_)); a.in[k_]; })
    float* Y = a.out;
    bf16_t* WT = (bf16_t*)(ws + WS_WT); bf16_t* YB = (bf16_t*)(ws + WS_HB); bf16_t* PROJ = (bf16_t*)(ws + WS_PROJ); bf16_t* ALOW = (bf16_t*)(ws + WS_ALOW);
    bf16_t* MIXIN = (bf16_t*)(ws + WS_MIXIN); bf16_t* Qb = (bf16_t*)(ws + WS_Q); bf16_t* ACT = (bf16_t*)(ws + WS_ACT);
    bf16_t* Kb = (bf16_t*)(ws + WS_K); bf16_t* Vt = (bf16_t*)(ws + WS_VT); bf16_t* MEMB = (bf16_t*)(ws + WS_MEMB); bf16_t* MEMP = (bf16_t*)(ws + WS_MEMP);
    float* UPD = (float*)(ws + WS_UPD); float* DEC = (float*)(ws + WS_DEC);
    float* CSP = (float*)(ws + WS_CSP); float* CS = (float*)(ws + WS_CS); float* MUR = (float*)(ws + WS_MUR);
    unsigned long long* SLOTS = (unsigned long long*)(ws + WS_SLOTS); unsigned* CNT = (unsigned*)(ws + WS_CNT);

    volatile LAS unsigned* bst = (volatile LAS unsigned*)(lds + 143360);
    if (threadIdx.x == 0) { bst[0] = 0u; bst[1] = 0u; }
    __syncthreads();
    XcdBarrier xbar; xbar.bar = (unsigned*)(ws + WS_BAR); xbar.x = 0; xbar.st = bst;
    if (a.ph_hi - a.ph_lo > 1) xbar = xcd_barrier_post((unsigned*)(ws + WS_BAR), bst);
    for (int p = a.ph_lo; p < a.ph_hi; ++p) {
      const int pkind = (p < 2 || p == NPH - 1) ? -1 : (p - 2) % NPL;
      int nrep = 1;
      if ((a.sub & 4) && (pkind == PK_IN || pkind == PK_Q || pkind == PK_FF1)) nrep = 2;
      if ((a.sub & 8) && (pkind == PK_CG1 || pkind == PK_G3)) nrep = 2;
      if ((a.sub & 16) && pkind == PK_ATT) nrep = 2;
      if ((a.sub & 64) && p < 2) nrep = 2;
      if ((a.sub & 128) && pkind == PK_G2) nrep = 2;
      for (int rep = 0; rep < nrep; ++rep) {
        const bool dummy = rep + 1 < nrep;
        int tid; asm volatile("v_mbcnt_lo_u32_b32 %0, -1, 0\n\tv_mbcnt_hi_u32_b32 %0, -1, %0\n\tv_lshl_or_b32 %0, %1, 6, %0" : "=&v"(tid) : "s"(wave));
        const int lane = tid & 63;
        if (p == 0) {
            LAS float* scr = (LAS float*)(lds + wave * 16384);
            if (blockIdx.x == 0) { CNT[tid] = 0u; CNT[512 + tid] = 0u; CNT[1024 + tid] = 0u; }
            for (int it = gw; it < DEPTH * I_LAYER; it += NGW) {
                const int l = it / I_LAYER; int r = it % I_LAYER;
                bf16_t* WL = WT + WT_L0 + (size_t)l * WT_LSTRIDE;
                float* cspl = CSP + (size_t)l * 2 * 16 * CSN;
                if (r < I_IN) { const int kb = r / 81, nb = r % 81; const float* gg = l == 0 ? INP(2) : INP(22) + (l - 1) * D; const float* bb = l == 0 ? INP(3) : INP(23) + (l - 1) * D;
                    cvt_item_ln(INP(4) + (size_t)l * 1024 * IN_COLS, 1024, IN_COLS, 64 * kb, 32 * nb, WL + WO_IN + (size_t)(32 * nb) * 1024, scr, lane, gg, bb, cspl + kb * CSN + CS_IN + 32 * nb, cspl + (16 + kb) * CSN + CS_IN + 32 * nb); continue; } r -= I_IN;
                if (r < I_SQ) { const int kb = r / 32, nb = r % 32; cvt_item(INP(12) + (size_t)l * 1024 * 1024, 1024, 1024, 64 * kb, 32 * nb, WL + WO_MIX + (size_t)(32 * nb) * 1024, scr, lane); continue; } r -= I_SQ;
                if (r < I_SQ) { const int kb = r / 32, nb = r % 32;
                    cvt_item_ln(INP(15) + (size_t)l * 1024 * 1024, 1024, 1024, 64 * kb, 32 * nb, WL + WO_XQ + (size_t)(32 * nb) * 1024, scr, lane, INP(13) + l * D, INP(14) + l * D, cspl + kb * CSN + CS_Q + 32 * nb, cspl + (16 + kb) * CSN + CS_Q + 32 * nb); continue; } r -= I_SQ;
                if (r < I_SQ) { const int kb = r / 32, nb = r % 32; cvt_item(INP(17) + (size_t)l * 1024 * 1024, 1024, 1024, 64 * kb, 32 * nb, WL + WO_XO + (size_t)(32 * nb) * 1024, scr, lane); continue; } r -= I_SQ;
                if (r < I_XKV) { const int kb = r / 64, n0 = 32 * (r % 64);
                    bf16_t* dst = n0 < 1024 ? WT + WT_XK + (size_t)(l * 1024 + n0) * 1024 : WT + WT_XV + (size_t)(l * 1024 + n0 - 1024) * 1024;
                    cvt_item(INP(16) + (size_t)l * 1024 * 2048, 1024, 2048, 64 * kb, n0, dst, scr, lane); continue; } r -= I_XKV;
                if (r < I_FF1) { const int kb = r / 176, n0 = 32 * (r % 176);
                    const int drow = n0 < D_FF ? 256 * (n0 / 128) + n0 % 128 : 256 * ((n0 - D_FF) / 128) + 128 + (n0 - D_FF) % 128;
                    cvt_item_ln(INP(20) + (size_t)l * 1024 * 2 * D_FF, 1024, 2 * D_FF, 64 * kb, n0, WL + WO_FF1 + (size_t)drow * 1024, scr, lane, INP(18) + l * D, INP(19) + l * D, cspl + kb * CSN + CS_FF1 + drow, cspl + (16 + kb) * CSN + CS_FF1 + drow); continue; } r -= I_FF1;
                { const int kb = r / 32, nb = r % 32; cvt_item(INP(21) + (size_t)l * D_FF * 1024, D_FF, 1024, 64 * kb, 32 * nb, WL + WO_FF2 + (size_t)(32 * nb) * D_FF, scr, lane); }
            }
            for (int i = blockIdx.x * 512 + tid; i < 1024 * 1024; i += G * 512) {
                const int row = i >> 10, c = i & 1023, b = row >> 8, key = row & 255; const bf16_t v = f2bf(INP(1)[i]);
                MEMB[i] = v; MEMP[(size_t)(b * 256 + slot_of_key(key)) * 1024 + c] = v; }
            for (int m = gw; m < M; m += NGW) x_row(INP(0) + (size_t)m * D, YB + (size_t)m * D, MUR + 2 * (size_t)m, lane);
        } else if (p == 1) {
            for (int i = blockIdx.x * 512 + tid; i < DEPTH * 2 * CSN; i += G * 512) { const int lc = i / CSN, c = i % CSN; const float* pp = CSP + (size_t)lc * 16 * CSN + c; float s = 0.f;
#pragma unroll
                for (int kb = 0; kb < 16; ++kb) s += pp[kb * CSN];
                CS[i] = s; }
            const int half = G / 2;
            if ((int)blockIdx.x < half) { pg8::Gemm g{MEMB, WT + WT_XK, 1024, 4096, 1024}; pg8::StaticOrderT<1024, 4096> S; S.init(half, (int)blockIdx.x);
                pg8::EpiBf16 E{Kb, 4096}; pg8::gemm_phase<pg8::EpiBf16, pg8::StaticOrderT<1024, 4096>, true, true, 1024>(lds, g, S, E, tid); }
            else { pg8::Gemm g{WT + WT_XV, MEMP, 4096, 1024, 1024}; pg8::StaticOrderT<4096, 1024> S; S.init(G - half, (int)blockIdx.x - half);
                pg8::EpiBf16 E{Vt, 1024}; pg8::gemm_phase<pg8::EpiBf16, pg8::StaticOrderT<4096, 1024>, true, true, 1024>(lds, g, S, E, tid); }
        } else if (p == NPH - 1) {
            const float* gg = INP(22) + (DEPTH - 1) * D; const float* bb = INP(23) + (DEPTH - 1) * D;
            for (int m = gw; m < M; m += NGW) ln_row_f32(Y + (size_t)m * D, gg, bb, lane);
        } else {
            const int l = (p - 2) / NPL, kind = (p - 2) % NPL;
            const bf16_t* WL = WT + WT_L0 + (size_t)l * WT_LSTRIDE;
            const float* csl = CS + (size_t)l * 2 * CSN; const float* cbl = csl + CSN;
            if (kind == PK_IN) { pg8::Gemm g{YB, WL + WO_IN, M, 2816, 1024}; pg8::StaticOrderT<M, 2816> S; S.init(G, (int)blockIdx.x);
                pg8::EpiProjLN E{PROJ, ALOW, MUR, csl + CS_IN, cbl + CS_IN}; pg8::gemm_phase<pg8::EpiProjLN, pg8::StaticOrderT<M, 2816>, true, true, 1024>(lds, g, S, E, tid); }
            else if (kind == PK_CG1) {
                if (a.sub & 1) conv_phase(lds, PROJ, INP(7) + l * 31 * 512, INP(8) + l * 512, INP(9) + l * 512, INP(10) + l * 512, MIXIN, G, tid);
                if (a.sub & 2) gla_g1_phase(lds, PROJ, ALOW, INP(5) + l * 16 * 256, INP(6) + l * 256, UPD, DEC, G, tid); }
            else if (kind == PK_G2) { gla_g2_phase(UPD, dummy ? (float*)a.out : UPD, DEC, G, tid); }
            else if (kind == PK_G3) { gla_g3_phase(lds, PROJ, ALOW, INP(5) + l * 16 * 256, INP(6) + l * 256, INP(11) + l * 128, UPD, MIXIN, G, tid); }
            else if (kind == PK_MIX || kind == PK_XO) {
                const bool mix = kind == PK_MIX;
                pg8::Gemm g{mix ? MIXIN : Qb, WL + (mix ? WO_MIX : WO_XO), M, 1024, 1024}; pg8::StaticOrderT<M, 1024> S; S.init(G, (int)blockIdx.x);
                const float* gp = mix ? (l == 0 ? INP(2) : INP(22) + (l - 1) * D) : INP(13) + l * D; const float* bp = mix ? (l == 0 ? INP(3) : INP(23) + (l - 1) * D) : INP(14) + l * D;
                pg8::EpiResLN E{(mix && l == 0) ? INP(0) : nullptr, nullptr, YB, MUR, gp, bp, SLOTS, CNT + (3 * l + (mix ? 0 : 1)) * 128, ALPHA, lds};
                pg8::gemm_phase<pg8::EpiResLN, pg8::StaticOrderT<M, 1024>, true, true, 1024>(lds, g, S, E, tid); }
            else if (kind == PK_Q) { pg8::Gemm g{YB, WL + WO_XQ, M, 1024, 1024}; pg8::StaticOrderT<M, 1024> S; S.init(G, (int)blockIdx.x);
                pg8::EpiBf16LN E{Qb, 1024, MUR, csl + CS_Q, cbl + CS_Q}; pg8::gemm_phase<pg8::EpiBf16LN, pg8::StaticOrderT<M, 1024>, true, true, 1024>(lds, g, S, E, tid); }
            else if (kind == PK_ATT) { att_phase(lds, Kb + l * 1024, Vt + (size_t)l * 1024 * 1024, Qb, dummy ? MIXIN : Qb, G, tid); }
            else if (kind == PK_FF1) { pg8::Gemm g{YB, WL + WO_FF1, M, 2 * D_FF, 1024}; pg8::StaticOrderT<M, 2 * D_FF> S; S.init(G, (int)blockIdx.x);
                pg8::EpiSwigluLN E{ACT, MUR, csl + CS_FF1, cbl + CS_FF1}; pg8::gemm_phase<pg8::EpiSwigluLN, pg8::StaticOrderT<M, 2 * D_FF>, true, true, 1024>(lds, g, S, E, tid); }
            else { pg8::Gemm g{ACT, WL + WO_FF2, M, 1024, D_FF}; pg8::StaticOrderT<M, 1024> S; S.init(G, (int)blockIdx.x);
                pg8::EpiResLN E{nullptr, l == DEPTH - 1 ? Y : nullptr, YB, MUR, INP(18) + l * D, INP(19) + l * D, SLOTS, CNT + (3 * l + 2) * 128, ALPHA, lds};
                pg8::gemm_phase<pg8::EpiResLN, pg8::StaticOrderT<M, 1024>, true, true, D_FF>(lds, g, S, E, tid); }
        }
      }
        if (p + 1 < a.ph_hi) { if (p == 0) cg::this_grid().sync(); else xcd_barrier(xbar); if (a.sub & 256) xcd_barrier(xbar); if (a.sub & 512) xcd_barrier_v<false, false>(xbar); }
    }
}

#undef INP
extern "C" void kernel_launch(void* const* d_in, const int* in_sizes, int n_in, void* d_out, int out_size, void* d_ws, size_t ws_size, hipStream_t stream) {
    if (n_in != 24 || out_size != M * D || ws_size < WS_END) { fprintf(stderr, "kernel_launch: unexpected shapes (n_in %d out %d ws %zu)\n", n_in, out_size, ws_size); return; }
    static int grid = 0;
    if (grid == 0) {
        int dev = 0, cus = 0, per_cu = 0;
        (void)hipGetDevice(&dev); (void)hipDeviceGetAttribute(&cus, hipDeviceAttributeMultiprocessorCount, dev);
        if (hipFuncSetAttribute((const void*)mega, hipFuncAttributeMaxDynamicSharedMemorySize, LDS_BYTES) != hipSuccess) { fprintf(stderr, "kernel_launch: hipFuncSetAttribute failed\n"); grid = -1; return; }
        if (hipOccupancyMaxActiveBlocksPerMultiprocessor(&per_cu, (const void*)mega, NWAVES * 64, LDS_BYTES) != hipSuccess || per_cu < 1) { fprintf(stderr, "kernel_launch: occupancy query says %d\n", per_cu); per_cu = 1; }
        (void)hipGetLastError();
        grid = cus;
    }
    if (grid < 0) return;
    Args a{};
    for (int i = 0; i < 24; ++i) a.in[i] = (const float*)d_in[i];
    a.out = (float*)d_out; a.ws = (unsigned char*)d_ws;
#if ONE_LAUNCH
    if (hipMemsetAsync((char*)d_ws + WS_BAR, 0, 16384, stream) != hipSuccess) { fprintf(stderr, "kernel_launch: memset of the barrier words failed\n"); return; }
    a.ph_lo = 0; a.ph_hi = NPH; a.sub = 3 | PROBE_MASK;
    void* kargs[] = {&a};
    hipError_t e = hipLaunchCooperativeKernel((const void*)mega, dim3(grid), dim3(NWAVES * 64), kargs, LDS_BYTES, stream);
    if (e != hipSuccess) fprintf(stderr, "kernel_launch: cooperative launch failed: %s\n", hipGetErrorString(e));
#else
    for (int p = 0; p < NPH; ++p) { a.ph_lo = p; a.ph_hi = p + 1; a.sub = 3; hipLaunchKernelGGL(mega, dim3(grid), dim3(NWAVES * 64), LDS_BYTES, stream, a); }
#endif
}
```

```cpp
#include <hip/hip_runtime.h>
#include <hip/hip_cooperative_groups.h>
#include <cstdio>
#include <cstdint>

typedef unsigned short bf16_t;
typedef unsigned u32x4 __attribute__((ext_vector_type(4)));
typedef float f32x4 __attribute__((ext_vector_type(4)));

constexpr int D = 1024, BATCH = 4, SEQ = 8192, DEPTH = 4, M = BATCH * SEQ;
constexpr int IN_COLS = 2576, PROJ_LD = 2560, MEM_LEN = 256, D_FF = 2816;
constexpr int C_CA = 0, C_CG = 512, C_Q = 1024, C_K = 1280, C_V = 1536, C_R = 2048, C_AL = 2560;
constexpr float LN_EPS = 1e-5f;
constexpr float ALPHA = 1.681792830507429f;

constexpr size_t MiB = 1u << 20;
constexpr size_t WS_CTL = 0;
constexpr size_t WS_K = 8 * MiB;
constexpr size_t WS_VT = 16 * MiB;
constexpr size_t WS_MEMB = 24 * MiB;
constexpr size_t WS_MEMP = 26 * MiB;
constexpr size_t WS_ALOW = 28 * MiB;
constexpr size_t WS_DEC = 29 * MiB;
constexpr size_t WS_CNT = 0;
constexpr size_t WS_BAR = 65536;
constexpr size_t WS_CSP = 1 * MiB;
constexpr size_t WS_CS = 6 * MiB;
constexpr size_t WS_SLOTS = 30 * MiB;
constexpr size_t WS_MUR = 31 * MiB;
constexpr size_t WS_WT = 32 * MiB;
constexpr size_t WS_HB = 160 * MiB;
constexpr size_t WS_PROJ = 224 * MiB;
constexpr size_t WS_Q = 224 * MiB;
constexpr size_t WS_ACT = 224 * MiB;
constexpr size_t WS_UPD = 384 * MiB;
constexpr size_t WS_MIXIN = 448 * MiB;
constexpr size_t WS_END = 512 * MiB;

__host__ __device__ __forceinline__ int key_of_slot(int p) { const int e = p & 7, kg = (p >> 3) & 3; return (p & ~31) + 16 * (e >> 2) + 4 * kg + (e & 3); }
__host__ __device__ __forceinline__ int slot_of_key(int k) { const int w = k & 31; return (k & ~31) + 8 * ((w >> 2) & 3) + 4 * (w >> 4) + (w & 3); }

__device__ __forceinline__ float bf2f(bf16_t b) { return __uint_as_float(((unsigned)b) << 16); }
__device__ __forceinline__ bf16_t f2bf(float f) { unsigned u = __float_as_uint(f); return (bf16_t)((u + 0x7fffu + ((u >> 16) & 1u)) >> 16); }
__device__ __forceinline__ float ldf(const float* p) { return *p; }
__device__ __forceinline__ float ldf(const bf16_t* p) { return bf2f(*p); }
__device__ __forceinline__ float sigmoidf_(float x) { return 1.f / (1.f + __expf(-x)); }
__device__ __forceinline__ float siluf_(float x) { return x / (1.f + __expf(-x)); }
__device__ __forceinline__ float wave_sum(float v) {
#pragma unroll
    for (int o = 1; o < 64; o <<= 1) v += __shfl_xor(v, o);
    return v;
}
__device__ __forceinline__ float wave_max(float v) {
#pragma unroll
    for (int o = 1; o < 64; o <<= 1) v = fmaxf(v, __shfl_xor(v, o));
    return v;
}

namespace pg8 {
#define PG8_LAS __attribute__((address_space(3)))
typedef unsigned short bf16_t;
typedef short bf16x8 __attribute__((ext_vector_type(8)));
typedef float f32x4 __attribute__((ext_vector_type(4)));
typedef unsigned u32x4 __attribute__((ext_vector_type(4)));
constexpr int BM = 256, BK = 64, HALF = 128, HTB = HALF * BK * 2  , STAGE_BYTES = 8 * HTB, NXCD = 8, WGM = 8;

__host__ __device__ __forceinline__ int lds_byte(int r, int c) { const int st = (r >> 4) * 2 + (c >> 5), rr = r & 15, cc = c & 31, ob = rr * 64 + cc * 2; return st * 1024 + (ob ^ (((ob >> 9) & 1) << 5)); }
__host__ __device__ __forceinline__ void stage_rc(int b, int& R, int& C) { const int st = b / 1024, sb = b % 1024, swz = sb ^ (((sb >> 9) & 1) << 5); R = (st >> 1) * 16 + swz / 64; C = (st & 1) * 32 + (swz % 64) / 2; }
__host__ __device__ __forceinline__ int perm32(int rho) { const int n = rho >> 4, i = rho & 15; return 8 * (i >> 2) + 4 * n + (i & 3); }

struct Unit { int pm, pn; };
struct Gemm { const bf16_t* A; const bf16_t* Bt; int M, N, K; };

struct StaticOrder {
    int nM, nN, nwg, G, c;
    __host__ __device__ void init(int M, int N, int G_, int c_) { nM = M / BM; nN = N / BM; nwg = nM * nN; G = G_; c = c_; }
    __host__ __device__ bool next(int i, Unit& u) const {
        const long L = (long)i * G + c; if (L >= nwg) return false;
        int wgid = (int)L; { const int q = nwg / NXCD, r = nwg % NXCD, xcd = wgid % NXCD, off = wgid / NXCD; wgid = (xcd < r ? xcd * (q + 1) : r * (q + 1) + (xcd - r) * q) + off; }
        const int nig = WGM * nN, gid = wgid / nig, fm = gid * WGM, gsz = (nM - fm) < WGM ? (nM - fm) : WGM;
        u.pm = fm + ((wgid % nig) % gsz); u.pn = (wgid % nig) / gsz; return true;
    }
    __device__ __forceinline__ void a_ready(const Unit&) const {}
    __device__ __forceinline__ void done(const Unit&) const {}
};


template <int MM, int NN> struct StaticOrderT {
    static constexpr int nM = MM / BM, nN = NN / BM, nwg = nM * nN;
    int G, c;
    __host__ __device__ void init(int G_, int c_) { G = G_; c = c_; }
    __host__ __device__ bool next(int i, Unit& u) const {
        const long L = (long)i * G + c; if (L >= nwg) return false;
        int wgid = (int)L; { constexpr int q = nwg / NXCD, r = nwg % NXCD; const int xcd = wgid % NXCD, off = wgid / NXCD; wgid = (xcd < r ? xcd * (q + 1) : r * (q + 1) + (xcd - r) * q) + off; }
        constexpr int nig = WGM * nN; const int gid = wgid / nig, fm = gid * WGM, gsz = (nM - fm) < WGM ? (nM - fm) : WGM;
        u.pm = fm + ((wgid % nig) % gsz); u.pn = (wgid % nig) / gsz; return true;
    }
    __device__ __forceinline__ void a_ready(const Unit&) const {}
    __device__ __forceinline__ void done(const Unit&) const {}
};
typedef float f32x2 __attribute__((ext_vector_type(2)));
__device__ __forceinline__ unsigned cvt_pk_bf16(float lo, float hi) { unsigned r; asm volatile("v_cvt_pk_bf16_f32 %0, %1, %2" : "=v"(r) : "v"(lo), "v"(hi)); return r; }
__device__ __forceinline__ u32x4 pack8(const f32x4 v0, const f32x4 v1) { u32x4 w; w.x = cvt_pk_bf16(v0[0], v0[1]); w.y = cvt_pk_bf16(v0[2], v0[3]); w.z = cvt_pk_bf16(v1[0], v1[1]); w.w = cvt_pk_bf16(v1[2], v1[3]); return w; }
__device__ __forceinline__ float silu_fast(float x) { return x * __builtin_amdgcn_rcpf(1.f + __expf(-x)); }
struct EpiBf16 {
    static constexpr bool PERM = true, AFTER_DRAIN = false;
    bf16_t* O; int ldc;
    __device__ __forceinline__ void operator()(const f32x4 (&acc)[2][2][4][2], const Unit& u, int wr, int wc, int fr, int fq) const {
        const int row0 = u.pm * BM + wr * 64 + fr, col0 = u.pn * BM + wc * 32 + 8 * fq;
#pragma unroll
        for (int ai = 0; ai < 2; ++ai)
#pragma unroll
            for (int m = 0; m < 4; ++m) { bf16_t* rowp = O + (size_t)(row0 + ai * HALF + m * 16) * ldc + col0;
#pragma unroll
                for (int bj = 0; bj < 2; ++bj) *(u32x4*)(rowp + bj * HALF) = pack8(acc[ai][bj][m][0], acc[ai][bj][m][1]); }
    }
};
struct EpiProj {
    static constexpr bool PERM = true, AFTER_DRAIN = false;
    bf16_t* O; bf16_t* AL;
    __device__ __forceinline__ void operator()(const f32x4 (&acc)[2][2][4][2], const Unit& u, int wr, int wc, int fr, int fq) const {
        const int row0 = u.pm * BM + wr * 64 + fr, col0 = u.pn * BM + wc * 32 + 8 * fq;
        if (u.pn < 10) {
#pragma unroll
            for (int ai = 0; ai < 2; ++ai)
#pragma unroll
                for (int m = 0; m < 4; ++m) { bf16_t* rowp = O + (size_t)(row0 + ai * HALF + m * 16) * 2560 + col0;
#pragma unroll
                    for (int bj = 0; bj < 2; ++bj) *(u32x4*)(rowp + bj * HALF) = pack8(acc[ai][bj][m][0], acc[ai][bj][m][1]); }
        } else if (wc == 0 && fq < 2) {
#pragma unroll
            for (int ai = 0; ai < 2; ++ai)
#pragma unroll
                for (int m = 0; m < 4; ++m) *(u32x4*)(AL + (size_t)(row0 + ai * HALF + m * 16) * 16 + 8 * fq) = pack8(acc[ai][0][m][0], acc[ai][0][m][1]);
        }
    }
};
struct EpiRes {
    static constexpr bool PERM = false, AFTER_DRAIN = false;
    float* HF; float alpha; static constexpr int ldc = 1024;
    __device__ __forceinline__ void operator()(const f32x4 (&acc)[2][2][4][2], const Unit& u, int wr, int wc, int fr, int fq) const {
        const int row0 = u.pm * BM + wr * 64 + fr, col0 = u.pn * BM + wc * 32 + 4 * fq;
#pragma unroll
        for (int ai = 0; ai < 2; ++ai)
#pragma unroll
            for (int m = 0; m < 4; ++m) { float* rowp = HF + (size_t)(row0 + ai * HALF + m * 16) * ldc + col0;
#pragma unroll
                for (int bj = 0; bj < 2; ++bj)
#pragma unroll
                    for (int n = 0; n < 2; ++n) { f32x4* p = (f32x4*)(rowp + bj * HALF + n * 16); const f32x4 h = *p; *p = h * alpha + acc[ai][bj][m][n]; } }
    }
};
struct EpiSwiglu {
    static constexpr bool PERM = true, AFTER_DRAIN = false;
    bf16_t* O; static constexpr int ldc = 2816;
    __device__ __forceinline__ void operator()(const f32x4 (&acc)[2][2][4][2], const Unit& u, int wr, int wc, int fr, int fq) const {
        const int row0 = u.pm * BM + wr * 64 + fr, col0 = u.pn * HALF + wc * 32 + 8 * fq;
#pragma unroll
        for (int ai = 0; ai < 2; ++ai)
#pragma unroll
            for (int m = 0; m < 4; ++m) { f32x4 a0, a1;
#pragma unroll
                for (int j = 0; j < 4; ++j) { a0[j] = silu_fast(acc[ai][0][m][0][j]) * acc[ai][1][m][0][j]; a1[j] = silu_fast(acc[ai][0][m][1][j]) * acc[ai][1][m][1][j]; }
                *(u32x4*)(O + (size_t)(row0 + ai * HALF + m * 16) * ldc + col0) = pack8(a0, a1); }
    }
};

__device__ __forceinline__ void row_stats8(const float* MUR, int row0, float (&mu)[2][4], float (&rs)[2][4]) {
#pragma unroll
    for (int ai = 0; ai < 2; ++ai)
#pragma unroll
        for (int m = 0; m < 4; ++m) { const f32x2 t = *(const f32x2*)(MUR + 2 * (size_t)(row0 + ai * HALF + m * 16)); mu[ai][m] = t.x; rs[ai][m] = t.y; }
}
struct EpiBf16LN {
    static constexpr bool PERM = true, AFTER_DRAIN = false;
    bf16_t* O; int ldc; const float* MUR; const float* cs; const float* cb;
    __device__ __forceinline__ void operator()(const f32x4 (&acc)[2][2][4][2], const Unit& u, int wr, int wc, int fr, int fq) const {
        const int row0 = u.pm * BM + wr * 64 + fr, col0 = u.pn * BM + wc * 32 + 8 * fq;
        float mu[2][4], rs[2][4]; row_stats8(MUR, row0, mu, rs);
#pragma unroll
        for (int bj = 0; bj < 2; ++bj) { const f32x4 s0 = *(const f32x4*)(cs + col0 + bj * HALF), s1 = *(const f32x4*)(cs + col0 + bj * HALF + 4), b0 = *(const f32x4*)(cb + col0 + bj * HALF), b1 = *(const f32x4*)(cb + col0 + bj * HALF + 4);
#pragma unroll
            for (int ai = 0; ai < 2; ++ai)
#pragma unroll
                for (int m = 0; m < 4; ++m) { const f32x4 v0 = (acc[ai][bj][m][0] - s0 * mu[ai][m]) * rs[ai][m] + b0, v1 = (acc[ai][bj][m][1] - s1 * mu[ai][m]) * rs[ai][m] + b1;
                    *(u32x4*)(O + (size_t)(row0 + ai * HALF + m * 16) * ldc + col0 + bj * HALF) = pack8(v0, v1); } }
    }
};
struct EpiProjLN {
    static constexpr bool PERM = true, AFTER_DRAIN = false;
    bf16_t* O; bf16_t* AL; const float* MUR; const float* cs; const float* cb;
    __device__ __forceinline__ void operator()(const f32x4 (&acc)[2][2][4][2], const Unit& u, int wr, int wc, int fr, int fq) const {
        const int row0 = u.pm * BM + wr * 64 + fr, col0 = u.pn * BM + wc * 32 + 8 * fq;
        float mu[2][4], rs[2][4]; row_stats8(MUR, row0, mu, rs);
        if (u.pn < 10) {
#pragma unroll
            for (int bj = 0; bj < 2; ++bj) { const f32x4 s0 = *(const f32x4*)(cs + col0 + bj * HALF), s1 = *(const f32x4*)(cs + col0 + bj * HALF + 4), b0 = *(const f32x4*)(cb + col0 + bj * HALF), b1 = *(const f32x4*)(cb + col0 + bj * HALF + 4);
#pragma unroll
                for (int ai = 0; ai < 2; ++ai)
#pragma unroll
                    for (int m = 0; m < 4; ++m) { const f32x4 v0 = (acc[ai][bj][m][0] - s0 * mu[ai][m]) * rs[ai][m] + b0, v1 = (acc[ai][bj][m][1] - s1 * mu[ai][m]) * rs[ai][m] + b1;
                        *(u32x4*)(O + (size_t)(row0 + ai * HALF + m * 16) * 2560 + col0 + bj * HALF) = pack8(v0, v1); } }
        } else if (wc == 0 && fq < 2) {
            const f32x4 s0 = *(const f32x4*)(cs + col0), s1 = *(const f32x4*)(cs + col0 + 4), b0 = *(const f32x4*)(cb + col0), b1 = *(const f32x4*)(cb + col0 + 4);
#pragma unroll
            for (int ai = 0; ai < 2; ++ai)
#pragma unroll
                for (int m = 0; m < 4; ++m) { const f32x4 v0 = (acc[ai][0][m][0] - s0 * mu[ai][m]) * rs[ai][m] + b0, v1 = (acc[ai][0][m][1] - s1 * mu[ai][m]) * rs[ai][m] + b1;
                    *(u32x4*)(AL + (size_t)(row0 + ai * HALF + m * 16) * 16 + 8 * fq) = pack8(v0, v1); }
        }
    }
};
struct EpiSwigluLN {
    static constexpr bool PERM = true, AFTER_DRAIN = false;
    bf16_t* O; const float* MUR; const float* cs; const float* cb; static constexpr int ldc = 2816;
    __device__ __forceinline__ void operator()(const f32x4 (&acc)[2][2][4][2], const Unit& u, int wr, int wc, int fr, int fq) const {
        const int row0 = u.pm * BM + wr * 64 + fr, wrow = u.pn * BM + wc * 32 + 8 * fq, col0 = u.pn * HALF + wc * 32 + 8 * fq;
        float mu[2][4], rs[2][4]; row_stats8(MUR, row0, mu, rs);
        const f32x4 sg0 = *(const f32x4*)(cs + wrow), sg1 = *(const f32x4*)(cs + wrow + 4), bg0 = *(const f32x4*)(cb + wrow), bg1 = *(const f32x4*)(cb + wrow + 4);
        const f32x4 su0 = *(const f32x4*)(cs + wrow + HALF), su1 = *(const f32x4*)(cs + wrow + HALF + 4), bu0 = *(const f32x4*)(cb + wrow + HALF), bu1 = *(const f32x4*)(cb + wrow + HALF + 4);
#pragma unroll
        for (int ai = 0; ai < 2; ++ai)
#pragma unroll
            for (int m = 0; m < 4; ++m) {
                const f32x4 g0 = (acc[ai][0][m][0] - sg0 * mu[ai][m]) * rs[ai][m] + bg0, g1 = (acc[ai][0][m][1] - sg1 * mu[ai][m]) * rs[ai][m] + bg1;
                const f32x4 u0 = (acc[ai][1][m][0] - su0 * mu[ai][m]) * rs[ai][m] + bu0, u1 = (acc[ai][1][m][1] - su1 * mu[ai][m]) * rs[ai][m] + bu1;
                f32x4 a0, a1;
#pragma unroll
                for (int j = 0; j < 4; ++j) { a0[j] = silu_fast(g0[j]) * u0[j]; a1[j] = silu_fast(g1[j]) * u1[j]; }
                *(u32x4*)(O + (size_t)(row0 + ai * HALF + m * 16) * ldc + col0) = pack8(a0, a1); }
    }
};
struct EpiResLN {
    static constexpr bool PERM = false, AFTER_DRAIN = false;
    const float* Xin; float* Yout; bf16_t* YB; float* MUR; const float* gp; const float* bp; unsigned long long* slots; unsigned* cnt; float alpha; PG8_LAS unsigned char* lds;
    __device__ __forceinline__ void operator()(f32x4 (&acc)[2][2][4][2], const Unit& u, int wr, int wc, int fr, int fq) const {
        typedef unsigned u32x2 __attribute__((ext_vector_type(2)));
        const int row0 = u.pm * BM + wr * 64 + fr, col0 = u.pn * BM + wc * 32 + 4 * fq;
        float mu[2][4], rs[2][4]; row_stats8(MUR, row0, mu, rs);
#pragma unroll
        for (int bj = 0; bj < 2; ++bj)
#pragma unroll
            for (int n = 0; n < 2; ++n) { const f32x4 g4 = *(const f32x4*)(gp + col0 + bj * HALF + n * 16), b4 = *(const f32x4*)(bp + col0 + bj * HALF + n * 16);
#pragma unroll
                for (int ai = 0; ai < 2; ++ai)
#pragma unroll
                    for (int m = 0; m < 4; ++m) { const size_t off = (size_t)(row0 + ai * HALF + m * 16) * 1024 + col0 + bj * HALF + n * 16;
                        f32x4 yo;
                        if (Xin) yo = *(const f32x4*)(Xin + off);
                        else { const u32x2 t = *(const u32x2*)(YB + off); yo = (f32x4){__uint_as_float(t.x << 16), __uint_as_float(t.x & 0xffff0000u), __uint_as_float(t.y << 16), __uint_as_float(t.y & 0xffff0000u)}; }
                        const f32x4 yn = ((yo - mu[ai][m]) * rs[ai][m] * g4 + b4) * alpha + acc[ai][bj][m][n];
                        acc[ai][bj][m][n] = yn; if (Yout) *(f32x4*)(Yout + off) = yn;
                        u32x2 w; w.x = cvt_pk_bf16(yn[0], yn[1]); w.y = cvt_pk_bf16(yn[2], yn[3]); *(u32x2*)(YB + off) = w; } }
        PG8_LAS f32x2* P = (PG8_LAS f32x2*)(lds + 131072);
#pragma unroll
        for (int ai = 0; ai < 2; ++ai)
#pragma unroll
            for (int m = 0; m < 4; ++m) {
                float s = 0.f;
#pragma unroll
                for (int bj = 0; bj < 2; ++bj)
#pragma unroll
                    for (int n = 0; n < 2; ++n) { const f32x4 x = acc[ai][bj][m][n]; s += (x[0] + x[1]) + (x[2] + x[3]); }
                s += __shfl_xor(s, 16); s += __shfl_xor(s, 32);
                const float mw = s * (1.0f / 64.0f); float q = 0.f;
#pragma unroll
                for (int bj = 0; bj < 2; ++bj)
#pragma unroll
                    for (int n = 0; n < 2; ++n) { const f32x4 d = acc[ai][bj][m][n] - mw; q += (d[0] * d[0] + d[1] * d[1]) + (d[2] * d[2] + d[3] * d[3]); }
                q += __shfl_xor(q, 16); q += __shfl_xor(q, 32);
                if (fq == 0) P[(ai * HALF + wr * 64 + m * 16 + fr) * 4 + wc] = (f32x2){mw, q};
            }
        asm volatile("s_waitcnt lgkmcnt(0)" ::: "memory"); __builtin_amdgcn_s_barrier(); asm volatile("" ::: "memory");
        const int wid = wr * 4 + wc, lane = fq * 16 + fr, row = wid * 32 + (lane & 31);
        if (lane < 32) {
            const f32x2 a = P[row * 4 + 0], b = P[row * 4 + 1], c = P[row * 4 + 2], d = P[row * 4 + 3];
            const float mt = (a.x + b.x + c.x + d.x) * 0.25f;
            const float da = a.x - mt, db = b.x - mt, dc = c.x - mt, dd = d.x - mt;
            const float m2 = (a.y + b.y) + (c.y + d.y) + 64.0f * ((da * da + db * db) + (dc * dc + dd * dd));
            __hip_atomic_store(slots + ((size_t)(u.pm * BM + row) * 4 + u.pn), ((unsigned long long)__float_as_uint(m2) << 32) | __float_as_uint(mt), __ATOMIC_RELAXED, __HIP_MEMORY_SCOPE_AGENT);
        }
        asm volatile("s_waitcnt vmcnt(0)" ::: "memory");
        unsigned old = 0u;
        if (lane == 0) old = __hip_atomic_fetch_add(cnt + u.pm, 1u, __ATOMIC_RELAXED, __HIP_MEMORY_SCOPE_AGENT);
        old = (unsigned)__builtin_amdgcn_readfirstlane((int)old);
        if (old == 31u) {
#pragma unroll
            for (int rr = 0; rr < 4; ++rr) { const int r = lane * 4 + rr; const unsigned long long* sl = slots + (size_t)(u.pm * BM + r) * 4; float mt[4], m2[4], ms = 0.f;
#pragma unroll
                for (int t = 0; t < 4; ++t) { const unsigned long long w = __hip_atomic_load(sl + t, __ATOMIC_RELAXED, __HIP_MEMORY_SCOPE_AGENT); mt[t] = __uint_as_float((unsigned)w); m2[t] = __uint_as_float((unsigned)(w >> 32)); ms += mt[t]; }
                const float mean = ms * 0.25f; float q = 0.f;
#pragma unroll
                for (int t = 0; t < 4; ++t) { const float dm = mt[t] - mean; q += m2[t] + 256.0f * dm * dm; }
                *(f32x2*)(MUR + 2 * (size_t)(u.pm * BM + r)) = (f32x2){mean, 1.0f / sqrtf(q * (1.0f / 1024.0f) + 1e-5f)}; }
        }
    }
};

template <class Epi, class Sched, bool ALIGN_EPI, bool SP2, int KC>
__device__ __forceinline__ void gemm_phase(PG8_LAS unsigned char* lds, const Gemm g, const Sched& S, const Epi& E, const int tid) {
    const int wid = __builtin_amdgcn_readfirstlane(tid >> 6), lane = tid & 63, wr = wid >> 2, wc = wid & 3, fr = lane & 15, fq = lane >> 4;
    constexpr int K = KC, nt = K / BK;
    unsigned voffA[2], voffB[2];
#pragma unroll
    for (int i = 0; i < 2; ++i) { int R, C; stage_rc(tid * 16 + i * 8192, R, C); const int Rb = Epi::PERM ? ((R & ~31) + perm32(R & 31)) : R;
        voffA[i] = (unsigned)(R * K + C) * 2u; voffB[i] = (unsigned)(Rb * K + C) * 2u; }
    const size_t kstep = (size_t)(BK * 2);
    const size_t hstep = (size_t)HALF * K * 2;
    const size_t tstep = 2 * hstep;
    const unsigned ldsw = (unsigned)wid * 1024u;
    const int aoff = lds_byte(wr * 64 + fr, fq * 8), boff = lds_byte(wc * 32 + fr, fq * 8);
#define PG8_SA(b, h) (((b) * 2 + (h)) * HTB)
#define PG8_SB(b, h) ((4 + (b) * 2 + (h)) * HTB)
#define PG8_STAGE(bufoff, gbase, voff) do { _Pragma("unroll") for (int _i = 0; _i < 2; ++_i) \
        __builtin_amdgcn_global_load_lds((const unsigned*)((const char*)(gbase) + (voff)[_i]), (PG8_LAS unsigned*)(lds + (bufoff) + ldsw + _i * 8192), 16, 0, 0); } while (0)
#define PG8_LDA(dst, b, h) do { _Pragma("unroll") for (int m = 0; m < 4; ++m) _Pragma("unroll") for (int k = 0; k < 2; ++k) dst[m][k] = *(const PG8_LAS bf16x8*)(lds + PG8_SA(b, h) + aoff + m * 2048 + k * 1024); } while (0)
#define PG8_LDB(dst, b, h) do { _Pragma("unroll") for (int n = 0; n < 2; ++n) _Pragma("unroll") for (int k = 0; k < 2; ++k) dst[n][k] = *(const PG8_LAS bf16x8*)(lds + PG8_SB(b, h) + boff + n * 2048 + k * 1024); } while (0)
#define PG8_MMA(ai, bj, At, Bt) do { __builtin_amdgcn_s_setprio(1); _Pragma("unroll") for (int m = 0; m < 4; ++m) _Pragma("unroll") for (int n = 0; n < 2; ++n) _Pragma("unroll") for (int k = 0; k < 2; ++k) \
        acc[ai][bj][m][n] = __builtin_amdgcn_mfma_f32_16x16x32_bf16(Bt[n][k], At[m][k], acc[ai][bj][m][n], 0, 0, 0); __builtin_amdgcn_s_setprio(0); } while (0)
#define PG8_WAIT_V(n) asm volatile("s_waitcnt vmcnt(" #n ")" ::: "memory")
#define PG8_WAIT_L(n) asm volatile("s_waitcnt lgkmcnt(" #n ")" ::: "memory")
#define PG8_BAR __builtin_amdgcn_s_barrier()
#define PG8_SCHED __builtin_amdgcn_sched_barrier(0)
    Unit cur, nxt; int ui = 0;
    if (!S.next(0, cur)) return;
    f32x4 acc[2][2][4][2];
#pragma unroll
    for (int a = 0; a < 2; ++a)
#pragma unroll
        for (int b = 0; b < 2; ++b)
#pragma unroll
            for (int m = 0; m < 4; ++m)
#pragma unroll
                for (int n = 0; n < 2; ++n) acc[a][b][m][n] = (f32x4){0.f, 0.f, 0.f, 0.f};
    bf16x8 At[4][2], B0[2][2], B1[2][2];
    const char* cA = (const char*)g.A + (size_t)cur.pm * tstep; const char* cB = (const char*)g.Bt + (size_t)cur.pn * tstep;
    S.a_ready(cur);
    if constexpr (SP2) {
        PG8_STAGE(PG8_SB(0, 0), cB, voffB); PG8_STAGE(PG8_SB(0, 1), cB + hstep, voffB); PG8_STAGE(PG8_SA(0, 0), cA, voffA); PG8_STAGE(PG8_SA(0, 1), cA + hstep, voffA);
        if (wr == 1) PG8_BAR;
        PG8_WAIT_V(2); PG8_BAR;
        PG8_STAGE(PG8_SB(1, 0), cB + kstep, voffB); PG8_STAGE(PG8_SA(1, 0), cA + kstep, voffA); PG8_STAGE(PG8_SB(1, 1), cB + hstep + kstep, voffB);
        PG8_WAIT_V(6); PG8_BAR;
    } else {
        PG8_STAGE(PG8_SB(0, 0), cB, voffB); PG8_STAGE(PG8_SA(0, 0), cA, voffA); PG8_STAGE(PG8_SB(0, 1), cB + hstep, voffB); PG8_STAGE(PG8_SA(0, 1), cA + hstep, voffA);
        if (wr == 1) PG8_BAR;
        PG8_WAIT_V(4); PG8_BAR;
        PG8_STAGE(PG8_SB(1, 0), cB + kstep, voffB); PG8_STAGE(PG8_SA(1, 0), cA + kstep, voffA); PG8_STAGE(PG8_SB(1, 1), cB + hstep + kstep, voffB);
        PG8_WAIT_V(6); PG8_BAR;
    }
    for (;;) {
        const bool has_next = S.next(ui + 1, nxt);
        const char* nA = has_next ? (const char*)g.A + (size_t)nxt.pm * tstep : cA; const char* nB = has_next ? (const char*)g.Bt + (size_t)nxt.pn * tstep : cB;
        for (int t = 0; t < nt; t += 2) {
            const bool last = (t == nt - 2);
            const char* a1 = cA + (size_t)(t + 1) * kstep;
            const char* a2 = last ? nA : cA + (size_t)(t + 2) * kstep; const char* b2 = last ? nB : cB + (size_t)(t + 2) * kstep;
            const char* a3 = a2 + kstep; const char* b3 = b2 + kstep;
            if (last && has_next) S.a_ready(nxt);
            if constexpr (SP2) {
            PG8_LDB(B0, 0, 0); PG8_LDB(B1, 0, 1); PG8_SCHED; PG8_LDA(At, 0, 0); PG8_STAGE(PG8_SA(1, 1), a1 + hstep, voffA);
            PG8_WAIT_V(8); PG8_WAIT_L(0); PG8_BAR; PG8_MMA(0, 0, At, B0); PG8_MMA(0, 1, At, B1); PG8_BAR; PG8_SCHED;
            PG8_LDA(At, 0, 1); PG8_STAGE(PG8_SB(0, 0), b2, voffB); PG8_STAGE(PG8_SB(0, 1), b2 + hstep, voffB); PG8_STAGE(PG8_SA(0, 0), a2, voffA);
            PG8_WAIT_V(8); PG8_WAIT_L(0); PG8_BAR; PG8_MMA(1, 0, At, B0); PG8_MMA(1, 1, At, B1); PG8_BAR; PG8_SCHED;
            PG8_LDB(B0, 1, 0); PG8_LDB(B1, 1, 1); PG8_SCHED; PG8_LDA(At, 1, 0); PG8_STAGE(PG8_SA(0, 1), a2 + hstep, voffA);
            PG8_WAIT_V(8); PG8_WAIT_L(0); PG8_BAR; PG8_MMA(0, 0, At, B0); PG8_MMA(0, 1, At, B1); PG8_BAR; PG8_SCHED;
            PG8_LDA(At, 1, 1); PG8_STAGE(PG8_SB(1, 0), b3, voffB); PG8_STAGE(PG8_SB(1, 1), b3 + hstep, voffB); PG8_STAGE(PG8_SA(1, 0), a3, voffA);
            PG8_WAIT_V(8); PG8_WAIT_L(0); PG8_BAR; PG8_MMA(1, 0, At, B0); PG8_MMA(1, 1, At, B1); PG8_BAR; PG8_SCHED;
            } else {
            PG8_LDB(B0, 0, 0); PG8_SCHED; PG8_LDA(At, 0, 0); PG8_STAGE(PG8_SA(1, 1), a1 + hstep, voffA);
            PG8_WAIT_L(8); PG8_BAR; PG8_WAIT_L(0); PG8_MMA(0, 0, At, B0); PG8_BAR; PG8_SCHED;
            PG8_LDB(B1, 0, 1); PG8_STAGE(PG8_SB(0, 0), b2, voffB);
            PG8_BAR; PG8_WAIT_L(0); PG8_MMA(0, 1, At, B1); PG8_BAR;
            PG8_LDA(At, 0, 1); PG8_STAGE(PG8_SA(0, 0), a2, voffA);
            PG8_BAR; PG8_WAIT_L(0); PG8_MMA(1, 0, At, B0); PG8_BAR; PG8_SCHED;
            PG8_STAGE(PG8_SB(0, 1), b2 + hstep, voffB);
            PG8_WAIT_V(6); PG8_BAR; PG8_MMA(1, 1, At, B1); PG8_BAR;
            PG8_LDB(B0, 1, 0); PG8_SCHED; PG8_LDA(At, 1, 0); PG8_STAGE(PG8_SA(0, 1), a2 + hstep, voffA);
            PG8_WAIT_L(8); PG8_BAR; PG8_WAIT_L(0); PG8_MMA(0, 0, At, B0); PG8_BAR; PG8_SCHED;
            PG8_LDB(B1, 1, 1); PG8_STAGE(PG8_SB(1, 0), b3, voffB);
            PG8_BAR; PG8_WAIT_L(0); PG8_MMA(0, 1, At, B1); PG8_BAR;
            PG8_LDA(At, 1, 1); PG8_STAGE(PG8_SA(1, 0), a3, voffA);
            PG8_BAR; PG8_WAIT_L(0); PG8_MMA(1, 0, At, B0); PG8_BAR; PG8_SCHED;
            PG8_STAGE(PG8_SB(1, 1), b3 + hstep, voffB);
            PG8_WAIT_V(6); PG8_BAR; PG8_MMA(1, 1, At, B1); PG8_BAR;
            }
        }
        if constexpr (ALIGN_EPI) { if (wr == 0) PG8_BAR; }
        if constexpr (!Epi::AFTER_DRAIN) { E(acc, cur, wr, wc, fr, fq); S.done(cur); }
        if (!has_next) break;
#pragma unroll
        for (int a = 0; a < 2; ++a)
#pragma unroll
            for (int b = 0; b < 2; ++b)
#pragma unroll
                for (int m = 0; m < 4; ++m)
#pragma unroll
                    for (int n = 0; n < 2; ++n) acc[a][b][m][n] = (f32x4){0.f, 0.f, 0.f, 0.f};
        cur = nxt; cA = nA; cB = nB; ++ui;
        if constexpr (ALIGN_EPI) { if (wr == 1) PG8_BAR; }
    }
    PG8_WAIT_V(0);
    if constexpr (!ALIGN_EPI) { if (wr == 0) PG8_BAR; }
    PG8_BAR;
    if constexpr (Epi::AFTER_DRAIN) { E.fused(acc, cur, wr, wc, fr, fq, lds, wid, lane); S.done(cur); }
#undef PG8_SA
#undef PG8_SB
#undef PG8_STAGE
#undef PG8_LDA
#undef PG8_LDB
#undef PG8_MMA
#undef PG8_WAIT_V
#undef PG8_WAIT_L
#undef PG8_BAR
#undef PG8_SCHED
}
}
namespace cg = cooperative_groups;
#define LAS __attribute__((address_space(3)))
#define LDS_WAIT() asm volatile("s_waitcnt lgkmcnt(0)" ::: "memory")
constexpr int NWAVES = 8, LDS_BYTES = 147456;
constexpr size_t WT_XK = 0, WT_XV = (size_t)4096 * 1024, WT_L0 = (size_t)2 * 4096 * 1024, WT_LSTRIDE = 14680064;
constexpr size_t WO_IN = 0, WO_MIX = 2883584, WO_XQ = WO_MIX + 1048576, WO_XO = WO_XQ + 1048576, WO_FF1 = WO_XO + 1048576, WO_FF2 = WO_FF1 + 5767168;
static_assert(WO_FF2 + 2883584 == WT_LSTRIDE && (WT_L0 + 4 * WT_LSTRIDE) * 2 == 128 * MiB, "weight map");
constexpr int I_IN = 16 * 81, I_SQ = 512, I_XKV = 1024, I_FF1 = 16 * 176, I_FF2 = 44 * 32, I_LAYER = I_IN + 3 * I_SQ + I_XKV + I_FF1 + I_FF2;

struct Args { const float* in[24]; float* out; unsigned char* ws; int ph_lo, ph_hi, sub, pad; };

__device__ __forceinline__ unsigned pk2(float lo, float hi) { return (unsigned)f2bf(lo) | ((unsigned)f2bf(hi) << 16); }
__device__ __forceinline__ void cvt_item(const float* W, int K, int N, int k0, int n0, bf16_t* dst, LAS float* scr, int lane) {
#pragma unroll
    for (int i = 0; i < 32; ++i) { const int kk = 2 * i + (lane >> 5), n = n0 + (lane & 31); scr[kk * 33 + (lane & 31)] = n < N ? W[(size_t)(k0 + kk) * N + n] : 0.f; }
    LDS_WAIT(); asm volatile("" ::: "memory");
    const int c = lane & 7;
#pragma unroll
    for (int j = 0; j < 4; ++j) { const int n = (lane >> 3) + 8 * j; const LAS float* s = scr + (8 * c) * 33 + n;
        u32x4 o; o.x = pk2(s[0 * 33], s[1 * 33]); o.y = pk2(s[2 * 33], s[3 * 33]); o.z = pk2(s[4 * 33], s[5 * 33]); o.w = pk2(s[6 * 33], s[7 * 33]);
        *(u32x4*)(dst + (size_t)n * K + k0 + 8 * c) = o; }
    LDS_WAIT(); asm volatile("" ::: "memory");
}
__device__ __forceinline__ void ln_row(const float* in, float* outf, bf16_t* outb, const float* g, const float* b, int lane) {
    const f32x4* xr = (const f32x4*)in + lane;
    f32x4 v[4]; float s = 0.f;
#pragma unroll
    for (int j = 0; j < 4; ++j) { v[j] = xr[64 * j]; s += (v[j].x + v[j].y) + (v[j].z + v[j].w); }
    const float mean = wave_sum(s) * (1.f / D); float s2 = 0.f;
#pragma unroll
    for (int j = 0; j < 4; ++j) { v[j] = v[j] - mean; s2 += (v[j].x * v[j].x + v[j].y * v[j].y) + (v[j].z * v[j].z + v[j].w * v[j].w); }
    const float rstd = rsqrtf(wave_sum(s2) * (1.f / D) + LN_EPS);
#pragma unroll
    for (int j = 0; j < 4; ++j) {
        const int c = (64 * j + lane) * 4;
        const f32x4 o = v[j] * rstd * *(const f32x4*)(g + c) + *(const f32x4*)(b + c);
        *((f32x4*)outf + 64 * j + lane) = o;
        *(unsigned long long*)(outb + c) = (unsigned long long)pk2(o.x, o.y) | ((unsigned long long)pk2(o.z, o.w) << 32);
    }
}


__device__ __forceinline__ void cvt_item_ln(const float* W, int K, int N, int k0, int n0, bf16_t* dst, LAS float* scr, int lane, const float* g, const float* b, float* csp, float* cbp) {
    float cs = 0.f, cb = 0.f;
#pragma unroll
    for (int i = 0; i < 32; ++i) { const int kk = 2 * i + (lane >> 5), n = n0 + (lane & 31); const float w = n < N ? W[(size_t)(k0 + kk) * N + n] : 0.f; const float wg = w * g[k0 + kk];
        scr[kk * 33 + (lane & 31)] = wg; cs += bf2f(f2bf(wg)); cb += b[k0 + kk] * w; }
    cs += __shfl_xor(cs, 32); cb += __shfl_xor(cb, 32);
    if (lane < 32) { csp[lane] = cs; cbp[lane] = cb; }
    LDS_WAIT(); asm volatile("" ::: "memory");
    const int c = lane & 7;
#pragma unroll
    for (int j = 0; j < 4; ++j) { const int n = (lane >> 3) + 8 * j; const LAS float* s = scr + (8 * c) * 33 + n;
        u32x4 o; o.x = pk2(s[0 * 33], s[1 * 33]); o.y = pk2(s[2 * 33], s[3 * 33]); o.z = pk2(s[4 * 33], s[5 * 33]); o.w = pk2(s[6 * 33], s[7 * 33]);
        *(u32x4*)(dst + (size_t)n * K + k0 + 8 * c) = o; }
    LDS_WAIT(); asm volatile("" ::: "memory");
}
__device__ __forceinline__ void x_row(const float* in, bf16_t* outb, float* mur, int lane) {
    const f32x4* xr = (const f32x4*)in + lane;
    f32x4 v[4]; float s = 0.f;
#pragma unroll
    for (int j = 0; j < 4; ++j) { v[j] = xr[64 * j]; s += (v[j].x + v[j].y) + (v[j].z + v[j].w);
        *(unsigned long long*)(outb + (64 * j + lane) * 4) = (unsigned long long)pk2(v[j].x, v[j].y) | ((unsigned long long)pk2(v[j].z, v[j].w) << 32); }
    const float mean = wave_sum(s) * (1.f / D); float s2 = 0.f;
#pragma unroll
    for (int j = 0; j < 4; ++j) { const f32x4 d = v[j] - mean; s2 += (d.x * d.x + d.y * d.y) + (d.z * d.z + d.w * d.w); }
    const float rstd = rsqrtf(wave_sum(s2) * (1.f / D) + LN_EPS);
    if (lane == 0) { mur[0] = mean; mur[1] = rstd; }
}
__device__ __forceinline__ void ln_row_f32(float* io, const float* g, const float* b, int lane) {
    f32x4* xr = (f32x4*)io + lane;
    f32x4 v[4]; float s = 0.f;
#pragma unroll
    for (int j = 0; j < 4; ++j) { v[j] = xr[64 * j]; s += (v[j].x + v[j].y) + (v[j].z + v[j].w); }
    const float mean = wave_sum(s) * (1.f / D); float s2 = 0.f;
#pragma unroll
    for (int j = 0; j < 4; ++j) { v[j] = v[j] - mean; s2 += (v[j].x * v[j].x + v[j].y * v[j].y) + (v[j].z * v[j].z + v[j].w * v[j].w); }
    const float rstd = rsqrtf(wave_sum(s2) * (1.f / D) + LN_EPS);
#pragma unroll
    for (int j = 0; j < 4; ++j) { const int c = (64 * j + lane) * 4; xr[64 * j] = v[j] * rstd * *(const f32x4*)(g + c) + *(const f32x4*)(b + c); }
}

__device__ __forceinline__ void alow_rows(const bf16_t* YB, const bf16_t* Wal, const float* MUR, const float* cs, const float* cb, bf16_t* ALOW, int gw, int NGW, int lane) {
    typedef short bf16x8_t __attribute__((ext_vector_type(8)));
    typedef unsigned u32x2_t __attribute__((ext_vector_type(2)));
    const int i = lane & 15, kg = lane >> 4;
    for (int rb = gw; rb < M / 16; rb += NGW) {
        const bf16_t* ap = YB + (size_t)(rb * 16 + i) * 1024 + 8 * kg; const bf16_t* wp = Wal + (size_t)i * 1024 + 8 * kg;
        f32x4 acc0 = (f32x4){0.f, 0.f, 0.f, 0.f}, acc1 = acc0;
#pragma unroll
        for (int s0 = 0; s0 < 32; s0 += 8) { bf16x8_t af[8], wf[8];
#pragma unroll
            for (int s = 0; s < 8; ++s) { af[s] = *(const bf16x8_t*)(ap + 32 * (s0 + s)); wf[s] = *(const bf16x8_t*)(wp + 32 * (s0 + s)); }
#pragma unroll
            for (int s = 0; s < 8; s += 2) { acc0 = __builtin_amdgcn_mfma_f32_16x16x32_bf16(wf[s], af[s], acc0, 0, 0, 0); acc1 = __builtin_amdgcn_mfma_f32_16x16x32_bf16(wf[s + 1], af[s + 1], acc1, 0, 0, 0); } }
        const float mu = MUR[2 * (size_t)(rb * 16 + i)], rs = MUR[2 * (size_t)(rb * 16 + i) + 1];
        const f32x4 c4 = *(const f32x4*)(cs + 4 * kg), b4 = *(const f32x4*)(cb + 4 * kg);
        const f32x4 z = ((acc0 + acc1) - c4 * mu) * rs + b4;
        u32x2_t w; w.x = pk2(z[0], z[1]); w.y = pk2(z[2], z[3]);
        *(u32x2_t*)(ALOW + (size_t)(rb * 16 + i) * 16 + 4 * kg) = w;
    }
}
#define XB_TMO      128
#define XB_XCNT(j)  (256  + 64 * (j))
#define XB_XSUB(j)  (1280 + 64 * (j))
#define XB_XGEN(j)  (2304 + 64 * (j))
#define XB_TOP      3328
#define XB_TOPGEN   3392
#define XCD_BAR_WORDS 3456
#define XB_SPIN_CAP (1u << 18)

__device__ __forceinline__ unsigned xb_ld(unsigned* p)              { return __hip_atomic_load(p, __ATOMIC_RELAXED, __HIP_MEMORY_SCOPE_AGENT); }
__device__ __forceinline__ unsigned xb_add(unsigned* p, unsigned v) { return __hip_atomic_fetch_add(p, v, __ATOMIC_RELAXED, __HIP_MEMORY_SCOPE_AGENT); }
__device__ __forceinline__ unsigned xb_xcc_id() { return (unsigned)__builtin_amdgcn_s_getreg((3 << 11) | 20) & 0xFu; }
#define XB_SPIN(cond, bar) do { unsigned _sp = 0; while (cond) { __builtin_amdgcn_s_sleep(1); \
    if ((++_sp & 255u) == 0u) { if (xb_ld(&(bar)[XB_TMO])) break; if (_sp > XB_SPIN_CAP) { atomicAdd(&(bar)[XB_TMO], 1u); break; } } } } while (0)

struct XcdBarrier {
    unsigned* bar; unsigned x;
    volatile LAS unsigned* st;
};

__device__ __forceinline__ XcdBarrier xcd_barrier_post(unsigned* bar, volatile LAS unsigned* st) {
    XcdBarrier b; b.bar = bar; b.x = xb_xcc_id(); b.st = st;
    if (threadIdx.x == 0) (void)xb_add(&bar[XB_XCNT(b.x)], 1u);
    return b;
}
__device__ __forceinline__ void xcd_barrier_complete(unsigned* bar, unsigned x, unsigned& nloc, unsigned& nx) {
    const unsigned G = gridDim.x * gridDim.y * gridDim.z;
    unsigned sum, cnt, mine, sp = 0u;
    for (;;) {
        sum = 0u; cnt = 0u; mine = 0u;
#pragma unroll
        for (unsigned j = 0; j < 16; ++j) { const unsigned c = xb_ld(&bar[XB_XCNT(j)]); sum += c; cnt += (c > 0u) ? 1u : 0u; mine = (j == x) ? c : mine; }
        if (sum == G) break;
        __builtin_amdgcn_s_sleep(1);
        if ((++sp & 255u) == 0u) { if (xb_ld(&bar[XB_TMO])) break; if (sp > XB_SPIN_CAP) { atomicAdd(&bar[XB_TMO], 1u); break; } }
    }
    nloc = mine > 0u ? mine : 1u; nx = cnt > 0u ? cnt : 1u;
}

__device__ __forceinline__ void xcd_barrier(const XcdBarrier& b) {
    asm volatile("s_waitcnt vmcnt(0)" ::: "memory");
    __syncthreads();
    if (threadIdx.x == 0) {
        unsigned* bar = b.bar;
        __builtin_amdgcn_s_waitcnt(0);
        unsigned nloc = b.st[0], nx = b.st[1];
        if (nloc == 0u) { xcd_barrier_complete(bar, b.x, nloc, nx); b.st[0] = nloc; b.st[1] = nx; }
        const unsigned old = xb_add(&bar[XB_XSUB(b.x)], 1u);
        const unsigned gen = old / nloc;
        if (old + 1u == (gen + 1u) * nloc) {
            __builtin_amdgcn_fence(__ATOMIC_RELEASE, "agent");
            asm volatile("s_waitcnt vmcnt(0)" ::: "memory");
            const unsigned og = xb_add(&bar[XB_TOP], 1u);
            const unsigned tg = og / nx;
            if (og + 1u == (tg + 1u) * nx) xb_add(&bar[XB_TOPGEN], 1u);
            else XB_SPIN(xb_ld(&bar[XB_TOPGEN]) == tg, bar);
            __builtin_amdgcn_fence(__ATOMIC_ACQUIRE, "agent");
            xb_add(&bar[XB_XGEN(b.x)], 1u);
            asm volatile("s_waitcnt vmcnt(0)" ::: "memory");
        } else {
            XB_SPIN(xb_ld(&bar[XB_XGEN(b.x)]) == gen, bar);
            __builtin_amdgcn_fence(__ATOMIC_ACQUIRE, "agent");
            asm volatile("s_waitcnt vmcnt(0)" ::: "memory");
        }
    }
    __syncthreads();
}

template <bool REL, bool ACQ> __device__ __forceinline__ void xcd_barrier_v(const XcdBarrier& b) {
    asm volatile("s_waitcnt vmcnt(0)" ::: "memory");
    __syncthreads();
    if (threadIdx.x == 0) {
        unsigned* bar = b.bar;
        __builtin_amdgcn_s_waitcnt(0);
        unsigned nloc = b.st[0], nx = b.st[1];
        if (nloc == 0u) { xcd_barrier_complete(bar, b.x, nloc, nx); b.st[0] = nloc; b.st[1] = nx; }
        const unsigned old = xb_add(&bar[XB_XSUB(b.x)], 1u);
        const unsigned gen = old / nloc;
        if (old + 1u == (gen + 1u) * nloc) {
            if (REL) __builtin_amdgcn_fence(__ATOMIC_RELEASE, "agent");
            asm volatile("s_waitcnt vmcnt(0)" ::: "memory");
            const unsigned og = xb_add(&bar[XB_TOP], 1u);
            const unsigned tg = og / nx;
            if (og + 1u == (tg + 1u) * nx) xb_add(&bar[XB_TOPGEN], 1u);
            else XB_SPIN(xb_ld(&bar[XB_TOPGEN]) == tg, bar);
            if (ACQ) __builtin_amdgcn_fence(__ATOMIC_ACQUIRE, "agent");
            xb_add(&bar[XB_XGEN(b.x)], 1u);
            asm volatile("s_waitcnt vmcnt(0)" ::: "memory");
        } else {
            XB_SPIN(xb_ld(&bar[XB_XGEN(b.x)]) == gen, bar);
            if (ACQ) __builtin_amdgcn_fence(__ATOMIC_ACQUIRE, "agent");
            asm volatile("s_waitcnt vmcnt(0)" ::: "memory");
        }
    }
    __syncthreads();
}
typedef short bf16x8_t __attribute__((ext_vector_type(8)));
typedef unsigned u32x2_t __attribute__((ext_vector_type(2)));
__device__ __forceinline__ unsigned cvtpk(float lo, float hi) { unsigned r; asm volatile("v_cvt_pk_bf16_f32 %0, %1, %2" : "=v"(r) : "v"(lo), "v"(hi)); return r; }
__device__ __forceinline__ void att_stage(LAS unsigned char* lds, const bf16_t* src, int pitch, int tid) {
    const int r0 = tid >> 5, ch = tid & 31;
    const bf16_t* g0 = src + (size_t)r0 * pitch + ch * 8;
    LAS unsigned char* l0 = lds + r0 * 512 + ((ch ^ r0) << 4);
    u32x4 v[16];
#pragma unroll
    for (int x = 0; x < 16; ++x) v[x] = *(const u32x4*)(g0 + (size_t)(16 * x) * pitch);
#pragma unroll
    for (int x = 0; x < 16; ++x) *(LAS u32x4*)(l0 + x * 8192) = v[x];
}
__device__ __forceinline__ void att_phase(LAS unsigned char* lds, const bf16_t* Kl, const bf16_t* Vl, const bf16_t* Qb, bf16_t* Ob, int G, int tid) {
    for (int u = blockIdx.x; u < (M / 256) * 4; u += G) {
        asm volatile("" : "+v"(tid));
        const int lane = tid & 63, wave = __builtin_amdgcn_readfirstlane(tid >> 6), j = lane & 15, kg = lane >> 4;
        const int h = u & 3, pm = u >> 2, b = pm >> 5;
        att_stage(lds, Kl + (size_t)(b * 256) * 4096 + h * 256, 4096, tid);
        const bf16_t* qrow = Qb + (size_t)(pm * 256 + 16 * wave + j) * 1024 + h * 256;
        bf16_t* orow = Ob + (size_t)(pm * 256 + 16 * wave + j) * 1024 + h * 256;
        __syncthreads();
        const LAS unsigned char* fbase = lds + j * 512;
        const float cs = 0.0625f * 1.4426950408889634f;
        bf16x8_t pf[2][8]; float inv[2];
#pragma unroll
        for (int hf = 0; hf < 2; ++hf) {
            bf16x8_t qf[8];
#pragma unroll
            for (int s = 0; s < 8; ++s) qf[s] = *(const bf16x8_t*)(qrow + (size_t)hf * 128 * 1024 + 32 * s + 8 * kg);
            f32x4 acc[16];
#pragma unroll
            for (int kb = 0; kb < 16; ++kb) acc[kb] = (f32x4){0.f, 0.f, 0.f, 0.f};
#pragma unroll
            for (int s = 0; s < 8; ++s)
#pragma unroll
                for (int kb = 0; kb < 16; ++kb) { const bf16x8_t af = *(const LAS bf16x8_t*)(fbase + kb * 8192 + (((4 * s + kg) ^ j) << 4));
                    acc[kb] = __builtin_amdgcn_mfma_f32_16x16x32_bf16(af, qf[s], acc[kb], 0, 0, 0); }
            float mx = acc[0][0];
#pragma unroll
            for (int kb = 0; kb < 16; ++kb) mx = fmaxf(fmaxf(mx, fmaxf(acc[kb][0], acc[kb][1])), fmaxf(acc[kb][2], acc[kb][3]));
            mx = fmaxf(mx, __shfl_xor(mx, 16)); mx = fmaxf(mx, __shfl_xor(mx, 32));
            const float mxc = mx * cs; float sum = 0.f;
#pragma unroll
            for (int t = 0; t < 8; ++t) { f32x4 p0, p1;
#pragma unroll
                for (int e = 0; e < 4; ++e) { p0[e] = __builtin_amdgcn_exp2f(acc[2 * t][e] * cs - mxc); p1[e] = __builtin_amdgcn_exp2f(acc[2 * t + 1][e] * cs - mxc); }
                sum += (p0[0] + p0[1]) + (p0[2] + p0[3]) + (p1[0] + p1[1]) + (p1[2] + p1[3]);
                u32x4 w; w.x = cvtpk(p0[0], p0[1]); w.y = cvtpk(p0[2], p0[3]); w.z = cvtpk(p1[0], p1[1]); w.w = cvtpk(p1[2], p1[3]); pf[hf][t] = __builtin_bit_cast(bf16x8_t, w); }
            sum += __shfl_xor(sum, 16); sum += __shfl_xor(sum, 32);
            inv[hf] = 1.f / sum;
            __builtin_amdgcn_sched_barrier(0);
        }
        __syncthreads();
        att_stage(lds, Vl + (size_t)(h * 256) * 1024 + b * 256, 1024, tid);
        __syncthreads();
#pragma unroll
        for (int hf = 0; hf < 2; ++hf) {
#pragma unroll
            for (int db = 0; db < 16; ++db) {
                f32x4 o = (f32x4){0.f, 0.f, 0.f, 0.f};
#pragma unroll
                for (int t = 0; t < 8; ++t) { const bf16x8_t af = *(const LAS bf16x8_t*)(fbase + db * 8192 + (((4 * t + kg) ^ j) << 4));
                    o = __builtin_amdgcn_mfma_f32_16x16x32_bf16(af, pf[hf][t], o, 0, 0, 0); }
                u32x2_t w; w.x = cvtpk(o[0] * inv[hf], o[1] * inv[hf]); w.y = cvtpk(o[2] * inv[hf], o[3] * inv[hf]);
                *(u32x2_t*)(orow + (size_t)hf * 128 * 1024 + 16 * db + 4 * kg) = w;
            }
        }
        __syncthreads();
    }
}

__device__ __forceinline__ void conv_phase(LAS unsigned char* lds, const bf16_t* PROJ, const float* cw, const float* cb, const float* lg, const float* lb, bf16_t* MIXIN, int G, int tid) {
    LAS float* U = (LAS float*)lds;
    for (int u = blockIdx.x; u < M / 32; u += G) {
        asm volatile("" : "+v"(tid));
        const int lane = tid & 63, wave = __builtin_amdgcn_readfirstlane(tid >> 6);
        const int row0 = u * 32, t0 = row0 % SEQ;
        const int c = tid;
        float w[31];
#pragma unroll
        for (int k = 0; k < 31; ++k) w[k] = cw[k * 512 + c];
        const float bias = cb[c];
#pragma unroll
        for (int pass = 0; pass < 8; ++pass) { const int rr = pass * 8 + wave;
            if (rr < 62) { f32x4 o0 = (f32x4){0.f, 0.f, 0.f, 0.f}, o1 = o0;
                if (t0 - 30 + rr >= 0) { const bf16_t* pr = PROJ + (size_t)(row0 - 30 + rr) * PROJ_LD + 8 * lane;
                    const u32x4 a = *(const u32x4*)(pr + C_CA), g = *(const u32x4*)(pr + C_CG);
#pragma unroll
                    for (int x = 0; x < 4; ++x) { const float a0 = __uint_as_float(a[x] << 16), a1 = __uint_as_float(a[x] & 0xffff0000u), g0 = __uint_as_float(g[x] << 16), g1 = __uint_as_float(g[x] & 0xffff0000u);
                        const float u0 = a0 * __builtin_amdgcn_rcpf(1.f + __expf(-g0)), u1 = a1 * __builtin_amdgcn_rcpf(1.f + __expf(-g1));
                        if (x < 2) { o0[2 * x] = u0; o0[2 * x + 1] = u1; } else { o1[2 * x - 4] = u0; o1[2 * x - 3] = u1; } } }
                *(LAS f32x4*)(U + rr * 512 + 8 * lane) = o0; *(LAS f32x4*)(U + rr * 512 + 8 * lane + 4) = o1; } }
        __syncthreads();
        float y[32];
#pragma unroll
        for (int blk = 0; blk < 4; ++blk) { float win[38];
#pragma unroll
            for (int x = 0; x < 38; ++x) win[x] = U[(8 * blk + x) * 512 + c];
#pragma unroll
            for (int o = 0; o < 8; ++o) { float acc = bias;
#pragma unroll
                for (int k = 0; k < 31; ++k) acc += w[k] * win[o + k];
                y[8 * blk + o] = acc; } }
        __syncthreads();
#pragma unroll
        for (int tt = 0; tt < 32; ++tt) U[tt * 512 + c] = y[tt];
        __syncthreads();
#pragma unroll
        for (int q = 0; q < 4; ++q) { const int tt = 4 * wave + q;
            f32x4 a = *(const LAS f32x4*)(U + tt * 512 + 8 * lane), b = *(const LAS f32x4*)(U + tt * 512 + 8 * lane + 4);
            const float mean = wave_sum((a[0] + a[1]) + (a[2] + a[3]) + (b[0] + b[1]) + (b[2] + b[3])) * (1.f / 512.f);
            a = a - mean; b = b - mean;
            const float var = wave_sum((a[0] * a[0] + a[1] * a[1]) + (a[2] * a[2] + a[3] * a[3]) + (b[0] * b[0] + b[1] * b[1]) + (b[2] * b[2] + b[3] * b[3])) * (1.f / 512.f);
            const float rstd = rsqrtf(var + LN_EPS);
            a = a * rstd * *(const f32x4*)(lg + 8 * lane) + *(const f32x4*)(lb + 8 * lane); b = b * rstd * *(const f32x4*)(lg + 8 * lane + 4) + *(const f32x4*)(lb + 8 * lane + 4);
#pragma unroll
            for (int x = 0; x < 4; ++x) { a[x] = pg8::silu_fast(a[x]); b[x] = pg8::silu_fast(b[x]); }
            *(u32x4*)(MIXIN + (size_t)(row0 + tt) * D + 8 * lane) = pg8::pack8(a, b); }
        __syncthreads();
    }
}

typedef float f32x16_t __attribute__((ext_vector_type(16)));
constexpr int GP = 72;
__device__ __forceinline__ int slot32(int c) { const int w = c & 15; return (c & ~15) + 8 * ((w >> 2) & 1) + (w & 3) + 4 * (w >> 3); }
__device__ __forceinline__ void gla_bcum(const bf16_t* ALOW, const float* wa2, const float* ba, int row0, int h, int lane, int wave, float (&bc)[8], float (&bl)[8]) {
    const u32x4 a0 = *(const u32x4*)(ALOW + (size_t)(row0 + lane) * 16), a1 = *(const u32x4*)(ALOW + (size_t)(row0 + lane) * 16 + 8);
    float al[16];
#pragma unroll
    for (int x = 0; x < 4; ++x) { al[2 * x] = __uint_as_float(a0[x] << 16); al[2 * x + 1] = __uint_as_float(a0[x] & 0xffff0000u); al[8 + 2 * x] = __uint_as_float(a1[x] << 16); al[8 + 2 * x + 1] = __uint_as_float(a1[x] & 0xffff0000u); }
#pragma unroll
    for (int x = 0; x < 8; ++x) { const int col = h * 64 + 8 * wave + x; float z = ba[col];
#pragma unroll
        for (int i = 0; i < 16; ++i) z += al[i] * wa2[i * 256 + col];
        float la = (fminf(z, 0.f) - __logf(1.f + __expf(-fabsf(z)))) * (1.f / 16.f);
        la += __builtin_bit_cast(float, __builtin_amdgcn_update_dpp(0, __builtin_bit_cast(int, la), 0x111, 0xf, 0xf, true));
        la += __builtin_bit_cast(float, __builtin_amdgcn_update_dpp(0, __builtin_bit_cast(int, la), 0x112, 0xf, 0xf, true));
        la += __builtin_bit_cast(float, __builtin_amdgcn_update_dpp(0, __builtin_bit_cast(int, la), 0x114, 0xf, 0xf, true));
        la += __builtin_bit_cast(float, __builtin_amdgcn_update_dpp(0, __builtin_bit_cast(int, la), 0x118, 0xf, 0xf, true));
        const float t0 = __builtin_bit_cast(float, __builtin_amdgcn_readlane(__builtin_bit_cast(int, la), 15)), t1 = __builtin_bit_cast(float, __builtin_amdgcn_readlane(__builtin_bit_cast(int, la), 31)),
                    t2 = __builtin_bit_cast(float, __builtin_amdgcn_readlane(__builtin_bit_cast(int, la), 47)), t3 = __builtin_bit_cast(float, __builtin_amdgcn_readlane(__builtin_bit_cast(int, la), 63));
        la += (lane >= 48) ? (t0 + t1) + t2 : (lane >= 32) ? t0 + t1 : (lane >= 16) ? t0 : 0.f;
        bc[x] = la; bl[x] = ((t0 + t1) + t2) + t3; }
}
__device__ __forceinline__ void unpack8(const u32x4 v, float (&f)[8]) {
#pragma unroll
    for (int x = 0; x < 4; ++x) { f[2 * x] = __uint_as_float(v[x] << 16); f[2 * x + 1] = __uint_as_float(v[x] & 0xffff0000u); }
}
__device__ __forceinline__ void gla_g1_phase(LAS unsigned char* lds, const bf16_t* PROJ, const bf16_t* ALOW, const float* wa2, const float* ba, float* UPD, float* DEC, int G, int tid) {
    LAS bf16_t* KD = (LAS bf16_t*)lds; LAS bf16_t* VT = (LAS bf16_t*)(lds + 18432);
    for (int u = blockIdx.x; u < 2048; u += G) {
        asm volatile("" : "+v"(tid));
        const int lane = tid & 63, wave = __builtin_amdgcn_readfirstlane(tid >> 6);
        const int bh = u >> 7, n = u & 127, b = bh >> 2, h = bh & 3, row0 = b * SEQ + n * 64;
        float bc[8], bl[8];
        gla_bcum(ALOW, wa2, ba, row0, h, lane, wave, bc, bl);
        const bf16_t* pr = PROJ + (size_t)(row0 + lane) * PROJ_LD;
        float kf[8]; unpack8(*(const u32x4*)(pr + C_K + h * 64 + 8 * wave), kf);
#pragma unroll
        for (int x = 0; x < 8; ++x) KD[(8 * wave + x) * GP + lane] = f2bf(kf[x] * __expf(bl[x] - bc[x]));
        if (lane == 63) {
#pragma unroll
            for (int x = 0; x < 8; ++x) DEC[u * 64 + 8 * wave + x] = __expf(bl[x]); }
#pragma unroll
        for (int pc = 0; pc < 2; ++pc) { const int e0 = 64 * pc + 8 * wave; const u32x4 v = *(const u32x4*)(pr + C_V + h * 128 + e0);
#pragma unroll
            for (int x = 0; x < 4; ++x) { VT[(e0 + 2 * x) * GP + lane] = (bf16_t)(v[x] & 0xffffu); VT[(e0 + 2 * x + 1) * GP + lane] = (bf16_t)(v[x] >> 16); } }
        __syncthreads();
        const int eb = wave >> 1, dbk = wave & 1, i = lane & 31, kg = lane >> 5;
        f32x16_t acc;
#pragma unroll
        for (int r = 0; r < 16; ++r) acc[r] = 0.f;
#pragma unroll
        for (int s = 0; s < 4; ++s) { const bf16x8_t af = *(const LAS bf16x8_t*)(VT + (32 * eb + i) * GP + 16 * s + 8 * kg), bfr = *(const LAS bf16x8_t*)(KD + (32 * dbk + i) * GP + 16 * s + 8 * kg);
            acc = __builtin_amdgcn_mfma_f32_32x32x16_bf16(af, bfr, acc, 0, 0, 0); }
        float* up = UPD + ((size_t)u * 128 + 32 * eb + 4 * kg) * 64 + 32 * dbk + i;
#pragma unroll
        for (int r = 0; r < 16; ++r) up[((r & 3) + 8 * (r >> 2)) * 64] = acc[r];
        __syncthreads();
    }
}
__device__ __forceinline__ void gla_g2_phase(float* UPD, float* SP, const float* DEC, int G, int tid) {
    for (int g = blockIdx.x * 512 + tid; g < 16 * 8192; g += G * 512) {
        const int bh = g >> 13, ed = g & 8191, d = g & 63;
        const float* p = UPD + (size_t)bh * 128 * 8192 + ed; float* po = SP + (size_t)bh * 128 * 8192 + ed; const float* dc = DEC + bh * 128 * 64 + d;
        float S = 0.f;
        for (int n0 = 0; n0 < 128; n0 += 16) { float uu[16], dd[16];
#pragma unroll
            for (int x = 0; x < 16; ++x) { uu[x] = p[(size_t)(n0 + x) * 8192]; dd[x] = dc[(n0 + x) * 64]; }
#pragma unroll
            for (int x = 0; x < 16; ++x) { po[(size_t)(n0 + x) * 8192] = S; S = dd[x] * S + uu[x]; } }
    }
}
__device__ __forceinline__ void gla_g3_phase(LAS unsigned char* lds, const bf16_t* PROJ, const bf16_t* ALOW, const float* wa2, const float* ba, const float* gn, const float* UPD, bf16_t* MIXIN, int G, int tid) {
    LAS bf16_t* KE = (LAS bf16_t*)lds; LAS bf16_t* QE = (LAS bf16_t*)(lds + 9216); LAS bf16_t* VT = (LAS bf16_t*)(lds + 18432); LAS float* RED = (LAS float*)(lds + 36864);
    for (int u = blockIdx.x; u < 2048; u += G) {
        asm volatile("" : "+v"(tid));
        const int lane = tid & 63, wave = __builtin_amdgcn_readfirstlane(tid >> 6);
        const int bh = u >> 7, n = u & 127, b = bh >> 2, h = bh & 3, row0 = b * SEQ + n * 64;
        const int eb = wave >> 1, cb = wave & 1, i = lane & 31, kg = lane >> 5;
        const size_t row = (size_t)(row0 + 32 * cb + i);
        f32x4 spv[4][2]; u32x2_t rrv[4]; f32x4 g4v[4];
        { const float* sp = UPD + ((size_t)u * 128 + 32 * eb + i) * 64 + 8 * kg;
#pragma unroll
          for (int s = 0; s < 4; ++s) { spv[s][0] = *(const f32x4*)(sp + 16 * s); spv[s][1] = *(const f32x4*)(sp + 16 * s + 4); }
#pragma unroll
          for (int rg = 0; rg < 4; ++rg) { const int e = 32 * eb + 8 * rg + 4 * kg; g4v[rg] = *(const f32x4*)(gn + e); rrv[rg] = *(const u32x2_t*)(PROJ + row * PROJ_LD + C_R + h * 128 + e); } }
        { float bc[8], bl[8];
          gla_bcum(ALOW, wa2, ba, row0, h, lane, wave, bc, bl);
          const bf16_t* pr = PROJ + (size_t)(row0 + lane) * PROJ_LD;
          float qf[8], kf[8]; unpack8(*(const u32x4*)(pr + C_Q + h * 64 + 8 * wave), qf); unpack8(*(const u32x4*)(pr + C_K + h * 64 + 8 * wave), kf);
          f32x4 q0, q1, k0, k1;
#pragma unroll
          for (int x = 0; x < 4; ++x) { q0[x] = qf[x] * 0.125f * __expf(bc[x]); q1[x] = qf[4 + x] * 0.125f * __expf(bc[4 + x]); k0[x] = kf[x] * __expf(-bc[x]); k1[x] = kf[4 + x] * __expf(-bc[4 + x]); }
          *(LAS u32x4*)(QE + lane * GP + 8 * wave) = pg8::pack8(q0, q1); *(LAS u32x4*)(KE + lane * GP + 8 * wave) = pg8::pack8(k0, k1);
          const int pcol = slot32(lane);
#pragma unroll
          for (int pc = 0; pc < 2; ++pc) { const int e0 = 64 * pc + 8 * wave; const u32x4 v = *(const u32x4*)(pr + C_V + h * 128 + e0);
#pragma unroll
              for (int x = 0; x < 4; ++x) { VT[(e0 + 2 * x) * GP + pcol] = (bf16_t)(v[x] & 0xffffu); VT[(e0 + 2 * x + 1) * GP + pcol] = (bf16_t)(v[x] >> 16); } } }
        __syncthreads();
        bf16x8_t qb[4];
#pragma unroll
        for (int s = 0; s < 4; ++s) qb[s] = *(const LAS bf16x8_t*)(QE + (32 * cb + i) * GP + 16 * s + 8 * kg);
        f32x16_t o;
#pragma unroll
        for (int r = 0; r < 16; ++r) o[r] = 0.f;
#pragma unroll
        for (int sb = 0; sb < 2; ++sb) if (sb <= cb) {
            f32x16_t at;
#pragma unroll
            for (int r = 0; r < 16; ++r) at[r] = 0.f;
#pragma unroll
            for (int s = 0; s < 4; ++s) { const bf16x8_t af = *(const LAS bf16x8_t*)(KE + (32 * sb + i) * GP + 16 * s + 8 * kg); at = __builtin_amdgcn_mfma_f32_32x32x16_bf16(af, qb[s], at, 0, 0, 0); }
            if (sb == cb) {
#pragma unroll
                for (int r = 0; r < 16; ++r) if ((r & 3) + 8 * (r >> 2) + 4 * kg > i) at[r] = 0.f; }
#pragma unroll
            for (int sp = 0; sp < 2; ++sp) { u32x4 w; w.x = cvtpk(at[8 * sp + 0], at[8 * sp + 1]); w.y = cvtpk(at[8 * sp + 2], at[8 * sp + 3]); w.z = cvtpk(at[8 * sp + 4], at[8 * sp + 5]); w.w = cvtpk(at[8 * sp + 6], at[8 * sp + 7]);
                const bf16x8_t af = *(const LAS bf16x8_t*)(VT + (32 * eb + i) * GP + 32 * sb + 16 * sp + 8 * kg);
                o = __builtin_amdgcn_mfma_f32_32x32x16_bf16(af, __builtin_bit_cast(bf16x8_t, w), o, 0, 0, 0); }
        }
#pragma unroll
        for (int s = 0; s < 4; ++s) o = __builtin_amdgcn_mfma_f32_32x32x16_bf16(__builtin_bit_cast(bf16x8_t, pg8::pack8(spv[s][0], spv[s][1])), qb[s], o, 0, 0, 0);
        float ss = 0.f;
#pragma unroll
        for (int r = 0; r < 16; ++r) ss += o[r] * o[r];
        ss += __shfl_xor(ss, 32);
        if (kg == 0) RED[eb * 64 + 32 * cb + i] = ss;
        __syncthreads();
        const float tot = (RED[32 * cb + i] + RED[64 + 32 * cb + i]) + (RED[128 + 32 * cb + i] + RED[192 + 32 * cb + i]);
        const float rstd = rsqrtf(tot * (1.f / 128.f) + LN_EPS);
#pragma unroll
        for (int rg = 0; rg < 4; ++rg) { const int e = 32 * eb + 8 * rg + 4 * kg;
            const f32x4 g4 = g4v[rg]; const u32x2_t rr = rrv[rg];
            const float r0 = __uint_as_float(rr.x << 16), r1 = __uint_as_float(rr.x & 0xffff0000u), r2 = __uint_as_float(rr.y << 16), r3 = __uint_as_float(rr.y & 0xffff0000u);
            u32x2_t w; w.x = cvtpk(o[4 * rg] * rstd * g4[0] * pg8::silu_fast(r0), o[4 * rg + 1] * rstd * g4[1] * pg8::silu_fast(r1));
            w.y = cvtpk(o[4 * rg + 2] * rstd * g4[2] * pg8::silu_fast(r2), o[4 * rg + 3] * rstd * g4[3] * pg8::silu_fast(r3));
            *(u32x2_t*)(MIXIN + row * D + 512 + h * 128 + e) = w; }
        __syncthreads();
    }
}

#ifndef PROBE_MASK
#define PROBE_MASK 0
#endif
#ifndef ONE_LAUNCH
#define ONE_LAUNCH 1
#endif
constexpr int NPL = 10, NPH = 2 + NPL * DEPTH + 1;
enum { PK_IN = 0, PK_CG1, PK_G2, PK_G3, PK_MIX, PK_Q, PK_ATT, PK_XO, PK_FF1, PK_FF2 };
constexpr int CSN = 9472, CS_IN = 0, CS_Q = 2816, CS_FF1 = 3840;

__global__ void __launch_bounds__(NWAVES * 64) mega(Args a) {
    extern __shared__ __attribute__((aligned(16))) unsigned char lds_raw[];
    LAS unsigned char* lds = (LAS unsigned char*)lds_raw;
    const int wave = __builtin_amdgcn_readfirstlane(threadIdx.x >> 6);
    const int G = gridDim.x, gw = blockIdx.x * NWAVES + wave, NGW = G * NWAVES;
    unsigned char* ws = a.ws;
#define INP(k) ({ int k_ = (k); asm volatile("" : "+s"(k_)); a.in[k_]; })
    float* Y = a.out;
    bf16_t* WT = (bf16_t*)(ws + WS_WT); bf16_t* YB = (bf16_t*)(ws + WS_HB); bf16_t* PROJ = (bf16_t*)(ws + WS_PROJ); bf16_t* ALOW = (bf16_t*)(ws + WS_ALOW);
    bf16_t* MIXIN = (bf16_t*)(ws + WS_MIXIN); bf16_t* Qb = (bf16_t*)(ws + WS_Q); bf16_t* ACT = (bf16_t*)(ws + WS_ACT);
    bf16_t* Kb = (bf16_t*)(ws + WS_K); bf16_t* Vt = (bf16_t*)(ws + WS_VT); bf16_t* MEMB = (bf16_t*)(ws + WS_MEMB); bf16_t* MEMP = (bf16_t*)(ws + WS_MEMP);
    float* UPD = (float*)(ws + WS_UPD); float* DEC = (float*)(ws + WS_DEC);
    float* CSP = (float*)(ws + WS_CSP); float* CS = (float*)(ws + WS_CS); float* MUR = (float*)(ws + WS_MUR);
    unsigned long long* SLOTS = (unsigned long long*)(ws + WS_SLOTS); unsigned* CNT = (unsigned*)(ws + WS_CNT);

    volatile LAS unsigned* bst = (volatile LAS unsigned*)(lds + 143360);
    if (threadIdx.x == 0) { bst[0] = 0u; bst[1] = 0u; }
    __syncthreads();
    XcdBarrier xbar; xbar.bar = (unsigned*)(ws + WS_BAR); xbar.x = 0; xbar.st = bst;
    if (a.ph_hi - a.ph_lo > 1) xbar = xcd_barrier_post((unsigned*)(ws + WS_BAR), bst);
    for (int p = a.ph_lo; p < a.ph_hi; ++p) {
      const int pkind = (p < 2 || p == NPH - 1) ? -1 : (p - 2) % NPL;
      int nrep = 1;
      if ((a.sub & 4) && (pkind == PK_IN || pkind == PK_Q || pkind == PK_FF1)) nrep = 2;
      if ((a.sub & (8 | 8192)) && pkind == PK_CG1) nrep = 2;
      if ((a.sub & 16384) && pkind == PK_G3) nrep = 2;
      if ((a.sub & 16) && pkind == PK_ATT) nrep = 2;
      if ((a.sub & 64) && p < 2) nrep = 2;
      if ((a.sub & 128) && pkind == PK_G2) nrep = 2;
      for (int rep = 0; rep < nrep; ++rep) {
        const bool dummy = rep + 1 < nrep;
        int tid; asm volatile("v_mbcnt_lo_u32_b32 %0, -1, 0\n\tv_mbcnt_hi_u32_b32 %0, -1, %0\n\tv_lshl_or_b32 %0, %1, 6, %0" : "=&v"(tid) : "s"(wave));
        const int lane = tid & 63;
        if (p == 0) {
            LAS float* scr = (LAS float*)(lds + wave * 16384);
            if (blockIdx.x == 0) { CNT[tid] = 0u; CNT[512 + tid] = 0u; CNT[1024 + tid] = 0u; }
            for (int it = gw; it < DEPTH * I_LAYER; it += NGW) {
                const int l = it / I_LAYER; int r = it % I_LAYER;
                bf16_t* WL = WT + WT_L0 + (size_t)l * WT_LSTRIDE;
                float* cspl = CSP + (size_t)l * 2 * 16 * CSN;
                if (r < I_IN) { const int kb = r / 81, nb = r % 81; const float* gg = l == 0 ? INP(2) : INP(22) + (l - 1) * D; const float* bb = l == 0 ? INP(3) : INP(23) + (l - 1) * D;
                    cvt_item_ln(INP(4) + (size_t)l * 1024 * IN_COLS, 1024, IN_COLS, 64 * kb, 32 * nb, WL + WO_IN + (size_t)(32 * nb) * 1024, scr, lane, gg, bb, cspl + kb * CSN + CS_IN + 32 * nb, cspl + (16 + kb) * CSN + CS_IN + 32 * nb); continue; } r -= I_IN;
                if (r < I_SQ) { const int kb = r / 32, nb = r % 32; cvt_item(INP(12) + (size_t)l * 1024 * 1024, 1024, 1024, 64 * kb, 32 * nb, WL + WO_MIX + (size_t)(32 * nb) * 1024, scr, lane); continue; } r -= I_SQ;
                if (r < I_SQ) { const int kb = r / 32, nb = r % 32;
                    cvt_item_ln(INP(15) + (size_t)l * 1024 * 1024, 1024, 1024, 64 * kb, 32 * nb, WL + WO_XQ + (size_t)(32 * nb) * 1024, scr, lane, INP(13) + l * D, INP(14) + l * D, cspl + kb * CSN + CS_Q + 32 * nb, cspl + (16 + kb) * CSN + CS_Q + 32 * nb); continue; } r -= I_SQ;
                if (r < I_SQ) { const int kb = r / 32, nb = r % 32; cvt_item(INP(17) + (size_t)l * 1024 * 1024, 1024, 1024, 64 * kb, 32 * nb, WL + WO_XO + (size_t)(32 * nb) * 1024, scr, lane); continue; } r -= I_SQ;
                if (r < I_XKV) { const int kb = r / 64, n0 = 32 * (r % 64);
                    bf16_t* dst = n0 < 1024 ? WT + WT_XK + (size_t)(l * 1024 + n0) * 1024 : WT + WT_XV + (size_t)(l * 1024 + n0 - 1024) * 1024;
                    cvt_item(INP(16) + (size_t)l * 1024 * 2048, 1024, 2048, 64 * kb, n0, dst, scr, lane); continue; } r -= I_XKV;
                if (r < I_FF1) { const int kb = r / 176, n0 = 32 * (r % 176);
                    const int drow = n0 < D_FF ? 256 * (n0 / 128) + n0 % 128 : 256 * ((n0 - D_FF) / 128) + 128 + (n0 - D_FF) % 128;
                    cvt_item_ln(INP(20) + (size_t)l * 1024 * 2 * D_FF, 1024, 2 * D_FF, 64 * kb, n0, WL + WO_FF1 + (size_t)drow * 1024, scr, lane, INP(18) + l * D, INP(19) + l * D, cspl + kb * CSN + CS_FF1 + drow, cspl + (16 + kb) * CSN + CS_FF1 + drow); continue; } r -= I_FF1;
                { const int kb = r / 32, nb = r % 32; cvt_item(INP(21) + (size_t)l * D_FF * 1024, D_FF, 1024, 64 * kb, 32 * nb, WL + WO_FF2 + (size_t)(32 * nb) * D_FF, scr, lane); }
            }
            for (int i = blockIdx.x * 512 + tid; i < 1024 * 1024; i += G * 512) {
                const int row = i >> 10, c = i & 1023, b = row >> 8, key = row & 255; const bf16_t v = f2bf(INP(1)[i]);
                MEMB[i] = v; MEMP[(size_t)(b * 256 + slot_of_key(key)) * 1024 + c] = v; }
            { const float* xin = INP(0);
              for (int m = gw; m < M; m += 2 * NGW) { x_row(xin + (size_t)m * D, YB + (size_t)m * D, MUR + 2 * (size_t)m, lane);
                  if (m + NGW < M) x_row(xin + (size_t)(m + NGW) * D, YB + (size_t)(m + NGW) * D, MUR + 2 * (size_t)(m + NGW), lane); } }
        } else if (p == 1) {
            for (int i = blockIdx.x * 512 + tid; i < DEPTH * 2 * CSN; i += G * 512) { const int lc = i / CSN, c = i % CSN; const float* pp = CSP + (size_t)lc * 16 * CSN + c; float s = 0.f;
#pragma unroll
                for (int kb = 0; kb < 16; ++kb) s += pp[kb * CSN];
                CS[i] = s; }
            const int half = G / 2;
            if ((int)blockIdx.x < half) { pg8::Gemm g{MEMB, WT + WT_XK, 1024, 4096, 1024}; pg8::StaticOrderT<1024, 4096> S; S.init(half, (int)blockIdx.x);
                pg8::EpiBf16 E{Kb, 4096}; pg8::gemm_phase<pg8::EpiBf16, pg8::StaticOrderT<1024, 4096>, true, true, 1024>(lds, g, S, E, tid); }
            else { pg8::Gemm g{WT + WT_XV, MEMP, 4096, 1024, 1024}; pg8::StaticOrderT<4096, 1024> S; S.init(G - half, (int)blockIdx.x - half);
                pg8::EpiBf16 E{Vt, 1024}; pg8::gemm_phase<pg8::EpiBf16, pg8::StaticOrderT<4096, 1024>, true, true, 1024>(lds, g, S, E, tid); }
        } else if (p == NPH - 1) {
            const float* gg = INP(22) + (DEPTH - 1) * D; const float* bb = INP(23) + (DEPTH - 1) * D;
            for (int m = gw; m < M; m += NGW) ln_row_f32(Y + (size_t)m * D, gg, bb, lane);
        } else {
            const int l = (p - 2) / NPL, kind = (p - 2) % NPL;
            const bf16_t* WL = WT + WT_L0 + (size_t)l * WT_LSTRIDE;
            const float* csl = CS + (size_t)l * 2 * CSN; const float* cbl = csl + CSN;
            if (kind == PK_IN) { pg8::Gemm g{YB, WL + WO_IN, M, 2560, 1024}; pg8::StaticOrderT<M, 2560> S; S.init(G, (int)blockIdx.x);
                pg8::EpiBf16LN E{PROJ, 2560, MUR, csl + CS_IN, cbl + CS_IN}; pg8::gemm_phase<pg8::EpiBf16LN, pg8::StaticOrderT<M, 2560>, true, true, 1024>(lds, g, S, E, tid);
                alow_rows(YB, WL + WO_IN + (size_t)2560 * 1024, MUR, csl + CS_IN + 2560, cbl + CS_IN + 2560, ALOW, gw, NGW, lane); }
            else if (kind == PK_CG1) {
                if ((a.sub & 1) && !(dummy && (a.sub & 8192))) conv_phase(lds, PROJ, INP(7) + l * 31 * 512, INP(8) + l * 512, INP(9) + l * 512, INP(10) + l * 512, MIXIN, G, tid);
                if ((a.sub & 2) && !(dummy && (a.sub & 8))) gla_g1_phase(lds, PROJ, ALOW, INP(5) + l * 16 * 256, INP(6) + l * 256, UPD, DEC, G, tid); }
            else if (kind == PK_G2) { gla_g2_phase(UPD, dummy ? (float*)a.out : UPD, DEC, G, tid); }
            else if (kind == PK_G3) { gla_g3_phase(lds, PROJ, ALOW, INP(5) + l * 16 * 256, INP(6) + l * 256, INP(11) + l * 128, UPD, MIXIN, G, tid); }
            else if (kind == PK_MIX || kind == PK_XO) {
                const bool mix = kind == PK_MIX;
                pg8::Gemm g{mix ? MIXIN : Qb, WL + (mix ? WO_MIX : WO_XO), M, 1024, 1024}; pg8::StaticOrderT<M, 1024> S; S.init(G, (int)blockIdx.x);
                const float* gp = mix ? (l == 0 ? INP(2) : INP(22) + (l - 1) * D) : INP(13) + l * D; const float* bp = mix ? (l == 0 ? INP(3) : INP(23) + (l - 1) * D) : INP(14) + l * D;
                pg8::EpiResLN E{(mix && l == 0) ? INP(0) : nullptr, nullptr, YB, MUR, gp, bp, SLOTS, CNT + (3 * l + (mix ? 0 : 1)) * 128, ALPHA, lds};
                pg8::gemm_phase<pg8::EpiResLN, pg8::StaticOrderT<M, 1024>, true, true, 1024>(lds, g, S, E, tid); }
            else if (kind == PK_Q) { pg8::Gemm g{YB, WL + WO_XQ, M, 1024, 1024}; pg8::StaticOrderT<M, 1024> S; S.init(G, (int)blockIdx.x);
                pg8::EpiBf16LN E{Qb, 1024, MUR, csl + CS_Q, cbl + CS_Q}; pg8::gemm_phase<pg8::EpiBf16LN, pg8::StaticOrderT<M, 1024>, true, true, 1024>(lds, g, S, E, tid); }
            else if (kind == PK_ATT) { att_phase(lds, Kb + l * 1024, Vt + (size_t)l * 1024 * 1024, Qb, dummy ? MIXIN : Qb, G, tid); }
            else if (kind == PK_FF1) { pg8::Gemm g{YB, WL + WO_FF1, M, 2 * D_FF, 1024}; pg8::StaticOrderT<M, 2 * D_FF> S; S.init(G, (int)blockIdx.x);
                pg8::EpiSwigluLN E{ACT, MUR, csl + CS_FF1, cbl + CS_FF1}; pg8::gemm_phase<pg8::EpiSwigluLN, pg8::StaticOrderT<M, 2 * D_FF>, true, true, 1024>(lds, g, S, E, tid); }
            else { pg8::Gemm g{ACT, WL + WO_FF2, M, 1024, D_FF}; pg8::StaticOrderT<M, 1024> S; S.init(G, (int)blockIdx.x);
                pg8::EpiResLN E{nullptr, l == DEPTH - 1 ? Y : nullptr, YB, MUR, INP(18) + l * D, INP(19) + l * D, SLOTS, CNT + (3 * l + 2) * 128, ALPHA, lds};
                pg8::gemm_phase<pg8::EpiResLN, pg8::StaticOrderT<M, 1024>, true, true, D_FF>(lds, g, S, E, tid); }
        }
      }
        if (p + 1 < a.ph_hi) { if (p == 0) cg::this_grid().sync(); else xcd_barrier(xbar); if (a.sub & 256) xcd_barrier(xbar); if (a.sub & 512) xcd_barrier_v<false, false>(xbar); }
    }
}

#undef INP
extern "C" void kernel_launch(void* const* d_in, const int* in_sizes, int n_in, void* d_out, int out_size, void* d_ws, size_t ws_size, hipStream_t stream) {
    if (n_in != 24 || out_size != M * D || ws_size < WS_END) { fprintf(stderr, "kernel_launch: unexpected shapes (n_in %d out %d ws %zu)\n", n_in, out_size, ws_size); return; }
    static int grid = 0;
    if (grid == 0) {
        int dev = 0, cus = 0, per_cu = 0;
        (void)hipGetDevice(&dev); (void)hipDeviceGetAttribute(&cus, hipDeviceAttributeMultiprocessorCount, dev);
        if (hipFuncSetAttribute((const void*)mega, hipFuncAttributeMaxDynamicSharedMemorySize, LDS_BYTES) != hipSuccess) { fprintf(stderr, "kernel_launch: hipFuncSetAttribute failed\n"); grid = -1; return; }
        if (hipOccupancyMaxActiveBlocksPerMultiprocessor(&per_cu, (const void*)mega, NWAVES * 64, LDS_BYTES) != hipSuccess || per_cu < 1) { fprintf(stderr, "kernel_launch: occupancy query says %d\n", per_cu); per_cu = 1; }
        (void)hipGetLastError();
        grid = cus;
    }
    if (grid < 0) return;
    Args a{};
    for (int i = 0; i < 24; ++i) a.in[i] = (const float*)d_in[i];
    a.out = (float*)d_out; a.ws = (unsigned char*)d_ws;
#if ONE_LAUNCH
    if (hipMemsetAsync((char*)d_ws + WS_BAR, 0, 16384, stream) != hipSuccess) { fprintf(stderr, "kernel_launch: memset of the barrier words failed\n"); return; }
    a.ph_lo = 0; a.ph_hi = NPH; a.sub = 3 | PROBE_MASK;
    void* kargs[] = {&a};
    hipError_t e = hipLaunchCooperativeKernel((const void*)mega, dim3(grid), dim3(NWAVES * 64), kargs, LDS_BYTES, stream);
    if (e != hipSuccess) fprintf(stderr, "kernel_launch: cooperative launch failed: %s\n", hipGetErrorString(e));
#else
    for (int p = 0; p < NPH; ++p) { a.ph_lo = p; a.ph_hi = p + 1; a.sub = 3; hipLaunchKernelGGL(mega, dim3(grid), dim3(NWAVES * 64), LDS_BYTES, stream, a); }
#endif
}
```

```cpp
#include <hip/hip_runtime.h>
#include <hip/hip_cooperative_groups.h>
#include <cstdio>
#include <cstdint>

typedef unsigned short bf16_t;
typedef unsigned u32x4 __attribute__((ext_vector_type(4)));
typedef float f32x4 __attribute__((ext_vector_type(4)));

constexpr int D = 1024, BATCH = 4, SEQ = 8192, DEPTH = 4, M = BATCH * SEQ;
constexpr int IN_COLS = 2576, PROJ_LD = 2560, MEM_LEN = 256, D_FF = 2816;
constexpr int C_CA = 0, C_CG = 512, C_Q = 1024, C_K = 1280, C_V = 1536, C_R = 2048, C_AL = 2560;
constexpr float LN_EPS = 1e-5f;
constexpr float ALPHA = 1.681792830507429f;

constexpr size_t MiB = 1u << 20;
constexpr size_t WS_CTL = 0;
constexpr size_t WS_K = 8 * MiB;
constexpr size_t WS_VT = 16 * MiB;
constexpr size_t WS_MEMB = 24 * MiB;
constexpr size_t WS_MEMP = 26 * MiB;
constexpr size_t WS_ALOW = 28 * MiB;
constexpr size_t WS_DEC = 29 * MiB;
constexpr size_t WS_CNT = 0;
constexpr size_t WS_BAR = 65536;
constexpr size_t WS_CSP = 1 * MiB;
constexpr size_t WS_CS = 6 * MiB;
constexpr size_t WS_SLOTS = 30 * MiB;
constexpr size_t WS_MUR = 31 * MiB;
constexpr size_t WS_WT = 32 * MiB;
constexpr size_t WS_HB = 160 * MiB;
constexpr size_t WS_PROJ = 224 * MiB;
constexpr size_t WS_Q = 224 * MiB;
constexpr size_t WS_ACT = 224 * MiB;
constexpr size_t WS_UPD = 384 * MiB;
constexpr size_t WS_MIXIN = 448 * MiB;
constexpr size_t WS_END = 512 * MiB;

__host__ __device__ __forceinline__ int key_of_slot(int p) { const int e = p & 7, kg = (p >> 3) & 3; return (p & ~31) + 16 * (e >> 2) + 4 * kg + (e & 3); }
__host__ __device__ __forceinline__ int slot_of_key(int k) { const int w = k & 31; return (k & ~31) + 8 * ((w >> 2) & 3) + 4 * (w >> 4) + (w & 3); }

__device__ __forceinline__ float bf2f(bf16_t b) { return __uint_as_float(((unsigned)b) << 16); }
__device__ __forceinline__ bf16_t f2bf(float f) { unsigned u = __float_as_uint(f); return (bf16_t)((u + 0x7fffu + ((u >> 16) & 1u)) >> 16); }
__device__ __forceinline__ float ldf(const float* p) { return *p; }
__device__ __forceinline__ float ldf(const bf16_t* p) { return bf2f(*p); }
__device__ __forceinline__ float sigmoidf_(float x) { return 1.f / (1.f + __expf(-x)); }
__device__ __forceinline__ float siluf_(float x) { return x / (1.f + __expf(-x)); }
__device__ __forceinline__ float wave_sum(float v) {
#pragma unroll
    for (int o = 1; o < 64; o <<= 1) v += __shfl_xor(v, o);
    return v;
}
__device__ __forceinline__ float wave_max(float v) {
#pragma unroll
    for (int o = 1; o < 64; o <<= 1) v = fmaxf(v, __shfl_xor(v, o));
    return v;
}

namespace pg8 {
#define PG8_LAS __attribute__((address_space(3)))
typedef unsigned short bf16_t;
typedef short bf16x8 __attribute__((ext_vector_type(8)));
typedef float f32x4 __attribute__((ext_vector_type(4)));
typedef unsigned u32x4 __attribute__((ext_vector_type(4)));
constexpr int BM = 256, BK = 64, HALF = 128, HTB = HALF * BK * 2  , STAGE_BYTES = 8 * HTB, NXCD = 8, WGM = 8;

__host__ __device__ __forceinline__ int lds_byte(int r, int c) { const int st = (r >> 4) * 2 + (c >> 5), rr = r & 15, cc = c & 31, ob = rr * 64 + cc * 2; return st * 1024 + (ob ^ (((ob >> 9) & 1) << 5)); }
__host__ __device__ __forceinline__ void stage_rc(int b, int& R, int& C) { const int st = b / 1024, sb = b % 1024, swz = sb ^ (((sb >> 9) & 1) << 5); R = (st >> 1) * 16 + swz / 64; C = (st & 1) * 32 + (swz % 64) / 2; }
__host__ __device__ __forceinline__ int perm32(int rho) { const int n = rho >> 4, i = rho & 15; return 8 * (i >> 2) + 4 * n + (i & 3); }

struct Unit { int pm, pn; };
struct Gemm { const bf16_t* A; const bf16_t* Bt; int M, N, K; };

struct StaticOrder {
    int nM, nN, nwg, G, c;
    __host__ __device__ void init(int M, int N, int G_, int c_) { nM = M / BM; nN = N / BM; nwg = nM * nN; G = G_; c = c_; }
    __host__ __device__ bool next(int i, Unit& u) const {
        const long L = (long)i * G + c; if (L >= nwg) return false;
        int wgid = (int)L; { const int q = nwg / NXCD, r = nwg % NXCD, xcd = wgid % NXCD, off = wgid / NXCD; wgid = (xcd < r ? xcd * (q + 1) : r * (q + 1) + (xcd - r) * q) + off; }
        const int nig = WGM * nN, gid = wgid / nig, fm = gid * WGM, gsz = (nM - fm) < WGM ? (nM - fm) : WGM;
        u.pm = fm + ((wgid % nig) % gsz); u.pn = (wgid % nig) / gsz; return true;
    }
    __device__ __forceinline__ void a_ready(const Unit&) const {}
    __device__ __forceinline__ void done(const Unit&) const {}
};


template <int MM, int NN> struct StaticOrderT {
    static constexpr int nM = MM / BM, nN = NN / BM, nwg = nM * nN;
    int G, c;
    __host__ __device__ void init(int G_, int c_) { G = G_; c = c_; }
    __host__ __device__ bool next(int i, Unit& u) const {
        const long L = (long)i * G + c; if (L >= nwg) return false;
        int wgid = (int)L; { constexpr int q = nwg / NXCD, r = nwg % NXCD; const int xcd = wgid % NXCD, off = wgid / NXCD; wgid = (xcd < r ? xcd * (q + 1) : r * (q + 1) + (xcd - r) * q) + off; }
        constexpr int nig = WGM * nN; const int gid = wgid / nig, fm = gid * WGM, gsz = (nM - fm) < WGM ? (nM - fm) : WGM;
        u.pm = fm + ((wgid % nig) % gsz); u.pn = (wgid % nig) / gsz; return true;
    }
    __device__ __forceinline__ void a_ready(const Unit&) const {}
    __device__ __forceinline__ void done(const Unit&) const {}
};
typedef float f32x2 __attribute__((ext_vector_type(2)));
__device__ __forceinline__ unsigned cvt_pk_bf16(float lo, float hi) { unsigned r; asm volatile("v_cvt_pk_bf16_f32 %0, %1, %2" : "=v"(r) : "v"(lo), "v"(hi)); return r; }
__device__ __forceinline__ u32x4 pack8(const f32x4 v0, const f32x4 v1) { u32x4 w; w.x = cvt_pk_bf16(v0[0], v0[1]); w.y = cvt_pk_bf16(v0[2], v0[3]); w.z = cvt_pk_bf16(v1[0], v1[1]); w.w = cvt_pk_bf16(v1[2], v1[3]); return w; }
__device__ __forceinline__ float silu_fast(float x) { return x * __builtin_amdgcn_rcpf(1.f + __expf(-x)); }
struct EpiBf16 {
    static constexpr bool PERM = true, AFTER_DRAIN = false;
    bf16_t* O; int ldc;
    __device__ __forceinline__ void operator()(const f32x4 (&acc)[2][2][4][2], const Unit& u, int wr, int wc, int fr, int fq) const {
        const int row0 = u.pm * BM + wr * 64 + fr, col0 = u.pn * BM + wc * 32 + 8 * fq;
#pragma unroll
        for (int ai = 0; ai < 2; ++ai)
#pragma unroll
            for (int m = 0; m < 4; ++m) { bf16_t* rowp = O + (size_t)(row0 + ai * HALF + m * 16) * ldc + col0;
#pragma unroll
                for (int bj = 0; bj < 2; ++bj) *(u32x4*)(rowp + bj * HALF) = pack8(acc[ai][bj][m][0], acc[ai][bj][m][1]); }
    }
};
struct EpiProj {
    static constexpr bool PERM = true, AFTER_DRAIN = false;
    bf16_t* O; bf16_t* AL;
    __device__ __forceinline__ void operator()(const f32x4 (&acc)[2][2][4][2], const Unit& u, int wr, int wc, int fr, int fq) const {
        const int row0 = u.pm * BM + wr * 64 + fr, col0 = u.pn * BM + wc * 32 + 8 * fq;
        if (u.pn < 10) {
#pragma unroll
            for (int ai = 0; ai < 2; ++ai)
#pragma unroll
                for (int m = 0; m < 4; ++m) { bf16_t* rowp = O + (size_t)(row0 + ai * HALF + m * 16) * 2560 + col0;
#pragma unroll
                    for (int bj = 0; bj < 2; ++bj) *(u32x4*)(rowp + bj * HALF) = pack8(acc[ai][bj][m][0], acc[ai][bj][m][1]); }
        } else if (wc == 0 && fq < 2) {
#pragma unroll
            for (int ai = 0; ai < 2; ++ai)
#pragma unroll
                for (int m = 0; m < 4; ++m) *(u32x4*)(AL + (size_t)(row0 + ai * HALF + m * 16) * 16 + 8 * fq) = pack8(acc[ai][0][m][0], acc[ai][0][m][1]);
        }
    }
};
struct EpiRes {
    static constexpr bool PERM = false, AFTER_DRAIN = false;
    float* HF; float alpha; static constexpr int ldc = 1024;
    __device__ __forceinline__ void operator()(const f32x4 (&acc)[2][2][4][2], const Unit& u, int wr, int wc, int fr, int fq) const {
        const int row0 = u.pm * BM + wr * 64 + fr, col0 = u.pn * BM + wc * 32 + 4 * fq;
#pragma unroll
        for (int ai = 0; ai < 2; ++ai)
#pragma unroll
            for (int m = 0; m < 4; ++m) { float* rowp = HF + (size_t)(row0 + ai * HALF + m * 16) * ldc + col0;
#pragma unroll
                for (int bj = 0; bj < 2; ++bj)
#pragma unroll
                    for (int n = 0; n < 2; ++n) { f32x4* p = (f32x4*)(rowp + bj * HALF + n * 16); const f32x4 h = *p; *p = h * alpha + acc[ai][bj][m][n]; } }
    }
};
struct EpiSwiglu {
    static constexpr bool PERM = true, AFTER_DRAIN = false;
    bf16_t* O; static constexpr int ldc = 2816;
    __device__ __forceinline__ void operator()(const f32x4 (&acc)[2][2][4][2], const Unit& u, int wr, int wc, int fr, int fq) const {
        const int row0 = u.pm * BM + wr * 64 + fr, col0 = u.pn * HALF + wc * 32 + 8 * fq;
#pragma unroll
        for (int ai = 0; ai < 2; ++ai)
#pragma unroll
            for (int m = 0; m < 4; ++m) { f32x4 a0, a1;
#pragma unroll
                for (int j = 0; j < 4; ++j) { a0[j] = silu_fast(acc[ai][0][m][0][j]) * acc[ai][1][m][0][j]; a1[j] = silu_fast(acc[ai][0][m][1][j]) * acc[ai][1][m][1][j]; }
                *(u32x4*)(O + (size_t)(row0 + ai * HALF + m * 16) * ldc + col0) = pack8(a0, a1); }
    }
};

__device__ __forceinline__ void row_stats8(const float* MUR, int row0, float (&mu)[2][4], float (&rs)[2][4]) {
#pragma unroll
    for (int ai = 0; ai < 2; ++ai)
#pragma unroll
        for (int m = 0; m < 4; ++m) { const f32x2 t = *(const f32x2*)(MUR + 2 * (size_t)(row0 + ai * HALF + m * 16)); mu[ai][m] = t.x; rs[ai][m] = t.y; }
}
struct EpiBf16LN {
    static constexpr bool PERM = true, AFTER_DRAIN = false;
    bf16_t* O; int ldc; const float* MUR; const float* cs; const float* cb;
    __device__ __forceinline__ void operator()(const f32x4 (&acc)[2][2][4][2], const Unit& u, int wr, int wc, int fr, int fq) const {
        const int row0 = u.pm * BM + wr * 64 + fr, col0 = u.pn * BM + wc * 32 + 8 * fq;
        float mu[2][4], rs[2][4]; row_stats8(MUR, row0, mu, rs);
#pragma unroll
        for (int bj = 0; bj < 2; ++bj) { const f32x4 s0 = *(const f32x4*)(cs + col0 + bj * HALF), s1 = *(const f32x4*)(cs + col0 + bj * HALF + 4), b0 = *(const f32x4*)(cb + col0 + bj * HALF), b1 = *(const f32x4*)(cb + col0 + bj * HALF + 4);
#pragma unroll
            for (int ai = 0; ai < 2; ++ai)
#pragma unroll
                for (int m = 0; m < 4; ++m) { const f32x4 v0 = (acc[ai][bj][m][0] - s0 * mu[ai][m]) * rs[ai][m] + b0, v1 = (acc[ai][bj][m][1] - s1 * mu[ai][m]) * rs[ai][m] + b1;
                    *(u32x4*)(O + (size_t)(row0 + ai * HALF + m * 16) * ldc + col0 + bj * HALF) = pack8(v0, v1); } }
    }
};
struct EpiProjLN {
    static constexpr bool PERM = true, AFTER_DRAIN = false;
    bf16_t* O; bf16_t* AL; const float* MUR; const float* cs; const float* cb;
    __device__ __forceinline__ void operator()(const f32x4 (&acc)[2][2][4][2], const Unit& u, int wr, int wc, int fr, int fq) const {
        const int row0 = u.pm * BM + wr * 64 + fr, col0 = u.pn * BM + wc * 32 + 8 * fq;
        float mu[2][4], rs[2][4]; row_stats8(MUR, row0, mu, rs);
        if (u.pn < 10) {
#pragma unroll
            for (int bj = 0; bj < 2; ++bj) { const f32x4 s0 = *(const f32x4*)(cs + col0 + bj * HALF), s1 = *(const f32x4*)(cs + col0 + bj * HALF + 4), b0 = *(const f32x4*)(cb + col0 + bj * HALF), b1 = *(const f32x4*)(cb + col0 + bj * HALF + 4);
#pragma unroll
                for (int ai = 0; ai < 2; ++ai)
#pragma unroll
                    for (int m = 0; m < 4; ++m) { const f32x4 v0 = (acc[ai][bj][m][0] - s0 * mu[ai][m]) * rs[ai][m] + b0, v1 = (acc[ai][bj][m][1] - s1 * mu[ai][m]) * rs[ai][m] + b1;
                        *(u32x4*)(O + (size_t)(row0 + ai * HALF + m * 16) * 2560 + col0 + bj * HALF) = pack8(v0, v1); } }
        } else if (wc == 0 && fq < 2) {
            const f32x4 s0 = *(const f32x4*)(cs + col0), s1 = *(const f32x4*)(cs + col0 + 4), b0 = *(const f32x4*)(cb + col0), b1 = *(const f32x4*)(cb + col0 + 4);
#pragma unroll
            for (int ai = 0; ai < 2; ++ai)
#pragma unroll
                for (int m = 0; m < 4; ++m) { const f32x4 v0 = (acc[ai][0][m][0] - s0 * mu[ai][m]) * rs[ai][m] + b0, v1 = (acc[ai][0][m][1] - s1 * mu[ai][m]) * rs[ai][m] + b1;
                    *(u32x4*)(AL + (size_t)(row0 + ai * HALF + m * 16) * 16 + 8 * fq) = pack8(v0, v1); }
        }
    }
};
struct EpiInLN {
    static constexpr bool PERM = true, AFTER_DRAIN = false;
    bf16_t* O; const float* MUR; const float* cs; const float* cb; static constexpr int ldc = 2560;
    __device__ __forceinline__ void operator()(const f32x4 (&acc)[2][2][4][2], const Unit& u, int wr, int wc, int fr, int fq) const {
        const int row0 = u.pm * BM + wr * 64 + fr, col0 = u.pn * BM + wc * 32 + 8 * fq;
        float mu[2][4], rs[2][4]; row_stats8(MUR, row0, mu, rs);
        if (u.pn >= 4) {
#pragma unroll
            for (int bj = 0; bj < 2; ++bj) { const f32x4 s0 = *(const f32x4*)(cs + col0 + bj * HALF), s1 = *(const f32x4*)(cs + col0 + bj * HALF + 4), b0 = *(const f32x4*)(cb + col0 + bj * HALF), b1 = *(const f32x4*)(cb + col0 + bj * HALF + 4);
#pragma unroll
                for (int ai = 0; ai < 2; ++ai)
#pragma unroll
                    for (int m = 0; m < 4; ++m) { const f32x4 v0 = (acc[ai][bj][m][0] - s0 * mu[ai][m]) * rs[ai][m] + b0, v1 = (acc[ai][bj][m][1] - s1 * mu[ai][m]) * rs[ai][m] + b1;
                        *(u32x4*)(O + (size_t)(row0 + ai * HALF + m * 16) * ldc + col0 + bj * HALF) = pack8(v0, v1); } }
        } else {
            const int ucol = u.pn * HALF + wc * 32 + 8 * fq;
            const f32x4 sa0 = *(const f32x4*)(cs + col0), sa1 = *(const f32x4*)(cs + col0 + 4), ba0 = *(const f32x4*)(cb + col0), ba1 = *(const f32x4*)(cb + col0 + 4);
            const f32x4 sg0 = *(const f32x4*)(cs + col0 + HALF), sg1 = *(const f32x4*)(cs + col0 + HALF + 4), bg0 = *(const f32x4*)(cb + col0 + HALF), bg1 = *(const f32x4*)(cb + col0 + HALF + 4);
#pragma unroll
            for (int ai = 0; ai < 2; ++ai)
#pragma unroll
                for (int m = 0; m < 4; ++m) {
                    const f32x4 a0 = (acc[ai][0][m][0] - sa0 * mu[ai][m]) * rs[ai][m] + ba0, a1 = (acc[ai][0][m][1] - sa1 * mu[ai][m]) * rs[ai][m] + ba1;
                    const f32x4 g0 = (acc[ai][1][m][0] - sg0 * mu[ai][m]) * rs[ai][m] + bg0, g1 = (acc[ai][1][m][1] - sg1 * mu[ai][m]) * rs[ai][m] + bg1;
                    f32x4 u0, u1;
#pragma unroll
                    for (int j = 0; j < 4; ++j) { u0[j] = a0[j] * __builtin_amdgcn_rcpf(1.f + __expf(-g0[j])); u1[j] = a1[j] * __builtin_amdgcn_rcpf(1.f + __expf(-g1[j])); }
                    *(u32x4*)(O + (size_t)(row0 + ai * HALF + m * 16) * ldc + ucol) = pack8(u0, u1); }
        }
    }
};
struct EpiSwigluLN {
    static constexpr bool PERM = true, AFTER_DRAIN = false;
    bf16_t* O; const float* MUR; const float* cs; const float* cb; static constexpr int ldc = 2816;
    __device__ __forceinline__ void operator()(const f32x4 (&acc)[2][2][4][2], const Unit& u, int wr, int wc, int fr, int fq) const {
        const int row0 = u.pm * BM + wr * 64 + fr, wrow = u.pn * BM + wc * 32 + 8 * fq, col0 = u.pn * HALF + wc * 32 + 8 * fq;
        float mu[2][4], rs[2][4]; row_stats8(MUR, row0, mu, rs);
        const f32x4 sg0 = *(const f32x4*)(cs + wrow), sg1 = *(const f32x4*)(cs + wrow + 4), bg0 = *(const f32x4*)(cb + wrow), bg1 = *(const f32x4*)(cb + wrow + 4);
        const f32x4 su0 = *(const f32x4*)(cs + wrow + HALF), su1 = *(const f32x4*)(cs + wrow + HALF + 4), bu0 = *(const f32x4*)(cb + wrow + HALF), bu1 = *(const f32x4*)(cb + wrow + HALF + 4);
#pragma unroll
        for (int ai = 0; ai < 2; ++ai)
#pragma unroll
            for (int m = 0; m < 4; ++m) {
                const f32x4 g0 = (acc[ai][0][m][0] - sg0 * mu[ai][m]) * rs[ai][m] + bg0, g1 = (acc[ai][0][m][1] - sg1 * mu[ai][m]) * rs[ai][m] + bg1;
                const f32x4 u0 = (acc[ai][1][m][0] - su0 * mu[ai][m]) * rs[ai][m] + bu0, u1 = (acc[ai][1][m][1] - su1 * mu[ai][m]) * rs[ai][m] + bu1;
                f32x4 a0, a1;
#pragma unroll
                for (int j = 0; j < 4; ++j) { a0[j] = silu_fast(g0[j]) * u0[j]; a1[j] = silu_fast(g1[j]) * u1[j]; }
                *(u32x4*)(O + (size_t)(row0 + ai * HALF + m * 16) * ldc + col0) = pack8(a0, a1); }
    }
};
struct EpiResLN {
    static constexpr bool PERM = false, AFTER_DRAIN = false;
    const float* Xin; float* Yout; bf16_t* YB; float* MUR; const float* gp; const float* bp; unsigned long long* slots; unsigned* cnt; float alpha; PG8_LAS unsigned char* lds;
    __device__ __forceinline__ void operator()(f32x4 (&acc)[2][2][4][2], const Unit& u, int wr, int wc, int fr, int fq) const {
        typedef unsigned u32x2 __attribute__((ext_vector_type(2)));
        const int row0 = u.pm * BM + wr * 64 + fr, col0 = u.pn * BM + wc * 32 + 4 * fq;
        float mu[2][4], rs[2][4]; row_stats8(MUR, row0, mu, rs);
#pragma unroll
        for (int bj = 0; bj < 2; ++bj)
#pragma unroll
            for (int n = 0; n < 2; ++n) { const f32x4 g4 = *(const f32x4*)(gp + col0 + bj * HALF + n * 16), b4 = *(const f32x4*)(bp + col0 + bj * HALF + n * 16);
#pragma unroll
                for (int ai = 0; ai < 2; ++ai)
#pragma unroll
                    for (int m = 0; m < 4; ++m) { const size_t off = (size_t)(row0 + ai * HALF + m * 16) * 1024 + col0 + bj * HALF + n * 16;
                        f32x4 yo;
                        if (Xin) yo = *(const f32x4*)(Xin + off);
                        else { const u32x2 t = *(const u32x2*)(YB + off); yo = (f32x4){__uint_as_float(t.x << 16), __uint_as_float(t.x & 0xffff0000u), __uint_as_float(t.y << 16), __uint_as_float(t.y & 0xffff0000u)}; }
                        const f32x4 yn = ((yo - mu[ai][m]) * rs[ai][m] * g4 + b4) * alpha + acc[ai][bj][m][n];
                        acc[ai][bj][m][n] = yn; if (Yout) *(f32x4*)(Yout + off) = yn;
                        u32x2 w; w.x = cvt_pk_bf16(yn[0], yn[1]); w.y = cvt_pk_bf16(yn[2], yn[3]); *(u32x2*)(YB + off) = w; } }
        PG8_LAS f32x2* P = (PG8_LAS f32x2*)(lds + 131072);
#pragma unroll
        for (int ai = 0; ai < 2; ++ai)
#pragma unroll
            for (int m = 0; m < 4; ++m) {
                float s = 0.f;
#pragma unroll
                for (int bj = 0; bj < 2; ++bj)
#pragma unroll
                    for (int n = 0; n < 2; ++n) { const f32x4 x = acc[ai][bj][m][n]; s += (x[0] + x[1]) + (x[2] + x[3]); }
                s += __shfl_xor(s, 16); s += __shfl_xor(s, 32);
                const float mw = s * (1.0f / 64.0f); float q = 0.f;
#pragma unroll
                for (int bj = 0; bj < 2; ++bj)
#pragma unroll
                    for (int n = 0; n < 2; ++n) { const f32x4 d = acc[ai][bj][m][n] - mw; q += (d[0] * d[0] + d[1] * d[1]) + (d[2] * d[2] + d[3] * d[3]); }
                q += __shfl_xor(q, 16); q += __shfl_xor(q, 32);
                if (fq == 0) P[(ai * HALF + wr * 64 + m * 16 + fr) * 4 + wc] = (f32x2){mw, q};
            }
        asm volatile("s_waitcnt lgkmcnt(0)" ::: "memory"); __builtin_amdgcn_s_barrier(); asm volatile("" ::: "memory");
        const int wid = wr * 4 + wc, lane = fq * 16 + fr, row = wid * 32 + (lane & 31);
        if (lane < 32) {
            const f32x2 a = P[row * 4 + 0], b = P[row * 4 + 1], c = P[row * 4 + 2], d = P[row * 4 + 3];
            const float mt = (a.x + b.x + c.x + d.x) * 0.25f;
            const float da = a.x - mt, db = b.x - mt, dc = c.x - mt, dd = d.x - mt;
            const float m2 = (a.y + b.y) + (c.y + d.y) + 64.0f * ((da * da + db * db) + (dc * dc + dd * dd));
            __hip_atomic_store(slots + ((size_t)(u.pm * BM + row) * 4 + u.pn), ((unsigned long long)__float_as_uint(m2) << 32) | __float_as_uint(mt), __ATOMIC_RELAXED, __HIP_MEMORY_SCOPE_AGENT);
        }
        asm volatile("s_waitcnt vmcnt(0)" ::: "memory");
        unsigned old = 0u;
        if (lane == 0) old = __hip_atomic_fetch_add(cnt + u.pm, 1u, __ATOMIC_RELAXED, __HIP_MEMORY_SCOPE_AGENT);
        old = (unsigned)__builtin_amdgcn_readfirstlane((int)old);
        if (old == 31u) {
#pragma unroll
            for (int rr = 0; rr < 4; ++rr) { const int r = lane * 4 + rr; const unsigned long long* sl = slots + (size_t)(u.pm * BM + r) * 4; float mt[4], m2[4], ms = 0.f;
#pragma unroll
                for (int t = 0; t < 4; ++t) { const unsigned long long w = __hip_atomic_load(sl + t, __ATOMIC_RELAXED, __HIP_MEMORY_SCOPE_AGENT); mt[t] = __uint_as_float((unsigned)w); m2[t] = __uint_as_float((unsigned)(w >> 32)); ms += mt[t]; }
                const float mean = ms * 0.25f; float q = 0.f;
#pragma unroll
                for (int t = 0; t < 4; ++t) { const float dm = mt[t] - mean; q += m2[t] + 256.0f * dm * dm; }
                *(f32x2*)(MUR + 2 * (size_t)(u.pm * BM + r)) = (f32x2){mean, 1.0f / sqrtf(q * (1.0f / 1024.0f) + 1e-5f)}; }
        }
    }
};

template <class Epi, class Sched, bool ALIGN_EPI, bool SP2, int KC>
__device__ __forceinline__ void gemm_phase(PG8_LAS unsigned char* lds, const Gemm g, const Sched& S, const Epi& E, const int tid) {
    const int wid = __builtin_amdgcn_readfirstlane(tid >> 6), lane = tid & 63, wr = wid >> 2, wc = wid & 3, fr = lane & 15, fq = lane >> 4;
    constexpr int K = KC, nt = K / BK;
    unsigned voffA[2], voffB[2];
#pragma unroll
    for (int i = 0; i < 2; ++i) { int R, C; stage_rc(tid * 16 + i * 8192, R, C); const int Rb = Epi::PERM ? ((R & ~31) + perm32(R & 31)) : R;
        voffA[i] = (unsigned)(R * K + C) * 2u; voffB[i] = (unsigned)(Rb * K + C) * 2u; }
    const size_t kstep = (size_t)(BK * 2);
    const size_t hstep = (size_t)HALF * K * 2;
    const size_t tstep = 2 * hstep;
    const unsigned ldsw = (unsigned)wid * 1024u;
    const int aoff = lds_byte(wr * 64 + fr, fq * 8), boff = lds_byte(wc * 32 + fr, fq * 8);
#define PG8_SA(b, h) (((b) * 2 + (h)) * HTB)
#define PG8_SB(b, h) ((4 + (b) * 2 + (h)) * HTB)
#define PG8_STAGE(bufoff, gbase, voff) do { _Pragma("unroll") for (int _i = 0; _i < 2; ++_i) \
        __builtin_amdgcn_global_load_lds((const unsigned*)((const char*)(gbase) + (voff)[_i]), (PG8_LAS unsigned*)(lds + (bufoff) + ldsw + _i * 8192), 16, 0, 0); } while (0)
#define PG8_LDA(dst, b, h) do { _Pragma("unroll") for (int m = 0; m < 4; ++m) _Pragma("unroll") for (int k = 0; k < 2; ++k) dst[m][k] = *(const PG8_LAS bf16x8*)(lds + PG8_SA(b, h) + aoff + m * 2048 + k * 1024); } while (0)
#define PG8_LDB(dst, b, h) do { _Pragma("unroll") for (int n = 0; n < 2; ++n) _Pragma("unroll") for (int k = 0; k < 2; ++k) dst[n][k] = *(const PG8_LAS bf16x8*)(lds + PG8_SB(b, h) + boff + n * 2048 + k * 1024); } while (0)
#define PG8_MMA(ai, bj, At, Bt) do { __builtin_amdgcn_s_setprio(1); _Pragma("unroll") for (int m = 0; m < 4; ++m) _Pragma("unroll") for (int n = 0; n < 2; ++n) _Pragma("unroll") for (int k = 0; k < 2; ++k) \
        acc[ai][bj][m][n] = __builtin_amdgcn_mfma_f32_16x16x32_bf16(Bt[n][k], At[m][k], acc[ai][bj][m][n], 0, 0, 0); __builtin_amdgcn_s_setprio(0); } while (0)
#define PG8_WAIT_V(n) asm volatile("s_waitcnt vmcnt(" #n ")" ::: "memory")
#define PG8_WAIT_L(n) asm volatile("s_waitcnt lgkmcnt(" #n ")" ::: "memory")
#define PG8_BAR __builtin_amdgcn_s_barrier()
#define PG8_SCHED __builtin_amdgcn_sched_barrier(0)
    Unit cur, nxt; int ui = 0;
    if (!S.next(0, cur)) return;
    f32x4 acc[2][2][4][2];
#pragma unroll
    for (int a = 0; a < 2; ++a)
#pragma unroll
        for (int b = 0; b < 2; ++b)
#pragma unroll
            for (int m = 0; m < 4; ++m)
#pragma unroll
                for (int n = 0; n < 2; ++n) acc[a][b][m][n] = (f32x4){0.f, 0.f, 0.f, 0.f};
    bf16x8 At[4][2], B0[2][2], B1[2][2];
    const char* cA = (const char*)g.A + (size_t)cur.pm * tstep; const char* cB = (const char*)g.Bt + (size_t)cur.pn * tstep;
    S.a_ready(cur);
    if constexpr (SP2) {
        PG8_STAGE(PG8_SB(0, 0), cB, voffB); PG8_STAGE(PG8_SB(0, 1), cB + hstep, voffB); PG8_STAGE(PG8_SA(0, 0), cA, voffA); PG8_STAGE(PG8_SA(0, 1), cA + hstep, voffA);
        if (wr == 1) PG8_BAR;
        PG8_WAIT_V(2); PG8_BAR;
        PG8_STAGE(PG8_SB(1, 0), cB + kstep, voffB); PG8_STAGE(PG8_SA(1, 0), cA + kstep, voffA); PG8_STAGE(PG8_SB(1, 1), cB + hstep + kstep, voffB);
        PG8_WAIT_V(6); PG8_BAR;
    } else {
        PG8_STAGE(PG8_SB(0, 0), cB, voffB); PG8_STAGE(PG8_SA(0, 0), cA, voffA); PG8_STAGE(PG8_SB(0, 1), cB + hstep, voffB); PG8_STAGE(PG8_SA(0, 1), cA + hstep, voffA);
        if (wr == 1) PG8_BAR;
        PG8_WAIT_V(4); PG8_BAR;
        PG8_STAGE(PG8_SB(1, 0), cB + kstep, voffB); PG8_STAGE(PG8_SA(1, 0), cA + kstep, voffA); PG8_STAGE(PG8_SB(1, 1), cB + hstep + kstep, voffB);
        PG8_WAIT_V(6); PG8_BAR;
    }
    for (;;) {
        const bool has_next = S.next(ui + 1, nxt);
        const char* nA = has_next ? (const char*)g.A + (size_t)nxt.pm * tstep : cA; const char* nB = has_next ? (const char*)g.Bt + (size_t)nxt.pn * tstep : cB;
        for (int t = 0; t < nt; t += 2) {
            const bool last = (t == nt - 2);
            const char* a1 = cA + (size_t)(t + 1) * kstep;
            const char* a2 = last ? nA : cA + (size_t)(t + 2) * kstep; const char* b2 = last ? nB : cB + (size_t)(t + 2) * kstep;
            const char* a3 = a2 + kstep; const char* b3 = b2 + kstep;
            if (last && has_next) S.a_ready(nxt);
            if constexpr (SP2) {
            PG8_LDB(B0, 0, 0); PG8_LDB(B1, 0, 1); PG8_SCHED; PG8_LDA(At, 0, 0); PG8_STAGE(PG8_SA(1, 1), a1 + hstep, voffA);
            PG8_WAIT_V(8); PG8_WAIT_L(0); PG8_BAR; PG8_MMA(0, 0, At, B0); PG8_MMA(0, 1, At, B1); PG8_BAR; PG8_SCHED;
            PG8_LDA(At, 0, 1); PG8_STAGE(PG8_SB(0, 0), b2, voffB); PG8_STAGE(PG8_SB(0, 1), b2 + hstep, voffB); PG8_STAGE(PG8_SA(0, 0), a2, voffA);
            PG8_WAIT_V(8); PG8_WAIT_L(0); PG8_BAR; PG8_MMA(1, 0, At, B0); PG8_MMA(1, 1, At, B1); PG8_BAR; PG8_SCHED;
            PG8_LDB(B0, 1, 0); PG8_LDB(B1, 1, 1); PG8_SCHED; PG8_LDA(At, 1, 0); PG8_STAGE(PG8_SA(0, 1), a2 + hstep, voffA);
            PG8_WAIT_V(8); PG8_WAIT_L(0); PG8_BAR; PG8_MMA(0, 0, At, B0); PG8_MMA(0, 1, At, B1); PG8_BAR; PG8_SCHED;
            PG8_LDA(At, 1, 1); PG8_STAGE(PG8_SB(1, 0), b3, voffB); PG8_STAGE(PG8_SB(1, 1), b3 + hstep, voffB); PG8_STAGE(PG8_SA(1, 0), a3, voffA);
            PG8_WAIT_V(8); PG8_WAIT_L(0); PG8_BAR; PG8_MMA(1, 0, At, B0); PG8_MMA(1, 1, At, B1); PG8_BAR; PG8_SCHED;
            } else {
            PG8_LDB(B0, 0, 0); PG8_SCHED; PG8_LDA(At, 0, 0); PG8_STAGE(PG8_SA(1, 1), a1 + hstep, voffA);
            PG8_WAIT_L(8); PG8_BAR; PG8_WAIT_L(0); PG8_MMA(0, 0, At, B0); PG8_BAR; PG8_SCHED;
            PG8_LDB(B1, 0, 1); PG8_STAGE(PG8_SB(0, 0), b2, voffB);
            PG8_BAR; PG8_WAIT_L(0); PG8_MMA(0, 1, At, B1); PG8_BAR;
            PG8_LDA(At, 0, 1); PG8_STAGE(PG8_SA(0, 0), a2, voffA);
            PG8_BAR; PG8_WAIT_L(0); PG8_MMA(1, 0, At, B0); PG8_BAR; PG8_SCHED;
            PG8_STAGE(PG8_SB(0, 1), b2 + hstep, voffB);
            PG8_WAIT_V(6); PG8_BAR; PG8_MMA(1, 1, At, B1); PG8_BAR;
            PG8_LDB(B0, 1, 0); PG8_SCHED; PG8_LDA(At, 1, 0); PG8_STAGE(PG8_SA(0, 1), a2 + hstep, voffA);
            PG8_WAIT_L(8); PG8_BAR; PG8_WAIT_L(0); PG8_MMA(0, 0, At, B0); PG8_BAR; PG8_SCHED;
            PG8_LDB(B1, 1, 1); PG8_STAGE(PG8_SB(1, 0), b3, voffB);
            PG8_BAR; PG8_WAIT_L(0); PG8_MMA(0, 1, At, B1); PG8_BAR;
            PG8_LDA(At, 1, 1); PG8_STAGE(PG8_SA(1, 0), a3, voffA);
            PG8_BAR; PG8_WAIT_L(0); PG8_MMA(1, 0, At, B0); PG8_BAR; PG8_SCHED;
            PG8_STAGE(PG8_SB(1, 1), b3 + hstep, voffB);
            PG8_WAIT_V(6); PG8_BAR; PG8_MMA(1, 1, At, B1); PG8_BAR;
            }
        }
        if constexpr (ALIGN_EPI) { if (wr == 0) PG8_BAR; }
        if constexpr (!Epi::AFTER_DRAIN) { E(acc, cur, wr, wc, fr, fq); S.done(cur); }
        if (!has_next) break;
#pragma unroll
        for (int a = 0; a < 2; ++a)
#pragma unroll
            for (int b = 0; b < 2; ++b)
#pragma unroll
                for (int m = 0; m < 4; ++m)
#pragma unroll
                    for (int n = 0; n < 2; ++n) acc[a][b][m][n] = (f32x4){0.f, 0.f, 0.f, 0.f};
        cur = nxt; cA = nA; cB = nB; ++ui;
        if constexpr (ALIGN_EPI) { if (wr == 1) PG8_BAR; }
    }
    PG8_WAIT_V(0);
    if constexpr (!ALIGN_EPI) { if (wr == 0) PG8_BAR; }
    PG8_BAR;
    if constexpr (Epi::AFTER_DRAIN) { E.fused(acc, cur, wr, wc, fr, fq, lds, wid, lane); S.done(cur); }
#undef PG8_SA
#undef PG8_SB
#undef PG8_STAGE
#undef PG8_LDA
#undef PG8_LDB
#undef PG8_MMA
#undef PG8_WAIT_V
#undef PG8_WAIT_L
#undef PG8_BAR
#undef PG8_SCHED
}
}
namespace cg = cooperative_groups;
#define LAS __attribute__((address_space(3)))
#define LDS_WAIT() asm volatile("s_waitcnt lgkmcnt(0)" ::: "memory")
constexpr int NWAVES = 8, LDS_BYTES = 147456;
constexpr size_t WT_XK = 0, WT_XV = (size_t)4096 * 1024, WT_L0 = (size_t)2 * 4096 * 1024, WT_LSTRIDE = 14680064;
constexpr size_t WO_IN = 0, WO_MIX = 2883584, WO_XQ = WO_MIX + 1048576, WO_XO = WO_XQ + 1048576, WO_FF1 = WO_XO + 1048576, WO_FF2 = WO_FF1 + 5767168;
static_assert(WO_FF2 + 2883584 == WT_LSTRIDE && (WT_L0 + 4 * WT_LSTRIDE) * 2 == 128 * MiB, "weight map");
constexpr int I_IN = 16 * 81, I_SQ = 512, I_XKV = 1024, I_FF1 = 16 * 176, I_FF2 = 44 * 32, I_LAYER = I_IN + 3 * I_SQ + I_XKV + I_FF1 + I_FF2;

struct Args { const float* in[24]; float* out; unsigned char* ws; int ph_lo, ph_hi, sub, pad; };

__device__ __forceinline__ unsigned pk2(float lo, float hi) { return (unsigned)f2bf(lo) | ((unsigned)f2bf(hi) << 16); }
__device__ __forceinline__ void cvt_item(const float* W, int K, int N, int k0, int n0, bf16_t* dst, LAS float* scr, int lane) {
#pragma unroll
    for (int i = 0; i < 32; ++i) { const int kk = 2 * i + (lane >> 5), n = n0 + (lane & 31); scr[kk * 33 + (lane & 31)] = n < N ? W[(size_t)(k0 + kk) * N + n] : 0.f; }
    LDS_WAIT(); asm volatile("" ::: "memory");
    const int c = lane & 7;
#pragma unroll
    for (int j = 0; j < 4; ++j) { const int n = (lane >> 3) + 8 * j; const LAS float* s = scr + (8 * c) * 33 + n;
        u32x4 o; o.x = pk2(s[0 * 33], s[1 * 33]); o.y = pk2(s[2 * 33], s[3 * 33]); o.z = pk2(s[4 * 33], s[5 * 33]); o.w = pk2(s[6 * 33], s[7 * 33]);
        *(u32x4*)(dst + (size_t)n * K + k0 + 8 * c) = o; }
    LDS_WAIT(); asm volatile("" ::: "memory");
}
__device__ __forceinline__ void ln_row(const float* in, float* outf, bf16_t* outb, const float* g, const float* b, int lane) {
    const f32x4* xr = (const f32x4*)in + lane;
    f32x4 v[4]; float s = 0.f;
#pragma unroll
    for (int j = 0; j < 4; ++j) { v[j] = xr[64 * j]; s += (v[j].x + v[j].y) + (v[j].z + v[j].w); }
    const float mean = wave_sum(s) * (1.f / D); float s2 = 0.f;
#pragma unroll
    for (int j = 0; j < 4; ++j) { v[j] = v[j] - mean; s2 += (v[j].x * v[j].x + v[j].y * v[j].y) + (v[j].z * v[j].z + v[j].w * v[j].w); }
    const float rstd = rsqrtf(wave_sum(s2) * (1.f / D) + LN_EPS);
#pragma unroll
    for (int j = 0; j < 4; ++j) {
        const int c = (64 * j + lane) * 4;
        const f32x4 o = v[j] * rstd * *(const f32x4*)(g + c) + *(const f32x4*)(b + c);
        *((f32x4*)outf + 64 * j + lane) = o;
        *(unsigned long long*)(outb + c) = (unsigned long long)pk2(o.x, o.y) | ((unsigned long long)pk2(o.z, o.w) << 32);
    }
}


__device__ __forceinline__ void cvt_item_ln(const float* W, int K, int N, int k0, int n0, bf16_t* dst, LAS float* scr, int lane, const float* g, const float* b, float* csp, float* cbp) {
    float cs = 0.f, cb = 0.f;
#pragma unroll
    for (int i = 0; i < 32; ++i) { const int kk = 2 * i + (lane >> 5), n = n0 + (lane & 31); const float w = n < N ? W[(size_t)(k0 + kk) * N + n] : 0.f; const float wg = w * g[k0 + kk];
        scr[kk * 33 + (lane & 31)] = wg; cs += bf2f(f2bf(wg)); cb += b[k0 + kk] * w; }
    cs += __shfl_xor(cs, 32); cb += __shfl_xor(cb, 32);
    if (lane < 32) { csp[lane] = cs; cbp[lane] = cb; }
    LDS_WAIT(); asm volatile("" ::: "memory");
    const int c = lane & 7;
#pragma unroll
    for (int j = 0; j < 4; ++j) { const int n = (lane >> 3) + 8 * j; const LAS float* s = scr + (8 * c) * 33 + n;
        u32x4 o; o.x = pk2(s[0 * 33], s[1 * 33]); o.y = pk2(s[2 * 33], s[3 * 33]); o.z = pk2(s[4 * 33], s[5 * 33]); o.w = pk2(s[6 * 33], s[7 * 33]);
        *(u32x4*)(dst + (size_t)n * K + k0 + 8 * c) = o; }
    LDS_WAIT(); asm volatile("" ::: "memory");
}
__device__ __forceinline__ void x_row(const float* in, bf16_t* outb, float* mur, int lane) {
    const f32x4* xr = (const f32x4*)in + lane;
    f32x4 v[4]; float s = 0.f;
#pragma unroll
    for (int j = 0; j < 4; ++j) { v[j] = xr[64 * j]; s += (v[j].x + v[j].y) + (v[j].z + v[j].w);
        *(unsigned long long*)(outb + (64 * j + lane) * 4) = (unsigned long long)pk2(v[j].x, v[j].y) | ((unsigned long long)pk2(v[j].z, v[j].w) << 32); }
    const float mean = wave_sum(s) * (1.f / D); float s2 = 0.f;
#pragma unroll
    for (int j = 0; j < 4; ++j) { const f32x4 d = v[j] - mean; s2 += (d.x * d.x + d.y * d.y) + (d.z * d.z + d.w * d.w); }
    const float rstd = rsqrtf(wave_sum(s2) * (1.f / D) + LN_EPS);
    if (lane == 0) { mur[0] = mean; mur[1] = rstd; }
}
__device__ __forceinline__ void ln_row_f32(float* io, const float* g, const float* b, int lane) {
    f32x4* xr = (f32x4*)io + lane;
    f32x4 v[4]; float s = 0.f;
#pragma unroll
    for (int j = 0; j < 4; ++j) { v[j] = xr[64 * j]; s += (v[j].x + v[j].y) + (v[j].z + v[j].w); }
    const float mean = wave_sum(s) * (1.f / D); float s2 = 0.f;
#pragma unroll
    for (int j = 0; j < 4; ++j) { v[j] = v[j] - mean; s2 += (v[j].x * v[j].x + v[j].y * v[j].y) + (v[j].z * v[j].z + v[j].w * v[j].w); }
    const float rstd = rsqrtf(wave_sum(s2) * (1.f / D) + LN_EPS);
#pragma unroll
    for (int j = 0; j < 4; ++j) { const int c = (64 * j + lane) * 4; xr[64 * j] = v[j] * rstd * *(const f32x4*)(g + c) + *(const f32x4*)(b + c); }
}

__device__ __forceinline__ void alow_rows(const bf16_t* YB, const bf16_t* Wal, const float* MUR, const float* cs, const float* cb, bf16_t* ALOW, int gw, int NGW, int lane) {
    typedef short bf16x8_t __attribute__((ext_vector_type(8)));
    typedef unsigned u32x2_t __attribute__((ext_vector_type(2)));
    const int i = lane & 15, kg = lane >> 4;
    for (int rb = gw; rb < M / 16; rb += NGW) {
        const bf16_t* ap = YB + (size_t)(rb * 16 + i) * 1024 + 8 * kg; const bf16_t* wp = Wal + (size_t)i * 1024 + 8 * kg;
        f32x4 acc0 = (f32x4){0.f, 0.f, 0.f, 0.f}, acc1 = acc0;
#pragma unroll
        for (int s0 = 0; s0 < 32; s0 += 8) { bf16x8_t af[8], wf[8];
#pragma unroll
            for (int s = 0; s < 8; ++s) { af[s] = *(const bf16x8_t*)(ap + 32 * (s0 + s)); wf[s] = *(const bf16x8_t*)(wp + 32 * (s0 + s)); }
#pragma unroll
            for (int s = 0; s < 8; s += 2) { acc0 = __builtin_amdgcn_mfma_f32_16x16x32_bf16(wf[s], af[s], acc0, 0, 0, 0); acc1 = __builtin_amdgcn_mfma_f32_16x16x32_bf16(wf[s + 1], af[s + 1], acc1, 0, 0, 0); } }
        const float mu = MUR[2 * (size_t)(rb * 16 + i)], rs = MUR[2 * (size_t)(rb * 16 + i) + 1];
        const f32x4 c4 = *(const f32x4*)(cs + 4 * kg), b4 = *(const f32x4*)(cb + 4 * kg);
        const f32x4 z = ((acc0 + acc1) - c4 * mu) * rs + b4;
        u32x2_t w; w.x = pk2(z[0], z[1]); w.y = pk2(z[2], z[3]);
        *(u32x2_t*)(ALOW + (size_t)(rb * 16 + i) * 16 + 4 * kg) = w;
    }
}
#define XB_TMO      128
#define XB_XCNT(j)  (256  + 64 * (j))
#define XB_XSUB(j)  (1280 + 64 * (j))
#define XB_XGEN(j)  (2304 + 64 * (j))
#define XB_TOP      3328
#define XB_TOPGEN   3392
#define XCD_BAR_WORDS 3456
#define XB_SPIN_CAP (1u << 18)

__device__ __forceinline__ unsigned xb_ld(unsigned* p)              { return __hip_atomic_load(p, __ATOMIC_RELAXED, __HIP_MEMORY_SCOPE_AGENT); }
__device__ __forceinline__ unsigned xb_add(unsigned* p, unsigned v) { return __hip_atomic_fetch_add(p, v, __ATOMIC_RELAXED, __HIP_MEMORY_SCOPE_AGENT); }
__device__ __forceinline__ unsigned xb_xcc_id() { return (unsigned)__builtin_amdgcn_s_getreg((3 << 11) | 20) & 0xFu; }
#define XB_SPIN(cond, bar) do { unsigned _sp = 0; while (cond) { __builtin_amdgcn_s_sleep(1); \
    if ((++_sp & 255u) == 0u) { if (xb_ld(&(bar)[XB_TMO])) break; if (_sp > XB_SPIN_CAP) { atomicAdd(&(bar)[XB_TMO], 1u); break; } } } } while (0)

struct XcdBarrier {
    unsigned* bar; unsigned x;
    volatile LAS unsigned* st;
};

__device__ __forceinline__ XcdBarrier xcd_barrier_post(unsigned* bar, volatile LAS unsigned* st) {
    XcdBarrier b; b.bar = bar; b.x = xb_xcc_id(); b.st = st;
    if (threadIdx.x == 0) (void)xb_add(&bar[XB_XCNT(b.x)], 1u);
    return b;
}
__device__ __forceinline__ void xcd_barrier_complete(unsigned* bar, unsigned x, unsigned& nloc, unsigned& nx) {
    const unsigned G = gridDim.x * gridDim.y * gridDim.z;
    unsigned sum, cnt, mine, sp = 0u;
    for (;;) {
        sum = 0u; cnt = 0u; mine = 0u;
#pragma unroll
        for (unsigned j = 0; j < 16; ++j) { const unsigned c = xb_ld(&bar[XB_XCNT(j)]); sum += c; cnt += (c > 0u) ? 1u : 0u; mine = (j == x) ? c : mine; }
        if (sum == G) break;
        __builtin_amdgcn_s_sleep(1);
        if ((++sp & 255u) == 0u) { if (xb_ld(&bar[XB_TMO])) break; if (sp > XB_SPIN_CAP) { atomicAdd(&bar[XB_TMO], 1u); break; } }
    }
    nloc = mine > 0u ? mine : 1u; nx = cnt > 0u ? cnt : 1u;
}

__device__ __forceinline__ void xcd_barrier(const XcdBarrier& b) {
    asm volatile("s_waitcnt vmcnt(0)" ::: "memory");
    __syncthreads();
    if (threadIdx.x == 0) {
        unsigned* bar = b.bar;
        __builtin_amdgcn_s_waitcnt(0);
        unsigned nloc = b.st[0], nx = b.st[1];
        if (nloc == 0u) { xcd_barrier_complete(bar, b.x, nloc, nx); b.st[0] = nloc; b.st[1] = nx; }
        const unsigned old = xb_add(&bar[XB_XSUB(b.x)], 1u);
        const unsigned gen = old / nloc;
        if (old + 1u == (gen + 1u) * nloc) {
            __builtin_amdgcn_fence(__ATOMIC_RELEASE, "agent");
            asm volatile("s_waitcnt vmcnt(0)" ::: "memory");
            const unsigned og = xb_add(&bar[XB_TOP], 1u);
            const unsigned tg = og / nx;
            if (og + 1u == (tg + 1u) * nx) xb_add(&bar[XB_TOPGEN], 1u);
            else XB_SPIN(xb_ld(&bar[XB_TOPGEN]) == tg, bar);
            __builtin_amdgcn_fence(__ATOMIC_ACQUIRE, "agent");
            xb_add(&bar[XB_XGEN(b.x)], 1u);
            asm volatile("s_waitcnt vmcnt(0)" ::: "memory");
        } else {
            XB_SPIN(xb_ld(&bar[XB_XGEN(b.x)]) == gen, bar);
            __builtin_amdgcn_fence(__ATOMIC_ACQUIRE, "agent");
            asm volatile("s_waitcnt vmcnt(0)" ::: "memory");
        }
    }
    __syncthreads();
}

template <bool REL, bool ACQ> __device__ __forceinline__ void xcd_barrier_v(const XcdBarrier& b) {
    asm volatile("s_waitcnt vmcnt(0)" ::: "memory");
    __syncthreads();
    if (threadIdx.x == 0) {
        unsigned* bar = b.bar;
        __builtin_amdgcn_s_waitcnt(0);
        unsigned nloc = b.st[0], nx = b.st[1];
        if (nloc == 0u) { xcd_barrier_complete(bar, b.x, nloc, nx); b.st[0] = nloc; b.st[1] = nx; }
        const unsigned old = xb_add(&bar[XB_XSUB(b.x)], 1u);
        const unsigned gen = old / nloc;
        if (old + 1u == (gen + 1u) * nloc) {
            if (REL) __builtin_amdgcn_fence(__ATOMIC_RELEASE, "agent");
            asm volatile("s_waitcnt vmcnt(0)" ::: "memory");
            const unsigned og = xb_add(&bar[XB_TOP], 1u);
            const unsigned tg = og / nx;
            if (og + 1u == (tg + 1u) * nx) xb_add(&bar[XB_TOPGEN], 1u);
            else XB_SPIN(xb_ld(&bar[XB_TOPGEN]) == tg, bar);
            if (ACQ) __builtin_amdgcn_fence(__ATOMIC_ACQUIRE, "agent");
            xb_add(&bar[XB_XGEN(b.x)], 1u);
            asm volatile("s_waitcnt vmcnt(0)" ::: "memory");
        } else {
            XB_SPIN(xb_ld(&bar[XB_XGEN(b.x)]) == gen, bar);
            if (ACQ) __builtin_amdgcn_fence(__ATOMIC_ACQUIRE, "agent");
            asm volatile("s_waitcnt vmcnt(0)" ::: "memory");
        }
    }
    __syncthreads();
}
typedef short bf16x8_t __attribute__((ext_vector_type(8)));
typedef unsigned u32x2_t __attribute__((ext_vector_type(2)));
__device__ __forceinline__ unsigned cvtpk(float lo, float hi) { unsigned r; asm volatile("v_cvt_pk_bf16_f32 %0, %1, %2" : "=v"(r) : "v"(lo), "v"(hi)); return r; }
__device__ __forceinline__ void att_stage(LAS unsigned char* lds, const bf16_t* src, int pitch, int tid) {
    const int r0 = tid >> 5, ch = tid & 31;
    const bf16_t* g0 = src + (size_t)r0 * pitch + ch * 8;
    LAS unsigned char* l0 = lds + r0 * 512 + ((ch ^ r0) << 4);
    u32x4 v[16];
#pragma unroll
    for (int x = 0; x < 16; ++x) v[x] = *(const u32x4*)(g0 + (size_t)(16 * x) * pitch);
#pragma unroll
    for (int x = 0; x < 16; ++x) *(LAS u32x4*)(l0 + x * 8192) = v[x];
}
__device__ __forceinline__ void att_phase(LAS unsigned char* lds, const bf16_t* Kl, const bf16_t* Vl, const bf16_t* Qb, bf16_t* Ob, int G, int tid) {
    for (int u = blockIdx.x; u < (M / 256) * 4; u += G) {
        asm volatile("" : "+v"(tid));
        const int lane = tid & 63, wave = __builtin_amdgcn_readfirstlane(tid >> 6), j = lane & 15, kg = lane >> 4;
        const int h = u & 3, pm = u >> 2, b = pm >> 5;
        att_stage(lds, Kl + (size_t)(b * 256) * 4096 + h * 256, 4096, tid);
        const bf16_t* qrow = Qb + (size_t)(pm * 256 + 16 * wave + j) * 1024 + h * 256;
        bf16_t* orow = Ob + (size_t)(pm * 256 + 16 * wave + j) * 1024 + h * 256;
        __syncthreads();
        const LAS unsigned char* fbase = lds + j * 512;
        const float cs = 0.0625f * 1.4426950408889634f;
        bf16x8_t pf[2][8]; float inv[2];
#pragma unroll
        for (int hf = 0; hf < 2; ++hf) {
            bf16x8_t qf[8];
#pragma unroll
            for (int s = 0; s < 8; ++s) qf[s] = *(const bf16x8_t*)(qrow + (size_t)hf * 128 * 1024 + 32 * s + 8 * kg);
            f32x4 acc[16];
#pragma unroll
            for (int kb = 0; kb < 16; ++kb) acc[kb] = (f32x4){0.f, 0.f, 0.f, 0.f};
#pragma unroll
            for (int s = 0; s < 8; ++s)
#pragma unroll
                for (int kb = 0; kb < 16; ++kb) { const bf16x8_t af = *(const LAS bf16x8_t*)(fbase + kb * 8192 + (((4 * s + kg) ^ j) << 4));
                    acc[kb] = __builtin_amdgcn_mfma_f32_16x16x32_bf16(af, qf[s], acc[kb], 0, 0, 0); }
            float mx = acc[0][0];
#pragma unroll
            for (int kb = 0; kb < 16; ++kb) mx = fmaxf(fmaxf(mx, fmaxf(acc[kb][0], acc[kb][1])), fmaxf(acc[kb][2], acc[kb][3]));
            mx = fmaxf(mx, __shfl_xor(mx, 16)); mx = fmaxf(mx, __shfl_xor(mx, 32));
            const float mxc = mx * cs; float sum = 0.f;
#pragma unroll
            for (int t = 0; t < 8; ++t) { f32x4 p0, p1;
#pragma unroll
                for (int e = 0; e < 4; ++e) { p0[e] = __builtin_amdgcn_exp2f(acc[2 * t][e] * cs - mxc); p1[e] = __builtin_amdgcn_exp2f(acc[2 * t + 1][e] * cs - mxc); }
                sum += (p0[0] + p0[1]) + (p0[2] + p0[3]) + (p1[0] + p1[1]) + (p1[2] + p1[3]);
                u32x4 w; w.x = cvtpk(p0[0], p0[1]); w.y = cvtpk(p0[2], p0[3]); w.z = cvtpk(p1[0], p1[1]); w.w = cvtpk(p1[2], p1[3]); pf[hf][t] = __builtin_bit_cast(bf16x8_t, w); }
            sum += __shfl_xor(sum, 16); sum += __shfl_xor(sum, 32);
            inv[hf] = 1.f / sum;
            __builtin_amdgcn_sched_barrier(0);
        }
        __syncthreads();
        att_stage(lds, Vl + (size_t)(h * 256) * 1024 + b * 256, 1024, tid);
        __syncthreads();
#pragma unroll
        for (int db = 0; db < 16; ++db) {
            f32x4 o0 = (f32x4){0.f, 0.f, 0.f, 0.f}, o1 = o0;
#pragma unroll
            for (int t = 0; t < 8; ++t) { const bf16x8_t af = *(const LAS bf16x8_t*)(fbase + db * 8192 + (((4 * t + kg) ^ j) << 4));
                o0 = __builtin_amdgcn_mfma_f32_16x16x32_bf16(af, pf[0][t], o0, 0, 0, 0); o1 = __builtin_amdgcn_mfma_f32_16x16x32_bf16(af, pf[1][t], o1, 0, 0, 0); }
            u32x2_t w; w.x = cvtpk(o0[0] * inv[0], o0[1] * inv[0]); w.y = cvtpk(o0[2] * inv[0], o0[3] * inv[0]);
            *(u32x2_t*)(orow + 16 * db + 4 * kg) = w;
            w.x = cvtpk(o1[0] * inv[1], o1[1] * inv[1]); w.y = cvtpk(o1[2] * inv[1], o1[3] * inv[1]);
            *(u32x2_t*)(orow + (size_t)128 * 1024 + 16 * db + 4 * kg) = w;
        }
        __syncthreads();
    }
}

__device__ __forceinline__ void conv_phase(LAS unsigned char* lds, const bf16_t* PROJ, const float* cw, const float* cb, const float* lg, const float* lb, bf16_t* MIXIN, int G, int tid) {
    LAS float* U = (LAS float*)lds;
    for (int u = blockIdx.x; u < M / 32; u += G) {
        asm volatile("" : "+v"(tid));
        const int lane = tid & 63, wave = __builtin_amdgcn_readfirstlane(tid >> 6);
        const int row0 = u * 32, t0 = row0 % SEQ;
        const int c = tid;
        float w[31];
#pragma unroll
        for (int k = 0; k < 31; ++k) w[k] = cw[k * 512 + c];
        const float bias = cb[c];
#pragma unroll
        for (int pass = 0; pass < 8; ++pass) { const int rr = pass * 8 + wave;
            if (rr < 62) { f32x4 o0 = (f32x4){0.f, 0.f, 0.f, 0.f}, o1 = o0;
                if (t0 - 30 + rr >= 0) { const u32x4 a = *(const u32x4*)(PROJ + (size_t)(row0 - 30 + rr) * PROJ_LD + 8 * lane);
                    o0 = (f32x4){__uint_as_float(a[0] << 16), __uint_as_float(a[0] & 0xffff0000u), __uint_as_float(a[1] << 16), __uint_as_float(a[1] & 0xffff0000u)};
                    o1 = (f32x4){__uint_as_float(a[2] << 16), __uint_as_float(a[2] & 0xffff0000u), __uint_as_float(a[3] << 16), __uint_as_float(a[3] & 0xffff0000u)}; }
                *(LAS f32x4*)(U + rr * 512 + 8 * lane) = o0; *(LAS f32x4*)(U + rr * 512 + 8 * lane + 4) = o1; } }
        __syncthreads();
        float y[32];
#pragma unroll
        for (int blk = 0; blk < 4; ++blk) { float win[38];
#pragma unroll
            for (int x = 0; x < 38; ++x) win[x] = U[(8 * blk + x) * 512 + c];
#pragma unroll
            for (int o = 0; o < 8; ++o) { float acc = bias;
#pragma unroll
                for (int k = 0; k < 31; ++k) acc += w[k] * win[o + k];
                y[8 * blk + o] = acc; } }
        __syncthreads();
#pragma unroll
        for (int tt = 0; tt < 32; ++tt) U[tt * 512 + c] = y[tt];
        __syncthreads();
#pragma unroll
        for (int q = 0; q < 4; ++q) { const int tt = 4 * wave + q;
            f32x4 a = *(const LAS f32x4*)(U + tt * 512 + 8 * lane), b = *(const LAS f32x4*)(U + tt * 512 + 8 * lane + 4);
            const float mean = wave_sum((a[0] + a[1]) + (a[2] + a[3]) + (b[0] + b[1]) + (b[2] + b[3])) * (1.f / 512.f);
            a = a - mean; b = b - mean;
            const float var = wave_sum((a[0] * a[0] + a[1] * a[1]) + (a[2] * a[2] + a[3] * a[3]) + (b[0] * b[0] + b[1] * b[1]) + (b[2] * b[2] + b[3] * b[3])) * (1.f / 512.f);
            const float rstd = rsqrtf(var + LN_EPS);
            a = a * rstd * *(const f32x4*)(lg + 8 * lane) + *(const f32x4*)(lb + 8 * lane); b = b * rstd * *(const f32x4*)(lg + 8 * lane + 4) + *(const f32x4*)(lb + 8 * lane + 4);
#pragma unroll
            for (int x = 0; x < 4; ++x) { a[x] = pg8::silu_fast(a[x]); b[x] = pg8::silu_fast(b[x]); }
            *(u32x4*)(MIXIN + (size_t)(row0 + tt) * D + 8 * lane) = pg8::pack8(a, b); }
        __syncthreads();
    }
}

typedef float f32x16_t __attribute__((ext_vector_type(16)));
constexpr int GP = 72;
__device__ __forceinline__ int slot32(int c) { const int w = c & 15; return (c & ~15) + 8 * ((w >> 2) & 1) + (w & 3) + 4 * (w >> 3); }
#define GLA_BAR() do { asm volatile("s_waitcnt lgkmcnt(0)" ::: "memory"); __builtin_amdgcn_s_barrier(); asm volatile("" ::: "memory"); } while (0)
__device__ __forceinline__ void gla_bcum(const u32x4 a0, const u32x4 a1, const float* wa2, const float* ba, int h, int lane, int wave, float (&bc)[8], float (&bl)[8]) {
    float al[16];
#pragma unroll
    for (int x = 0; x < 4; ++x) { al[2 * x] = __uint_as_float(a0[x] << 16); al[2 * x + 1] = __uint_as_float(a0[x] & 0xffff0000u); al[8 + 2 * x] = __uint_as_float(a1[x] << 16); al[8 + 2 * x + 1] = __uint_as_float(a1[x] & 0xffff0000u); }
#pragma unroll
    for (int x = 0; x < 8; ++x) { const int col = h * 64 + 8 * wave + x; float z = ba[col];
#pragma unroll
        for (int i = 0; i < 16; ++i) z += al[i] * wa2[i * 256 + col];
        float la = (fminf(z, 0.f) - __logf(1.f + __expf(-fabsf(z)))) * (1.f / 16.f);
        la += __builtin_bit_cast(float, __builtin_amdgcn_update_dpp(0, __builtin_bit_cast(int, la), 0x111, 0xf, 0xf, true));
        la += __builtin_bit_cast(float, __builtin_amdgcn_update_dpp(0, __builtin_bit_cast(int, la), 0x112, 0xf, 0xf, true));
        la += __builtin_bit_cast(float, __builtin_amdgcn_update_dpp(0, __builtin_bit_cast(int, la), 0x114, 0xf, 0xf, true));
        la += __builtin_bit_cast(float, __builtin_amdgcn_update_dpp(0, __builtin_bit_cast(int, la), 0x118, 0xf, 0xf, true));
        const float t0 = __builtin_bit_cast(float, __builtin_amdgcn_readlane(__builtin_bit_cast(int, la), 15)), t1 = __builtin_bit_cast(float, __builtin_amdgcn_readlane(__builtin_bit_cast(int, la), 31)),
                    t2 = __builtin_bit_cast(float, __builtin_amdgcn_readlane(__builtin_bit_cast(int, la), 47)), t3 = __builtin_bit_cast(float, __builtin_amdgcn_readlane(__builtin_bit_cast(int, la), 63));
        la += (lane >= 48) ? (t0 + t1) + t2 : (lane >= 32) ? t0 + t1 : (lane >= 16) ? t0 : 0.f;
        bc[x] = la; bl[x] = ((t0 + t1) + t2) + t3; }
}
__device__ __forceinline__ void unpack8(const u32x4 v, float (&f)[8]) {
#pragma unroll
    for (int x = 0; x < 4; ++x) { f[2 * x] = __uint_as_float(v[x] << 16); f[2 * x + 1] = __uint_as_float(v[x] & 0xffff0000u); }
}
struct G1In { u32x4 a0, a1, k, v0, v1; };
__device__ __forceinline__ G1In g1_load(const bf16_t* PROJ, const bf16_t* ALOW, int u, int lane, int wave) {
    const int bh = u >> 7, n = u & 127, b = bh >> 2, h = bh & 3, row0 = b * SEQ + n * 64;
    const bf16_t* pr = PROJ + (size_t)(row0 + lane) * PROJ_LD; const bf16_t* al = ALOW + (size_t)(row0 + lane) * 16;
    G1In r; r.a0 = *(const u32x4*)al; r.a1 = *(const u32x4*)(al + 8); r.k = *(const u32x4*)(pr + C_K + h * 64 + 8 * wave);
    r.v0 = *(const u32x4*)(pr + C_V + h * 128 + 8 * wave); r.v1 = *(const u32x4*)(pr + C_V + h * 128 + 64 + 8 * wave); return r;
}
__device__ __forceinline__ void gla_g1_phase(LAS unsigned char* lds, const bf16_t* PROJ, const bf16_t* ALOW, const float* wa2, const float* ba, float* UPD, float* DEC, int G, int tid) {
    LAS bf16_t* KD = (LAS bf16_t*)lds; LAS bf16_t* VT = (LAS bf16_t*)(lds + 18432);
    const int lane = tid & 63, wave = __builtin_amdgcn_readfirstlane(tid >> 6);
    G1In cur; if ((int)blockIdx.x < 2048) cur = g1_load(PROJ, ALOW, blockIdx.x, lane, wave);
    for (int u = blockIdx.x; u < 2048; u += G) {
        G1In nxt; if (u + G < 2048) nxt = g1_load(PROJ, ALOW, u + G, lane, wave);
        const int bh = u >> 7, h = bh & 3;
        float bc[8], bl[8];
        gla_bcum(cur.a0, cur.a1, wa2, ba, h, lane, wave, bc, bl);
        float kf[8]; unpack8(cur.k, kf);
#pragma unroll
        for (int x = 0; x < 8; ++x) KD[(8 * wave + x) * GP + lane] = f2bf(kf[x] * __expf(bl[x] - bc[x]));
        if (lane == 63) {
#pragma unroll
            for (int x = 0; x < 8; ++x) DEC[u * 64 + 8 * wave + x] = __expf(bl[x]); }
#pragma unroll
        for (int pc = 0; pc < 2; ++pc) { const int e0 = 64 * pc + 8 * wave; const u32x4 v = pc ? cur.v1 : cur.v0;
#pragma unroll
            for (int x = 0; x < 4; ++x) { VT[(e0 + 2 * x) * GP + lane] = (bf16_t)(v[x] & 0xffffu); VT[(e0 + 2 * x + 1) * GP + lane] = (bf16_t)(v[x] >> 16); } }
        GLA_BAR();
        const int eb = wave >> 1, dbk = wave & 1, i = lane & 31, kg = lane >> 5;
        f32x16_t acc;
#pragma unroll
        for (int r = 0; r < 16; ++r) acc[r] = 0.f;
#pragma unroll
        for (int s = 0; s < 4; ++s) { const bf16x8_t af = *(const LAS bf16x8_t*)(VT + (32 * eb + i) * GP + 16 * s + 8 * kg), bfr = *(const LAS bf16x8_t*)(KD + (32 * dbk + i) * GP + 16 * s + 8 * kg);
            acc = __builtin_amdgcn_mfma_f32_32x32x16_bf16(af, bfr, acc, 0, 0, 0); }
        float* up = UPD + ((size_t)u * 128 + 32 * eb + 4 * kg) * 64 + 32 * dbk + i;
#pragma unroll
        for (int r = 0; r < 16; ++r) up[((r & 3) + 8 * (r >> 2)) * 64] = acc[r];
        GLA_BAR();
        cur = nxt;
    }
}
__device__ __forceinline__ void gla_g2_phase(const float* UPD, bf16_t* SP, const float* DEC, int G, int tid) {
    for (int g = blockIdx.x * 512 + tid; g < 16 * 8192; g += G * 512) {
        const int bh = g >> 13, ed = g & 8191, d = g & 63;
        const float* p = UPD + (size_t)bh * 128 * 8192 + ed; bf16_t* po = SP + (size_t)bh * 128 * 8192 + ed; const float* dc = DEC + bh * 128 * 64 + d;
        float S = 0.f;
        for (int n0 = 0; n0 < 128; n0 += 16) { float uu[16], dd[16];
#pragma unroll
            for (int x = 0; x < 16; ++x) { uu[x] = p[(size_t)(n0 + x) * 8192]; dd[x] = dc[(n0 + x) * 64]; }
#pragma unroll
            for (int x = 0; x < 16; ++x) { po[(size_t)(n0 + x) * 8192] = f2bf(S); S = dd[x] * S + uu[x]; } }
    }
}
struct G3In { u32x4 a0, a1, q, k, v0, v1; bf16x8_t sp[4]; u32x2_t rr[4]; };
__device__ __forceinline__ G3In g3_load(const bf16_t* PROJ, const bf16_t* ALOW, const bf16_t* SPV, int u, int lane, int wave) {
    const int bh = u >> 7, n = u & 127, b = bh >> 2, h = bh & 3, row0 = b * SEQ + n * 64;
    const int eb = wave >> 1, cb = wave & 1, i = lane & 31, kg = lane >> 5;
    const bf16_t* pr = PROJ + (size_t)(row0 + lane) * PROJ_LD; const bf16_t* al = ALOW + (size_t)(row0 + lane) * 16;
    G3In r; r.a0 = *(const u32x4*)al; r.a1 = *(const u32x4*)(al + 8); r.q = *(const u32x4*)(pr + C_Q + h * 64 + 8 * wave); r.k = *(const u32x4*)(pr + C_K + h * 64 + 8 * wave);
    r.v0 = *(const u32x4*)(pr + C_V + h * 128 + 8 * wave); r.v1 = *(const u32x4*)(pr + C_V + h * 128 + 64 + 8 * wave);
    const bf16_t* sp = SPV + ((size_t)u * 128 + 32 * eb + i) * 64 + 8 * kg;
#pragma unroll
    for (int s = 0; s < 4; ++s) r.sp[s] = *(const bf16x8_t*)(sp + 16 * s);
    const bf16_t* rp = PROJ + (size_t)(row0 + 32 * cb + i) * PROJ_LD + C_R + h * 128 + 32 * eb + 4 * kg;
#pragma unroll
    for (int rg = 0; rg < 4; ++rg) r.rr[rg] = *(const u32x2_t*)(rp + 8 * rg);
    return r;
}
__device__ __forceinline__ void gla_g3_phase(LAS unsigned char* lds, const bf16_t* PROJ, const bf16_t* ALOW, const float* wa2, const float* ba, const float* gn, const bf16_t* UPD, bf16_t* MIXIN, int G, int tid) {
    LAS bf16_t* KE = (LAS bf16_t*)lds; LAS bf16_t* QE = (LAS bf16_t*)(lds + 9216); LAS bf16_t* VT = (LAS bf16_t*)(lds + 18432); LAS float* RED = (LAS float*)(lds + 36864);
    const int lane = tid & 63, wave = __builtin_amdgcn_readfirstlane(tid >> 6);
    const int eb = wave >> 1, cb = wave & 1, i = lane & 31, kg = lane >> 5;
    G3In cur; if ((int)blockIdx.x < 2048) cur = g3_load(PROJ, ALOW, UPD, blockIdx.x, lane, wave);
    for (int u = blockIdx.x; u < 2048; u += G) {
        G3In nxt; if (u + G < 2048) nxt = g3_load(PROJ, ALOW, UPD, u + G, lane, wave);
        const int bh = u >> 7, n = u & 127, b = bh >> 2, h = bh & 3, row0 = b * SEQ + n * 64;
        const size_t row = (size_t)(row0 + 32 * cb + i);
        { float bc[8], bl[8];
          gla_bcum(cur.a0, cur.a1, wa2, ba, h, lane, wave, bc, bl);
          float qf[8], kf[8]; unpack8(cur.q, qf); unpack8(cur.k, kf);
          f32x4 q0, q1, k0, k1;
#pragma unroll
          for (int x = 0; x < 4; ++x) { q0[x] = qf[x] * 0.125f * __expf(bc[x]); q1[x] = qf[4 + x] * 0.125f * __expf(bc[4 + x]); k0[x] = kf[x] * __expf(-bc[x]); k1[x] = kf[4 + x] * __expf(-bc[4 + x]); }
          *(LAS u32x4*)(QE + lane * GP + 8 * wave) = pg8::pack8(q0, q1); *(LAS u32x4*)(KE + lane * GP + 8 * wave) = pg8::pack8(k0, k1);
          const int pcol = slot32(lane);
#pragma unroll
          for (int pc = 0; pc < 2; ++pc) { const int e0 = 64 * pc + 8 * wave; const u32x4 v = pc ? cur.v1 : cur.v0;
#pragma unroll
              for (int x = 0; x < 4; ++x) { VT[(e0 + 2 * x) * GP + pcol] = (bf16_t)(v[x] & 0xffffu); VT[(e0 + 2 * x + 1) * GP + pcol] = (bf16_t)(v[x] >> 16); } } }
        GLA_BAR();
        bf16x8_t qb[4];
#pragma unroll
        for (int s = 0; s < 4; ++s) qb[s] = *(const LAS bf16x8_t*)(QE + (32 * cb + i) * GP + 16 * s + 8 * kg);
        f32x16_t o;
#pragma unroll
        for (int r = 0; r < 16; ++r) o[r] = 0.f;
#pragma unroll
        for (int sb = 0; sb < 2; ++sb) if (sb <= cb) {
            f32x16_t at;
#pragma unroll
            for (int r = 0; r < 16; ++r) at[r] = 0.f;
#pragma unroll
            for (int s = 0; s < 4; ++s) { const bf16x8_t af = *(const LAS bf16x8_t*)(KE + (32 * sb + i) * GP + 16 * s + 8 * kg); at = __builtin_amdgcn_mfma_f32_32x32x16_bf16(af, qb[s], at, 0, 0, 0); }
            if (sb == cb) {
#pragma unroll
                for (int r = 0; r < 16; ++r) if ((r & 3) + 8 * (r >> 2) + 4 * kg > i) at[r] = 0.f; }
#pragma unroll
            for (int sp = 0; sp < 2; ++sp) { u32x4 w; w.x = cvtpk(at[8 * sp + 0], at[8 * sp + 1]); w.y = cvtpk(at[8 * sp + 2], at[8 * sp + 3]); w.z = cvtpk(at[8 * sp + 4], at[8 * sp + 5]); w.w = cvtpk(at[8 * sp + 6], at[8 * sp + 7]);
                const bf16x8_t af = *(const LAS bf16x8_t*)(VT + (32 * eb + i) * GP + 32 * sb + 16 * sp + 8 * kg);
                o = __builtin_amdgcn_mfma_f32_32x32x16_bf16(af, __builtin_bit_cast(bf16x8_t, w), o, 0, 0, 0); }
        }
#pragma unroll
        for (int s = 0; s < 4; ++s) o = __builtin_amdgcn_mfma_f32_32x32x16_bf16(cur.sp[s], qb[s], o, 0, 0, 0);
        float ss = 0.f;
#pragma unroll
        for (int r = 0; r < 16; ++r) ss += o[r] * o[r];
        ss += __shfl_xor(ss, 32);
        if (kg == 0) RED[eb * 64 + 32 * cb + i] = ss;
        GLA_BAR();
        const float tot = (RED[32 * cb + i] + RED[64 + 32 * cb + i]) + (RED[128 + 32 * cb + i] + RED[192 + 32 * cb + i]);
        const float rstd = rsqrtf(tot * (1.f / 128.f) + LN_EPS);
#pragma unroll
        for (int rg = 0; rg < 4; ++rg) { const int e = 32 * eb + 8 * rg + 4 * kg;
            const f32x4 g4 = *(const f32x4*)(gn + e); const u32x2_t rr = cur.rr[rg];
            const float r0 = __uint_as_float(rr.x << 16), r1 = __uint_as_float(rr.x & 0xffff0000u), r2 = __uint_as_float(rr.y << 16), r3 = __uint_as_float(rr.y & 0xffff0000u);
            u32x2_t w; w.x = cvtpk(o[4 * rg] * rstd * g4[0] * pg8::silu_fast(r0), o[4 * rg + 1] * rstd * g4[1] * pg8::silu_fast(r1));
            w.y = cvtpk(o[4 * rg + 2] * rstd * g4[2] * pg8::silu_fast(r2), o[4 * rg + 3] * rstd * g4[3] * pg8::silu_fast(r3));
            *(u32x2_t*)(MIXIN + row * D + 512 + h * 128 + e) = w; }
        GLA_BAR();
        cur = nxt;
    }
}

#ifndef PROBE_MASK
#define PROBE_MASK 0
#endif
#ifndef ONE_LAUNCH
#define ONE_LAUNCH 1
#endif
constexpr int NPL = 10, NPH = 2 + NPL * DEPTH + 1;
enum { PK_IN = 0, PK_CG1, PK_G2, PK_G3, PK_MIX, PK_Q, PK_ATT, PK_XO, PK_FF1, PK_FF2 };
constexpr int CSN = 9472, CS_IN = 0, CS_Q = 2816, CS_FF1 = 3840;

__global__ void __launch_bounds__(NWAVES * 64) mega(Args a) {
    extern __shared__ __attribute__((aligned(16))) unsigned char lds_raw[];
    LAS unsigned char* lds = (LAS unsigned char*)lds_raw;
    const int wave = __builtin_amdgcn_readfirstlane(threadIdx.x >> 6);
    const int G = gridDim.x, gw = blockIdx.x * NWAVES + wave, NGW = G * NWAVES;
    unsigned char* ws = a.ws;
#define INP(k) ({ int k_ = (k); asm volatile("" : "+s"(k_)); a.in[k_]; })
    float* Y = a.out;
    bf16_t* WT = (bf16_t*)(ws + WS_WT); bf16_t* YB = (bf16_t*)(ws + WS_HB); bf16_t* PROJ = (bf16_t*)(ws + WS_PROJ); bf16_t* ALOW = (bf16_t*)(ws + WS_ALOW);
    bf16_t* MIXIN = (bf16_t*)(ws + WS_MIXIN); bf16_t* Qb = (bf16_t*)(ws + WS_Q); bf16_t* ACT = (bf16_t*)(ws + WS_ACT);
    bf16_t* Kb = (bf16_t*)(ws + WS_K); bf16_t* Vt = (bf16_t*)(ws + WS_VT); bf16_t* MEMB = (bf16_t*)(ws + WS_MEMB); bf16_t* MEMP = (bf16_t*)(ws + WS_MEMP);
    float* UPD = (float*)(ws + WS_UPD); float* DEC = (float*)(ws + WS_DEC);
    float* CSP = (float*)(ws + WS_CSP); float* CS = (float*)(ws + WS_CS); float* MUR = (float*)(ws + WS_MUR);
    unsigned long long* SLOTS = (unsigned long long*)(ws + WS_SLOTS); unsigned* CNT = (unsigned*)(ws + WS_CNT);

    volatile LAS unsigned* bst = (volatile LAS unsigned*)(lds + 143360);
    if (threadIdx.x == 0) { bst[0] = 0u; bst[1] = 0u; }
    __syncthreads();
    XcdBarrier xbar; xbar.bar = (unsigned*)(ws + WS_BAR); xbar.x = 0; xbar.st = bst;
    if (a.ph_hi - a.ph_lo > 1) xbar = xcd_barrier_post((unsigned*)(ws + WS_BAR), bst);
    for (int p = a.ph_lo; p < a.ph_hi; ++p) {
      const int pkind = (p < 2 || p == NPH - 1) ? -1 : (p - 2) % NPL;
      int nrep = 1;
      if ((a.sub & 4) && (pkind == PK_IN || pkind == PK_Q || pkind == PK_FF1)) nrep = 2;
      if ((a.sub & (8 | 8192)) && pkind == PK_CG1) nrep = 2;
      if ((a.sub & 16384) && pkind == PK_G3) nrep = 2;
      if ((a.sub & 16) && pkind == PK_ATT) nrep = 2;
      if ((a.sub & 64) && p < 2) nrep = 2;
      for (int rep = 0; rep < nrep; ++rep) {
        const bool dummy = rep + 1 < nrep;
        int tid; asm volatile("v_mbcnt_lo_u32_b32 %0, -1, 0\n\tv_mbcnt_hi_u32_b32 %0, -1, %0\n\tv_lshl_or_b32 %0, %1, 6, %0" : "=&v"(tid) : "s"(wave));
        const int lane = tid & 63;
        if (p == 0) {
            LAS float* scr = (LAS float*)(lds + wave * 16384);
            if (blockIdx.x == 0) { CNT[tid] = 0u; CNT[512 + tid] = 0u; CNT[1024 + tid] = 0u; }
            for (int it = gw; it < DEPTH * I_LAYER; it += NGW) {
                const int l = it / I_LAYER; int r = it % I_LAYER;
                bf16_t* WL = WT + WT_L0 + (size_t)l * WT_LSTRIDE;
                float* cspl = CSP + (size_t)l * 2 * 16 * CSN;
                if (r < I_IN) { const int kb = r / 81, n0 = 32 * (r % 81); const float* gg = l == 0 ? INP(2) : INP(22) + (l - 1) * D; const float* bb = l == 0 ? INP(3) : INP(23) + (l - 1) * D;
                    const int drow = n0 < 512 ? 256 * (n0 / 128) + n0 % 128 : n0 < 1024 ? 256 * ((n0 - 512) / 128) + 128 + (n0 - 512) % 128 : n0;
                    cvt_item_ln(INP(4) + (size_t)l * 1024 * IN_COLS, 1024, IN_COLS, 64 * kb, n0, WL + WO_IN + (size_t)drow * 1024, scr, lane, gg, bb, cspl + kb * CSN + CS_IN + drow, cspl + (16 + kb) * CSN + CS_IN + drow); continue; } r -= I_IN;
                if (r < I_SQ) { const int kb = r / 32, nb = r % 32; cvt_item(INP(12) + (size_t)l * 1024 * 1024, 1024, 1024, 64 * kb, 32 * nb, WL + WO_MIX + (size_t)(32 * nb) * 1024, scr, lane); continue; } r -= I_SQ;
                if (r < I_SQ) { const int kb = r / 32, nb = r % 32;
                    cvt_item_ln(INP(15) + (size_t)l * 1024 * 1024, 1024, 1024, 64 * kb, 32 * nb, WL + WO_XQ + (size_t)(32 * nb) * 1024, scr, lane, INP(13) + l * D, INP(14) + l * D, cspl + kb * CSN + CS_Q + 32 * nb, cspl + (16 + kb) * CSN + CS_Q + 32 * nb); continue; } r -= I_SQ;
                if (r < I_SQ) { const int kb = r / 32, nb = r % 32; cvt_item(INP(17) + (size_t)l * 1024 * 1024, 1024, 1024, 64 * kb, 32 * nb, WL + WO_XO + (size_t)(32 * nb) * 1024, scr, lane); continue; } r -= I_SQ;
                if (r < I_XKV) { const int kb = r / 64, n0 = 32 * (r % 64);
                    bf16_t* dst = n0 < 1024 ? WT + WT_XK + (size_t)(l * 1024 + n0) * 1024 : WT + WT_XV + (size_t)(l * 1024 + n0 - 1024) * 1024;
                    cvt_item(INP(16) + (size_t)l * 1024 * 2048, 1024, 2048, 64 * kb, n0, dst, scr, lane); continue; } r -= I_XKV;
                if (r < I_FF1) { const int kb = r / 176, n0 = 32 * (r % 176);
                    const int drow = n0 < D_FF ? 256 * (n0 / 128) + n0 % 128 : 256 * ((n0 - D_FF) / 128) + 128 + (n0 - D_FF) % 128;
                    cvt_item_ln(INP(20) + (size_t)l * 1024 * 2 * D_FF, 1024, 2 * D_FF, 64 * kb, n0, WL + WO_FF1 + (size_t)drow * 1024, scr, lane, INP(18) + l * D, INP(19) + l * D, cspl + kb * CSN + CS_FF1 + drow, cspl + (16 + kb) * CSN + CS_FF1 + drow); continue; } r -= I_FF1;
                { const int kb = r / 32, nb = r % 32; cvt_item(INP(21) + (size_t)l * D_FF * 1024, D_FF, 1024, 64 * kb, 32 * nb, WL + WO_FF2 + (size_t)(32 * nb) * D_FF, scr, lane); }
            }
            for (int i = blockIdx.x * 512 + tid; i < 1024 * 1024; i += G * 512) {
                const int row = i >> 10, c = i & 1023, b = row >> 8, key = row & 255; const bf16_t v = f2bf(INP(1)[i]);
                MEMB[i] = v; MEMP[(size_t)(b * 256 + slot_of_key(key)) * 1024 + c] = v; }
            { const float* xin = INP(0);
              for (int m = gw; m < M; m += 2 * NGW) { x_row(xin + (size_t)m * D, YB + (size_t)m * D, MUR + 2 * (size_t)m, lane);
                  if (m + NGW < M) x_row(xin + (size_t)(m + NGW) * D, YB + (size_t)(m + NGW) * D, MUR + 2 * (size_t)(m + NGW), lane); } }
        } else if (p == 1) {
            for (int i = blockIdx.x * 512 + tid; i < DEPTH * 2 * CSN; i += G * 512) { const int lc = i / CSN, c = i % CSN; const float* pp = CSP + (size_t)lc * 16 * CSN + c; float s = 0.f;
#pragma unroll
                for (int kb = 0; kb < 16; ++kb) s += pp[kb * CSN];
                CS[i] = s; }
            const int half = G / 2;
            if ((int)blockIdx.x < half) { pg8::Gemm g{MEMB, WT + WT_XK, 1024, 4096, 1024}; pg8::StaticOrderT<1024, 4096> S; S.init(half, (int)blockIdx.x);
                pg8::EpiBf16 E{Kb, 4096}; pg8::gemm_phase<pg8::EpiBf16, pg8::StaticOrderT<1024, 4096>, true, true, 1024>(lds, g, S, E, tid); }
            else { pg8::Gemm g{WT + WT_XV, MEMP, 4096, 1024, 1024}; pg8::StaticOrderT<4096, 1024> S; S.init(G - half, (int)blockIdx.x - half);
                pg8::EpiBf16 E{Vt, 1024}; pg8::gemm_phase<pg8::EpiBf16, pg8::StaticOrderT<4096, 1024>, true, true, 1024>(lds, g, S, E, tid); }
        } else if (p == NPH - 1) {
            const float* gg = INP(22) + (DEPTH - 1) * D; const float* bb = INP(23) + (DEPTH - 1) * D;
            for (int m = gw; m < M; m += NGW) ln_row_f32(Y + (size_t)m * D, gg, bb, lane);
        } else {
            const int l = (p - 2) / NPL, kind = (p - 2) % NPL;
            const bf16_t* WL = WT + WT_L0 + (size_t)l * WT_LSTRIDE;
            const float* csl = CS + (size_t)l * 2 * CSN; const float* cbl = csl + CSN;
            if (kind == PK_IN) { pg8::Gemm g{YB, WL + WO_IN, M, 2560, 1024}; pg8::StaticOrderT<M, 2560> S; S.init(G, (int)blockIdx.x);
                pg8::EpiInLN E{PROJ, MUR, csl + CS_IN, cbl + CS_IN}; pg8::gemm_phase<pg8::EpiInLN, pg8::StaticOrderT<M, 2560>, true, true, 1024>(lds, g, S, E, tid);
                alow_rows(YB, WL + WO_IN + (size_t)2560 * 1024, MUR, csl + CS_IN + 2560, cbl + CS_IN + 2560, ALOW, gw, NGW, lane); }
            else if (kind == PK_CG1) {
                if ((a.sub & 1) && !(dummy && (a.sub & 8192))) conv_phase(lds, PROJ, INP(7) + l * 31 * 512, INP(8) + l * 512, INP(9) + l * 512, INP(10) + l * 512, MIXIN, G, tid);
                if ((a.sub & 2) && !(dummy && (a.sub & 8))) gla_g1_phase(lds, PROJ, ALOW, INP(5) + l * 16 * 256, INP(6) + l * 256, UPD, DEC, G, tid); }
            else if (kind == PK_G2) { gla_g2_phase(UPD, (bf16_t*)a.out, DEC, G, tid); }
            else if (kind == PK_G3) { gla_g3_phase(lds, PROJ, ALOW, INP(5) + l * 16 * 256, INP(6) + l * 256, INP(11) + l * 128, (const bf16_t*)a.out, MIXIN, G, tid); }
            else if (kind == PK_MIX || kind == PK_XO) {
                const bool mix = kind == PK_MIX;
                pg8::Gemm g{mix ? MIXIN : Qb, WL + (mix ? WO_MIX : WO_XO), M, 1024, 1024}; pg8::StaticOrderT<M, 1024> S; S.init(G, (int)blockIdx.x);
                const float* gp = mix ? (l == 0 ? INP(2) : INP(22) + (l - 1) * D) : INP(13) + l * D; const float* bp = mix ? (l == 0 ? INP(3) : INP(23) + (l - 1) * D) : INP(14) + l * D;
                pg8::EpiResLN E{(mix && l == 0) ? INP(0) : nullptr, nullptr, YB, MUR, gp, bp, SLOTS, CNT + (3 * l + (mix ? 0 : 1)) * 128, ALPHA, lds};
                pg8::gemm_phase<pg8::EpiResLN, pg8::StaticOrderT<M, 1024>, true, true, 1024>(lds, g, S, E, tid); }
            else if (kind == PK_Q) { pg8::Gemm g{YB, WL + WO_XQ, M, 1024, 1024}; pg8::StaticOrderT<M, 1024> S; S.init(G, (int)blockIdx.x);
                pg8::EpiBf16LN E{Qb, 1024, MUR, csl + CS_Q, cbl + CS_Q}; pg8::gemm_phase<pg8::EpiBf16LN, pg8::StaticOrderT<M, 1024>, true, true, 1024>(lds, g, S, E, tid); }
            else if (kind == PK_ATT) { att_phase(lds, Kb + l * 1024, Vt + (size_t)l * 1024 * 1024, Qb, dummy ? MIXIN : Qb, G, tid); }
            else if (kind == PK_FF1) { pg8::Gemm g{YB, WL + WO_FF1, M, 2 * D_FF, 1024}; pg8::StaticOrderT<M, 2 * D_FF> S; S.init(G, (int)blockIdx.x);
                pg8::EpiSwigluLN E{ACT, MUR, csl + CS_FF1, cbl + CS_FF1}; pg8::gemm_phase<pg8::EpiSwigluLN, pg8::StaticOrderT<M, 2 * D_FF>, true, true, 1024>(lds, g, S, E, tid); }
            else { pg8::Gemm g{ACT, WL + WO_FF2, M, 1024, D_FF}; pg8::StaticOrderT<M, 1024> S; S.init(G, (int)blockIdx.x);
                pg8::EpiResLN E{nullptr, l == DEPTH - 1 ? Y : nullptr, YB, MUR, INP(18) + l * D, INP(19) + l * D, SLOTS, CNT + (3 * l + 2) * 128, ALPHA, lds};
                pg8::gemm_phase<pg8::EpiResLN, pg8::StaticOrderT<M, 1024>, true, true, D_FF>(lds, g, S, E, tid); }
        }
      }
        if (p + 1 < a.ph_hi) { if (p == 0) cg::this_grid().sync(); else xcd_barrier(xbar); if (a.sub & 256) xcd_barrier(xbar); if (a.sub & 512) xcd_barrier_v<false, false>(xbar); }
    }
}

#undef INP
extern "C" void kernel_launch(void* const* d_in, const int* in_sizes, int n_in, void* d_out, int out_size, void* d_ws, size_t ws_size, hipStream_t stream) {
    if (n_in != 24 || out_size != M * D || ws_size < WS_END) { fprintf(stderr, "kernel_launch: unexpected shapes (n_in %d out %d ws %zu)\n", n_in, out_size, ws_size); return; }
    static int grid = 0;
    if (grid == 0) {
        int dev = 0, cus = 0, per_cu = 0;
        (void)hipGetDevice(&dev); (void)hipDeviceGetAttribute(&cus, hipDeviceAttributeMultiprocessorCount, dev);
        if (hipFuncSetAttribute((const void*)mega, hipFuncAttributeMaxDynamicSharedMemorySize, LDS_BYTES) != hipSuccess) { fprintf(stderr, "kernel_launch: hipFuncSetAttribute failed\n"); grid = -1; return; }
        if (hipOccupancyMaxActiveBlocksPerMultiprocessor(&per_cu, (const void*)mega, NWAVES * 64, LDS_BYTES) != hipSuccess || per_cu < 1) { fprintf(stderr, "kernel_launch: occupancy query says %d\n", per_cu); per_cu = 1; }
        (void)hipGetLastError();
        grid = cus;
    }
    if (grid < 0) return;
    Args a{};
    for (int i = 0; i < 24; ++i) a.in[i] = (const float*)d_in[i];
    a.out = (float*)d_out; a.ws = (unsigned char*)d_ws;
#if ONE_LAUNCH
    if (hipMemsetAsync((char*)d_ws + WS_BAR, 0, 16384, stream) != hipSuccess) { fprintf(stderr, "kernel_launch: memset of the barrier words failed\n"); return; }
    a.ph_lo = 0; a.ph_hi = NPH; a.sub = 3 | PROBE_MASK;
    void* kargs[] = {&a};
    hipError_t e = hipLaunchCooperativeKernel((const void*)mega, dim3(grid), dim3(NWAVES * 64), kargs, LDS_BYTES, stream);
    if (e != hipSuccess) fprintf(stderr, "kernel_launch: cooperative launch failed: %s\n", hipGetErrorString(e));
#else
    for (int p = 0; p < NPH; ++p) { a.ph_lo = p; a.ph_hi = p + 1; a.sub = 3; hipLaunchKernelGGL(mega, dim3(grid), dim3(NWAVES * 64), LDS_BYTES, stream, a); }
#endif
}
```

```cpp
#include <hip/hip_runtime.h>
#include <hip/hip_cooperative_groups.h>
#include <cstdio>
#include <cstdint>

typedef unsigned short bf16_t;
typedef unsigned u32x4 __attribute__((ext_vector_type(4)));
typedef float f32x4 __attribute__((ext_vector_type(4)));

constexpr int D = 1024, BATCH = 4, SEQ = 8192, DEPTH = 4, M = BATCH * SEQ;
constexpr int IN_COLS = 2576, PROJ_LD = 2560, MEM_LEN = 256, D_FF = 2816;
constexpr int C_CA = 0, C_CG = 512, C_Q = 1024, C_K = 1280, C_V = 1536, C_R = 2048, C_AL = 2560;
constexpr float LN_EPS = 1e-5f;
constexpr float ALPHA = 1.681792830507429f;

constexpr size_t MiB = 1u << 20;
constexpr size_t WS_CTL = 0;
constexpr size_t WS_K = 8 * MiB;
constexpr size_t WS_VT = 16 * MiB;
constexpr size_t WS_MEMB = 24 * MiB;
constexpr size_t WS_MEMP = 26 * MiB;
constexpr size_t WS_ALOW = 28 * MiB;
constexpr size_t WS_DEC = 29 * MiB;
constexpr size_t WS_CNT = 0;
constexpr size_t WS_BAR = 65536;
constexpr size_t WS_CSP = 1 * MiB;
constexpr size_t WS_CS = 6 * MiB;
constexpr size_t WS_SLOTS = 30 * MiB;
constexpr size_t WS_MUR = 31 * MiB;
constexpr size_t WS_WT = 32 * MiB;
constexpr size_t WS_HB = 160 * MiB;
constexpr size_t WS_PROJ = 224 * MiB;
constexpr size_t WS_Q = 224 * MiB;
constexpr size_t WS_ACT = 224 * MiB;
constexpr size_t WS_UPD = 384 * MiB;
constexpr size_t WS_MIXIN = 448 * MiB;
constexpr size_t WS_END = 512 * MiB;

__host__ __device__ __forceinline__ int key_of_slot(int p) { const int e = p & 7, kg = (p >> 3) & 3; return (p & ~31) + 16 * (e >> 2) + 4 * kg + (e & 3); }
__host__ __device__ __forceinline__ int slot_of_key(int k) { const int w = k & 31; return (k & ~31) + 8 * ((w >> 2) & 3) + 4 * (w >> 4) + (w & 3); }

__device__ __forceinline__ float bf2f(bf16_t b) { return __uint_as_float(((unsigned)b) << 16); }
__device__ __forceinline__ bf16_t f2bf(float f) { unsigned u = __float_as_uint(f); return (bf16_t)((u + 0x7fffu + ((u >> 16) & 1u)) >> 16); }
__device__ __forceinline__ float ldf(const float* p) { return *p; }
__device__ __forceinline__ float ldf(const bf16_t* p) { return bf2f(*p); }
__device__ __forceinline__ float sigmoidf_(float x) { return 1.f / (1.f + __expf(-x)); }
__device__ __forceinline__ float siluf_(float x) { return x / (1.f + __expf(-x)); }
__device__ __forceinline__ float wave_sum(float v) {
#pragma unroll
    for (int o = 1; o < 64; o <<= 1) v += __shfl_xor(v, o);
    return v;
}
__device__ __forceinline__ float wave_max(float v) {
#pragma unroll
    for (int o = 1; o < 64; o <<= 1) v = fmaxf(v, __shfl_xor(v, o));
    return v;
}

namespace pg8 {
#define PG8_LAS __attribute__((address_space(3)))
typedef unsigned short bf16_t;
typedef short bf16x8 __attribute__((ext_vector_type(8)));
typedef float f32x4 __attribute__((ext_vector_type(4)));
typedef unsigned u32x4 __attribute__((ext_vector_type(4)));
constexpr int BM = 256, BK = 64, HALF = 128, HTB = HALF * BK * 2  , STAGE_BYTES = 8 * HTB, NXCD = 8, WGM = 8;

__host__ __device__ __forceinline__ int lds_byte(int r, int c) { const int st = (r >> 4) * 2 + (c >> 5), rr = r & 15, cc = c & 31, ob = rr * 64 + cc * 2; return st * 1024 + (ob ^ (((ob >> 9) & 1) << 5)); }
__host__ __device__ __forceinline__ void stage_rc(int b, int& R, int& C) { const int st = b / 1024, sb = b % 1024, swz = sb ^ (((sb >> 9) & 1) << 5); R = (st >> 1) * 16 + swz / 64; C = (st & 1) * 32 + (swz % 64) / 2; }
__host__ __device__ __forceinline__ int perm32(int rho) { const int n = rho >> 4, i = rho & 15; return 8 * (i >> 2) + 4 * n + (i & 3); }

struct Unit { int pm, pn; };
struct Gemm { const bf16_t* A; const bf16_t* Bt; int M, N, K; };

struct StaticOrder {
    int nM, nN, nwg, G, c;
    __host__ __device__ void init(int M, int N, int G_, int c_) { nM = M / BM; nN = N / BM; nwg = nM * nN; G = G_; c = c_; }
    __host__ __device__ bool next(int i, Unit& u) const {
        const long L = (long)i * G + c; if (L >= nwg) return false;
        int wgid = (int)L; { const int q = nwg / NXCD, r = nwg % NXCD, xcd = wgid % NXCD, off = wgid / NXCD; wgid = (xcd < r ? xcd * (q + 1) : r * (q + 1) + (xcd - r) * q) + off; }
        const int nig = WGM * nN, gid = wgid / nig, fm = gid * WGM, gsz = (nM - fm) < WGM ? (nM - fm) : WGM;
        u.pm = fm + ((wgid % nig) % gsz); u.pn = (wgid % nig) / gsz; return true;
    }
    __device__ __forceinline__ void a_ready(const Unit&) const {}
    __device__ __forceinline__ void done(const Unit&) const {}
};


template <int MM, int NN> struct StaticOrderT {
    static constexpr int nM = MM / BM, nN = NN / BM, nwg = nM * nN;
    int G, c;
    __host__ __device__ void init(int G_, int c_) { G = G_; c = c_; }
    __host__ __device__ bool next(int i, Unit& u) const {
        const long L = (long)i * G + c; if (L >= nwg) return false;
        int wgid = (int)L; { constexpr int q = nwg / NXCD, r = nwg % NXCD; const int xcd = wgid % NXCD, off = wgid / NXCD; wgid = (xcd < r ? xcd * (q + 1) : r * (q + 1) + (xcd - r) * q) + off; }
        constexpr int nig = WGM * nN; const int gid = wgid / nig, fm = gid * WGM, gsz = (nM - fm) < WGM ? (nM - fm) : WGM;
        u.pm = fm + ((wgid % nig) % gsz); u.pn = (wgid % nig) / gsz; return true;
    }
    __device__ __forceinline__ void a_ready(const Unit&) const {}
    __device__ __forceinline__ void done(const Unit&) const {}
};
typedef float f32x2 __attribute__((ext_vector_type(2)));
__device__ __forceinline__ unsigned cvt_pk_bf16(float lo, float hi) { unsigned r; asm volatile("v_cvt_pk_bf16_f32 %0, %1, %2" : "=v"(r) : "v"(lo), "v"(hi)); return r; }
__device__ __forceinline__ u32x4 pack8(const f32x4 v0, const f32x4 v1) { u32x4 w; w.x = cvt_pk_bf16(v0[0], v0[1]); w.y = cvt_pk_bf16(v0[2], v0[3]); w.z = cvt_pk_bf16(v1[0], v1[1]); w.w = cvt_pk_bf16(v1[2], v1[3]); return w; }
__device__ __forceinline__ float silu_fast(float x) { return x * __builtin_amdgcn_rcpf(1.f + __expf(-x)); }
struct EpiBf16 {
    static constexpr bool PERM = true, AFTER_DRAIN = false;
    bf16_t* O; int ldc;
    __device__ __forceinline__ void operator()(const f32x4 (&acc)[2][2][4][2], const Unit& u, int wr, int wc, int fr, int fq) const {
        const int row0 = u.pm * BM + wr * 64 + fr, col0 = u.pn * BM + wc * 32 + 8 * fq;
#pragma unroll
        for (int ai = 0; ai < 2; ++ai)
#pragma unroll
            for (int m = 0; m < 4; ++m) { bf16_t* rowp = O + (size_t)(row0 + ai * HALF + m * 16) * ldc + col0;
#pragma unroll
                for (int bj = 0; bj < 2; ++bj) *(u32x4*)(rowp + bj * HALF) = pack8(acc[ai][bj][m][0], acc[ai][bj][m][1]); }
    }
};
struct EpiProj {
    static constexpr bool PERM = true, AFTER_DRAIN = false;
    bf16_t* O; bf16_t* AL;
    __device__ __forceinline__ void operator()(const f32x4 (&acc)[2][2][4][2], const Unit& u, int wr, int wc, int fr, int fq) const {
        const int row0 = u.pm * BM + wr * 64 + fr, col0 = u.pn * BM + wc * 32 + 8 * fq;
        if (u.pn < 10) {
#pragma unroll
            for (int ai = 0; ai < 2; ++ai)
#pragma unroll
                for (int m = 0; m < 4; ++m) { bf16_t* rowp = O + (size_t)(row0 + ai * HALF + m * 16) * 2560 + col0;
#pragma unroll
                    for (int bj = 0; bj < 2; ++bj) *(u32x4*)(rowp + bj * HALF) = pack8(acc[ai][bj][m][0], acc[ai][bj][m][1]); }
        } else if (wc == 0 && fq < 2) {
#pragma unroll
            for (int ai = 0; ai < 2; ++ai)
#pragma unroll
                for (int m = 0; m < 4; ++m) *(u32x4*)(AL + (size_t)(row0 + ai * HALF + m * 16) * 16 + 8 * fq) = pack8(acc[ai][0][m][0], acc[ai][0][m][1]);
        }
    }
};
struct EpiRes {
    static constexpr bool PERM = false, AFTER_DRAIN = false;
    float* HF; float alpha; static constexpr int ldc = 1024;
    __device__ __forceinline__ void operator()(const f32x4 (&acc)[2][2][4][2], const Unit& u, int wr, int wc, int fr, int fq) const {
        const int row0 = u.pm * BM + wr * 64 + fr, col0 = u.pn * BM + wc * 32 + 4 * fq;
#pragma unroll
        for (int ai = 0; ai < 2; ++ai)
#pragma unroll
            for (int m = 0; m < 4; ++m) { float* rowp = HF + (size_t)(row0 + ai * HALF + m * 16) * ldc + col0;
#pragma unroll
                for (int bj = 0; bj < 2; ++bj)
#pragma unroll
                    for (int n = 0; n < 2; ++n) { f32x4* p = (f32x4*)(rowp + bj * HALF + n * 16); const f32x4 h = *p; *p = h * alpha + acc[ai][bj][m][n]; } }
    }
};
struct EpiSwiglu {
    static constexpr bool PERM = true, AFTER_DRAIN = false;
    bf16_t* O; static constexpr int ldc = 2816;
    __device__ __forceinline__ void operator()(const f32x4 (&acc)[2][2][4][2], const Unit& u, int wr, int wc, int fr, int fq) const {
        const int row0 = u.pm * BM + wr * 64 + fr, col0 = u.pn * HALF + wc * 32 + 8 * fq;
#pragma unroll
        for (int ai = 0; ai < 2; ++ai)
#pragma unroll
            for (int m = 0; m < 4; ++m) { f32x4 a0, a1;
#pragma unroll
                for (int j = 0; j < 4; ++j) { a0[j] = silu_fast(acc[ai][0][m][0][j]) * acc[ai][1][m][0][j]; a1[j] = silu_fast(acc[ai][0][m][1][j]) * acc[ai][1][m][1][j]; }
                *(u32x4*)(O + (size_t)(row0 + ai * HALF + m * 16) * ldc + col0) = pack8(a0, a1); }
    }
};

__device__ __forceinline__ void row_stats8(const float* MUR, int row0, float (&mu)[2][4], float (&rs)[2][4]) {
#pragma unroll
    for (int ai = 0; ai < 2; ++ai)
#pragma unroll
        for (int m = 0; m < 4; ++m) { const f32x2 t = *(const f32x2*)(MUR + 2 * (size_t)(row0 + ai * HALF + m * 16)); mu[ai][m] = t.x; rs[ai][m] = t.y; }
}
struct EpiBf16LN {
    static constexpr bool PERM = true, AFTER_DRAIN = false;
    bf16_t* O; int ldc; const float* MUR; const float* cs; const float* cb;
    __device__ __forceinline__ void operator()(const f32x4 (&acc)[2][2][4][2], const Unit& u, int wr, int wc, int fr, int fq) const {
        const int row0 = u.pm * BM + wr * 64 + fr, col0 = u.pn * BM + wc * 32 + 8 * fq;
        float mu[2][4], rs[2][4]; row_stats8(MUR, row0, mu, rs);
#pragma unroll
        for (int bj = 0; bj < 2; ++bj) { const f32x4 s0 = *(const f32x4*)(cs + col0 + bj * HALF), s1 = *(const f32x4*)(cs + col0 + bj * HALF + 4), b0 = *(const f32x4*)(cb + col0 + bj * HALF), b1 = *(const f32x4*)(cb + col0 + bj * HALF + 4);
#pragma unroll
            for (int ai = 0; ai < 2; ++ai)
#pragma unroll
                for (int m = 0; m < 4; ++m) { const f32x4 v0 = (acc[ai][bj][m][0] - s0 * mu[ai][m]) * rs[ai][m] + b0, v1 = (acc[ai][bj][m][1] - s1 * mu[ai][m]) * rs[ai][m] + b1;
                    *(u32x4*)(O + (size_t)(row0 + ai * HALF + m * 16) * ldc + col0 + bj * HALF) = pack8(v0, v1); } }
    }
};
struct EpiProjLN {
    static constexpr bool PERM = true, AFTER_DRAIN = false;
    bf16_t* O; bf16_t* AL; const float* MUR; const float* cs; const float* cb;
    __device__ __forceinline__ void operator()(const f32x4 (&acc)[2][2][4][2], const Unit& u, int wr, int wc, int fr, int fq) const {
        const int row0 = u.pm * BM + wr * 64 + fr, col0 = u.pn * BM + wc * 32 + 8 * fq;
        float mu[2][4], rs[2][4]; row_stats8(MUR, row0, mu, rs);
        if (u.pn < 10) {
#pragma unroll
            for (int bj = 0; bj < 2; ++bj) { const f32x4 s0 = *(const f32x4*)(cs + col0 + bj * HALF), s1 = *(const f32x4*)(cs + col0 + bj * HALF + 4), b0 = *(const f32x4*)(cb + col0 + bj * HALF), b1 = *(const f32x4*)(cb + col0 + bj * HALF + 4);
#pragma unroll
                for (int ai = 0; ai < 2; ++ai)
#pragma unroll
                    for (int m = 0; m < 4; ++m) { const f32x4 v0 = (acc[ai][bj][m][0] - s0 * mu[ai][m]) * rs[ai][m] + b0, v1 = (acc[ai][bj][m][1] - s1 * mu[ai][m]) * rs[ai][m] + b1;
                        *(u32x4*)(O + (size_t)(row0 + ai * HALF + m * 16) * 2560 + col0 + bj * HALF) = pack8(v0, v1); } }
        } else if (wc == 0 && fq < 2) {
            const f32x4 s0 = *(const f32x4*)(cs + col0), s1 = *(const f32x4*)(cs + col0 + 4), b0 = *(const f32x4*)(cb + col0), b1 = *(const f32x4*)(cb + col0 + 4);
#pragma unroll
            for (int ai = 0; ai < 2; ++ai)
#pragma unroll
                for (int m = 0; m < 4; ++m) { const f32x4 v0 = (acc[ai][0][m][0] - s0 * mu[ai][m]) * rs[ai][m] + b0, v1 = (acc[ai][0][m][1] - s1 * mu[ai][m]) * rs[ai][m] + b1;
                    *(u32x4*)(AL + (size_t)(row0 + ai * HALF + m * 16) * 16 + 8 * fq) = pack8(v0, v1); }
        }
    }
};
struct EpiInLN {
    static constexpr bool PERM = true, AFTER_DRAIN = false;
    bf16_t* O; const float* MUR; const float* cs; const float* cb; static constexpr int ldc = 2560;
    __device__ __forceinline__ void operator()(const f32x4 (&acc)[2][2][4][2], const Unit& u, int wr, int wc, int fr, int fq) const {
        const int row0 = u.pm * BM + wr * 64 + fr, col0 = u.pn * BM + wc * 32 + 8 * fq;
        float mu[2][4], rs[2][4]; row_stats8(MUR, row0, mu, rs);
        if (u.pn >= 4) {
#pragma unroll
            for (int bj = 0; bj < 2; ++bj) { const f32x4 s0 = *(const f32x4*)(cs + col0 + bj * HALF), s1 = *(const f32x4*)(cs + col0 + bj * HALF + 4), b0 = *(const f32x4*)(cb + col0 + bj * HALF), b1 = *(const f32x4*)(cb + col0 + bj * HALF + 4);
#pragma unroll
                for (int ai = 0; ai < 2; ++ai)
#pragma unroll
                    for (int m = 0; m < 4; ++m) { const f32x4 v0 = (acc[ai][bj][m][0] - s0 * mu[ai][m]) * rs[ai][m] + b0, v1 = (acc[ai][bj][m][1] - s1 * mu[ai][m]) * rs[ai][m] + b1;
                        *(u32x4*)(O + (size_t)(row0 + ai * HALF + m * 16) * ldc + col0 + bj * HALF) = pack8(v0, v1); } }
        } else {
            const int ucol = u.pn * HALF + wc * 32 + 8 * fq;
            const f32x4 sa0 = *(const f32x4*)(cs + col0), sa1 = *(const f32x4*)(cs + col0 + 4), ba0 = *(const f32x4*)(cb + col0), ba1 = *(const f32x4*)(cb + col0 + 4);
            const f32x4 sg0 = *(const f32x4*)(cs + col0 + HALF), sg1 = *(const f32x4*)(cs + col0 + HALF + 4), bg0 = *(const f32x4*)(cb + col0 + HALF), bg1 = *(const f32x4*)(cb + col0 + HALF + 4);
#pragma unroll
            for (int ai = 0; ai < 2; ++ai)
#pragma unroll
                for (int m = 0; m < 4; ++m) {
                    const f32x4 a0 = (acc[ai][0][m][0] - sa0 * mu[ai][m]) * rs[ai][m] + ba0, a1 = (acc[ai][0][m][1] - sa1 * mu[ai][m]) * rs[ai][m] + ba1;
                    const f32x4 g0 = (acc[ai][1][m][0] - sg0 * mu[ai][m]) * rs[ai][m] + bg0, g1 = (acc[ai][1][m][1] - sg1 * mu[ai][m]) * rs[ai][m] + bg1;
                    f32x4 u0, u1;
#pragma unroll
                    for (int j = 0; j < 4; ++j) { u0[j] = a0[j] * __builtin_amdgcn_rcpf(1.f + __expf(-g0[j])); u1[j] = a1[j] * __builtin_amdgcn_rcpf(1.f + __expf(-g1[j])); }
                    *(u32x4*)(O + (size_t)(row0 + ai * HALF + m * 16) * ldc + ucol) = pack8(u0, u1); }
        }
    }
};
struct EpiSwigluLN {
    static constexpr bool PERM = true, AFTER_DRAIN = false;
    bf16_t* O; const float* MUR; const float* cs; const float* cb; static constexpr int ldc = 2816;
    __device__ __forceinline__ void operator()(const f32x4 (&acc)[2][2][4][2], const Unit& u, int wr, int wc, int fr, int fq) const {
        const int row0 = u.pm * BM + wr * 64 + fr, wrow = u.pn * BM + wc * 32 + 8 * fq, col0 = u.pn * HALF + wc * 32 + 8 * fq;
        float mu[2][4], rs[2][4]; row_stats8(MUR, row0, mu, rs);
        const f32x4 sg0 = *(const f32x4*)(cs + wrow), sg1 = *(const f32x4*)(cs + wrow + 4), bg0 = *(const f32x4*)(cb + wrow), bg1 = *(const f32x4*)(cb + wrow + 4);
        const f32x4 su0 = *(const f32x4*)(cs + wrow + HALF), su1 = *(const f32x4*)(cs + wrow + HALF + 4), bu0 = *(const f32x4*)(cb + wrow + HALF), bu1 = *(const f32x4*)(cb + wrow + HALF + 4);
#pragma unroll
        for (int ai = 0; ai < 2; ++ai)
#pragma unroll
            for (int m = 0; m < 4; ++m) {
                const f32x4 g0 = (acc[ai][0][m][0] - sg0 * mu[ai][m]) * rs[ai][m] + bg0, g1 = (acc[ai][0][m][1] - sg1 * mu[ai][m]) * rs[ai][m] + bg1;
                const f32x4 u0 = (acc[ai][1][m][0] - su0 * mu[ai][m]) * rs[ai][m] + bu0, u1 = (acc[ai][1][m][1] - su1 * mu[ai][m]) * rs[ai][m] + bu1;
                f32x4 a0, a1;
#pragma unroll
                for (int j = 0; j < 4; ++j) { a0[j] = silu_fast(g0[j]) * u0[j]; a1[j] = silu_fast(g1[j]) * u1[j]; }
                *(u32x4*)(O + (size_t)(row0 + ai * HALF + m * 16) * ldc + col0) = pack8(a0, a1); }
    }
};
struct EpiResLN {
    static constexpr bool PERM = false, AFTER_DRAIN = false;
    const float* Xin; float* Yout; bf16_t* YB; float* MUR; const float* gp; const float* bp; unsigned long long* slots; unsigned* cnt; float alpha; PG8_LAS unsigned char* lds;
    __device__ __forceinline__ void operator()(f32x4 (&acc)[2][2][4][2], const Unit& u, int wr, int wc, int fr, int fq) const {
        typedef unsigned u32x2 __attribute__((ext_vector_type(2)));
        const int row0 = u.pm * BM + wr * 64 + fr, col0 = u.pn * BM + wc * 32 + 4 * fq;
#pragma unroll
        for (int ai = 0; ai < 2; ++ai) {
            float mu[4], rs[4];
#pragma unroll
            for (int m = 0; m < 4; ++m) { const f32x2 t = *(const f32x2*)(MUR + 2 * (size_t)(row0 + ai * HALF + m * 16)); mu[m] = t.x; rs[m] = t.y; }
#pragma unroll
            for (int bj = 0; bj < 2; ++bj)
#pragma unroll
                for (int n = 0; n < 2; ++n) { const f32x4 g4 = *(const f32x4*)(gp + col0 + bj * HALF + n * 16), b4 = *(const f32x4*)(bp + col0 + bj * HALF + n * 16);
                    u32x2 told[4];
                    if (!Xin) {
#pragma unroll
                        for (int m = 0; m < 4; ++m) told[m] = *(const u32x2*)(YB + (size_t)(row0 + ai * HALF + m * 16) * 1024 + col0 + bj * HALF + n * 16);
                    }
#pragma unroll
                    for (int m = 0; m < 4; ++m) { const size_t off = (size_t)(row0 + ai * HALF + m * 16) * 1024 + col0 + bj * HALF + n * 16;
                        f32x4 yo;
                        if (Xin) yo = *(const f32x4*)(Xin + off);
                        else { const u32x2 t = told[m]; yo = (f32x4){__uint_as_float(t.x << 16), __uint_as_float(t.x & 0xffff0000u), __uint_as_float(t.y << 16), __uint_as_float(t.y & 0xffff0000u)}; }
                        const f32x4 yn = ((yo - mu[m]) * rs[m] * g4 + b4) * alpha + acc[ai][bj][m][n];
                        acc[ai][bj][m][n] = yn; if (Yout) *(f32x4*)(Yout + off) = yn;
                        u32x2 w; w.x = cvt_pk_bf16(yn[0], yn[1]); w.y = cvt_pk_bf16(yn[2], yn[3]); *(u32x2*)(YB + off) = w; } } }
        PG8_LAS f32x2* P = (PG8_LAS f32x2*)(lds + 131072);
#pragma unroll
        for (int ai = 0; ai < 2; ++ai)
#pragma unroll
            for (int m = 0; m < 4; ++m) {
                float s = 0.f;
#pragma unroll
                for (int bj = 0; bj < 2; ++bj)
#pragma unroll
                    for (int n = 0; n < 2; ++n) { const f32x4 x = acc[ai][bj][m][n]; s += (x[0] + x[1]) + (x[2] + x[3]); }
                s += __shfl_xor(s, 16); s += __shfl_xor(s, 32);
                const float mw = s * (1.0f / 64.0f); float q = 0.f;
#pragma unroll
                for (int bj = 0; bj < 2; ++bj)
#pragma unroll
                    for (int n = 0; n < 2; ++n) { const f32x4 d = acc[ai][bj][m][n] - mw; q += (d[0] * d[0] + d[1] * d[1]) + (d[2] * d[2] + d[3] * d[3]); }
                q += __shfl_xor(q, 16); q += __shfl_xor(q, 32);
                if (fq == 0) P[(ai * HALF + wr * 64 + m * 16 + fr) * 4 + wc] = (f32x2){mw, q};
            }
        asm volatile("s_waitcnt lgkmcnt(0)" ::: "memory"); __builtin_amdgcn_s_barrier(); asm volatile("" ::: "memory");
        const int wid = wr * 4 + wc, lane = fq * 16 + fr, row = wid * 32 + (lane & 31);
        if (lane < 32) {
            const f32x2 a = P[row * 4 + 0], b = P[row * 4 + 1], c = P[row * 4 + 2], d = P[row * 4 + 3];
            const float mt = (a.x + b.x + c.x + d.x) * 0.25f;
            const float da = a.x - mt, db = b.x - mt, dc = c.x - mt, dd = d.x - mt;
            const float m2 = (a.y + b.y) + (c.y + d.y) + 64.0f * ((da * da + db * db) + (dc * dc + dd * dd));
            __hip_atomic_store(slots + ((size_t)(u.pm * BM + row) * 4 + u.pn), ((unsigned long long)__float_as_uint(m2) << 32) | __float_as_uint(mt), __ATOMIC_RELAXED, __HIP_MEMORY_SCOPE_AGENT);
        }
        asm volatile("s_waitcnt vmcnt(0)" ::: "memory");
        unsigned old = 0u;
        if (lane == 0) old = __hip_atomic_fetch_add(cnt + u.pm, 1u, __ATOMIC_RELAXED, __HIP_MEMORY_SCOPE_AGENT);
        old = (unsigned)__builtin_amdgcn_readfirstlane((int)old);
        if (old == 31u) {
#pragma unroll
            for (int rr = 0; rr < 4; ++rr) { const int r = lane * 4 + rr; const unsigned long long* sl = slots + (size_t)(u.pm * BM + r) * 4; float mt[4], m2[4], ms = 0.f;
#pragma unroll
                for (int t = 0; t < 4; ++t) { const unsigned long long w = __hip_atomic_load(sl + t, __ATOMIC_RELAXED, __HIP_MEMORY_SCOPE_AGENT); mt[t] = __uint_as_float((unsigned)w); m2[t] = __uint_as_float((unsigned)(w >> 32)); ms += mt[t]; }
                const float mean = ms * 0.25f; float q = 0.f;
#pragma unroll
                for (int t = 0; t < 4; ++t) { const float dm = mt[t] - mean; q += m2[t] + 256.0f * dm * dm; }
                *(f32x2*)(MUR + 2 * (size_t)(u.pm * BM + r)) = (f32x2){mean, 1.0f / sqrtf(q * (1.0f / 1024.0f) + 1e-5f)}; }
        }
    }
};

template <class Epi, class Sched, bool ALIGN_EPI, bool SP2, int KC>
__device__ __forceinline__ void gemm_phase(PG8_LAS unsigned char* lds, const Gemm g, const Sched& S, const Epi& E, const int tid) {
    const int wid = __builtin_amdgcn_readfirstlane(tid >> 6), lane = tid & 63, wr = wid >> 2, wc = wid & 3, fr = lane & 15, fq = lane >> 4;
    constexpr int K = KC, nt = K / BK;
    unsigned voffA[2], voffB[2];
#pragma unroll
    for (int i = 0; i < 2; ++i) { int R, C; stage_rc(tid * 16 + i * 8192, R, C); const int Rb = Epi::PERM ? ((R & ~31) + perm32(R & 31)) : R;
        voffA[i] = (unsigned)(R * K + C) * 2u; voffB[i] = (unsigned)(Rb * K + C) * 2u; }
    const size_t kstep = (size_t)(BK * 2);
    const size_t hstep = (size_t)HALF * K * 2;
    const size_t tstep = 2 * hstep;
    const unsigned ldsw = (unsigned)wid * 1024u;
    const int aoff = lds_byte(wr * 64 + fr, fq * 8), boff = lds_byte(wc * 32 + fr, fq * 8);
#define PG8_SA(b, h) (((b) * 2 + (h)) * HTB)
#define PG8_SB(b, h) ((4 + (b) * 2 + (h)) * HTB)
#define PG8_STAGE(bufoff, gbase, voff) do { _Pragma("unroll") for (int _i = 0; _i < 2; ++_i) \
        __builtin_amdgcn_global_load_lds((const unsigned*)((const char*)(gbase) + (voff)[_i]), (PG8_LAS unsigned*)(lds + (bufoff) + ldsw + _i * 8192), 16, 0, 0); } while (0)
#define PG8_LDA(dst, b, h) do { _Pragma("unroll") for (int m = 0; m < 4; ++m) _Pragma("unroll") for (int k = 0; k < 2; ++k) dst[m][k] = *(const PG8_LAS bf16x8*)(lds + PG8_SA(b, h) + aoff + m * 2048 + k * 1024); } while (0)
#define PG8_LDB(dst, b, h) do { _Pragma("unroll") for (int n = 0; n < 2; ++n) _Pragma("unroll") for (int k = 0; k < 2; ++k) dst[n][k] = *(const PG8_LAS bf16x8*)(lds + PG8_SB(b, h) + boff + n * 2048 + k * 1024); } while (0)
#define PG8_MMA(ai, bj, At, Bt) do { __builtin_amdgcn_s_setprio(1); _Pragma("unroll") for (int m = 0; m < 4; ++m) _Pragma("unroll") for (int n = 0; n < 2; ++n) _Pragma("unroll") for (int k = 0; k < 2; ++k) \
        acc[ai][bj][m][n] = __builtin_amdgcn_mfma_f32_16x16x32_bf16(Bt[n][k], At[m][k], acc[ai][bj][m][n], 0, 0, 0); __builtin_amdgcn_s_setprio(0); } while (0)
#define PG8_WAIT_V(n) asm volatile("s_waitcnt vmcnt(" #n ")" ::: "memory")
#define PG8_WAIT_L(n) asm volatile("s_waitcnt lgkmcnt(" #n ")" ::: "memory")
#define PG8_BAR __builtin_amdgcn_s_barrier()
#define PG8_SCHED __builtin_amdgcn_sched_barrier(0)
    Unit cur, nxt; int ui = 0;
    if (!S.next(0, cur)) return;
    f32x4 acc[2][2][4][2];
#pragma unroll
    for (int a = 0; a < 2; ++a)
#pragma unroll
        for (int b = 0; b < 2; ++b)
#pragma unroll
            for (int m = 0; m < 4; ++m)
#pragma unroll
                for (int n = 0; n < 2; ++n) acc[a][b][m][n] = (f32x4){0.f, 0.f, 0.f, 0.f};
    bf16x8 At[4][2], B0[2][2], B1[2][2];
    const char* cA = (const char*)g.A + (size_t)cur.pm * tstep; const char* cB = (const char*)g.Bt + (size_t)cur.pn * tstep;
    S.a_ready(cur);
    if constexpr (SP2) {
        PG8_STAGE(PG8_SB(0, 0), cB, voffB); PG8_STAGE(PG8_SB(0, 1), cB + hstep, voffB); PG8_STAGE(PG8_SA(0, 0), cA, voffA); PG8_STAGE(PG8_SA(0, 1), cA + hstep, voffA);
        if (wr == 1) PG8_BAR;
        PG8_WAIT_V(2); PG8_BAR;
        PG8_STAGE(PG8_SB(1, 0), cB + kstep, voffB); PG8_STAGE(PG8_SA(1, 0), cA + kstep, voffA); PG8_STAGE(PG8_SB(1, 1), cB + hstep + kstep, voffB);
        PG8_WAIT_V(6); PG8_BAR;
    } else {
        PG8_STAGE(PG8_SB(0, 0), cB, voffB); PG8_STAGE(PG8_SA(0, 0), cA, voffA); PG8_STAGE(PG8_SB(0, 1), cB + hstep, voffB); PG8_STAGE(PG8_SA(0, 1), cA + hstep, voffA);
        if (wr == 1) PG8_BAR;
        PG8_WAIT_V(4); PG8_BAR;
        PG8_STAGE(PG8_SB(1, 0), cB + kstep, voffB); PG8_STAGE(PG8_SA(1, 0), cA + kstep, voffA); PG8_STAGE(PG8_SB(1, 1), cB + hstep + kstep, voffB);
        PG8_WAIT_V(6); PG8_BAR;
    }
    for (;;) {
        const bool has_next = S.next(ui + 1, nxt);
        const char* nA = has_next ? (const char*)g.A + (size_t)nxt.pm * tstep : cA; const char* nB = has_next ? (const char*)g.Bt + (size_t)nxt.pn * tstep : cB;
        for (int t = 0; t < nt; t += 2) {
            const bool last = (t == nt - 2);
            const char* a1 = cA + (size_t)(t + 1) * kstep;
            const char* a2 = last ? nA : cA + (size_t)(t + 2) * kstep; const char* b2 = last ? nB : cB + (size_t)(t + 2) * kstep;
            const char* a3 = a2 + kstep; const char* b3 = b2 + kstep;
            if (last && has_next) S.a_ready(nxt);
            if constexpr (SP2) {
            PG8_LDB(B0, 0, 0); PG8_LDB(B1, 0, 1); PG8_SCHED; PG8_LDA(At, 0, 0); PG8_STAGE(PG8_SA(1, 1), a1 + hstep, voffA);
            PG8_WAIT_V(8); PG8_WAIT_L(0); PG8_BAR; PG8_MMA(0, 0, At, B0); PG8_MMA(0, 1, At, B1); PG8_BAR; PG8_SCHED;
            PG8_LDA(At, 0, 1); PG8_STAGE(PG8_SB(0, 0), b2, voffB); PG8_STAGE(PG8_SB(0, 1), b2 + hstep, voffB); PG8_STAGE(PG8_SA(0, 0), a2, voffA);
            PG8_WAIT_V(8); PG8_WAIT_L(0); PG8_BAR; PG8_MMA(1, 0, At, B0); PG8_MMA(1, 1, At, B1); PG8_BAR; PG8_SCHED;
            PG8_LDB(B0, 1, 0); PG8_LDB(B1, 1, 1); PG8_SCHED; PG8_LDA(At, 1, 0); PG8_STAGE(PG8_SA(0, 1), a2 + hstep, voffA);
            PG8_WAIT_V(8); PG8_WAIT_L(0); PG8_BAR; PG8_MMA(0, 0, At, B0); PG8_MMA(0, 1, At, B1); PG8_BAR; PG8_SCHED;
            PG8_LDA(At, 1, 1); PG8_STAGE(PG8_SB(1, 0), b3, voffB); PG8_STAGE(PG8_SB(1, 1), b3 + hstep, voffB); PG8_STAGE(PG8_SA(1, 0), a3, voffA);
            PG8_WAIT_V(8); PG8_WAIT_L(0); PG8_BAR; PG8_MMA(1, 0, At, B0); PG8_MMA(1, 1, At, B1); PG8_BAR; PG8_SCHED;
            } else {
            PG8_LDB(B0, 0, 0); PG8_SCHED; PG8_LDA(At, 0, 0); PG8_STAGE(PG8_SA(1, 1), a1 + hstep, voffA);
            PG8_WAIT_L(8); PG8_BAR; PG8_WAIT_L(0); PG8_MMA(0, 0, At, B0); PG8_BAR; PG8_SCHED;
            PG8_LDB(B1, 0, 1); PG8_STAGE(PG8_SB(0, 0), b2, voffB);
            PG8_BAR; PG8_WAIT_L(0); PG8_MMA(0, 1, At, B1); PG8_BAR;
            PG8_LDA(At, 0, 1); PG8_STAGE(PG8_SA(0, 0), a2, voffA);
            PG8_BAR; PG8_WAIT_L(0); PG8_MMA(1, 0, At, B0); PG8_BAR; PG8_SCHED;
            PG8_STAGE(PG8_SB(0, 1), b2 + hstep, voffB);
            PG8_WAIT_V(6); PG8_BAR; PG8_MMA(1, 1, At, B1); PG8_BAR;
            PG8_LDB(B0, 1, 0); PG8_SCHED; PG8_LDA(At, 1, 0); PG8_STAGE(PG8_SA(0, 1), a2 + hstep, voffA);
            PG8_WAIT_L(8); PG8_BAR; PG8_WAIT_L(0); PG8_MMA(0, 0, At, B0); PG8_BAR; PG8_SCHED;
            PG8_LDB(B1, 1, 1); PG8_STAGE(PG8_SB(1, 0), b3, voffB);
            PG8_BAR; PG8_WAIT_L(0); PG8_MMA(0, 1, At, B1); PG8_BAR;
            PG8_LDA(At, 1, 1); PG8_STAGE(PG8_SA(1, 0), a3, voffA);
            PG8_BAR; PG8_WAIT_L(0); PG8_MMA(1, 0, At, B0); PG8_BAR; PG8_SCHED;
            PG8_STAGE(PG8_SB(1, 1), b3 + hstep, voffB);
            PG8_WAIT_V(6); PG8_BAR; PG8_MMA(1, 1, At, B1); PG8_BAR;
            }
        }
        if constexpr (ALIGN_EPI) { if (wr == 0) PG8_BAR; }
        if constexpr (!Epi::AFTER_DRAIN) { E(acc, cur, wr, wc, fr, fq); S.done(cur); }
        if (!has_next) break;
#pragma unroll
        for (int a = 0; a < 2; ++a)
#pragma unroll
            for (int b = 0; b < 2; ++b)
#pragma unroll
                for (int m = 0; m < 4; ++m)
#pragma unroll
                    for (int n = 0; n < 2; ++n) acc[a][b][m][n] = (f32x4){0.f, 0.f, 0.f, 0.f};
        cur = nxt; cA = nA; cB = nB; ++ui;
        if constexpr (ALIGN_EPI) { if (wr == 1) PG8_BAR; }
    }
    PG8_WAIT_V(0);
    if constexpr (!ALIGN_EPI) { if (wr == 0) PG8_BAR; }
    PG8_BAR;
    if constexpr (Epi::AFTER_DRAIN) { E.fused(acc, cur, wr, wc, fr, fq, lds, wid, lane); S.done(cur); }
#undef PG8_SA
#undef PG8_SB
#undef PG8_STAGE
#undef PG8_LDA
#undef PG8_LDB
#undef PG8_MMA
#undef PG8_WAIT_V
#undef PG8_WAIT_L
#undef PG8_BAR
#undef PG8_SCHED
}
}
namespace cg = cooperative_groups;
#define LAS __attribute__((address_space(3)))
#define LDS_WAIT() asm volatile("s_waitcnt lgkmcnt(0)" ::: "memory")
constexpr int NWAVES = 8, LDS_BYTES = 147456;
constexpr size_t WT_XK = 0, WT_XV = (size_t)4096 * 1024, WT_L0 = (size_t)2 * 4096 * 1024, WT_LSTRIDE = 14680064;
constexpr size_t WO_IN = 0, WO_MIX = 2883584, WO_XQ = WO_MIX + 1048576, WO_XO = WO_XQ + 1048576, WO_FF1 = WO_XO + 1048576, WO_FF2 = WO_FF1 + 5767168;
static_assert(WO_FF2 + 2883584 == WT_LSTRIDE && (WT_L0 + 4 * WT_LSTRIDE) * 2 == 128 * MiB, "weight map");
constexpr int I_IN = 16 * 81, I_SQ = 512, I_XKV = 1024, I_FF1 = 16 * 176, I_FF2 = 44 * 32, I_LAYER = I_IN + 3 * I_SQ + I_XKV + I_FF1 + I_FF2;

struct Args { const float* in[24]; float* out; unsigned char* ws; int ph_lo, ph_hi, sub, pad; };

__device__ __forceinline__ unsigned pk2(float lo, float hi) { return (unsigned)f2bf(lo) | ((unsigned)f2bf(hi) << 16); }
__device__ __forceinline__ void cvt_item(const float* W, int K, int N, int k0, int n0, bf16_t* dst, LAS float* scr, int lane) {
#pragma unroll
    for (int i = 0; i < 32; ++i) { const int kk = 2 * i + (lane >> 5), n = n0 + (lane & 31); scr[kk * 33 + (lane & 31)] = n < N ? W[(size_t)(k0 + kk) * N + n] : 0.f; }
    LDS_WAIT(); asm volatile("" ::: "memory");
    const int c = lane & 7;
#pragma unroll
    for (int j = 0; j < 4; ++j) { const int n = (lane >> 3) + 8 * j; const LAS float* s = scr + (8 * c) * 33 + n;
        u32x4 o; o.x = pk2(s[0 * 33], s[1 * 33]); o.y = pk2(s[2 * 33], s[3 * 33]); o.z = pk2(s[4 * 33], s[5 * 33]); o.w = pk2(s[6 * 33], s[7 * 33]);
        *(u32x4*)(dst + (size_t)n * K + k0 + 8 * c) = o; }
    LDS_WAIT(); asm volatile("" ::: "memory");
}
__device__ __forceinline__ void ln_row(const float* in, float* outf, bf16_t* outb, const float* g, const float* b, int lane) {
    const f32x4* xr = (const f32x4*)in + lane;
    f32x4 v[4]; float s = 0.f;
#pragma unroll
    for (int j = 0; j < 4; ++j) { v[j] = xr[64 * j]; s += (v[j].x + v[j].y) + (v[j].z + v[j].w); }
    const float mean = wave_sum(s) * (1.f / D); float s2 = 0.f;
#pragma unroll
    for (int j = 0; j < 4; ++j) { v[j] = v[j] - mean; s2 += (v[j].x * v[j].x + v[j].y * v[j].y) + (v[j].z * v[j].z + v[j].w * v[j].w); }
    const float rstd = rsqrtf(wave_sum(s2) * (1.f / D) + LN_EPS);
#pragma unroll
    for (int j = 0; j < 4; ++j) {
        const int c = (64 * j + lane) * 4;
        const f32x4 o = v[j] * rstd * *(const f32x4*)(g + c) + *(const f32x4*)(b + c);
        *((f32x4*)outf + 64 * j + lane) = o;
        *(unsigned long long*)(outb + c) = (unsigned long long)pk2(o.x, o.y) | ((unsigned long long)pk2(o.z, o.w) << 32);
    }
}


__device__ __forceinline__ void cvt_item_ln(const float* W, int K, int N, int k0, int n0, bf16_t* dst, LAS float* scr, int lane, const float* g, const float* b, float* csp, float* cbp) {
    float cs = 0.f, cb = 0.f;
#pragma unroll
    for (int i = 0; i < 32; ++i) { const int kk = 2 * i + (lane >> 5), n = n0 + (lane & 31); const float w = n < N ? W[(size_t)(k0 + kk) * N + n] : 0.f; const float wg = w * g[k0 + kk];
        scr[kk * 33 + (lane & 31)] = wg; cs += bf2f(f2bf(wg)); cb += b[k0 + kk] * w; }
    cs += __shfl_xor(cs, 32); cb += __shfl_xor(cb, 32);
    if (lane < 32) { csp[lane] = cs; cbp[lane] = cb; }
    LDS_WAIT(); asm volatile("" ::: "memory");
    const int c = lane & 7;
#pragma unroll
    for (int j = 0; j < 4; ++j) { const int n = (lane >> 3) + 8 * j; const LAS float* s = scr + (8 * c) * 33 + n;
        u32x4 o; o.x = pk2(s[0 * 33], s[1 * 33]); o.y = pk2(s[2 * 33], s[3 * 33]); o.z = pk2(s[4 * 33], s[5 * 33]); o.w = pk2(s[6 * 33], s[7 * 33]);
        *(u32x4*)(dst + (size_t)n * K + k0 + 8 * c) = o; }
    LDS_WAIT(); asm volatile("" ::: "memory");
}
__device__ __forceinline__ void x_row(const float* in, bf16_t* outb, float* mur, int lane) {
    const f32x4* xr = (const f32x4*)in + lane;
    f32x4 v[4]; float s = 0.f;
#pragma unroll
    for (int j = 0; j < 4; ++j) { v[j] = xr[64 * j]; s += (v[j].x + v[j].y) + (v[j].z + v[j].w);
        *(unsigned long long*)(outb + (64 * j + lane) * 4) = (unsigned long long)pk2(v[j].x, v[j].y) | ((unsigned long long)pk2(v[j].z, v[j].w) << 32); }
    const float mean = wave_sum(s) * (1.f / D); float s2 = 0.f;
#pragma unroll
    for (int j = 0; j < 4; ++j) { const f32x4 d = v[j] - mean; s2 += (d.x * d.x + d.y * d.y) + (d.z * d.z + d.w * d.w); }
    const float rstd = rsqrtf(wave_sum(s2) * (1.f / D) + LN_EPS);
    if (lane == 0) { mur[0] = mean; mur[1] = rstd; }
}
__device__ __forceinline__ void ln_row_f32(float* io, const float* g, const float* b, int lane) {
    f32x4* xr = (f32x4*)io + lane;
    f32x4 v[4]; float s = 0.f;
#pragma unroll
    for (int j = 0; j < 4; ++j) { v[j] = xr[64 * j]; s += (v[j].x + v[j].y) + (v[j].z + v[j].w); }
    const float mean = wave_sum(s) * (1.f / D); float s2 = 0.f;
#pragma unroll
    for (int j = 0; j < 4; ++j) { v[j] = v[j] - mean; s2 += (v[j].x * v[j].x + v[j].y * v[j].y) + (v[j].z * v[j].z + v[j].w * v[j].w); }
    const float rstd = rsqrtf(wave_sum(s2) * (1.f / D) + LN_EPS);
#pragma unroll
    for (int j = 0; j < 4; ++j) { const int c = (64 * j + lane) * 4; xr[64 * j] = v[j] * rstd * *(const f32x4*)(g + c) + *(const f32x4*)(b + c); }
}

__device__ __forceinline__ void alow_rows(const bf16_t* YB, const bf16_t* Wal, const float* MUR, const float* cs, const float* cb, bf16_t* ALOW, int gw, int NGW, int lane) {
    typedef short bf16x8_t __attribute__((ext_vector_type(8)));
    typedef unsigned u32x2_t __attribute__((ext_vector_type(2)));
    const int i = lane & 15, kg = lane >> 4;
    for (int rb = gw; rb < M / 16; rb += NGW) {
        const bf16_t* ap = YB + (size_t)(rb * 16 + i) * 1024 + 8 * kg; const bf16_t* wp = Wal + (size_t)i * 1024 + 8 * kg;
        f32x4 acc0 = (f32x4){0.f, 0.f, 0.f, 0.f}, acc1 = acc0;
#pragma unroll
        for (int s0 = 0; s0 < 32; s0 += 8) { bf16x8_t af[8], wf[8];
#pragma unroll
            for (int s = 0; s < 8; ++s) { af[s] = *(const bf16x8_t*)(ap + 32 * (s0 + s)); wf[s] = *(const bf16x8_t*)(wp + 32 * (s0 + s)); }
#pragma unroll
            for (int s = 0; s < 8; s += 2) { acc0 = __builtin_amdgcn_mfma_f32_16x16x32_bf16(wf[s], af[s], acc0, 0, 0, 0); acc1 = __builtin_amdgcn_mfma_f32_16x16x32_bf16(wf[s + 1], af[s + 1], acc1, 0, 0, 0); } }
        const float mu = MUR[2 * (size_t)(rb * 16 + i)], rs = MUR[2 * (size_t)(rb * 16 + i) + 1];
        const f32x4 c4 = *(const f32x4*)(cs + 4 * kg), b4 = *(const f32x4*)(cb + 4 * kg);
        const f32x4 z = ((acc0 + acc1) - c4 * mu) * rs + b4;
        u32x2_t w; w.x = pk2(z[0], z[1]); w.y = pk2(z[2], z[3]);
        *(u32x2_t*)(ALOW + (size_t)(rb * 16 + i) * 16 + 4 * kg) = w;
    }
}
#define XB_TMO      128
#define XB_XCNT(j)  (256  + 64 * (j))
#define XB_XSUB(j)  (1280 + 64 * (j))
#define XB_XGEN(j)  (2304 + 64 * (j))
#define XB_TOP      3328
#define XB_TOPGEN   3392
#define XCD_BAR_WORDS 3456
#define XB_SPIN_CAP (1u << 18)

__device__ __forceinline__ unsigned xb_ld(unsigned* p)              { return __hip_atomic_load(p, __ATOMIC_RELAXED, __HIP_MEMORY_SCOPE_AGENT); }
__device__ __forceinline__ unsigned xb_add(unsigned* p, unsigned v) { return __hip_atomic_fetch_add(p, v, __ATOMIC_RELAXED, __HIP_MEMORY_SCOPE_AGENT); }
__device__ __forceinline__ unsigned xb_xcc_id() { return (unsigned)__builtin_amdgcn_s_getreg((3 << 11) | 20) & 0xFu; }
#define XB_SPIN(cond, bar) do { unsigned _sp = 0; while (cond) { __builtin_amdgcn_s_sleep(1); \
    if ((++_sp & 255u) == 0u) { if (xb_ld(&(bar)[XB_TMO])) break; if (_sp > XB_SPIN_CAP) { atomicAdd(&(bar)[XB_TMO], 1u); break; } } } } while (0)

struct XcdBarrier {
    unsigned* bar; unsigned x;
    volatile LAS unsigned* st;
};

__device__ __forceinline__ XcdBarrier xcd_barrier_post(unsigned* bar, volatile LAS unsigned* st) {
    XcdBarrier b; b.bar = bar; b.x = xb_xcc_id(); b.st = st;
    if (threadIdx.x == 0) (void)xb_add(&bar[XB_XCNT(b.x)], 1u);
    return b;
}
__device__ __forceinline__ void xcd_barrier_complete(unsigned* bar, unsigned x, unsigned& nloc, unsigned& nx) {
    const unsigned G = gridDim.x * gridDim.y * gridDim.z;
    unsigned sum, cnt, mine, sp = 0u;
    for (;;) {
        sum = 0u; cnt = 0u; mine = 0u;
#pragma unroll
        for (unsigned j = 0; j < 16; ++j) { const unsigned c = xb_ld(&bar[XB_XCNT(j)]); sum += c; cnt += (c > 0u) ? 1u : 0u; mine = (j == x) ? c : mine; }
        if (sum == G) break;
        __builtin_amdgcn_s_sleep(1);
        if ((++sp & 255u) == 0u) { if (xb_ld(&bar[XB_TMO])) break; if (sp > XB_SPIN_CAP) { atomicAdd(&bar[XB_TMO], 1u); break; } }
    }
    nloc = mine > 0u ? mine : 1u; nx = cnt > 0u ? cnt : 1u;
}

__device__ __forceinline__ void xcd_barrier(const XcdBarrier& b) {
    asm volatile("s_waitcnt vmcnt(0)" ::: "memory");
    __syncthreads();
    if (threadIdx.x == 0) {
        unsigned* bar = b.bar;
        __builtin_amdgcn_s_waitcnt(0);
        unsigned nloc = b.st[0], nx = b.st[1];
        if (nloc == 0u) { xcd_barrier_complete(bar, b.x, nloc, nx); b.st[0] = nloc; b.st[1] = nx; }
        const unsigned old = xb_add(&bar[XB_XSUB(b.x)], 1u);
        const unsigned gen = old / nloc;
        if (old + 1u == (gen + 1u) * nloc) {
            __builtin_amdgcn_fence(__ATOMIC_RELEASE, "agent");
            asm volatile("s_waitcnt vmcnt(0)" ::: "memory");
            const unsigned og = xb_add(&bar[XB_TOP], 1u);
            const unsigned tg = og / nx;
            if (og + 1u == (tg + 1u) * nx) xb_add(&bar[XB_TOPGEN], 1u);
            else XB_SPIN(xb_ld(&bar[XB_TOPGEN]) == tg, bar);
            __builtin_amdgcn_fence(__ATOMIC_ACQUIRE, "agent");
            xb_add(&bar[XB_XGEN(b.x)], 1u);
            asm volatile("s_waitcnt vmcnt(0)" ::: "memory");
        } else {
            XB_SPIN(xb_ld(&bar[XB_XGEN(b.x)]) == gen, bar);
            __builtin_amdgcn_fence(__ATOMIC_ACQUIRE, "agent");
            asm volatile("s_waitcnt vmcnt(0)" ::: "memory");
        }
    }
    __syncthreads();
}

template <bool REL, bool ACQ> __device__ __forceinline__ void xcd_barrier_v(const XcdBarrier& b) {
    asm volatile("s_waitcnt vmcnt(0)" ::: "memory");
    __syncthreads();
    if (threadIdx.x == 0) {
        unsigned* bar = b.bar;
        __builtin_amdgcn_s_waitcnt(0);
        unsigned nloc = b.st[0], nx = b.st[1];
        if (nloc == 0u) { xcd_barrier_complete(bar, b.x, nloc, nx); b.st[0] = nloc; b.st[1] = nx; }
        const unsigned old = xb_add(&bar[XB_XSUB(b.x)], 1u);
        const unsigned gen = old / nloc;
        if (old + 1u == (gen + 1u) * nloc) {
            if (REL) __builtin_amdgcn_fence(__ATOMIC_RELEASE, "agent");
            asm volatile("s_waitcnt vmcnt(0)" ::: "memory");
            const unsigned og = xb_add(&bar[XB_TOP], 1u);
            const unsigned tg = og / nx;
            if (og + 1u == (tg + 1u) * nx) xb_add(&bar[XB_TOPGEN], 1u);
            else XB_SPIN(xb_ld(&bar[XB_TOPGEN]) == tg, bar);
            if (ACQ) __builtin_amdgcn_fence(__ATOMIC_ACQUIRE, "agent");
            xb_add(&bar[XB_XGEN(b.x)], 1u);
            asm volatile("s_waitcnt vmcnt(0)" ::: "memory");
        } else {
            XB_SPIN(xb_ld(&bar[XB_XGEN(b.x)]) == gen, bar);
            if (ACQ) __builtin_amdgcn_fence(__ATOMIC_ACQUIRE, "agent");
            asm volatile("s_waitcnt vmcnt(0)" ::: "memory");
        }
    }
    __syncthreads();
}
typedef short bf16x8_t __attribute__((ext_vector_type(8)));
typedef unsigned u32x2_t __attribute__((ext_vector_type(2)));
__device__ __forceinline__ unsigned cvtpk(float lo, float hi) { unsigned r; asm volatile("v_cvt_pk_bf16_f32 %0, %1, %2" : "=v"(r) : "v"(lo), "v"(hi)); return r; }
__device__ __forceinline__ void att_stage(LAS unsigned char* lds, const bf16_t* src, int pitch, int tid) {
    const int r0 = tid >> 5, ch = tid & 31;
    const bf16_t* g0 = src + (size_t)r0 * pitch + ch * 8;
    LAS unsigned char* l0 = lds + r0 * 512 + ((ch ^ r0) << 4);
    u32x4 v[16];
#pragma unroll
    for (int x = 0; x < 16; ++x) v[x] = *(const u32x4*)(g0 + (size_t)(16 * x) * pitch);
#pragma unroll
    for (int x = 0; x < 16; ++x) *(LAS u32x4*)(l0 + x * 8192) = v[x];
}
__device__ __forceinline__ void att_phase(LAS unsigned char* lds, const bf16_t* Kl, const bf16_t* Vl, const bf16_t* Qb, bf16_t* Ob, int G, int tid) {
    for (int u = blockIdx.x; u < (M / 256) * 4; u += G) {
        asm volatile("" : "+v"(tid));
        const int lane = tid & 63, wave = __builtin_amdgcn_readfirstlane(tid >> 6), j = lane & 15, kg = lane >> 4;
        const int h = u & 3, pm = u >> 2, b = pm >> 5;
        att_stage(lds, Kl + (size_t)(b * 256) * 4096 + h * 256, 4096, tid);
        const bf16_t* qrow = Qb + (size_t)(pm * 256 + 16 * wave + j) * 1024 + h * 256;
        bf16_t* orow = Ob + (size_t)(pm * 256 + 16 * wave + j) * 1024 + h * 256;
        __syncthreads();
        const LAS unsigned char* fbase = lds + j * 512;
        const float cs = 0.0625f * 1.4426950408889634f;
        bf16x8_t pf[2][8]; float inv[2];
#pragma unroll
        for (int hf = 0; hf < 2; ++hf) {
            bf16x8_t qf[8];
#pragma unroll
            for (int s = 0; s < 8; ++s) qf[s] = *(const bf16x8_t*)(qrow + (size_t)hf * 128 * 1024 + 32 * s + 8 * kg);
            f32x4 acc[16];
#pragma unroll
            for (int kb = 0; kb < 16; ++kb) acc[kb] = (f32x4){0.f, 0.f, 0.f, 0.f};
#pragma unroll
            for (int s = 0; s < 8; ++s)
#pragma unroll
                for (int kb = 0; kb < 16; ++kb) { const bf16x8_t af = *(const LAS bf16x8_t*)(fbase + kb * 8192 + (((4 * s + kg) ^ j) << 4));
                    acc[kb] = __builtin_amdgcn_mfma_f32_16x16x32_bf16(af, qf[s], acc[kb], 0, 0, 0); }
            float mx = acc[0][0];
#pragma unroll
            for (int kb = 0; kb < 16; ++kb) mx = fmaxf(fmaxf(mx, fmaxf(acc[kb][0], acc[kb][1])), fmaxf(acc[kb][2], acc[kb][3]));
            mx = fmaxf(mx, __shfl_xor(mx, 16)); mx = fmaxf(mx, __shfl_xor(mx, 32));
            const float mxc = mx * cs; float sum = 0.f;
#pragma unroll
            for (int t = 0; t < 8; ++t) { f32x4 p0, p1;
#pragma unroll
                for (int e = 0; e < 4; ++e) { p0[e] = __builtin_amdgcn_exp2f(acc[2 * t][e] * cs - mxc); p1[e] = __builtin_amdgcn_exp2f(acc[2 * t + 1][e] * cs - mxc); }
                sum += (p0[0] + p0[1]) + (p0[2] + p0[3]) + (p1[0] + p1[1]) + (p1[2] + p1[3]);
                u32x4 w; w.x = cvtpk(p0[0], p0[1]); w.y = cvtpk(p0[2], p0[3]); w.z = cvtpk(p1[0], p1[1]); w.w = cvtpk(p1[2], p1[3]); pf[hf][t] = __builtin_bit_cast(bf16x8_t, w); }
            sum += __shfl_xor(sum, 16); sum += __shfl_xor(sum, 32);
            inv[hf] = 1.f / sum;
            __builtin_amdgcn_sched_barrier(0);
        }
        __syncthreads();
        att_stage(lds, Vl + (size_t)(h * 256) * 1024 + b * 256, 1024, tid);
        __syncthreads();
#pragma unroll
        for (int db = 0; db < 16; ++db) {
            f32x4 o0 = (f32x4){0.f, 0.f, 0.f, 0.f}, o1 = o0;
#pragma unroll
            for (int t = 0; t < 8; ++t) { const bf16x8_t af = *(const LAS bf16x8_t*)(fbase + db * 8192 + (((4 * t + kg) ^ j) << 4));
                o0 = __builtin_amdgcn_mfma_f32_16x16x32_bf16(af, pf[0][t], o0, 0, 0, 0); o1 = __builtin_amdgcn_mfma_f32_16x16x32_bf16(af, pf[1][t], o1, 0, 0, 0); }
            u32x2_t w; w.x = cvtpk(o0[0] * inv[0], o0[1] * inv[0]); w.y = cvtpk(o0[2] * inv[0], o0[3] * inv[0]);
            *(u32x2_t*)(orow + 16 * db + 4 * kg) = w;
            w.x = cvtpk(o1[0] * inv[1], o1[1] * inv[1]); w.y = cvtpk(o1[2] * inv[1], o1[3] * inv[1]);
            *(u32x2_t*)(orow + (size_t)128 * 1024 + 16 * db + 4 * kg) = w;
        }
        __syncthreads();
    }
}

__device__ __forceinline__ void conv_phase(LAS unsigned char* lds, const bf16_t* PROJ, const float* cw, const float* cb, const float* lg, const float* lb, bf16_t* MIXIN, int G, int tid) {
    LAS float* U = (LAS float*)lds;
    for (int u = blockIdx.x; u < M / 32; u += G) {
        asm volatile("" : "+v"(tid));
        const int lane = tid & 63, wave = __builtin_amdgcn_readfirstlane(tid >> 6);
        const int row0 = u * 32, t0 = row0 % SEQ;
        const int c = tid;
        float w[31];
#pragma unroll
        for (int k = 0; k < 31; ++k) w[k] = cw[k * 512 + c];
        const float bias = cb[c];
#pragma unroll
        for (int pass = 0; pass < 8; ++pass) { const int rr = pass * 8 + wave;
            if (rr < 62) { f32x4 o0 = (f32x4){0.f, 0.f, 0.f, 0.f}, o1 = o0;
                if (t0 - 30 + rr >= 0) { const u32x4 a = *(const u32x4*)(PROJ + (size_t)(row0 - 30 + rr) * PROJ_LD + 8 * lane);
                    o0 = (f32x4){__uint_as_float(a[0] << 16), __uint_as_float(a[0] & 0xffff0000u), __uint_as_float(a[1] << 16), __uint_as_float(a[1] & 0xffff0000u)};
                    o1 = (f32x4){__uint_as_float(a[2] << 16), __uint_as_float(a[2] & 0xffff0000u), __uint_as_float(a[3] << 16), __uint_as_float(a[3] & 0xffff0000u)}; }
                *(LAS f32x4*)(U + rr * 512 + 8 * lane) = o0; *(LAS f32x4*)(U + rr * 512 + 8 * lane + 4) = o1; } }
        __syncthreads();
        float y[32];
#pragma unroll
        for (int blk = 0; blk < 4; ++blk) { float win[38];
#pragma unroll
            for (int x = 0; x < 38; ++x) win[x] = U[(8 * blk + x) * 512 + c];
#pragma unroll
            for (int o = 0; o < 8; ++o) { float acc = bias;
#pragma unroll
                for (int k = 0; k < 31; ++k) acc += w[k] * win[o + k];
                y[8 * blk + o] = acc; } }
        __syncthreads();
#pragma unroll
        for (int tt = 0; tt < 32; ++tt) U[tt * 512 + c] = y[tt];
        __syncthreads();
#pragma unroll
        for (int q = 0; q < 4; ++q) { const int tt = 4 * wave + q;
            f32x4 a = *(const LAS f32x4*)(U + tt * 512 + 8 * lane), b = *(const LAS f32x4*)(U + tt * 512 + 8 * lane + 4);
            const float mean = wave_sum((a[0] + a[1]) + (a[2] + a[3]) + (b[0] + b[1]) + (b[2] + b[3])) * (1.f / 512.f);
            a = a - mean; b = b - mean;
            const float var = wave_sum((a[0] * a[0] + a[1] * a[1]) + (a[2] * a[2] + a[3] * a[3]) + (b[0] * b[0] + b[1] * b[1]) + (b[2] * b[2] + b[3] * b[3])) * (1.f / 512.f);
            const float rstd = rsqrtf(var + LN_EPS);
            a = a * rstd * *(const f32x4*)(lg + 8 * lane) + *(const f32x4*)(lb + 8 * lane); b = b * rstd * *(const f32x4*)(lg + 8 * lane + 4) + *(const f32x4*)(lb + 8 * lane + 4);
#pragma unroll
            for (int x = 0; x < 4; ++x) { a[x] = pg8::silu_fast(a[x]); b[x] = pg8::silu_fast(b[x]); }
            *(u32x4*)(MIXIN + (size_t)(row0 + tt) * D + 8 * lane) = pg8::pack8(a, b); }
        __syncthreads();
    }
}

typedef float f32x16_t __attribute__((ext_vector_type(16)));
constexpr int GP = 72;
__device__ __forceinline__ int slot32(int c) { const int w = c & 15; return (c & ~15) + 8 * ((w >> 2) & 1) + (w & 3) + 4 * (w >> 3); }
#define GLA_BAR() do { asm volatile("s_waitcnt lgkmcnt(0)" ::: "memory"); __builtin_amdgcn_s_barrier(); asm volatile("" ::: "memory"); } while (0)
__device__ __forceinline__ void gla_bcum(const u32x4 a0, const u32x4 a1, const float* wa2, const float* ba, int h, int lane, int wave, float (&bc)[8], float (&bl)[8]) {
    float al[16];
#pragma unroll
    for (int x = 0; x < 4; ++x) { al[2 * x] = __uint_as_float(a0[x] << 16); al[2 * x + 1] = __uint_as_float(a0[x] & 0xffff0000u); al[8 + 2 * x] = __uint_as_float(a1[x] << 16); al[8 + 2 * x + 1] = __uint_as_float(a1[x] & 0xffff0000u); }
#pragma unroll
    for (int x = 0; x < 8; ++x) { const int col = h * 64 + 8 * wave + x; float z = ba[col];
#pragma unroll
        for (int i = 0; i < 16; ++i) z += al[i] * wa2[i * 256 + col];
        float la = (fminf(z, 0.f) - __logf(1.f + __expf(-fabsf(z)))) * (1.f / 16.f);
        la += __builtin_bit_cast(float, __builtin_amdgcn_update_dpp(0, __builtin_bit_cast(int, la), 0x111, 0xf, 0xf, true));
        la += __builtin_bit_cast(float, __builtin_amdgcn_update_dpp(0, __builtin_bit_cast(int, la), 0x112, 0xf, 0xf, true));
        la += __builtin_bit_cast(float, __builtin_amdgcn_update_dpp(0, __builtin_bit_cast(int, la), 0x114, 0xf, 0xf, true));
        la += __builtin_bit_cast(float, __builtin_amdgcn_update_dpp(0, __builtin_bit_cast(int, la), 0x118, 0xf, 0xf, true));
        const float t0 = __builtin_bit_cast(float, __builtin_amdgcn_readlane(__builtin_bit_cast(int, la), 15)), t1 = __builtin_bit_cast(float, __builtin_amdgcn_readlane(__builtin_bit_cast(int, la), 31)),
                    t2 = __builtin_bit_cast(float, __builtin_amdgcn_readlane(__builtin_bit_cast(int, la), 47)), t3 = __builtin_bit_cast(float, __builtin_amdgcn_readlane(__builtin_bit_cast(int, la), 63));
        la += (lane >= 48) ? (t0 + t1) + t2 : (lane >= 32) ? t0 + t1 : (lane >= 16) ? t0 : 0.f;
        bc[x] = la; bl[x] = ((t0 + t1) + t2) + t3; }
}
__device__ __forceinline__ void unpack8(const u32x4 v, float (&f)[8]) {
#pragma unroll
    for (int x = 0; x < 4; ++x) { f[2 * x] = __uint_as_float(v[x] << 16); f[2 * x + 1] = __uint_as_float(v[x] & 0xffff0000u); }
}
struct G1In { u32x4 a0, a1, k, v0, v1; };
__device__ __forceinline__ G1In g1_load(const bf16_t* PROJ, const bf16_t* ALOW, int u, int lane, int wave) {
    const int bh = u >> 7, n = u & 127, b = bh >> 2, h = bh & 3, row0 = b * SEQ + n * 64;
    const bf16_t* pr = PROJ + (size_t)(row0 + lane) * PROJ_LD; const bf16_t* al = ALOW + (size_t)(row0 + lane) * 16;
    G1In r; r.a0 = *(const u32x4*)al; r.a1 = *(const u32x4*)(al + 8); r.k = *(const u32x4*)(pr + C_K + h * 64 + 8 * wave);
    r.v0 = *(const u32x4*)(pr + C_V + h * 128 + 8 * wave); r.v1 = *(const u32x4*)(pr + C_V + h * 128 + 64 + 8 * wave); return r;
}
__device__ __forceinline__ void gla_g1_phase(LAS unsigned char* lds, const bf16_t* PROJ, const bf16_t* ALOW, const float* wa2, const float* ba, float* UPD, float* DEC, int G, int tid) {
    LAS bf16_t* KD = (LAS bf16_t*)lds; LAS bf16_t* VT = (LAS bf16_t*)(lds + 18432);
    const int lane = tid & 63, wave = __builtin_amdgcn_readfirstlane(tid >> 6);
    G1In cur; if ((int)blockIdx.x < 2048) cur = g1_load(PROJ, ALOW, blockIdx.x, lane, wave);
    for (int u = blockIdx.x; u < 2048; u += G) {
        G1In nxt; if (u + G < 2048) nxt = g1_load(PROJ, ALOW, u + G, lane, wave);
        const int bh = u >> 7, h = bh & 3;
        float bc[8], bl[8];
        gla_bcum(cur.a0, cur.a1, wa2, ba, h, lane, wave, bc, bl);
        float kf[8]; unpack8(cur.k, kf);
#pragma unroll
        for (int x = 0; x < 8; ++x) KD[(8 * wave + x) * GP + lane] = f2bf(kf[x] * __expf(bl[x] - bc[x]));
        if (lane == 63) {
#pragma unroll
            for (int x = 0; x < 8; ++x) DEC[u * 64 + 8 * wave + x] = __expf(bl[x]); }
#pragma unroll
        for (int pc = 0; pc < 2; ++pc) { const int e0 = 64 * pc + 8 * wave; const u32x4 v = pc ? cur.v1 : cur.v0;
#pragma unroll
            for (int x = 0; x < 4; ++x) { VT[(e0 + 2 * x) * GP + lane] = (bf16_t)(v[x] & 0xffffu); VT[(e0 + 2 * x + 1) * GP + lane] = (bf16_t)(v[x] >> 16); } }
        GLA_BAR();
        const int eb = wave >> 1, dbk = wave & 1, i = lane & 31, kg = lane >> 5;
        f32x16_t acc;
#pragma unroll
        for (int r = 0; r < 16; ++r) acc[r] = 0.f;
#pragma unroll
        for (int s = 0; s < 4; ++s) { const bf16x8_t af = *(const LAS bf16x8_t*)(VT + (32 * eb + i) * GP + 16 * s + 8 * kg), bfr = *(const LAS bf16x8_t*)(KD + (32 * dbk + i) * GP + 16 * s + 8 * kg);
            acc = __builtin_amdgcn_mfma_f32_32x32x16_bf16(af, bfr, acc, 0, 0, 0); }
        float* up = UPD + ((size_t)u * 128 + 32 * eb + 4 * kg) * 64 + 32 * dbk + i;
#pragma unroll
        for (int r = 0; r < 16; ++r) up[((r & 3) + 8 * (r >> 2)) * 64] = acc[r];
        GLA_BAR();
        cur = nxt;
    }
}
__device__ __forceinline__ void gla_g2_phase(const float* UPD, bf16_t* SP, const float* DEC, int G, int tid) {
    for (int g = blockIdx.x * 512 + tid; g < 16 * 8192; g += G * 512) {
        const int bh = g >> 13, ed = g & 8191, d = g & 63;
        const float* p = UPD + (size_t)bh * 128 * 8192 + ed; bf16_t* po = SP + (size_t)bh * 128 * 8192 + ed; const float* dc = DEC + bh * 128 * 64 + d;
        float S = 0.f;
        for (int n0 = 0; n0 < 128; n0 += 16) { float uu[16], dd[16];
#pragma unroll
            for (int x = 0; x < 16; ++x) { uu[x] = p[(size_t)(n0 + x) * 8192]; dd[x] = dc[(n0 + x) * 64]; }
#pragma unroll
            for (int x = 0; x < 16; ++x) { po[(size_t)(n0 + x) * 8192] = f2bf(S); S = dd[x] * S + uu[x]; } }
    }
}
struct G3In { u32x4 a0, a1, q, k, v0, v1; bf16x8_t sp[4]; u32x2_t rr[4]; };
__device__ __forceinline__ G3In g3_load(const bf16_t* PROJ, const bf16_t* ALOW, const bf16_t* SPV, int u, int lane, int wave) {
    const int bh = u >> 7, n = u & 127, b = bh >> 2, h = bh & 3, row0 = b * SEQ + n * 64;
    const int eb = wave >> 1, cb = wave & 1, i = lane & 31, kg = lane >> 5;
    const bf16_t* pr = PROJ + (size_t)(row0 + lane) * PROJ_LD; const bf16_t* al = ALOW + (size_t)(row0 + lane) * 16;
    G3In r; r.a0 = *(const u32x4*)al; r.a1 = *(const u32x4*)(al + 8); r.q = *(const u32x4*)(pr + C_Q + h * 64 + 8 * wave); r.k = *(const u32x4*)(pr + C_K + h * 64 + 8 * wave);
    r.v0 = *(const u32x4*)(pr + C_V + h * 128 + 8 * wave); r.v1 = *(const u32x4*)(pr + C_V + h * 128 + 64 + 8 * wave);
    const bf16_t* sp = SPV + ((size_t)u * 128 + 32 * eb + i) * 64 + 8 * kg;
#pragma unroll
    for (int s = 0; s < 4; ++s) r.sp[s] = *(const bf16x8_t*)(sp + 16 * s);
    const bf16_t* rp = PROJ + (size_t)(row0 + 32 * cb + i) * PROJ_LD + C_R + h * 128 + 32 * eb + 4 * kg;
#pragma unroll
    for (int rg = 0; rg < 4; ++rg) r.rr[rg] = *(const u32x2_t*)(rp + 8 * rg);
    return r;
}
__device__ __forceinline__ void gla_g3_phase(LAS unsigned char* lds, const bf16_t* PROJ, const bf16_t* ALOW, const float* wa2, const float* ba, const float* gn, const bf16_t* UPD, bf16_t* MIXIN, int G, int tid) {
    LAS bf16_t* KE = (LAS bf16_t*)lds; LAS bf16_t* QE = (LAS bf16_t*)(lds + 9216); LAS bf16_t* VT = (LAS bf16_t*)(lds + 18432); LAS float* RED = (LAS float*)(lds + 36864);
    const int lane = tid & 63, wave = __builtin_amdgcn_readfirstlane(tid >> 6);
    const int eb = wave >> 1, cb = wave & 1, i = lane & 31, kg = lane >> 5;
    G3In cur; if ((int)blockIdx.x < 2048) cur = g3_load(PROJ, ALOW, UPD, blockIdx.x, lane, wave);
    for (int u = blockIdx.x; u < 2048; u += G) {
        G3In nxt; if (u + G < 2048) nxt = g3_load(PROJ, ALOW, UPD, u + G, lane, wave);
        const int bh = u >> 7, n = u & 127, b = bh >> 2, h = bh & 3, row0 = b * SEQ + n * 64;
        const size_t row = (size_t)(row0 + 32 * cb + i);
        { float bc[8], bl[8];
          gla_bcum(cur.a0, cur.a1, wa2, ba, h, lane, wave, bc, bl);
          float qf[8], kf[8]; unpack8(cur.q, qf); unpack8(cur.k, kf);
          f32x4 q0, q1, k0, k1;
#pragma unroll
          for (int x = 0; x < 4; ++x) { q0[x] = qf[x] * 0.125f * __expf(bc[x]); q1[x] = qf[4 + x] * 0.125f * __expf(bc[4 + x]); k0[x] = kf[x] * __expf(-bc[x]); k1[x] = kf[4 + x] * __expf(-bc[4 + x]); }
          *(LAS u32x4*)(QE + lane * GP + 8 * wave) = pg8::pack8(q0, q1); *(LAS u32x4*)(KE + lane * GP + 8 * wave) = pg8::pack8(k0, k1);
          const int pcol = slot32(lane);
#pragma unroll
          for (int pc = 0; pc < 2; ++pc) { const int e0 = 64 * pc + 8 * wave; const u32x4 v = pc ? cur.v1 : cur.v0;
#pragma unroll
              for (int x = 0; x < 4; ++x) { VT[(e0 + 2 * x) * GP + pcol] = (bf16_t)(v[x] & 0xffffu); VT[(e0 + 2 * x + 1) * GP + pcol] = (bf16_t)(v[x] >> 16); } } }
        GLA_BAR();
        bf16x8_t qb[4];
#pragma unroll
        for (int s = 0; s < 4; ++s) qb[s] = *(const LAS bf16x8_t*)(QE + (32 * cb + i) * GP + 16 * s + 8 * kg);
        f32x16_t o;
#pragma unroll
        for (int r = 0; r < 16; ++r) o[r] = 0.f;
#pragma unroll
        for (int sb = 0; sb < 2; ++sb) if (sb <= cb) {
            f32x16_t at;
#pragma unroll
            for (int r = 0; r < 16; ++r) at[r] = 0.f;
#pragma unroll
            for (int s = 0; s < 4; ++s) { const bf16x8_t af = *(const LAS bf16x8_t*)(KE + (32 * sb + i) * GP + 16 * s + 8 * kg); at = __builtin_amdgcn_mfma_f32_32x32x16_bf16(af, qb[s], at, 0, 0, 0); }
            if (sb == cb) {
#pragma unroll
                for (int r = 0; r < 16; ++r) if ((r & 3) + 8 * (r >> 2) + 4 * kg > i) at[r] = 0.f; }
#pragma unroll
            for (int sp = 0; sp < 2; ++sp) { u32x4 w; w.x = cvtpk(at[8 * sp + 0], at[8 * sp + 1]); w.y = cvtpk(at[8 * sp + 2], at[8 * sp + 3]); w.z = cvtpk(at[8 * sp + 4], at[8 * sp + 5]); w.w = cvtpk(at[8 * sp + 6], at[8 * sp + 7]);
                const bf16x8_t af = *(const LAS bf16x8_t*)(VT + (32 * eb + i) * GP + 32 * sb + 16 * sp + 8 * kg);
                o = __builtin_amdgcn_mfma_f32_32x32x16_bf16(af, __builtin_bit_cast(bf16x8_t, w), o, 0, 0, 0); }
        }
#pragma unroll
        for (int s = 0; s < 4; ++s) o = __builtin_amdgcn_mfma_f32_32x32x16_bf16(cur.sp[s], qb[s], o, 0, 0, 0);
        float ss = 0.f;
#pragma unroll
        for (int r = 0; r < 16; ++r) ss += o[r] * o[r];
        ss += __shfl_xor(ss, 32);
        if (kg == 0) RED[eb * 64 + 32 * cb + i] = ss;
        GLA_BAR();
        const float tot = (RED[32 * cb + i] + RED[64 + 32 * cb + i]) + (RED[128 + 32 * cb + i] + RED[192 + 32 * cb + i]);
        const float rstd = rsqrtf(tot * (1.f / 128.f) + LN_EPS);
#pragma unroll
        for (int rg = 0; rg < 4; ++rg) { const int e = 32 * eb + 8 * rg + 4 * kg;
            const f32x4 g4 = *(const f32x4*)(gn + e); const u32x2_t rr = cur.rr[rg];
            const float r0 = __uint_as_float(rr.x << 16), r1 = __uint_as_float(rr.x & 0xffff0000u), r2 = __uint_as_float(rr.y << 16), r3 = __uint_as_float(rr.y & 0xffff0000u);
            u32x2_t w; w.x = cvtpk(o[4 * rg] * rstd * g4[0] * pg8::silu_fast(r0), o[4 * rg + 1] * rstd * g4[1] * pg8::silu_fast(r1));
            w.y = cvtpk(o[4 * rg + 2] * rstd * g4[2] * pg8::silu_fast(r2), o[4 * rg + 3] * rstd * g4[3] * pg8::silu_fast(r3));
            *(u32x2_t*)(MIXIN + row * D + 512 + h * 128 + e) = w; }
        GLA_BAR();
        cur = nxt;
    }
}

#ifndef PROBE_MASK
#define PROBE_MASK 0
#endif
#ifndef ONE_LAUNCH
#define ONE_LAUNCH 1
#endif
constexpr int NPL = 10, NPH = 2 + NPL * DEPTH + 1;
enum { PK_IN = 0, PK_CG1, PK_G2, PK_G3, PK_MIX, PK_Q, PK_ATT, PK_XO, PK_FF1, PK_FF2 };
constexpr int CSN = 9472, CS_IN = 0, CS_Q = 2816, CS_FF1 = 3840;

__global__ void __launch_bounds__(NWAVES * 64) mega(Args a) {
    extern __shared__ __attribute__((aligned(16))) unsigned char lds_raw[];
    LAS unsigned char* lds = (LAS unsigned char*)lds_raw;
    const int wave = __builtin_amdgcn_readfirstlane(threadIdx.x >> 6);
    const int G = gridDim.x, gw = blockIdx.x * NWAVES + wave, NGW = G * NWAVES;
    unsigned char* ws = a.ws;
#define INP(k) ({ int k_ = (k); asm volatile("" : "+s"(k_)); a.in[k_]; })
    float* Y = a.out;
    bf16_t* WT = (bf16_t*)(ws + WS_WT); bf16_t* YB = (bf16_t*)(ws + WS_HB); bf16_t* PROJ = (bf16_t*)(ws + WS_PROJ); bf16_t* ALOW = (bf16_t*)(ws + WS_ALOW);
    bf16_t* MIXIN = (bf16_t*)(ws + WS_MIXIN); bf16_t* Qb = (bf16_t*)(ws + WS_Q); bf16_t* ACT = (bf16_t*)(ws + WS_ACT);
    bf16_t* Kb = (bf16_t*)(ws + WS_K); bf16_t* Vt = (bf16_t*)(ws + WS_VT); bf16_t* MEMB = (bf16_t*)(ws + WS_MEMB); bf16_t* MEMP = (bf16_t*)(ws + WS_MEMP);
    float* UPD = (float*)(ws + WS_UPD); float* DEC = (float*)(ws + WS_DEC);
    float* CSP = (float*)(ws + WS_CSP); float* CS = (float*)(ws + WS_CS); float* MUR = (float*)(ws + WS_MUR);
    unsigned long long* SLOTS = (unsigned long long*)(ws + WS_SLOTS); unsigned* CNT = (unsigned*)(ws + WS_CNT);

    volatile LAS unsigned* bst = (volatile LAS unsigned*)(lds + 143360);
    if (threadIdx.x == 0) { bst[0] = 0u; bst[1] = 0u; }
    __syncthreads();
    XcdBarrier xbar; xbar.bar = (unsigned*)(ws + WS_BAR); xbar.x = 0; xbar.st = bst;
    if (a.ph_hi - a.ph_lo > 1) xbar = xcd_barrier_post((unsigned*)(ws + WS_BAR), bst);
    for (int p = a.ph_lo; p < a.ph_hi; ++p) {
      const int pkind = (p < 2 || p == NPH - 1) ? -1 : (p - 2) % NPL;
      int nrep = 1;
      if ((a.sub & 4) && (pkind == PK_IN || pkind == PK_Q || pkind == PK_FF1)) nrep = 2;
      if ((a.sub & (8 | 8192)) && pkind == PK_CG1) nrep = 2;
      if ((a.sub & 16384) && pkind == PK_G3) nrep = 2;
      if ((a.sub & 16) && pkind == PK_ATT) nrep = 2;
      if ((a.sub & 64) && p < 2) nrep = 2;
      for (int rep = 0; rep < nrep; ++rep) {
        const bool dummy = rep + 1 < nrep;
        int tid; asm volatile("v_mbcnt_lo_u32_b32 %0, -1, 0\n\tv_mbcnt_hi_u32_b32 %0, -1, %0\n\tv_lshl_or_b32 %0, %1, 6, %0" : "=&v"(tid) : "s"(wave));
        const int lane = tid & 63;
        if (p == 0) {
            LAS float* scr = (LAS float*)(lds + wave * 16384);
            if (blockIdx.x == 0) { CNT[tid] = 0u; CNT[512 + tid] = 0u; CNT[1024 + tid] = 0u; }
            for (int it = gw; it < DEPTH * I_LAYER; it += NGW) {
                const int l = it / I_LAYER; int r = it % I_LAYER;
                bf16_t* WL = WT + WT_L0 + (size_t)l * WT_LSTRIDE;
                float* cspl = CSP + (size_t)l * 2 * 16 * CSN;
                if (r < I_IN) { const int kb = r / 81, n0 = 32 * (r % 81); const float* gg = l == 0 ? INP(2) : INP(22) + (l - 1) * D; const float* bb = l == 0 ? INP(3) : INP(23) + (l - 1) * D;
                    const int drow = n0 < 512 ? 256 * (n0 / 128) + n0 % 128 : n0 < 1024 ? 256 * ((n0 - 512) / 128) + 128 + (n0 - 512) % 128 : n0;
                    cvt_item_ln(INP(4) + (size_t)l * 1024 * IN_COLS, 1024, IN_COLS, 64 * kb, n0, WL + WO_IN + (size_t)drow * 1024, scr, lane, gg, bb, cspl + kb * CSN + CS_IN + drow, cspl + (16 + kb) * CSN + CS_IN + drow); continue; } r -= I_IN;
                if (r < I_SQ) { const int kb = r / 32, nb = r % 32; cvt_item(INP(12) + (size_t)l * 1024 * 1024, 1024, 1024, 64 * kb, 32 * nb, WL + WO_MIX + (size_t)(32 * nb) * 1024, scr, lane); continue; } r -= I_SQ;
                if (r < I_SQ) { const int kb = r / 32, nb = r % 32;
                    cvt_item_ln(INP(15) + (size_t)l * 1024 * 1024, 1024, 1024, 64 * kb, 32 * nb, WL + WO_XQ + (size_t)(32 * nb) * 1024, scr, lane, INP(13) + l * D, INP(14) + l * D, cspl + kb * CSN + CS_Q + 32 * nb, cspl + (16 + kb) * CSN + CS_Q + 32 * nb); continue; } r -= I_SQ;
                if (r < I_SQ) { const int kb = r / 32, nb = r % 32; cvt_item(INP(17) + (size_t)l * 1024 * 1024, 1024, 1024, 64 * kb, 32 * nb, WL + WO_XO + (size_t)(32 * nb) * 1024, scr, lane); continue; } r -= I_SQ;
                if (r < I_XKV) { const int kb = r / 64, n0 = 32 * (r % 64);
                    bf16_t* dst = n0 < 1024 ? WT + WT_XK + (size_t)(l * 1024 + n0) * 1024 : WT + WT_XV + (size_t)(l * 1024 + n0 - 1024) * 1024;
                    cvt_item(INP(16) + (size_t)l * 1024 * 2048, 1024, 2048, 64 * kb, n0, dst, scr, lane); continue; } r -= I_XKV;
                if (r < I_FF1) { const int kb = r / 176, n0 = 32 * (r % 176);
                    const int drow = n0 < D_FF ? 256 * (n0 / 128) + n0 % 128 : 256 * ((n0 - D_FF) / 128) + 128 + (n0 - D_FF) % 128;
                    cvt_item_ln(INP(20) + (size_t)l * 1024 * 2 * D_FF, 1024, 2 * D_FF, 64 * kb, n0, WL + WO_FF1 + (size_t)drow * 1024, scr, lane, INP(18) + l * D, INP(19) + l * D, cspl + kb * CSN + CS_FF1 + drow, cspl + (16 + kb) * CSN + CS_FF1 + drow); continue; } r -= I_FF1;
                { const int kb = r / 32, nb = r % 32; cvt_item(INP(21) + (size_t)l * D_FF * 1024, D_FF, 1024, 64 * kb, 32 * nb, WL + WO_FF2 + (size_t)(32 * nb) * D_FF, scr, lane); }
            }
            for (int i = blockIdx.x * 512 + tid; i < 1024 * 1024; i += G * 512) {
                const int row = i >> 10, c = i & 1023, b = row >> 8, key = row & 255; const bf16_t v = f2bf(INP(1)[i]);
                MEMB[i] = v; MEMP[(size_t)(b * 256 + slot_of_key(key)) * 1024 + c] = v; }
            { const float* xin = INP(0);
              for (int m = gw; m < M; m += 2 * NGW) { x_row(xin + (size_t)m * D, YB + (size_t)m * D, MUR + 2 * (size_t)m, lane);
                  if (m + NGW < M) x_row(xin + (size_t)(m + NGW) * D, YB + (size_t)(m + NGW) * D, MUR + 2 * (size_t)(m + NGW), lane); } }
        } else if (p == 1) {
            for (int i = blockIdx.x * 512 + tid; i < DEPTH * 2 * CSN; i += G * 512) { const int lc = i / CSN, c = i % CSN; const float* pp = CSP + (size_t)lc * 16 * CSN + c; float s = 0.f;
#pragma unroll
                for (int kb = 0; kb < 16; ++kb) s += pp[kb * CSN];
                CS[i] = s; }
            const int half = G / 2;
            if ((int)blockIdx.x < half) { pg8::Gemm g{MEMB, WT + WT_XK, 1024, 4096, 1024}; pg8::StaticOrderT<1024, 4096> S; S.init(half, (int)blockIdx.x);
                pg8::EpiBf16 E{Kb, 4096}; pg8::gemm_phase<pg8::EpiBf16, pg8::StaticOrderT<1024, 4096>, true, true, 1024>(lds, g, S, E, tid); }
            else { pg8::Gemm g{WT + WT_XV, MEMP, 4096, 1024, 1024}; pg8::StaticOrderT<4096, 1024> S; S.init(G - half, (int)blockIdx.x - half);
                pg8::EpiBf16 E{Vt, 1024}; pg8::gemm_phase<pg8::EpiBf16, pg8::StaticOrderT<4096, 1024>, true, true, 1024>(lds, g, S, E, tid); }
        } else if (p == NPH - 1) {
            const float* gg = INP(22) + (DEPTH - 1) * D; const float* bb = INP(23) + (DEPTH - 1) * D;
            for (int m = gw; m < M; m += NGW) ln_row_f32(Y + (size_t)m * D, gg, bb, lane);
        } else {
            const int l = (p - 2) / NPL, kind = (p - 2) % NPL;
            const bf16_t* WL = WT + WT_L0 + (size_t)l * WT_LSTRIDE;
            const float* csl = CS + (size_t)l * 2 * CSN; const float* cbl = csl + CSN;
            if (kind == PK_IN) { pg8::Gemm g{YB, WL + WO_IN, M, 2560, 1024}; pg8::StaticOrderT<M, 2560> S; S.init(G, (int)blockIdx.x);
                pg8::EpiInLN E{PROJ, MUR, csl + CS_IN, cbl + CS_IN}; pg8::gemm_phase<pg8::EpiInLN, pg8::StaticOrderT<M, 2560>, true, true, 1024>(lds, g, S, E, tid);
                alow_rows(YB, WL + WO_IN + (size_t)2560 * 1024, MUR, csl + CS_IN + 2560, cbl + CS_IN + 2560, ALOW, gw, NGW, lane); }
            else if (kind == PK_CG1) {
                if ((a.sub & 1) && !(dummy && (a.sub & 8192))) conv_phase(lds, PROJ, INP(7) + l * 31 * 512, INP(8) + l * 512, INP(9) + l * 512, INP(10) + l * 512, MIXIN, G, tid);
                if ((a.sub & 2) && !(dummy && (a.sub & 8))) gla_g1_phase(lds, PROJ, ALOW, INP(5) + l * 16 * 256, INP(6) + l * 256, UPD, DEC, G, tid); }
            else if (kind == PK_G2) { gla_g2_phase(UPD, (bf16_t*)a.out, DEC, G, tid); }
            else if (kind == PK_G3) { gla_g3_phase(lds, PROJ, ALOW, INP(5) + l * 16 * 256, INP(6) + l * 256, INP(11) + l * 128, (const bf16_t*)a.out, MIXIN, G, tid); }
            else if (kind == PK_MIX || kind == PK_XO) {
                const bool mix = kind == PK_MIX;
                pg8::Gemm g{mix ? MIXIN : Qb, WL + (mix ? WO_MIX : WO_XO), M, 1024, 1024}; pg8::StaticOrderT<M, 1024> S; S.init(G, (int)blockIdx.x);
                const float* gp = mix ? (l == 0 ? INP(2) : INP(22) + (l - 1) * D) : INP(13) + l * D; const float* bp = mix ? (l == 0 ? INP(3) : INP(23) + (l - 1) * D) : INP(14) + l * D;
                pg8::EpiResLN E{(mix && l == 0) ? INP(0) : nullptr, nullptr, YB, MUR, gp, bp, SLOTS, CNT + (3 * l + (mix ? 0 : 1)) * 128, ALPHA, lds};
                pg8::gemm_phase<pg8::EpiResLN, pg8::StaticOrderT<M, 1024>, true, true, 1024>(lds, g, S, E, tid); }
            else if (kind == PK_Q) { pg8::Gemm g{YB, WL + WO_XQ, M, 1024, 1024}; pg8::StaticOrderT<M, 1024> S; S.init(G, (int)blockIdx.x);
                pg8::EpiBf16LN E{Qb, 1024, MUR, csl + CS_Q, cbl + CS_Q}; pg8::gemm_phase<pg8::EpiBf16LN, pg8::StaticOrderT<M, 1024>, true, true, 1024>(lds, g, S, E, tid); }
            else if (kind == PK_ATT) { att_phase(lds, Kb + l * 1024, Vt + (size_t)l * 1024 * 1024, Qb, dummy ? MIXIN : Qb, G, tid); }
            else if (kind == PK_FF1) { pg8::Gemm g{YB, WL + WO_FF1, M, 2 * D_FF, 1024}; pg8::StaticOrderT<M, 2 * D_FF> S; S.init(G, (int)blockIdx.x);
                pg8::EpiSwigluLN E{ACT, MUR, csl + CS_FF1, cbl + CS_FF1}; pg8::gemm_phase<pg8::EpiSwigluLN, pg8::StaticOrderT<M, 2 * D_FF>, true, true, 1024>(lds, g, S, E, tid); }
            else { pg8::Gemm g{ACT, WL + WO_FF2, M, 1024, D_FF}; pg8::StaticOrderT<M, 1024> S; S.init(G, (int)blockIdx.x);
                pg8::EpiResLN E{nullptr, l == DEPTH - 1 ? Y : nullptr, YB, MUR, INP(18) + l * D, INP(19) + l * D, SLOTS, CNT + (3 * l + 2) * 128, ALPHA, lds};
                pg8::gemm_phase<pg8::EpiResLN, pg8::StaticOrderT<M, 1024>, true, true, D_FF>(lds, g, S, E, tid); }
        }
      }
        if (p + 1 < a.ph_hi) { if (p == 0) cg::this_grid().sync(); else xcd_barrier(xbar); if (a.sub & 256) xcd_barrier(xbar); if (a.sub & 512) xcd_barrier_v<false, false>(xbar); }
    }
}

#undef INP
extern "C" void kernel_launch(void* const* d_in, const int* in_sizes, int n_in, void* d_out, int out_size, void* d_ws, size_t ws_size, hipStream_t stream) {
    if (n_in != 24 || out_size != M * D || ws_size < WS_END) { fprintf(stderr, "kernel_launch: unexpected shapes (n_in %d out %d ws %zu)\n", n_in, out_size, ws_size); return; }
    static int grid = 0;
    if (grid == 0) {
        int dev = 0, cus = 0, per_cu = 0;
        (void)hipGetDevice(&dev); (void)hipDeviceGetAttribute(&cus, hipDeviceAttributeMultiprocessorCount, dev);
        if (hipFuncSetAttribute((const void*)mega, hipFuncAttributeMaxDynamicSharedMemorySize, LDS_BYTES) != hipSuccess) { fprintf(stderr, "kernel_launch: hipFuncSetAttribute failed\n"); grid = -1; return; }
        if (hipOccupancyMaxActiveBlocksPerMultiprocessor(&per_cu, (const void*)mega, NWAVES * 64, LDS_BYTES) != hipSuccess || per_cu < 1) { fprintf(stderr, "kernel_launch: occupancy query says %d\n", per_cu); per_cu = 1; }
        (void)hipGetLastError();
        grid = cus;
    }
    if (grid < 0) return;
    Args a{};
    for (int i = 0; i < 24; ++i) a.in[i] = (const float*)d_in[i];
    a.out = (float*)d_out; a.ws = (unsigned char*)d_ws;
#if ONE_LAUNCH
    if (hipMemsetAsync((char*)d_ws + WS_BAR, 0, 16384, stream) != hipSuccess) { fprintf(stderr, "kernel_launch: memset of the barrier words failed\n"); return; }
    a.ph_lo = 0; a.ph_hi = NPH; a.sub = 3 | PROBE_MASK;
    void* kargs[] = {&a};
    hipError_t e = hipLaunchCooperativeKernel((const void*)mega, dim3(grid), dim3(NWAVES * 64), kargs, LDS_BYTES, stream);
    if (e != hipSuccess) fprintf(stderr, "kernel_launch: cooperative launch failed: %s\n", hipGetErrorString(e));
#else
    for (int p = 0; p < NPH; ++p) { a.ph_lo = p; a.ph_hi = p + 1; a.sub = 3; hipLaunchKernelGGL(mega, dim3(grid), dim3(NWAVES * 64), LDS_BYTES, stream, a); }
#endif
}
```

```cpp
#include <hip/hip_runtime.h>
#include <hip/hip_cooperative_groups.h>
#include <cstdio>
#include <cstdint>

typedef unsigned short bf16_t;
typedef unsigned u32x4 __attribute__((ext_vector_type(4)));
typedef float f32x4 __attribute__((ext_vector_type(4)));

constexpr int D = 1024, BATCH = 4, SEQ = 8192, DEPTH = 4, M = BATCH * SEQ;
constexpr int IN_COLS = 2576, PROJ_LD = 2560, MEM_LEN = 256, D_FF = 2816;
constexpr int C_CA = 0, C_CG = 512, C_Q = 1024, C_K = 1280, C_V = 1536, C_R = 2048, C_AL = 2560;
constexpr float LN_EPS = 1e-5f;
constexpr float ALPHA = 1.681792830507429f;

constexpr size_t MiB = 1u << 20;
constexpr size_t WS_CTL = 0;
constexpr size_t WS_K = 8 * MiB;
constexpr size_t WS_VT = 16 * MiB;
constexpr size_t WS_MEMB = 24 * MiB;
constexpr size_t WS_MEMP = 26 * MiB;
constexpr size_t WS_ALOW = 28 * MiB;
constexpr size_t WS_DEC = 29 * MiB;
constexpr size_t WS_CNT = 0;
constexpr size_t WS_BAR = 65536;
constexpr size_t WS_CSP = 1 * MiB;
constexpr size_t WS_CS = 6 * MiB;
constexpr size_t WS_SLOTS = 30 * MiB;
constexpr size_t WS_MUR = 31 * MiB;
constexpr size_t WS_WT = 32 * MiB;
constexpr size_t WS_HB = 160 * MiB;
constexpr size_t WS_PROJ = 224 * MiB;
constexpr size_t WS_Q = 224 * MiB;
constexpr size_t WS_ACT = 224 * MiB;
constexpr size_t WS_UPD = 384 * MiB;
constexpr size_t WS_MIXIN = 448 * MiB;
constexpr size_t WS_END = 512 * MiB;

__host__ __device__ __forceinline__ int key_of_slot(int p) { const int e = p & 7, kg = (p >> 3) & 3; return (p & ~31) + 16 * (e >> 2) + 4 * kg + (e & 3); }
__host__ __device__ __forceinline__ int slot_of_key(int k) { const int w = k & 31; return (k & ~31) + 8 * ((w >> 2) & 3) + 4 * (w >> 4) + (w & 3); }

__device__ __forceinline__ float bf2f(bf16_t b) { return __uint_as_float(((unsigned)b) << 16); }
__device__ __forceinline__ bf16_t f2bf(float f) { unsigned u = __float_as_uint(f); return (bf16_t)((u + 0x7fffu + ((u >> 16) & 1u)) >> 16); }
__device__ __forceinline__ float ldf(const float* p) { return *p; }
__device__ __forceinline__ float ldf(const bf16_t* p) { return bf2f(*p); }
__device__ __forceinline__ float sigmoidf_(float x) { return 1.f / (1.f + __expf(-x)); }
__device__ __forceinline__ float siluf_(float x) { return x / (1.f + __expf(-x)); }
__device__ __forceinline__ float wave_sum(float v) {
#pragma unroll
    for (int o = 1; o < 64; o <<= 1) v += __shfl_xor(v, o);
    return v;
}
__device__ __forceinline__ float wave_max(float v) {
#pragma unroll
    for (int o = 1; o < 64; o <<= 1) v = fmaxf(v, __shfl_xor(v, o));
    return v;
}

namespace pg8 {
#define PG8_LAS __attribute__((address_space(3)))
typedef unsigned short bf16_t;
typedef short bf16x8 __attribute__((ext_vector_type(8)));
typedef float f32x4 __attribute__((ext_vector_type(4)));
typedef unsigned u32x4 __attribute__((ext_vector_type(4)));
constexpr int BM = 256, BK = 64, HALF = 128, HTB = HALF * BK * 2  , STAGE_BYTES = 8 * HTB, NXCD = 8, WGM = 8;

__host__ __device__ __forceinline__ int lds_byte(int r, int c) { const int st = (r >> 4) * 2 + (c >> 5), rr = r & 15, cc = c & 31, ob = rr * 64 + cc * 2; return st * 1024 + (ob ^ (((ob >> 9) & 1) << 5)); }
__host__ __device__ __forceinline__ void stage_rc(int b, int& R, int& C) { const int st = b / 1024, sb = b % 1024, swz = sb ^ (((sb >> 9) & 1) << 5); R = (st >> 1) * 16 + swz / 64; C = (st & 1) * 32 + (swz % 64) / 2; }
__host__ __device__ __forceinline__ int perm32(int rho) { const int n = rho >> 4, i = rho & 15; return 8 * (i >> 2) + 4 * n + (i & 3); }

struct Unit { int pm, pn; };
struct Gemm { const bf16_t* A; const bf16_t* Bt; int M, N, K; };

struct StaticOrder {
    int nM, nN, nwg, G, c;
    __host__ __device__ void init(int M, int N, int G_, int c_) { nM = M / BM; nN = N / BM; nwg = nM * nN; G = G_; c = c_; }
    __host__ __device__ bool next(int i, Unit& u) const {
        const long L = (long)i * G + c; if (L >= nwg) return false;
        int wgid = (int)L; { const int q = nwg / NXCD, r = nwg % NXCD, xcd = wgid % NXCD, off = wgid / NXCD; wgid = (xcd < r ? xcd * (q + 1) : r * (q + 1) + (xcd - r) * q) + off; }
        const int nig = WGM * nN, gid = wgid / nig, fm = gid * WGM, gsz = (nM - fm) < WGM ? (nM - fm) : WGM;
        u.pm = fm + ((wgid % nig) % gsz); u.pn = (wgid % nig) / gsz; return true;
    }
    __device__ __forceinline__ void a_ready(const Unit&) const {}
    __device__ __forceinline__ void done(const Unit&) const {}
};


template <int MM, int NN> struct StaticOrderT {
    static constexpr int nM = MM / BM, nN = NN / BM, nwg = nM * nN;
    int G, c;
    __host__ __device__ void init(int G_, int c_) { G = G_; c = c_; }
    __host__ __device__ bool next(int i, Unit& u) const {
        const long L = (long)i * G + c; if (L >= nwg) return false;
        int wgid = (int)L; { constexpr int q = nwg / NXCD, r = nwg % NXCD; const int xcd = wgid % NXCD, off = wgid / NXCD; wgid = (xcd < r ? xcd * (q + 1) : r * (q + 1) + (xcd - r) * q) + off; }
        constexpr int nig = WGM * nN; const int gid = wgid / nig, fm = gid * WGM, gsz = (nM - fm) < WGM ? (nM - fm) : WGM;
        u.pm = fm + ((wgid % nig) % gsz); u.pn = (wgid % nig) / gsz; return true;
    }
    __device__ __forceinline__ void a_ready(const Unit&) const {}
    __device__ __forceinline__ void done(const Unit&) const {}
};
typedef float f32x2 __attribute__((ext_vector_type(2)));
__device__ __forceinline__ unsigned cvt_pk_bf16(float lo, float hi) { unsigned r; asm volatile("v_cvt_pk_bf16_f32 %0, %1, %2" : "=v"(r) : "v"(lo), "v"(hi)); return r; }
__device__ __forceinline__ u32x4 pack8(const f32x4 v0, const f32x4 v1) { u32x4 w; w.x = cvt_pk_bf16(v0[0], v0[1]); w.y = cvt_pk_bf16(v0[2], v0[3]); w.z = cvt_pk_bf16(v1[0], v1[1]); w.w = cvt_pk_bf16(v1[2], v1[3]); return w; }
__device__ __forceinline__ float silu_fast(float x) { return x * __builtin_amdgcn_rcpf(1.f + __expf(-x)); }
struct EpiBf16 {
    static constexpr bool PERM = true, AFTER_DRAIN = false;
    bf16_t* O; int ldc;
    __device__ __forceinline__ void operator()(const f32x4 (&acc)[2][2][4][2], const Unit& u, int wr, int wc, int fr, int fq) const {
        const int row0 = u.pm * BM + wr * 64 + fr, col0 = u.pn * BM + wc * 32 + 8 * fq;
#pragma unroll
        for (int ai = 0; ai < 2; ++ai)
#pragma unroll
            for (int m = 0; m < 4; ++m) { bf16_t* rowp = O + (size_t)(row0 + ai * HALF + m * 16) * ldc + col0;
#pragma unroll
                for (int bj = 0; bj < 2; ++bj) *(u32x4*)(rowp + bj * HALF) = pack8(acc[ai][bj][m][0], acc[ai][bj][m][1]); }
    }
};
struct EpiProj {
    static constexpr bool PERM = true, AFTER_DRAIN = false;
    bf16_t* O; bf16_t* AL;
    __device__ __forceinline__ void operator()(const f32x4 (&acc)[2][2][4][2], const Unit& u, int wr, int wc, int fr, int fq) const {
        const int row0 = u.pm * BM + wr * 64 + fr, col0 = u.pn * BM + wc * 32 + 8 * fq;
        if (u.pn < 10) {
#pragma unroll
            for (int ai = 0; ai < 2; ++ai)
#pragma unroll
                for (int m = 0; m < 4; ++m) { bf16_t* rowp = O + (size_t)(row0 + ai * HALF + m * 16) * 2560 + col0;
#pragma unroll
                    for (int bj = 0; bj < 2; ++bj) *(u32x4*)(rowp + bj * HALF) = pack8(acc[ai][bj][m][0], acc[ai][bj][m][1]); }
        } else if (wc == 0 && fq < 2) {
#pragma unroll
            for (int ai = 0; ai < 2; ++ai)
#pragma unroll
                for (int m = 0; m < 4; ++m) *(u32x4*)(AL + (size_t)(row0 + ai * HALF + m * 16) * 16 + 8 * fq) = pack8(acc[ai][0][m][0], acc[ai][0][m][1]);
        }
    }
};
struct EpiRes {
    static constexpr bool PERM = false, AFTER_DRAIN = false;
    float* HF; float alpha; static constexpr int ldc = 1024;
    __device__ __forceinline__ void operator()(const f32x4 (&acc)[2][2][4][2], const Unit& u, int wr, int wc, int fr, int fq) const {
        const int row0 = u.pm * BM + wr * 64 + fr, col0 = u.pn * BM + wc * 32 + 4 * fq;
#pragma unroll
        for (int ai = 0; ai < 2; ++ai)
#pragma unroll
            for (int m = 0; m < 4; ++m) { float* rowp = HF + (size_t)(row0 + ai * HALF + m * 16) * ldc + col0;
#pragma unroll
                for (int bj = 0; bj < 2; ++bj)
#pragma unroll
                    for (int n = 0; n < 2; ++n) { f32x4* p = (f32x4*)(rowp + bj * HALF + n * 16); const f32x4 h = *p; *p = h * alpha + acc[ai][bj][m][n]; } }
    }
};
struct EpiSwiglu {
    static constexpr bool PERM = true, AFTER_DRAIN = false;
    bf16_t* O; static constexpr int ldc = 2816;
    __device__ __forceinline__ void operator()(const f32x4 (&acc)[2][2][4][2], const Unit& u, int wr, int wc, int fr, int fq) const {
        const int row0 = u.pm * BM + wr * 64 + fr, col0 = u.pn * HALF + wc * 32 + 8 * fq;
#pragma unroll
        for (int ai = 0; ai < 2; ++ai)
#pragma unroll
            for (int m = 0; m < 4; ++m) { f32x4 a0, a1;
#pragma unroll
                for (int j = 0; j < 4; ++j) { a0[j] = silu_fast(acc[ai][0][m][0][j]) * acc[ai][1][m][0][j]; a1[j] = silu_fast(acc[ai][0][m][1][j]) * acc[ai][1][m][1][j]; }
                *(u32x4*)(O + (size_t)(row0 + ai * HALF + m * 16) * ldc + col0) = pack8(a0, a1); }
    }
};

__device__ __forceinline__ void row_stats8(const float* MUR, int row0, float (&mu)[2][4], float (&rs)[2][4]) {
#pragma unroll
    for (int ai = 0; ai < 2; ++ai)
#pragma unroll
        for (int m = 0; m < 4; ++m) { const f32x2 t = *(const f32x2*)(MUR + 2 * (size_t)(row0 + ai * HALF + m * 16)); mu[ai][m] = t.x; rs[ai][m] = t.y; }
}
struct EpiBf16LN {
    static constexpr bool PERM = true, AFTER_DRAIN = false;
    bf16_t* O; int ldc; const float* MUR; const float* cs; const float* cb;
    __device__ __forceinline__ void operator()(const f32x4 (&acc)[2][2][4][2], const Unit& u, int wr, int wc, int fr, int fq) const {
        const int row0 = u.pm * BM + wr * 64 + fr, col0 = u.pn * BM + wc * 32 + 8 * fq;
        float mu[2][4], rs[2][4]; row_stats8(MUR, row0, mu, rs);
#pragma unroll
        for (int bj = 0; bj < 2; ++bj) { const f32x4 s0 = *(const f32x4*)(cs + col0 + bj * HALF), s1 = *(const f32x4*)(cs + col0 + bj * HALF + 4), b0 = *(const f32x4*)(cb + col0 + bj * HALF), b1 = *(const f32x4*)(cb + col0 + bj * HALF + 4);
#pragma unroll
            for (int ai = 0; ai < 2; ++ai)
#pragma unroll
                for (int m = 0; m < 4; ++m) { const f32x4 v0 = (acc[ai][bj][m][0] - s0 * mu[ai][m]) * rs[ai][m] + b0, v1 = (acc[ai][bj][m][1] - s1 * mu[ai][m]) * rs[ai][m] + b1;
                    *(u32x4*)(O + (size_t)(row0 + ai * HALF + m * 16) * ldc + col0 + bj * HALF) = pack8(v0, v1); } }
    }
};
struct EpiProjLN {
    static constexpr bool PERM = true, AFTER_DRAIN = false;
    bf16_t* O; bf16_t* AL; const float* MUR; const float* cs; const float* cb;
    __device__ __forceinline__ void operator()(const f32x4 (&acc)[2][2][4][2], const Unit& u, int wr, int wc, int fr, int fq) const {
        const int row0 = u.pm * BM + wr * 64 + fr, col0 = u.pn * BM + wc * 32 + 8 * fq;
        float mu[2][4], rs[2][4]; row_stats8(MUR, row0, mu, rs);
        if (u.pn < 10) {
#pragma unroll
            for (int bj = 0; bj < 2; ++bj) { const f32x4 s0 = *(const f32x4*)(cs + col0 + bj * HALF), s1 = *(const f32x4*)(cs + col0 + bj * HALF + 4), b0 = *(const f32x4*)(cb + col0 + bj * HALF), b1 = *(const f32x4*)(cb + col0 + bj * HALF + 4);
#pragma unroll
                for (int ai = 0; ai < 2; ++ai)
#pragma unroll
                    for (int m = 0; m < 4; ++m) { const f32x4 v0 = (acc[ai][bj][m][0] - s0 * mu[ai][m]) * rs[ai][m] + b0, v1 = (acc[ai][bj][m][1] - s1 * mu[ai][m]) * rs[ai][m] + b1;
                        *(u32x4*)(O + (size_t)(row0 + ai * HALF + m * 16) * 2560 + col0 + bj * HALF) = pack8(v0, v1); } }
        } else if (wc == 0 && fq < 2) {
            const f32x4 s0 = *(const f32x4*)(cs + col0), s1 = *(const f32x4*)(cs + col0 + 4), b0 = *(const f32x4*)(cb + col0), b1 = *(const f32x4*)(cb + col0 + 4);
#pragma unroll
            for (int ai = 0; ai < 2; ++ai)
#pragma unroll
                for (int m = 0; m < 4; ++m) { const f32x4 v0 = (acc[ai][0][m][0] - s0 * mu[ai][m]) * rs[ai][m] + b0, v1 = (acc[ai][0][m][1] - s1 * mu[ai][m]) * rs[ai][m] + b1;
                    *(u32x4*)(AL + (size_t)(row0 + ai * HALF + m * 16) * 16 + 8 * fq) = pack8(v0, v1); }
        }
    }
};
struct EpiInLN {
    static constexpr bool PERM = true, AFTER_DRAIN = false;
    bf16_t* O; const float* MUR; const float* cs; const float* cb; static constexpr int ldc = 2560;
    __device__ __forceinline__ void operator()(const f32x4 (&acc)[2][2][4][2], const Unit& u, int wr, int wc, int fr, int fq) const {
        const int row0 = u.pm * BM + wr * 64 + fr, col0 = u.pn * BM + wc * 32 + 8 * fq;
        float mu[2][4], rs[2][4]; row_stats8(MUR, row0, mu, rs);
        if (u.pn >= 4) {
#pragma unroll
            for (int bj = 0; bj < 2; ++bj) { const f32x4 s0 = *(const f32x4*)(cs + col0 + bj * HALF), s1 = *(const f32x4*)(cs + col0 + bj * HALF + 4), b0 = *(const f32x4*)(cb + col0 + bj * HALF), b1 = *(const f32x4*)(cb + col0 + bj * HALF + 4);
#pragma unroll
                for (int ai = 0; ai < 2; ++ai)
#pragma unroll
                    for (int m = 0; m < 4; ++m) { const f32x4 v0 = (acc[ai][bj][m][0] - s0 * mu[ai][m]) * rs[ai][m] + b0, v1 = (acc[ai][bj][m][1] - s1 * mu[ai][m]) * rs[ai][m] + b1;
                        *(u32x4*)(O + (size_t)(row0 + ai * HALF + m * 16) * ldc + col0 + bj * HALF) = pack8(v0, v1); } }
        } else {
            const int ucol = u.pn * HALF + wc * 32 + 8 * fq;
            const f32x4 sa0 = *(const f32x4*)(cs + col0), sa1 = *(const f32x4*)(cs + col0 + 4), ba0 = *(const f32x4*)(cb + col0), ba1 = *(const f32x4*)(cb + col0 + 4);
            const f32x4 sg0 = *(const f32x4*)(cs + col0 + HALF), sg1 = *(const f32x4*)(cs + col0 + HALF + 4), bg0 = *(const f32x4*)(cb + col0 + HALF), bg1 = *(const f32x4*)(cb + col0 + HALF + 4);
#pragma unroll
            for (int ai = 0; ai < 2; ++ai)
#pragma unroll
                for (int m = 0; m < 4; ++m) {
                    const f32x4 a0 = (acc[ai][0][m][0] - sa0 * mu[ai][m]) * rs[ai][m] + ba0, a1 = (acc[ai][0][m][1] - sa1 * mu[ai][m]) * rs[ai][m] + ba1;
                    const f32x4 g0 = (acc[ai][1][m][0] - sg0 * mu[ai][m]) * rs[ai][m] + bg0, g1 = (acc[ai][1][m][1] - sg1 * mu[ai][m]) * rs[ai][m] + bg1;
                    f32x4 u0, u1;
#pragma unroll
                    for (int j = 0; j < 4; ++j) { u0[j] = a0[j] * __builtin_amdgcn_rcpf(1.f + __expf(-g0[j])); u1[j] = a1[j] * __builtin_amdgcn_rcpf(1.f + __expf(-g1[j])); }
                    *(u32x4*)(O + (size_t)(row0 + ai * HALF + m * 16) * ldc + ucol) = pack8(u0, u1); }
        }
    }
};
struct EpiSwigluLN {
    static constexpr bool PERM = true, AFTER_DRAIN = false;
    bf16_t* O; const float* MUR; const float* cs; const float* cb; static constexpr int ldc = 2816;
    __device__ __forceinline__ void operator()(const f32x4 (&acc)[2][2][4][2], const Unit& u, int wr, int wc, int fr, int fq) const {
        const int row0 = u.pm * BM + wr * 64 + fr, wrow = u.pn * BM + wc * 32 + 8 * fq, col0 = u.pn * HALF + wc * 32 + 8 * fq;
        float mu[2][4], rs[2][4]; row_stats8(MUR, row0, mu, rs);
        const f32x4 sg0 = *(const f32x4*)(cs + wrow), sg1 = *(const f32x4*)(cs + wrow + 4), bg0 = *(const f32x4*)(cb + wrow), bg1 = *(const f32x4*)(cb + wrow + 4);
        const f32x4 su0 = *(const f32x4*)(cs + wrow + HALF), su1 = *(const f32x4*)(cs + wrow + HALF + 4), bu0 = *(const f32x4*)(cb + wrow + HALF), bu1 = *(const f32x4*)(cb + wrow + HALF + 4);
#pragma unroll
        for (int ai = 0; ai < 2; ++ai)
#pragma unroll
            for (int m = 0; m < 4; ++m) {
                const f32x4 g0 = (acc[ai][0][m][0] - sg0 * mu[ai][m]) * rs[ai][m] + bg0, g1 = (acc[ai][0][m][1] - sg1 * mu[ai][m]) * rs[ai][m] + bg1;
                const f32x4 u0 = (acc[ai][1][m][0] - su0 * mu[ai][m]) * rs[ai][m] + bu0, u1 = (acc[ai][1][m][1] - su1 * mu[ai][m]) * rs[ai][m] + bu1;
                f32x4 a0, a1;
#pragma unroll
                for (int j = 0; j < 4; ++j) { a0[j] = silu_fast(g0[j]) * u0[j]; a1[j] = silu_fast(g1[j]) * u1[j]; }
                *(u32x4*)(O + (size_t)(row0 + ai * HALF + m * 16) * ldc + col0) = pack8(a0, a1); }
    }
};
struct EpiResLN {
    static constexpr bool PERM = false, AFTER_DRAIN = false;
    const float* Xin; float* Yout; bf16_t* YB; float* MUR; const float* gp; const float* bp; unsigned long long* slots; unsigned* cnt; float alpha; PG8_LAS unsigned char* lds;
    __device__ __forceinline__ void operator()(f32x4 (&acc)[2][2][4][2], const Unit& u, int wr, int wc, int fr, int fq) const {
        typedef unsigned u32x2 __attribute__((ext_vector_type(2)));
        const int row0 = u.pm * BM + wr * 64 + fr, col0 = u.pn * BM + wc * 32 + 4 * fq;
#pragma unroll
        for (int ai = 0; ai < 2; ++ai) {
            float mu[4], rs[4];
#pragma unroll
            for (int m = 0; m < 4; ++m) { const f32x2 t = *(const f32x2*)(MUR + 2 * (size_t)(row0 + ai * HALF + m * 16)); mu[m] = t.x; rs[m] = t.y; }
#pragma unroll
            for (int bj = 0; bj < 2; ++bj)
#pragma unroll
                for (int n = 0; n < 2; ++n) { const f32x4 g4 = *(const f32x4*)(gp + col0 + bj * HALF + n * 16), b4 = *(const f32x4*)(bp + col0 + bj * HALF + n * 16);
                    u32x2 told[4];
                    if (!Xin) {
#pragma unroll
                        for (int m = 0; m < 4; ++m) told[m] = *(const u32x2*)(YB + (size_t)(row0 + ai * HALF + m * 16) * 1024 + col0 + bj * HALF + n * 16);
                    }
#pragma unroll
                    for (int m = 0; m < 4; ++m) { const size_t off = (size_t)(row0 + ai * HALF + m * 16) * 1024 + col0 + bj * HALF + n * 16;
                        f32x4 yo;
                        if (Xin) yo = *(const f32x4*)(Xin + off);
                        else { const u32x2 t = told[m]; yo = (f32x4){__uint_as_float(t.x << 16), __uint_as_float(t.x & 0xffff0000u), __uint_as_float(t.y << 16), __uint_as_float(t.y & 0xffff0000u)}; }
                        const f32x4 yn = ((yo - mu[m]) * rs[m] * g4 + b4) * alpha + acc[ai][bj][m][n];
                        acc[ai][bj][m][n] = yn; if (Yout) *(f32x4*)(Yout + off) = yn;
                        u32x2 w; w.x = cvt_pk_bf16(yn[0], yn[1]); w.y = cvt_pk_bf16(yn[2], yn[3]); *(u32x2*)(YB + off) = w; } } }
        PG8_LAS f32x2* P = (PG8_LAS f32x2*)(lds + 131072);
#pragma unroll
        for (int ai = 0; ai < 2; ++ai)
#pragma unroll
            for (int m = 0; m < 4; ++m) {
                float s = 0.f;
#pragma unroll
                for (int bj = 0; bj < 2; ++bj)
#pragma unroll
                    for (int n = 0; n < 2; ++n) { const f32x4 x = acc[ai][bj][m][n]; s += (x[0] + x[1]) + (x[2] + x[3]); }
                s += __shfl_xor(s, 16); s += __shfl_xor(s, 32);
                const float mw = s * (1.0f / 64.0f); float q = 0.f;
#pragma unroll
                for (int bj = 0; bj < 2; ++bj)
#pragma unroll
                    for (int n = 0; n < 2; ++n) { const f32x4 d = acc[ai][bj][m][n] - mw; q += (d[0] * d[0] + d[1] * d[1]) + (d[2] * d[2] + d[3] * d[3]); }
                q += __shfl_xor(q, 16); q += __shfl_xor(q, 32);
                if (fq == 0) P[(ai * HALF + wr * 64 + m * 16 + fr) * 4 + wc] = (f32x2){mw, q};
            }
        asm volatile("s_waitcnt lgkmcnt(0)" ::: "memory"); __builtin_amdgcn_s_barrier(); asm volatile("" ::: "memory");
        const int wid = wr * 4 + wc, lane = fq * 16 + fr, row = wid * 32 + (lane & 31);
        if (lane < 32) {
            const f32x2 a = P[row * 4 + 0], b = P[row * 4 + 1], c = P[row * 4 + 2], d = P[row * 4 + 3];
            const float mt = (a.x + b.x + c.x + d.x) * 0.25f;
            const float da = a.x - mt, db = b.x - mt, dc = c.x - mt, dd = d.x - mt;
            const float m2 = (a.y + b.y) + (c.y + d.y) + 64.0f * ((da * da + db * db) + (dc * dc + dd * dd));
            __hip_atomic_store(slots + ((size_t)(u.pm * BM + row) * 4 + u.pn), ((unsigned long long)__float_as_uint(m2) << 32) | __float_as_uint(mt), __ATOMIC_RELAXED, __HIP_MEMORY_SCOPE_AGENT);
        }
        asm volatile("s_waitcnt vmcnt(0)" ::: "memory");
        unsigned old = 0u;
        if (lane == 0) old = __hip_atomic_fetch_add(cnt + u.pm, 1u, __ATOMIC_RELAXED, __HIP_MEMORY_SCOPE_AGENT);
        old = (unsigned)__builtin_amdgcn_readfirstlane((int)old);
        if (old == 31u) {
#pragma unroll
            for (int rr = 0; rr < 4; ++rr) { const int r = lane * 4 + rr; const unsigned long long* sl = slots + (size_t)(u.pm * BM + r) * 4; float mt[4], m2[4], ms = 0.f;
#pragma unroll
                for (int t = 0; t < 4; ++t) { const unsigned long long w = __hip_atomic_load(sl + t, __ATOMIC_RELAXED, __HIP_MEMORY_SCOPE_AGENT); mt[t] = __uint_as_float((unsigned)w); m2[t] = __uint_as_float((unsigned)(w >> 32)); ms += mt[t]; }
                const float mean = ms * 0.25f; float q = 0.f;
#pragma unroll
                for (int t = 0; t < 4; ++t) { const float dm = mt[t] - mean; q += m2[t] + 256.0f * dm * dm; }
                *(f32x2*)(MUR + 2 * (size_t)(u.pm * BM + r)) = (f32x2){mean, 1.0f / sqrtf(q * (1.0f / 1024.0f) + 1e-5f)}; }
        }
    }
};

template <class Epi, class Sched, bool ALIGN_EPI, bool SP2, int KC>
__device__ __forceinline__ void gemm_phase(PG8_LAS unsigned char* lds, const Gemm g, const Sched& S, const Epi& E, const int tid) {
    const int wid = __builtin_amdgcn_readfirstlane(tid >> 6), lane = tid & 63, wr = wid >> 2, wc = wid & 3, fr = lane & 15, fq = lane >> 4;
    constexpr int K = KC, nt = K / BK;
    unsigned voffA[2], voffB[2];
#pragma unroll
    for (int i = 0; i < 2; ++i) { int R, C; stage_rc(tid * 16 + i * 8192, R, C); const int Rb = Epi::PERM ? ((R & ~31) + perm32(R & 31)) : R;
        voffA[i] = (unsigned)(R * K + C) * 2u; voffB[i] = (unsigned)(Rb * K + C) * 2u; }
    const size_t kstep = (size_t)(BK * 2);
    const size_t hstep = (size_t)HALF * K * 2;
    const size_t tstep = 2 * hstep;
    const unsigned ldsw = (unsigned)wid * 1024u;
    const int aoff = lds_byte(wr * 64 + fr, fq * 8), boff = lds_byte(wc * 32 + fr, fq * 8);
#define PG8_SA(b, h) (((b) * 2 + (h)) * HTB)
#define PG8_SB(b, h) ((4 + (b) * 2 + (h)) * HTB)
#define PG8_STAGE(bufoff, gbase, voff) do { _Pragma("unroll") for (int _i = 0; _i < 2; ++_i) \
        __builtin_amdgcn_global_load_lds((const unsigned*)((const char*)(gbase) + (voff)[_i]), (PG8_LAS unsigned*)(lds + (bufoff) + ldsw + _i * 8192), 16, 0, 0); } while (0)
#define PG8_LDA(dst, b, h) do { _Pragma("unroll") for (int m = 0; m < 4; ++m) _Pragma("unroll") for (int k = 0; k < 2; ++k) dst[m][k] = *(const PG8_LAS bf16x8*)(lds + PG8_SA(b, h) + aoff + m * 2048 + k * 1024); } while (0)
#define PG8_LDB(dst, b, h) do { _Pragma("unroll") for (int n = 0; n < 2; ++n) _Pragma("unroll") for (int k = 0; k < 2; ++k) dst[n][k] = *(const PG8_LAS bf16x8*)(lds + PG8_SB(b, h) + boff + n * 2048 + k * 1024); } while (0)
#define PG8_MMA(ai, bj, At, Bt) do { __builtin_amdgcn_s_setprio(1); _Pragma("unroll") for (int m = 0; m < 4; ++m) _Pragma("unroll") for (int n = 0; n < 2; ++n) _Pragma("unroll") for (int k = 0; k < 2; ++k) \
        acc[ai][bj][m][n] = __builtin_amdgcn_mfma_f32_16x16x32_bf16(Bt[n][k], At[m][k], acc[ai][bj][m][n], 0, 0, 0); __builtin_amdgcn_s_setprio(0); } while (0)
#define PG8_WAIT_V(n) asm volatile("s_waitcnt vmcnt(" #n ")" ::: "memory")
#define PG8_WAIT_L(n) asm volatile("s_waitcnt lgkmcnt(" #n ")" ::: "memory")
#define PG8_BAR __builtin_amdgcn_s_barrier()
#define PG8_SCHED __builtin_amdgcn_sched_barrier(0)
    Unit cur, nxt; int ui = 0;
    if (!S.next(0, cur)) return;
    f32x4 acc[2][2][4][2];
#pragma unroll
    for (int a = 0; a < 2; ++a)
#pragma unroll
        for (int b = 0; b < 2; ++b)
#pragma unroll
            for (int m = 0; m < 4; ++m)
#pragma unroll
                for (int n = 0; n < 2; ++n) acc[a][b][m][n] = (f32x4){0.f, 0.f, 0.f, 0.f};
    bf16x8 At[4][2], B0[2][2], B1[2][2];
    const char* cA = (const char*)g.A + (size_t)cur.pm * tstep; const char* cB = (const char*)g.Bt + (size_t)cur.pn * tstep;
    S.a_ready(cur);
    if constexpr (SP2) {
        PG8_STAGE(PG8_SB(0, 0), cB, voffB); PG8_STAGE(PG8_SB(0, 1), cB + hstep, voffB); PG8_STAGE(PG8_SA(0, 0), cA, voffA); PG8_STAGE(PG8_SA(0, 1), cA + hstep, voffA);
        if (wr == 1) PG8_BAR;
        PG8_WAIT_V(2); PG8_BAR;
        PG8_STAGE(PG8_SB(1, 0), cB + kstep, voffB); PG8_STAGE(PG8_SA(1, 0), cA + kstep, voffA); PG8_STAGE(PG8_SB(1, 1), cB + hstep + kstep, voffB);
        PG8_WAIT_V(6); PG8_BAR;
    } else {
        PG8_STAGE(PG8_SB(0, 0), cB, voffB); PG8_STAGE(PG8_SA(0, 0), cA, voffA); PG8_STAGE(PG8_SB(0, 1), cB + hstep, voffB); PG8_STAGE(PG8_SA(0, 1), cA + hstep, voffA);
        if (wr == 1) PG8_BAR;
        PG8_WAIT_V(4); PG8_BAR;
        PG8_STAGE(PG8_SB(1, 0), cB + kstep, voffB); PG8_STAGE(PG8_SA(1, 0), cA + kstep, voffA); PG8_STAGE(PG8_SB(1, 1), cB + hstep + kstep, voffB);
        PG8_WAIT_V(6); PG8_BAR;
    }
    for (;;) {
        const bool has_next = S.next(ui + 1, nxt);
        const char* nA = has_next ? (const char*)g.A + (size_t)nxt.pm * tstep : cA; const char* nB = has_next ? (const char*)g.Bt + (size_t)nxt.pn * tstep : cB;
        for (int t = 0; t < nt; t += 2) {
            const bool last = (t == nt - 2);
            const char* a1 = cA + (size_t)(t + 1) * kstep;
            const char* a2 = last ? nA : cA + (size_t)(t + 2) * kstep; const char* b2 = last ? nB : cB + (size_t)(t + 2) * kstep;
            const char* a3 = a2 + kstep; const char* b3 = b2 + kstep;
            if (last && has_next) S.a_ready(nxt);
            if constexpr (SP2) {
            PG8_LDB(B0, 0, 0); PG8_LDB(B1, 0, 1); PG8_SCHED; PG8_LDA(At, 0, 0); PG8_STAGE(PG8_SA(1, 1), a1 + hstep, voffA);
            PG8_WAIT_V(8); PG8_WAIT_L(0); PG8_BAR; PG8_MMA(0, 0, At, B0); PG8_MMA(0, 1, At, B1); PG8_BAR; PG8_SCHED;
            PG8_LDA(At, 0, 1); PG8_STAGE(PG8_SB(0, 0), b2, voffB); PG8_STAGE(PG8_SB(0, 1), b2 + hstep, voffB); PG8_STAGE(PG8_SA(0, 0), a2, voffA);
            PG8_WAIT_V(8); PG8_WAIT_L(0); PG8_BAR; PG8_MMA(1, 0, At, B0); PG8_MMA(1, 1, At, B1); PG8_BAR; PG8_SCHED;
            PG8_LDB(B0, 1, 0); PG8_LDB(B1, 1, 1); PG8_SCHED; PG8_LDA(At, 1, 0); PG8_STAGE(PG8_SA(0, 1), a2 + hstep, voffA);
            PG8_WAIT_V(8); PG8_WAIT_L(0); PG8_BAR; PG8_MMA(0, 0, At, B0); PG8_MMA(0, 1, At, B1); PG8_BAR; PG8_SCHED;
            PG8_LDA(At, 1, 1); PG8_STAGE(PG8_SB(1, 0), b3, voffB); PG8_STAGE(PG8_SB(1, 1), b3 + hstep, voffB); PG8_STAGE(PG8_SA(1, 0), a3, voffA);
            PG8_WAIT_V(8); PG8_WAIT_L(0); PG8_BAR; PG8_MMA(1, 0, At, B0); PG8_MMA(1, 1, At, B1); PG8_BAR; PG8_SCHED;
            } else {
            PG8_LDB(B0, 0, 0); PG8_SCHED; PG8_LDA(At, 0, 0); PG8_STAGE(PG8_SA(1, 1), a1 + hstep, voffA);
            PG8_WAIT_L(8); PG8_BAR; PG8_WAIT_L(0); PG8_MMA(0, 0, At, B0); PG8_BAR; PG8_SCHED;
            PG8_LDB(B1, 0, 1); PG8_STAGE(PG8_SB(0, 0), b2, voffB);
            PG8_BAR; PG8_WAIT_L(0); PG8_MMA(0, 1, At, B1); PG8_BAR;
            PG8_LDA(At, 0, 1); PG8_STAGE(PG8_SA(0, 0), a2, voffA);
            PG8_BAR; PG8_WAIT_L(0); PG8_MMA(1, 0, At, B0); PG8_BAR; PG8_SCHED;
            PG8_STAGE(PG8_SB(0, 1), b2 + hstep, voffB);
            PG8_WAIT_V(6); PG8_BAR; PG8_MMA(1, 1, At, B1); PG8_BAR;
            PG8_LDB(B0, 1, 0); PG8_SCHED; PG8_LDA(At, 1, 0); PG8_STAGE(PG8_SA(0, 1), a2 + hstep, voffA);
            PG8_WAIT_L(8); PG8_BAR; PG8_WAIT_L(0); PG8_MMA(0, 0, At, B0); PG8_BAR; PG8_SCHED;
            PG8_LDB(B1, 1, 1); PG8_STAGE(PG8_SB(1, 0), b3, voffB);
            PG8_BAR; PG8_WAIT_L(0); PG8_MMA(0, 1, At, B1); PG8_BAR;
            PG8_LDA(At, 1, 1); PG8_STAGE(PG8_SA(1, 0), a3, voffA);
            PG8_BAR; PG8_WAIT_L(0); PG8_MMA(1, 0, At, B0); PG8_BAR; PG8_SCHED;
            PG8_STAGE(PG8_SB(1, 1), b3 + hstep, voffB);
            PG8_WAIT_V(6); PG8_BAR; PG8_MMA(1, 1, At, B1); PG8_BAR;
            }
        }
        if constexpr (ALIGN_EPI) { if (wr == 0) PG8_BAR; }
        if constexpr (!Epi::AFTER_DRAIN) { E(acc, cur, wr, wc, fr, fq); S.done(cur); }
        if (!has_next) break;
#pragma unroll
        for (int a = 0; a < 2; ++a)
#pragma unroll
            for (int b = 0; b < 2; ++b)
#pragma unroll
                for (int m = 0; m < 4; ++m)
#pragma unroll
                    for (int n = 0; n < 2; ++n) acc[a][b][m][n] = (f32x4){0.f, 0.f, 0.f, 0.f};
        cur = nxt; cA = nA; cB = nB; ++ui;
        if constexpr (ALIGN_EPI) { if (wr == 1) PG8_BAR; }
    }
    PG8_WAIT_V(0);
    if constexpr (!ALIGN_EPI) { if (wr == 0) PG8_BAR; }
    PG8_BAR;
    if constexpr (Epi::AFTER_DRAIN) { E.fused(acc, cur, wr, wc, fr, fq, lds, wid, lane); S.done(cur); }
#undef PG8_SA
#undef PG8_SB
#undef PG8_STAGE
#undef PG8_LDA
#undef PG8_LDB
#undef PG8_MMA
#undef PG8_WAIT_V
#undef PG8_WAIT_L
#undef PG8_BAR
#undef PG8_SCHED
}
}
namespace cg = cooperative_groups;
#define LAS __attribute__((address_space(3)))
#define LDS_WAIT() asm volatile("s_waitcnt lgkmcnt(0)" ::: "memory")
constexpr int NWAVES = 8, LDS_BYTES = 147456;
constexpr size_t WT_XK = 0, WT_XV = (size_t)4096 * 1024, WT_L0 = (size_t)2 * 4096 * 1024, WT_LSTRIDE = 14680064;
constexpr size_t WO_IN = 0, WO_MIX = 2883584, WO_XQ = WO_MIX + 1048576, WO_XO = WO_XQ + 1048576, WO_FF1 = WO_XO + 1048576, WO_FF2 = WO_FF1 + 5767168;
static_assert(WO_FF2 + 2883584 == WT_LSTRIDE && (WT_L0 + 4 * WT_LSTRIDE) * 2 == 128 * MiB, "weight map");
constexpr int I_IN = 16 * 81, I_SQ = 512, I_XKV = 1024, I_FF1 = 16 * 176, I_FF2 = 44 * 32, I_LAYER = I_IN + 3 * I_SQ + I_XKV + I_FF1 + I_FF2;

struct Args { const float* in[24]; float* out; unsigned char* ws; int ph_lo, ph_hi, sub, pad; };

__device__ __forceinline__ unsigned pk2(float lo, float hi) { return (unsigned)f2bf(lo) | ((unsigned)f2bf(hi) << 16); }
__device__ __forceinline__ void cvt_item(const float* W, int K, int N, int k0, int n0, bf16_t* dst, LAS float* scr, int lane) {
#pragma unroll
    for (int i = 0; i < 32; ++i) { const int kk = 2 * i + (lane >> 5), n = n0 + (lane & 31); scr[kk * 33 + (lane & 31)] = n < N ? W[(size_t)(k0 + kk) * N + n] : 0.f; }
    LDS_WAIT(); asm volatile("" ::: "memory");
    const int c = lane & 7;
#pragma unroll
    for (int j = 0; j < 4; ++j) { const int n = (lane >> 3) + 8 * j; const LAS float* s = scr + (8 * c) * 33 + n;
        u32x4 o; o.x = pk2(s[0 * 33], s[1 * 33]); o.y = pk2(s[2 * 33], s[3 * 33]); o.z = pk2(s[4 * 33], s[5 * 33]); o.w = pk2(s[6 * 33], s[7 * 33]);
        *(u32x4*)(dst + (size_t)n * K + k0 + 8 * c) = o; }
    LDS_WAIT(); asm volatile("" ::: "memory");
}
__device__ __forceinline__ void ln_row(const float* in, float* outf, bf16_t* outb, const float* g, const float* b, int lane) {
    const f32x4* xr = (const f32x4*)in + lane;
    f32x4 v[4]; float s = 0.f;
#pragma unroll
    for (int j = 0; j < 4; ++j) { v[j] = xr[64 * j]; s += (v[j].x + v[j].y) + (v[j].z + v[j].w); }
    const float mean = wave_sum(s) * (1.f / D); float s2 = 0.f;
#pragma unroll
    for (int j = 0; j < 4; ++j) { v[j] = v[j] - mean; s2 += (v[j].x * v[j].x + v[j].y * v[j].y) + (v[j].z * v[j].z + v[j].w * v[j].w); }
    const float rstd = rsqrtf(wave_sum(s2) * (1.f / D) + LN_EPS);
#pragma unroll
    for (int j = 0; j < 4; ++j) {
        const int c = (64 * j + lane) * 4;
        const f32x4 o = v[j] * rstd * *(const f32x4*)(g + c) + *(const f32x4*)(b + c);
        *((f32x4*)outf + 64 * j + lane) = o;
        *(unsigned long long*)(outb + c) = (unsigned long long)pk2(o.x, o.y) | ((unsigned long long)pk2(o.z, o.w) << 32);
    }
}


__device__ __forceinline__ void cvt_item_ln(const float* W, int K, int N, int k0, int n0, bf16_t* dst, LAS float* scr, int lane, const float* g, const float* b, float* csp, float* cbp) {
    float cs = 0.f, cb = 0.f;
#pragma unroll
    for (int i = 0; i < 32; ++i) { const int kk = 2 * i + (lane >> 5), n = n0 + (lane & 31); const float w = n < N ? W[(size_t)(k0 + kk) * N + n] : 0.f; const float wg = w * g[k0 + kk];
        scr[kk * 33 + (lane & 31)] = wg; cs += bf2f(f2bf(wg)); cb += b[k0 + kk] * w; }
    cs += __shfl_xor(cs, 32); cb += __shfl_xor(cb, 32);
    if (lane < 32) { csp[lane] = cs; cbp[lane] = cb; }
    LDS_WAIT(); asm volatile("" ::: "memory");
    const int c = lane & 7;
#pragma unroll
    for (int j = 0; j < 4; ++j) { const int n = (lane >> 3) + 8 * j; const LAS float* s = scr + (8 * c) * 33 + n;
        u32x4 o; o.x = pk2(s[0 * 33], s[1 * 33]); o.y = pk2(s[2 * 33], s[3 * 33]); o.z = pk2(s[4 * 33], s[5 * 33]); o.w = pk2(s[6 * 33], s[7 * 33]);
        *(u32x4*)(dst + (size_t)n * K + k0 + 8 * c) = o; }
    LDS_WAIT(); asm volatile("" ::: "memory");
}
__device__ __forceinline__ void x_row(const float* in, bf16_t* outb, float* mur, int lane) {
    const f32x4* xr = (const f32x4*)in + lane;
    f32x4 v[4]; float s = 0.f;
#pragma unroll
    for (int j = 0; j < 4; ++j) { v[j] = xr[64 * j]; s += (v[j].x + v[j].y) + (v[j].z + v[j].w);
        *(unsigned long long*)(outb + (64 * j + lane) * 4) = (unsigned long long)pk2(v[j].x, v[j].y) | ((unsigned long long)pk2(v[j].z, v[j].w) << 32); }
    const float mean = wave_sum(s) * (1.f / D); float s2 = 0.f;
#pragma unroll
    for (int j = 0; j < 4; ++j) { const f32x4 d = v[j] - mean; s2 += (d.x * d.x + d.y * d.y) + (d.z * d.z + d.w * d.w); }
    const float rstd = rsqrtf(wave_sum(s2) * (1.f / D) + LN_EPS);
    if (lane == 0) { mur[0] = mean; mur[1] = rstd; }
}
__device__ __forceinline__ void ln_row_f32(float* io, const float* g, const float* b, int lane) {
    f32x4* xr = (f32x4*)io + lane;
    f32x4 v[4]; float s = 0.f;
#pragma unroll
    for (int j = 0; j < 4; ++j) { v[j] = xr[64 * j]; s += (v[j].x + v[j].y) + (v[j].z + v[j].w); }
    const float mean = wave_sum(s) * (1.f / D); float s2 = 0.f;
#pragma unroll
    for (int j = 0; j < 4; ++j) { v[j] = v[j] - mean; s2 += (v[j].x * v[j].x + v[j].y * v[j].y) + (v[j].z * v[j].z + v[j].w * v[j].w); }
    const float rstd = rsqrtf(wave_sum(s2) * (1.f / D) + LN_EPS);
#pragma unroll
    for (int j = 0; j < 4; ++j) { const int c = (64 * j + lane) * 4; xr[64 * j] = v[j] * rstd * *(const f32x4*)(g + c) + *(const f32x4*)(b + c); }
}

__device__ __forceinline__ void alow_rows(const bf16_t* YB, const bf16_t* Wal, const float* MUR, const float* cs, const float* cb, bf16_t* ALOW, int gw, int NGW, int lane) {
    typedef short bf16x8_t __attribute__((ext_vector_type(8)));
    typedef unsigned u32x2_t __attribute__((ext_vector_type(2)));
    const int i = lane & 15, kg = lane >> 4;
    for (int rb = gw; rb < M / 16; rb += NGW) {
        const bf16_t* ap = YB + (size_t)(rb * 16 + i) * 1024 + 8 * kg; const bf16_t* wp = Wal + (size_t)i * 1024 + 8 * kg;
        f32x4 acc0 = (f32x4){0.f, 0.f, 0.f, 0.f}, acc1 = acc0;
#pragma unroll
        for (int s0 = 0; s0 < 32; s0 += 8) { bf16x8_t af[8], wf[8];
#pragma unroll
            for (int s = 0; s < 8; ++s) { af[s] = *(const bf16x8_t*)(ap + 32 * (s0 + s)); wf[s] = *(const bf16x8_t*)(wp + 32 * (s0 + s)); }
#pragma unroll
            for (int s = 0; s < 8; s += 2) { acc0 = __builtin_amdgcn_mfma_f32_16x16x32_bf16(wf[s], af[s], acc0, 0, 0, 0); acc1 = __builtin_amdgcn_mfma_f32_16x16x32_bf16(wf[s + 1], af[s + 1], acc1, 0, 0, 0); } }
        const float mu = MUR[2 * (size_t)(rb * 16 + i)], rs = MUR[2 * (size_t)(rb * 16 + i) + 1];
        const f32x4 c4 = *(const f32x4*)(cs + 4 * kg), b4 = *(const f32x4*)(cb + 4 * kg);
        const f32x4 z = ((acc0 + acc1) - c4 * mu) * rs + b4;
        u32x2_t w; w.x = pk2(z[0], z[1]); w.y = pk2(z[2], z[3]);
        *(u32x2_t*)(ALOW + (size_t)(rb * 16 + i) * 16 + 4 * kg) = w;
    }
}
#define XB_TMO      128
#define XB_XCNT(j)  (256  + 64 * (j))
#define XB_XSUB(j)  (1280 + 64 * (j))
#define XB_XGEN(j)  (2304 + 64 * (j))
#define XB_TOP      3328
#define XB_TOPGEN   3392
#define XCD_BAR_WORDS 3456
#define XB_SPIN_CAP (1u << 18)

__device__ __forceinline__ unsigned xb_ld(unsigned* p)              { return __hip_atomic_load(p, __ATOMIC_RELAXED, __HIP_MEMORY_SCOPE_AGENT); }
__device__ __forceinline__ unsigned xb_add(unsigned* p, unsigned v) { return __hip_atomic_fetch_add(p, v, __ATOMIC_RELAXED, __HIP_MEMORY_SCOPE_AGENT); }
__device__ __forceinline__ unsigned xb_xcc_id() { return (unsigned)__builtin_amdgcn_s_getreg((3 << 11) | 20) & 0xFu; }
#define XB_SPIN(cond, bar) do { unsigned _sp = 0; while (cond) { __builtin_amdgcn_s_sleep(1); \
    if ((++_sp & 255u) == 0u) { if (xb_ld(&(bar)[XB_TMO])) break; if (_sp > XB_SPIN_CAP) { atomicAdd(&(bar)[XB_TMO], 1u); break; } } } } while (0)

struct XcdBarrier {
    unsigned* bar; unsigned x;
    volatile LAS unsigned* st;
};

__device__ __forceinline__ XcdBarrier xcd_barrier_post(unsigned* bar, volatile LAS unsigned* st) {
    XcdBarrier b; b.bar = bar; b.x = xb_xcc_id(); b.st = st;
    if (threadIdx.x == 0) (void)xb_add(&bar[XB_XCNT(b.x)], 1u);
    return b;
}
__device__ __forceinline__ void xcd_barrier_complete(unsigned* bar, unsigned x, unsigned& nloc, unsigned& nx) {
    const unsigned G = gridDim.x * gridDim.y * gridDim.z;
    unsigned sum, cnt, mine, sp = 0u;
    for (;;) {
        sum = 0u; cnt = 0u; mine = 0u;
#pragma unroll
        for (unsigned j = 0; j < 16; ++j) { const unsigned c = xb_ld(&bar[XB_XCNT(j)]); sum += c; cnt += (c > 0u) ? 1u : 0u; mine = (j == x) ? c : mine; }
        if (sum == G) break;
        __builtin_amdgcn_s_sleep(1);
        if ((++sp & 255u) == 0u) { if (xb_ld(&bar[XB_TMO])) break; if (sp > XB_SPIN_CAP) { atomicAdd(&bar[XB_TMO], 1u); break; } }
    }
    nloc = mine > 0u ? mine : 1u; nx = cnt > 0u ? cnt : 1u;
}

__device__ __forceinline__ void xcd_barrier(const XcdBarrier& b) {
    asm volatile("s_waitcnt vmcnt(0)" ::: "memory");
    __syncthreads();
    if (threadIdx.x == 0) {
        unsigned* bar = b.bar;
        __builtin_amdgcn_s_waitcnt(0);
        unsigned nloc = b.st[0], nx = b.st[1];
        if (nloc == 0u) { xcd_barrier_complete(bar, b.x, nloc, nx); b.st[0] = nloc; b.st[1] = nx; }
        const unsigned old = xb_add(&bar[XB_XSUB(b.x)], 1u);
        const unsigned gen = old / nloc;
        if (old + 1u == (gen + 1u) * nloc) {
            __builtin_amdgcn_fence(__ATOMIC_RELEASE, "agent");
            asm volatile("s_waitcnt vmcnt(0)" ::: "memory");
            const unsigned og = xb_add(&bar[XB_TOP], 1u);
            const unsigned tg = og / nx;
            if (og + 1u == (tg + 1u) * nx) xb_add(&bar[XB_TOPGEN], 1u);
            else XB_SPIN(xb_ld(&bar[XB_TOPGEN]) == tg, bar);
            __builtin_amdgcn_fence(__ATOMIC_ACQUIRE, "agent");
            xb_add(&bar[XB_XGEN(b.x)], 1u);
            asm volatile("s_waitcnt vmcnt(0)" ::: "memory");
        } else {
            XB_SPIN(xb_ld(&bar[XB_XGEN(b.x)]) == gen, bar);
            __builtin_amdgcn_fence(__ATOMIC_ACQUIRE, "agent");
            asm volatile("s_waitcnt vmcnt(0)" ::: "memory");
        }
    }
    __syncthreads();
}

template <bool REL, bool ACQ> __device__ __forceinline__ void xcd_barrier_v(const XcdBarrier& b) {
    asm volatile("s_waitcnt vmcnt(0)" ::: "memory");
    __syncthreads();
    if (threadIdx.x == 0) {
        unsigned* bar = b.bar;
        __builtin_amdgcn_s_waitcnt(0);
        unsigned nloc = b.st[0], nx = b.st[1];
        if (nloc == 0u) { xcd_barrier_complete(bar, b.x, nloc, nx); b.st[0] = nloc; b.st[1] = nx; }
        const unsigned old = xb_add(&bar[XB_XSUB(b.x)], 1u);
        const unsigned gen = old / nloc;
        if (old + 1u == (gen + 1u) * nloc) {
            if (REL) __builtin_amdgcn_fence(__ATOMIC_RELEASE, "agent");
            asm volatile("s_waitcnt vmcnt(0)" ::: "memory");
            const unsigned og = xb_add(&bar[XB_TOP], 1u);
            const unsigned tg = og / nx;
            if (og + 1u == (tg + 1u) * nx) xb_add(&bar[XB_TOPGEN], 1u);
            else XB_SPIN(xb_ld(&bar[XB_TOPGEN]) == tg, bar);
            if (ACQ) __builtin_amdgcn_fence(__ATOMIC_ACQUIRE, "agent");
            xb_add(&bar[XB_XGEN(b.x)], 1u);
            asm volatile("s_waitcnt vmcnt(0)" ::: "memory");
        } else {
            XB_SPIN(xb_ld(&bar[XB_XGEN(b.x)]) == gen, bar);
            if (ACQ) __builtin_amdgcn_fence(__ATOMIC_ACQUIRE, "agent");
            asm volatile("s_waitcnt vmcnt(0)" ::: "memory");
        }
    }
    __syncthreads();
}
typedef short bf16x8_t __attribute__((ext_vector_type(8)));
typedef unsigned u32x2_t __attribute__((ext_vector_type(2)));
__device__ __forceinline__ unsigned cvtpk(float lo, float hi) { unsigned r; asm volatile("v_cvt_pk_bf16_f32 %0, %1, %2" : "=v"(r) : "v"(lo), "v"(hi)); return r; }
__device__ __forceinline__ void att_stage(LAS unsigned char* lds, const bf16_t* src, int pitch, int tid) {
    const int r0 = tid >> 5, ch = tid & 31;
    const bf16_t* g0 = src + (size_t)r0 * pitch + ch * 8;
    LAS unsigned char* l0 = lds + r0 * 512 + ((ch ^ r0) << 4);
    u32x4 v[16];
#pragma unroll
    for (int x = 0; x < 16; ++x) v[x] = *(const u32x4*)(g0 + (size_t)(16 * x) * pitch);
#pragma unroll
    for (int x = 0; x < 16; ++x) *(LAS u32x4*)(l0 + x * 8192) = v[x];
}
template <class Sched> __device__ __forceinline__ void att_phase(LAS unsigned char* lds, const bf16_t* Kl, const bf16_t* Vl, const bf16_t* Qb, bf16_t* Ob, const Sched& S, int tid) {
    pg8::Unit un;
    for (int ui = 0; S.next(ui, un); ++ui) {
        asm volatile("" : "+v"(tid));
        const int lane = tid & 63, wave = __builtin_amdgcn_readfirstlane(tid >> 6), j = lane & 15, kg = lane >> 4;
        const int h = un.pn, pm = un.pm, b = pm >> 5;
        att_stage(lds, Kl + (size_t)(b * 256) * 4096 + h * 256, 4096, tid);
        const bf16_t* qrow = Qb + (size_t)(pm * 256 + 16 * wave + j) * 1024 + h * 256;
        bf16_t* orow = Ob + (size_t)(pm * 256 + 16 * wave + j) * 1024 + h * 256;
        __syncthreads();
        const LAS unsigned char* fbase = lds + j * 512;
        const float cs = 0.0625f * 1.4426950408889634f;
        bf16x8_t pf[2][8]; float inv[2];
#pragma unroll
        for (int hf = 0; hf < 2; ++hf) {
            bf16x8_t qf[8];
#pragma unroll
            for (int s = 0; s < 8; ++s) qf[s] = *(const bf16x8_t*)(qrow + (size_t)hf * 128 * 1024 + 32 * s + 8 * kg);
            f32x4 acc[16];
#pragma unroll
            for (int kb = 0; kb < 16; ++kb) acc[kb] = (f32x4){0.f, 0.f, 0.f, 0.f};
#pragma unroll
            for (int s = 0; s < 8; ++s)
#pragma unroll
                for (int kb = 0; kb < 16; ++kb) { const bf16x8_t af = *(const LAS bf16x8_t*)(fbase + kb * 8192 + (((4 * s + kg) ^ j) << 4));
                    acc[kb] = __builtin_amdgcn_mfma_f32_16x16x32_bf16(af, qf[s], acc[kb], 0, 0, 0); }
            float mx = acc[0][0];
#pragma unroll
            for (int kb = 0; kb < 16; ++kb) mx = fmaxf(fmaxf(mx, fmaxf(acc[kb][0], acc[kb][1])), fmaxf(acc[kb][2], acc[kb][3]));
            mx = fmaxf(mx, __shfl_xor(mx, 16)); mx = fmaxf(mx, __shfl_xor(mx, 32));
            const float mxc = mx * cs; float sum = 0.f;
#pragma unroll
            for (int t = 0; t < 8; ++t) { f32x4 p0, p1;
#pragma unroll
                for (int e = 0; e < 4; ++e) { p0[e] = __builtin_amdgcn_exp2f(acc[2 * t][e] * cs - mxc); p1[e] = __builtin_amdgcn_exp2f(acc[2 * t + 1][e] * cs - mxc); }
                sum += (p0[0] + p0[1]) + (p0[2] + p0[3]) + (p1[0] + p1[1]) + (p1[2] + p1[3]);
                u32x4 w; w.x = cvtpk(p0[0], p0[1]); w.y = cvtpk(p0[2], p0[3]); w.z = cvtpk(p1[0], p1[1]); w.w = cvtpk(p1[2], p1[3]); pf[hf][t] = __builtin_bit_cast(bf16x8_t, w); }
            sum += __shfl_xor(sum, 16); sum += __shfl_xor(sum, 32);
            inv[hf] = 1.f / sum;
            __builtin_amdgcn_sched_barrier(0);
        }
        __syncthreads();
        att_stage(lds, Vl + (size_t)(h * 256) * 1024 + b * 256, 1024, tid);
        __syncthreads();
#pragma unroll
        for (int db = 0; db < 16; ++db) {
            f32x4 o0 = (f32x4){0.f, 0.f, 0.f, 0.f}, o1 = o0;
#pragma unroll
            for (int t = 0; t < 8; ++t) { const bf16x8_t af = *(const LAS bf16x8_t*)(fbase + db * 8192 + (((4 * t + kg) ^ j) << 4));
                o0 = __builtin_amdgcn_mfma_f32_16x16x32_bf16(af, pf[0][t], o0, 0, 0, 0); o1 = __builtin_amdgcn_mfma_f32_16x16x32_bf16(af, pf[1][t], o1, 0, 0, 0); }
            u32x2_t w; w.x = cvtpk(o0[0] * inv[0], o0[1] * inv[0]); w.y = cvtpk(o0[2] * inv[0], o0[3] * inv[0]);
            *(u32x2_t*)(orow + 16 * db + 4 * kg) = w;
            w.x = cvtpk(o1[0] * inv[1], o1[1] * inv[1]); w.y = cvtpk(o1[2] * inv[1], o1[3] * inv[1]);
            *(u32x2_t*)(orow + (size_t)128 * 1024 + 16 * db + 4 * kg) = w;
        }
        __syncthreads();
    }
}

__device__ __forceinline__ void conv_phase(LAS unsigned char* lds, const bf16_t* PROJ, const float* cw, const float* cb, const float* lg, const float* lb, bf16_t* MIXIN, int G, int tid) {
    LAS float* U = (LAS float*)lds;
    for (int u = blockIdx.x; u < M / 32; u += G) {
        asm volatile("" : "+v"(tid));
        const int lane = tid & 63, wave = __builtin_amdgcn_readfirstlane(tid >> 6);
        const int row0 = u * 32, t0 = row0 % SEQ;
        const int c = tid;
        float w[31];
#pragma unroll
        for (int k = 0; k < 31; ++k) w[k] = cw[k * 512 + c];
        const float bias = cb[c];
#pragma unroll
        for (int pass = 0; pass < 8; ++pass) { const int rr = pass * 8 + wave;
            if (rr < 62) { f32x4 o0 = (f32x4){0.f, 0.f, 0.f, 0.f}, o1 = o0;
                if (t0 - 30 + rr >= 0) { const u32x4 a = *(const u32x4*)(PROJ + (size_t)(row0 - 30 + rr) * PROJ_LD + 8 * lane);
                    o0 = (f32x4){__uint_as_float(a[0] << 16), __uint_as_float(a[0] & 0xffff0000u), __uint_as_float(a[1] << 16), __uint_as_float(a[1] & 0xffff0000u)};
                    o1 = (f32x4){__uint_as_float(a[2] << 16), __uint_as_float(a[2] & 0xffff0000u), __uint_as_float(a[3] << 16), __uint_as_float(a[3] & 0xffff0000u)}; }
                *(LAS f32x4*)(U + rr * 512 + 8 * lane) = o0; *(LAS f32x4*)(U + rr * 512 + 8 * lane + 4) = o1; } }
        __syncthreads();
        float y[32];
#pragma unroll
        for (int blk = 0; blk < 4; ++blk) { float win[38];
#pragma unroll
            for (int x = 0; x < 38; ++x) win[x] = U[(8 * blk + x) * 512 + c];
#pragma unroll
            for (int o = 0; o < 8; ++o) { float acc = bias;
#pragma unroll
                for (int k = 0; k < 31; ++k) acc += w[k] * win[o + k];
                y[8 * blk + o] = acc; } }
        __syncthreads();
#pragma unroll
        for (int tt = 0; tt < 32; ++tt) U[tt * 512 + c] = y[tt];
        __syncthreads();
#pragma unroll
        for (int q = 0; q < 4; ++q) { const int tt = 4 * wave + q;
            f32x4 a = *(const LAS f32x4*)(U + tt * 512 + 8 * lane), b = *(const LAS f32x4*)(U + tt * 512 + 8 * lane + 4);
            const float mean = wave_sum((a[0] + a[1]) + (a[2] + a[3]) + (b[0] + b[1]) + (b[2] + b[3])) * (1.f / 512.f);
            a = a - mean; b = b - mean;
            const float var = wave_sum((a[0] * a[0] + a[1] * a[1]) + (a[2] * a[2] + a[3] * a[3]) + (b[0] * b[0] + b[1] * b[1]) + (b[2] * b[2] + b[3] * b[3])) * (1.f / 512.f);
            const float rstd = rsqrtf(var + LN_EPS);
            a = a * rstd * *(const f32x4*)(lg + 8 * lane) + *(const f32x4*)(lb + 8 * lane); b = b * rstd * *(const f32x4*)(lg + 8 * lane + 4) + *(const f32x4*)(lb + 8 * lane + 4);
#pragma unroll
            for (int x = 0; x < 4; ++x) { a[x] = pg8::silu_fast(a[x]); b[x] = pg8::silu_fast(b[x]); }
            *(u32x4*)(MIXIN + (size_t)(row0 + tt) * D + 8 * lane) = pg8::pack8(a, b); }
        __syncthreads();
    }
}

typedef float f32x16_t __attribute__((ext_vector_type(16)));
constexpr int GP = 72;
__device__ __forceinline__ int slot32(int c) { const int w = c & 15; return (c & ~15) + 8 * ((w >> 2) & 1) + (w & 3) + 4 * (w >> 3); }
#define GLA_BAR() do { asm volatile("s_waitcnt lgkmcnt(0)" ::: "memory"); __builtin_amdgcn_s_barrier(); asm volatile("" ::: "memory"); } while (0)
__device__ __forceinline__ void gla_bcum(const u32x4 a0, const u32x4 a1, const float* wa2, const float* ba, int h, int lane, int wave, float (&bc)[8], float (&bl)[8]) {
    float al[16];
#pragma unroll
    for (int x = 0; x < 4; ++x) { al[2 * x] = __uint_as_float(a0[x] << 16); al[2 * x + 1] = __uint_as_float(a0[x] & 0xffff0000u); al[8 + 2 * x] = __uint_as_float(a1[x] << 16); al[8 + 2 * x + 1] = __uint_as_float(a1[x] & 0xffff0000u); }
#pragma unroll
    for (int x = 0; x < 8; ++x) { const int col = h * 64 + 8 * wave + x; float z = ba[col];
#pragma unroll
        for (int i = 0; i < 16; ++i) z += al[i] * wa2[i * 256 + col];
        float la = (fminf(z, 0.f) - __logf(1.f + __expf(-fabsf(z)))) * (1.f / 16.f);
        la += __builtin_bit_cast(float, __builtin_amdgcn_update_dpp(0, __builtin_bit_cast(int, la), 0x111, 0xf, 0xf, true));
        la += __builtin_bit_cast(float, __builtin_amdgcn_update_dpp(0, __builtin_bit_cast(int, la), 0x112, 0xf, 0xf, true));
        la += __builtin_bit_cast(float, __builtin_amdgcn_update_dpp(0, __builtin_bit_cast(int, la), 0x114, 0xf, 0xf, true));
        la += __builtin_bit_cast(float, __builtin_amdgcn_update_dpp(0, __builtin_bit_cast(int, la), 0x118, 0xf, 0xf, true));
        const float t0 = __builtin_bit_cast(float, __builtin_amdgcn_readlane(__builtin_bit_cast(int, la), 15)), t1 = __builtin_bit_cast(float, __builtin_amdgcn_readlane(__builtin_bit_cast(int, la), 31)),
                    t2 = __builtin_bit_cast(float, __builtin_amdgcn_readlane(__builtin_bit_cast(int, la), 47)), t3 = __builtin_bit_cast(float, __builtin_amdgcn_readlane(__builtin_bit_cast(int, la), 63));
        la += (lane >= 48) ? (t0 + t1) + t2 : (lane >= 32) ? t0 + t1 : (lane >= 16) ? t0 : 0.f;
        bc[x] = la; bl[x] = ((t0 + t1) + t2) + t3; }
}
__device__ __forceinline__ void unpack8(const u32x4 v, float (&f)[8]) {
#pragma unroll
    for (int x = 0; x < 4; ++x) { f[2 * x] = __uint_as_float(v[x] << 16); f[2 * x + 1] = __uint_as_float(v[x] & 0xffff0000u); }
}
struct G1In { u32x4 a0, a1, k, v0, v1; };
__device__ __forceinline__ G1In g1_load(const bf16_t* PROJ, const bf16_t* ALOW, int u, int lane, int wave) {
    const int bh = u >> 7, n = u & 127, b = bh >> 2, h = bh & 3, row0 = b * SEQ + n * 64;
    const bf16_t* pr = PROJ + (size_t)(row0 + lane) * PROJ_LD; const bf16_t* al = ALOW + (size_t)(row0 + lane) * 16;
    G1In r; r.a0 = *(const u32x4*)al; r.a1 = *(const u32x4*)(al + 8); r.k = *(const u32x4*)(pr + C_K + h * 64 + 8 * wave);
    r.v0 = *(const u32x4*)(pr + C_V + h * 128 + 8 * wave); r.v1 = *(const u32x4*)(pr + C_V + h * 128 + 64 + 8 * wave); return r;
}
__device__ __forceinline__ void gla_g1_phase(LAS unsigned char* lds, const bf16_t* PROJ, const bf16_t* ALOW, const float* wa2, const float* ba, float* UPD, float* DEC, int G, int tid) {
    LAS bf16_t* KD = (LAS bf16_t*)lds; LAS bf16_t* VT = (LAS bf16_t*)(lds + 18432);
    const int lane = tid & 63, wave = __builtin_amdgcn_readfirstlane(tid >> 6);
    G1In cur; if ((int)blockIdx.x < 2048) cur = g1_load(PROJ, ALOW, blockIdx.x, lane, wave);
    for (int u = blockIdx.x; u < 2048; u += G) {
        G1In nxt; if (u + G < 2048) nxt = g1_load(PROJ, ALOW, u + G, lane, wave);
        const int bh = u >> 7, h = bh & 3;
        float bc[8], bl[8];
        gla_bcum(cur.a0, cur.a1, wa2, ba, h, lane, wave, bc, bl);
        float kf[8]; unpack8(cur.k, kf);
#pragma unroll
        for (int x = 0; x < 8; ++x) KD[(8 * wave + x) * GP + lane] = f2bf(kf[x] * __expf(bl[x] - bc[x]));
        if (lane == 63) {
#pragma unroll
            for (int x = 0; x < 8; ++x) DEC[u * 64 + 8 * wave + x] = __expf(bl[x]); }
#pragma unroll
        for (int pc = 0; pc < 2; ++pc) { const int e0 = 64 * pc + 8 * wave; const u32x4 v = pc ? cur.v1 : cur.v0;
#pragma unroll
            for (int x = 0; x < 4; ++x) { VT[(e0 + 2 * x) * GP + lane] = (bf16_t)(v[x] & 0xffffu); VT[(e0 + 2 * x + 1) * GP + lane] = (bf16_t)(v[x] >> 16); } }
        GLA_BAR();
        const int eb = wave >> 1, dbk = wave & 1, i = lane & 31, kg = lane >> 5;
        f32x16_t acc;
#pragma unroll
        for (int r = 0; r < 16; ++r) acc[r] = 0.f;
#pragma unroll
        for (int s = 0; s < 4; ++s) { const bf16x8_t af = *(const LAS bf16x8_t*)(VT + (32 * eb + i) * GP + 16 * s + 8 * kg), bfr = *(const LAS bf16x8_t*)(KD + (32 * dbk + i) * GP + 16 * s + 8 * kg);
            acc = __builtin_amdgcn_mfma_f32_32x32x16_bf16(af, bfr, acc, 0, 0, 0); }
        float* up = UPD + ((size_t)u * 128 + 32 * eb + 4 * kg) * 64 + 32 * dbk + i;
#pragma unroll
        for (int r = 0; r < 16; ++r) up[((r & 3) + 8 * (r >> 2)) * 64] = acc[r];
        GLA_BAR();
        cur = nxt;
    }
}
__device__ __forceinline__ void gla_g2_phase(const float* UPD, bf16_t* SP, const float* DEC, int G, int tid) {
    for (int g = blockIdx.x * 512 + tid; g < 16 * 8192; g += G * 512) {
        const int bh = g >> 13, ed = g & 8191, d = g & 63;
        const float* p = UPD + (size_t)bh * 128 * 8192 + ed; bf16_t* po = SP + (size_t)bh * 128 * 8192 + ed; const float* dc = DEC + bh * 128 * 64 + d;
        float S = 0.f;
        for (int n0 = 0; n0 < 128; n0 += 16) { float uu[16], dd[16];
#pragma unroll
            for (int x = 0; x < 16; ++x) { uu[x] = p[(size_t)(n0 + x) * 8192]; dd[x] = dc[(n0 + x) * 64]; }
#pragma unroll
            for (int x = 0; x < 16; ++x) { po[(size_t)(n0 + x) * 8192] = f2bf(S); S = dd[x] * S + uu[x]; } }
    }
}
struct G3In { u32x4 a0, a1, q, k, v0, v1; bf16x8_t sp[4]; u32x2_t rr[4]; };
__device__ __forceinline__ G3In g3_load(const bf16_t* PROJ, const bf16_t* ALOW, const bf16_t* SPV, int u, int lane, int wave) {
    const int bh = u >> 7, n = u & 127, b = bh >> 2, h = bh & 3, row0 = b * SEQ + n * 64;
    const int eb = wave >> 1, cb = wave & 1, i = lane & 31, kg = lane >> 5;
    const bf16_t* pr = PROJ + (size_t)(row0 + lane) * PROJ_LD; const bf16_t* al = ALOW + (size_t)(row0 + lane) * 16;
    G3In r; r.a0 = *(const u32x4*)al; r.a1 = *(const u32x4*)(al + 8); r.q = *(const u32x4*)(pr + C_Q + h * 64 + 8 * wave); r.k = *(const u32x4*)(pr + C_K + h * 64 + 8 * wave);
    r.v0 = *(const u32x4*)(pr + C_V + h * 128 + 8 * wave); r.v1 = *(const u32x4*)(pr + C_V + h * 128 + 64 + 8 * wave);
    const bf16_t* sp = SPV + ((size_t)u * 128 + 32 * eb + i) * 64 + 8 * kg;
#pragma unroll
    for (int s = 0; s < 4; ++s) r.sp[s] = *(const bf16x8_t*)(sp + 16 * s);
    const bf16_t* rp = PROJ + (size_t)(row0 + 32 * cb + i) * PROJ_LD + C_R + h * 128 + 32 * eb + 4 * kg;
#pragma unroll
    for (int rg = 0; rg < 4; ++rg) r.rr[rg] = *(const u32x2_t*)(rp + 8 * rg);
    return r;
}
__device__ __forceinline__ void gla_g3_phase(LAS unsigned char* lds, const bf16_t* PROJ, const bf16_t* ALOW, const float* wa2, const float* ba, const float* gn, const bf16_t* UPD, bf16_t* MIXIN, int G, int tid) {
    LAS bf16_t* KE = (LAS bf16_t*)lds; LAS bf16_t* QE = (LAS bf16_t*)(lds + 9216); LAS bf16_t* VT = (LAS bf16_t*)(lds + 18432); LAS float* RED = (LAS float*)(lds + 36864);
    const int lane = tid & 63, wave = __builtin_amdgcn_readfirstlane(tid >> 6);
    const int eb = wave >> 1, cb = wave & 1, i = lane & 31, kg = lane >> 5;
    G3In cur; if ((int)blockIdx.x < 2048) cur = g3_load(PROJ, ALOW, UPD, blockIdx.x, lane, wave);
    for (int u = blockIdx.x; u < 2048; u += G) {
        G3In nxt; if (u + G < 2048) nxt = g3_load(PROJ, ALOW, UPD, u + G, lane, wave);
        const int bh = u >> 7, n = u & 127, b = bh >> 2, h = bh & 3, row0 = b * SEQ + n * 64;
        const size_t row = (size_t)(row0 + 32 * cb + i);
        { float bc[8], bl[8];
          gla_bcum(cur.a0, cur.a1, wa2, ba, h, lane, wave, bc, bl);
          float qf[8], kf[8]; unpack8(cur.q, qf); unpack8(cur.k, kf);
          f32x4 q0, q1, k0, k1;
#pragma unroll
          for (int x = 0; x < 4; ++x) { q0[x] = qf[x] * 0.125f * __expf(bc[x]); q1[x] = qf[4 + x] * 0.125f * __expf(bc[4 + x]); k0[x] = kf[x] * __expf(-bc[x]); k1[x] = kf[4 + x] * __expf(-bc[4 + x]); }
          *(LAS u32x4*)(QE + lane * GP + 8 * wave) = pg8::pack8(q0, q1); *(LAS u32x4*)(KE + lane * GP + 8 * wave) = pg8::pack8(k0, k1);
          const int pcol = slot32(lane);
#pragma unroll
          for (int pc = 0; pc < 2; ++pc) { const int e0 = 64 * pc + 8 * wave; const u32x4 v = pc ? cur.v1 : cur.v0;
#pragma unroll
              for (int x = 0; x < 4; ++x) { VT[(e0 + 2 * x) * GP + pcol] = (bf16_t)(v[x] & 0xffffu); VT[(e0 + 2 * x + 1) * GP + pcol] = (bf16_t)(v[x] >> 16); } } }
        GLA_BAR();
        bf16x8_t qb[4];
#pragma unroll
        for (int s = 0; s < 4; ++s) qb[s] = *(const LAS bf16x8_t*)(QE + (32 * cb + i) * GP + 16 * s + 8 * kg);
        f32x16_t o;
#pragma unroll
        for (int r = 0; r < 16; ++r) o[r] = 0.f;
#pragma unroll
        for (int sb = 0; sb < 2; ++sb) if (sb <= cb) {
            f32x16_t at;
#pragma unroll
            for (int r = 0; r < 16; ++r) at[r] = 0.f;
#pragma unroll
            for (int s = 0; s < 4; ++s) { const bf16x8_t af = *(const LAS bf16x8_t*)(KE + (32 * sb + i) * GP + 16 * s + 8 * kg); at = __builtin_amdgcn_mfma_f32_32x32x16_bf16(af, qb[s], at, 0, 0, 0); }
            if (sb == cb) {
#pragma unroll
                for (int r = 0; r < 16; ++r) if ((r & 3) + 8 * (r >> 2) + 4 * kg > i) at[r] = 0.f; }
#pragma unroll
            for (int sp = 0; sp < 2; ++sp) { u32x4 w; w.x = cvtpk(at[8 * sp + 0], at[8 * sp + 1]); w.y = cvtpk(at[8 * sp + 2], at[8 * sp + 3]); w.z = cvtpk(at[8 * sp + 4], at[8 * sp + 5]); w.w = cvtpk(at[8 * sp + 6], at[8 * sp + 7]);
                const bf16x8_t af = *(const LAS bf16x8_t*)(VT + (32 * eb + i) * GP + 32 * sb + 16 * sp + 8 * kg);
                o = __builtin_amdgcn_mfma_f32_32x32x16_bf16(af, __builtin_bit_cast(bf16x8_t, w), o, 0, 0, 0); }
        }
#pragma unroll
        for (int s = 0; s < 4; ++s) o = __builtin_amdgcn_mfma_f32_32x32x16_bf16(cur.sp[s], qb[s], o, 0, 0, 0);
        float ss = 0.f;
#pragma unroll
        for (int r = 0; r < 16; ++r) ss += o[r] * o[r];
        ss += __shfl_xor(ss, 32);
        if (kg == 0) RED[eb * 64 + 32 * cb + i] = ss;
        GLA_BAR();
        const float tot = (RED[32 * cb + i] + RED[64 + 32 * cb + i]) + (RED[128 + 32 * cb + i] + RED[192 + 32 * cb + i]);
        const float rstd = rsqrtf(tot * (1.f / 128.f) + LN_EPS);
#pragma unroll
        for (int rg = 0; rg < 4; ++rg) { const int e = 32 * eb + 8 * rg + 4 * kg;
            const f32x4 g4 = *(const f32x4*)(gn + e); const u32x2_t rr = cur.rr[rg];
            const float r0 = __uint_as_float(rr.x << 16), r1 = __uint_as_float(rr.x & 0xffff0000u), r2 = __uint_as_float(rr.y << 16), r3 = __uint_as_float(rr.y & 0xffff0000u);
            u32x2_t w; w.x = cvtpk(o[4 * rg] * rstd * g4[0] * pg8::silu_fast(r0), o[4 * rg + 1] * rstd * g4[1] * pg8::silu_fast(r1));
            w.y = cvtpk(o[4 * rg + 2] * rstd * g4[2] * pg8::silu_fast(r2), o[4 * rg + 3] * rstd * g4[3] * pg8::silu_fast(r3));
            *(u32x2_t*)(MIXIN + row * D + 512 + h * 128 + e) = w; }
        GLA_BAR();
        cur = nxt;
    }
}

#ifndef PROBE_MASK
#define PROBE_MASK 0
#endif
#ifndef ONE_LAUNCH
#define ONE_LAUNCH 1
#endif
constexpr int NPL = 9, NPH = 2 + NPL * DEPTH + 1;
enum { PK_IN = 0, PK_CG1, PK_G2, PK_G3, PK_MIX, PK_Q, PK_XO, PK_FF1, PK_FF2 };
constexpr int CSN = 9472, CS_IN = 0, CS_Q = 2816, CS_FF1 = 3840;

__global__ void __launch_bounds__(NWAVES * 64) mega(Args a) {
    extern __shared__ __attribute__((aligned(16))) unsigned char lds_raw[];
    LAS unsigned char* lds = (LAS unsigned char*)lds_raw;
    const int wave = __builtin_amdgcn_readfirstlane(threadIdx.x >> 6);
    const int G = gridDim.x, gw = blockIdx.x * NWAVES + wave, NGW = G * NWAVES;
    unsigned char* ws = a.ws;
#define INP(k) ({ int k_ = (k); asm volatile("" : "+s"(k_)); a.in[k_]; })
    float* Y = a.out;
    bf16_t* WT = (bf16_t*)(ws + WS_WT); bf16_t* YB = (bf16_t*)(ws + WS_HB); bf16_t* PROJ = (bf16_t*)(ws + WS_PROJ); bf16_t* ALOW = (bf16_t*)(ws + WS_ALOW);
    bf16_t* MIXIN = (bf16_t*)(ws + WS_MIXIN); bf16_t* Qb = (bf16_t*)(ws + WS_Q); bf16_t* ACT = (bf16_t*)(ws + WS_ACT);
    bf16_t* Kb = (bf16_t*)(ws + WS_K); bf16_t* Vt = (bf16_t*)(ws + WS_VT); bf16_t* MEMB = (bf16_t*)(ws + WS_MEMB); bf16_t* MEMP = (bf16_t*)(ws + WS_MEMP);
    float* UPD = (float*)(ws + WS_UPD); float* DEC = (float*)(ws + WS_DEC);
    float* CSP = (float*)(ws + WS_CSP); float* CS = (float*)(ws + WS_CS); float* MUR = (float*)(ws + WS_MUR);
    unsigned long long* SLOTS = (unsigned long long*)(ws + WS_SLOTS); unsigned* CNT = (unsigned*)(ws + WS_CNT);

    volatile LAS unsigned* bst = (volatile LAS unsigned*)(lds + 143360);
    if (threadIdx.x == 0) { bst[0] = 0u; bst[1] = 0u; }
    __syncthreads();
    XcdBarrier xbar; xbar.bar = (unsigned*)(ws + WS_BAR); xbar.x = 0; xbar.st = bst;
    if (a.ph_hi - a.ph_lo > 1) xbar = xcd_barrier_post((unsigned*)(ws + WS_BAR), bst);
    for (int p = a.ph_lo; p < a.ph_hi; ++p) {
      const int pkind = (p < 2 || p == NPH - 1) ? -1 : (p - 2) % NPL;
      int nrep = 1;
      if ((a.sub & 4) && (pkind == PK_IN || pkind == PK_Q || pkind == PK_FF1)) nrep = 2;
      if ((a.sub & (8 | 8192)) && pkind == PK_CG1) nrep = 2;
      if ((a.sub & 16384) && pkind == PK_G3) nrep = 2;
      if ((a.sub & 64) && p < 2) nrep = 2;
      for (int rep = 0; rep < nrep; ++rep) {
        const bool dummy = rep + 1 < nrep;
        int tid; asm volatile("v_mbcnt_lo_u32_b32 %0, -1, 0\n\tv_mbcnt_hi_u32_b32 %0, -1, %0\n\tv_lshl_or_b32 %0, %1, 6, %0" : "=&v"(tid) : "s"(wave));
        const int lane = tid & 63;
        if (p == 0) {
            LAS float* scr = (LAS float*)(lds + wave * 16384);
            if (blockIdx.x == 0) { CNT[tid] = 0u; CNT[512 + tid] = 0u; CNT[1024 + tid] = 0u; }
            for (int it = gw; it < DEPTH * I_LAYER; it += NGW) {
                const int l = it / I_LAYER; int r = it % I_LAYER;
                bf16_t* WL = WT + WT_L0 + (size_t)l * WT_LSTRIDE;
                float* cspl = CSP + (size_t)l * 2 * 16 * CSN;
                if (r < I_IN) { const int kb = r / 81, n0 = 32 * (r % 81); const float* gg = l == 0 ? INP(2) : INP(22) + (l - 1) * D; const float* bb = l == 0 ? INP(3) : INP(23) + (l - 1) * D;
                    const int drow = n0 < 512 ? 256 * (n0 / 128) + n0 % 128 : n0 < 1024 ? 256 * ((n0 - 512) / 128) + 128 + (n0 - 512) % 128 : n0;
                    cvt_item_ln(INP(4) + (size_t)l * 1024 * IN_COLS, 1024, IN_COLS, 64 * kb, n0, WL + WO_IN + (size_t)drow * 1024, scr, lane, gg, bb, cspl + kb * CSN + CS_IN + drow, cspl + (16 + kb) * CSN + CS_IN + drow); continue; } r -= I_IN;
                if (r < I_SQ) { const int kb = r / 32, nb = r % 32; cvt_item(INP(12) + (size_t)l * 1024 * 1024, 1024, 1024, 64 * kb, 32 * nb, WL + WO_MIX + (size_t)(32 * nb) * 1024, scr, lane); continue; } r -= I_SQ;
                if (r < I_SQ) { const int kb = r / 32, nb = r % 32;
                    cvt_item_ln(INP(15) + (size_t)l * 1024 * 1024, 1024, 1024, 64 * kb, 32 * nb, WL + WO_XQ + (size_t)(32 * nb) * 1024, scr, lane, INP(13) + l * D, INP(14) + l * D, cspl + kb * CSN + CS_Q + 32 * nb, cspl + (16 + kb) * CSN + CS_Q + 32 * nb); continue; } r -= I_SQ;
                if (r < I_SQ) { const int kb = r / 32, nb = r % 32; cvt_item(INP(17) + (size_t)l * 1024 * 1024, 1024, 1024, 64 * kb, 32 * nb, WL + WO_XO + (size_t)(32 * nb) * 1024, scr, lane); continue; } r -= I_SQ;
                if (r < I_XKV) { const int kb = r / 64, n0 = 32 * (r % 64);
                    bf16_t* dst = n0 < 1024 ? WT + WT_XK + (size_t)(l * 1024 + n0) * 1024 : WT + WT_XV + (size_t)(l * 1024 + n0 - 1024) * 1024;
                    cvt_item(INP(16) + (size_t)l * 1024 * 2048, 1024, 2048, 64 * kb, n0, dst, scr, lane); continue; } r -= I_XKV;
                if (r < I_FF1) { const int kb = r / 176, n0 = 32 * (r % 176);
                    const int drow = n0 < D_FF ? 256 * (n0 / 128) + n0 % 128 : 256 * ((n0 - D_FF) / 128) + 128 + (n0 - D_FF) % 128;
                    cvt_item_ln(INP(20) + (size_t)l * 1024 * 2 * D_FF, 1024, 2 * D_FF, 64 * kb, n0, WL + WO_FF1 + (size_t)drow * 1024, scr, lane, INP(18) + l * D, INP(19) + l * D, cspl + kb * CSN + CS_FF1 + drow, cspl + (16 + kb) * CSN + CS_FF1 + drow); continue; } r -= I_FF1;
                { const int kb = r / 32, nb = r % 32; cvt_item(INP(21) + (size_t)l * D_FF * 1024, D_FF, 1024, 64 * kb, 32 * nb, WL + WO_FF2 + (size_t)(32 * nb) * D_FF, scr, lane); }
            }
            for (int i = blockIdx.x * 512 + tid; i < 1024 * 1024; i += G * 512) {
                const int row = i >> 10, c = i & 1023, b = row >> 8, key = row & 255; const bf16_t v = f2bf(INP(1)[i]);
                MEMB[i] = v; MEMP[(size_t)(b * 256 + slot_of_key(key)) * 1024 + c] = v; }
            { const float* xin = INP(0);
              for (int m = gw; m < M; m += 2 * NGW) { x_row(xin + (size_t)m * D, YB + (size_t)m * D, MUR + 2 * (size_t)m, lane);
                  if (m + NGW < M) x_row(xin + (size_t)(m + NGW) * D, YB + (size_t)(m + NGW) * D, MUR + 2 * (size_t)(m + NGW), lane); } }
        } else if (p == 1) {
            for (int i = blockIdx.x * 512 + tid; i < DEPTH * 2 * CSN; i += G * 512) { const int lc = i / CSN, c = i % CSN; const float* pp = CSP + (size_t)lc * 16 * CSN + c; float s = 0.f;
#pragma unroll
                for (int kb = 0; kb < 16; ++kb) s += pp[kb * CSN];
                CS[i] = s; }
            const int half = G / 2;
            if ((int)blockIdx.x < half) { pg8::Gemm g{MEMB, WT + WT_XK, 1024, 4096, 1024}; pg8::StaticOrderT<1024, 4096> S; S.init(half, (int)blockIdx.x);
                pg8::EpiBf16 E{Kb, 4096}; pg8::gemm_phase<pg8::EpiBf16, pg8::StaticOrderT<1024, 4096>, true, true, 1024>(lds, g, S, E, tid); }
            else { pg8::Gemm g{WT + WT_XV, MEMP, 4096, 1024, 1024}; pg8::StaticOrderT<4096, 1024> S; S.init(G - half, (int)blockIdx.x - half);
                pg8::EpiBf16 E{Vt, 1024}; pg8::gemm_phase<pg8::EpiBf16, pg8::StaticOrderT<4096, 1024>, true, true, 1024>(lds, g, S, E, tid); }
        } else if (p == NPH - 1) {
            const float* gg = INP(22) + (DEPTH - 1) * D; const float* bb = INP(23) + (DEPTH - 1) * D;
            for (int m = gw; m < M; m += NGW) ln_row_f32(Y + (size_t)m * D, gg, bb, lane);
        } else {
            const int l = (p - 2) / NPL, kind = (p - 2) % NPL;
            const bf16_t* WL = WT + WT_L0 + (size_t)l * WT_LSTRIDE;
            const float* csl = CS + (size_t)l * 2 * CSN; const float* cbl = csl + CSN;
            if (kind == PK_IN) { pg8::Gemm g{YB, WL + WO_IN, M, 2560, 1024}; pg8::StaticOrderT<M, 2560> S; S.init(G, (int)blockIdx.x);
                pg8::EpiInLN E{PROJ, MUR, csl + CS_IN, cbl + CS_IN}; pg8::gemm_phase<pg8::EpiInLN, pg8::StaticOrderT<M, 2560>, true, true, 1024>(lds, g, S, E, tid);
                alow_rows(YB, WL + WO_IN + (size_t)2560 * 1024, MUR, csl + CS_IN + 2560, cbl + CS_IN + 2560, ALOW, gw, NGW, lane); }
            else if (kind == PK_CG1) {
                if ((a.sub & 1) && !(dummy && (a.sub & 8192))) conv_phase(lds, PROJ, INP(7) + l * 31 * 512, INP(8) + l * 512, INP(9) + l * 512, INP(10) + l * 512, MIXIN, G, tid);
                if ((a.sub & 2) && !(dummy && (a.sub & 8))) gla_g1_phase(lds, PROJ, ALOW, INP(5) + l * 16 * 256, INP(6) + l * 256, UPD, DEC, G, tid); }
            else if (kind == PK_G2) { gla_g2_phase(UPD, (bf16_t*)a.out, DEC, G, tid); }
            else if (kind == PK_G3) { gla_g3_phase(lds, PROJ, ALOW, INP(5) + l * 16 * 256, INP(6) + l * 256, INP(11) + l * 128, (const bf16_t*)a.out, MIXIN, G, tid); }
            else if (kind == PK_MIX || kind == PK_XO) {
                const bool mix = kind == PK_MIX;
                pg8::Gemm g{mix ? MIXIN : Qb, WL + (mix ? WO_MIX : WO_XO), M, 1024, 1024}; pg8::StaticOrderT<M, 1024> S; S.init(G, (int)blockIdx.x);
                const float* gp = mix ? (l == 0 ? INP(2) : INP(22) + (l - 1) * D) : INP(13) + l * D; const float* bp = mix ? (l == 0 ? INP(3) : INP(23) + (l - 1) * D) : INP(14) + l * D;
                pg8::EpiResLN E{(mix && l == 0) ? INP(0) : nullptr, nullptr, YB, MUR, gp, bp, SLOTS, CNT + (3 * l + (mix ? 0 : 1)) * 128, ALPHA, lds};
                pg8::gemm_phase<pg8::EpiResLN, pg8::StaticOrderT<M, 1024>, true, true, 1024>(lds, g, S, E, tid); }
            else if (kind == PK_Q) { pg8::Gemm g{YB, WL + WO_XQ, M, 1024, 1024}; pg8::StaticOrderT<M, 1024> S; S.init(G, (int)blockIdx.x);
                pg8::EpiBf16LN E{Qb, 1024, MUR, csl + CS_Q, cbl + CS_Q}; pg8::gemm_phase<pg8::EpiBf16LN, pg8::StaticOrderT<M, 1024>, true, true, 1024>(lds, g, S, E, tid);
                asm volatile("s_waitcnt vmcnt(0)" ::: "memory"); __syncthreads();
                att_phase(lds, Kb + l * 1024, Vt + (size_t)l * 1024 * 1024, Qb, Qb, S, tid); }
            else if (kind == PK_FF1) { pg8::Gemm g{YB, WL + WO_FF1, M, 2 * D_FF, 1024}; pg8::StaticOrderT<M, 2 * D_FF> S; S.init(G, (int)blockIdx.x);
                pg8::EpiSwigluLN E{ACT, MUR, csl + CS_FF1, cbl + CS_FF1}; pg8::gemm_phase<pg8::EpiSwigluLN, pg8::StaticOrderT<M, 2 * D_FF>, true, true, 1024>(lds, g, S, E, tid); }
            else { pg8::Gemm g{ACT, WL + WO_FF2, M, 1024, D_FF}; pg8::StaticOrderT<M, 1024> S; S.init(G, (int)blockIdx.x);
                pg8::EpiResLN E{nullptr, l == DEPTH - 1 ? Y : nullptr, YB, MUR, INP(18) + l * D, INP(19) + l * D, SLOTS, CNT + (3 * l + 2) * 128, ALPHA, lds};
                pg8::gemm_phase<pg8::EpiResLN, pg8::StaticOrderT<M, 1024>, true, true, D_FF>(lds, g, S, E, tid); }
        }
      }
        if (p + 1 < a.ph_hi) { if (p == 0) cg::this_grid().sync(); else xcd_barrier(xbar); if (a.sub & 256) xcd_barrier(xbar); if (a.sub & 512) xcd_barrier_v<false, false>(xbar); }
    }
}

#undef INP
extern "C" void kernel_launch(void* const* d_in, const int* in_sizes, int n_in, void* d_out, int out_size, void* d_ws, size_t ws_size, hipStream_t stream) {
    if (n_in != 24 || out_size != M * D || ws_size < WS_END) { fprintf(stderr, "kernel_launch: unexpected shapes (n_in %d out %d ws %zu)\n", n_in, out_size, ws_size); return; }
    static int grid = 0;
    if (grid == 0) {
        int dev = 0, cus = 0, per_cu = 0;
        (void)hipGetDevice(&dev); (void)hipDeviceGetAttribute(&cus, hipDeviceAttributeMultiprocessorCount, dev);
        if (hipFuncSetAttribute((const void*)mega, hipFuncAttributeMaxDynamicSharedMemorySize, LDS_BYTES) != hipSuccess) { fprintf(stderr, "kernel_launch: hipFuncSetAttribute failed\n"); grid = -1; return; }
        if (hipOccupancyMaxActiveBlocksPerMultiprocessor(&per_cu, (const void*)mega, NWAVES * 64, LDS_BYTES) != hipSuccess || per_cu < 1) { fprintf(stderr, "kernel_launch: occupancy query says %d\n", per_cu); per_cu = 1; }
        (void)hipGetLastError();
        grid = cus;
    }
    if (grid < 0) return;
    Args a{};
    for (int i = 0; i < 24; ++i) a.in[i] = (const float*)d_in[i];
    a.out = (float*)d_out; a.ws = (unsigned char*)d_ws;
#if ONE_LAUNCH
    if (hipMemsetAsync((char*)d_ws + WS_BAR, 0, 16384, stream) != hipSuccess) { fprintf(stderr, "kernel_launch: memset of the barrier words failed\n"); return; }
    a.ph_lo = 0; a.ph_hi = NPH; a.sub = 3 | PROBE_MASK;
    void* kargs[] = {&a};
    hipError_t e = hipLaunchCooperativeKernel((const void*)mega, dim3(grid), dim3(NWAVES * 64), kargs, LDS_BYTES, stream);
    if (e != hipSuccess) fprintf(stderr, "kernel_launch: cooperative launch failed: %s\n", hipGetErrorString(e));
#else
    for (int p = 0; p < NPH; ++p) { a.ph_lo = p; a.ph_hi = p + 1; a.sub = 3; hipLaunchKernelGGL(mega, dim3(grid), dim3(NWAVES * 64), LDS_BYTES, stream, a); }
#endif
}
```

```cpp
#include <hip/hip_runtime.h>
#include <hip/hip_cooperative_groups.h>
#include <cstdio>
#include <cstdint>

typedef unsigned short bf16_t;
typedef unsigned u32x4 __attribute__((ext_vector_type(4)));
typedef float f32x4 __attribute__((ext_vector_type(4)));

constexpr int D = 1024, BATCH = 4, SEQ = 8192, DEPTH = 4, M = BATCH * SEQ;
constexpr int IN_COLS = 2576, PROJ_LD = 2560, MEM_LEN = 256, D_FF = 2816;
constexpr int C_CA = 0, C_CG = 512, C_Q = 1024, C_K = 1280, C_V = 1536, C_R = 2048, C_AL = 2560;
constexpr float LN_EPS = 1e-5f;
constexpr float ALPHA = 1.681792830507429f;

constexpr size_t MiB = 1u << 20;
constexpr size_t WS_CTL = 0;
constexpr size_t WS_K = 8 * MiB;
constexpr size_t WS_VT = 16 * MiB;
constexpr size_t WS_MEMB = 24 * MiB;
constexpr size_t WS_MEMP = 26 * MiB;
constexpr size_t WS_ALOW = 28 * MiB;
constexpr size_t WS_DEC = 29 * MiB;
constexpr size_t WS_CNT = 0;
constexpr size_t WS_BAR = 65536;
constexpr size_t WS_CSP = 1 * MiB;
constexpr size_t WS_CS = 6 * MiB;
constexpr size_t WS_SLOTS = 30 * MiB;
constexpr size_t WS_MUR = 31 * MiB;
constexpr size_t WS_WT = 32 * MiB;
constexpr size_t WS_HB = 160 * MiB;
constexpr size_t WS_PROJ = 224 * MiB;
constexpr size_t WS_Q = 224 * MiB;
constexpr size_t WS_ACT = 224 * MiB;
constexpr size_t WS_UPD = 384 * MiB;
constexpr size_t WS_MIXIN = 448 * MiB;
constexpr size_t WS_END = 512 * MiB;

__host__ __device__ __forceinline__ int key_of_slot(int p) { const int e = p & 7, kg = (p >> 3) & 3; return (p & ~31) + 16 * (e >> 2) + 4 * kg + (e & 3); }
__host__ __device__ __forceinline__ int slot_of_key(int k) { const int w = k & 31; return (k & ~31) + 8 * ((w >> 2) & 3) + 4 * (w >> 4) + (w & 3); }

__device__ __forceinline__ float bf2f(bf16_t b) { return __uint_as_float(((unsigned)b) << 16); }
__device__ __forceinline__ bf16_t f2bf(float f) { unsigned u = __float_as_uint(f); return (bf16_t)((u + 0x7fffu + ((u >> 16) & 1u)) >> 16); }
__device__ __forceinline__ float ldf(const float* p) { return *p; }
__device__ __forceinline__ float ldf(const bf16_t* p) { return bf2f(*p); }
__device__ __forceinline__ float sigmoidf_(float x) { return 1.f / (1.f + __expf(-x)); }
__device__ __forceinline__ float siluf_(float x) { return x / (1.f + __expf(-x)); }
__device__ __forceinline__ float wave_sum(float v) {
#pragma unroll
    for (int o = 1; o < 64; o <<= 1) v += __shfl_xor(v, o);
    return v;
}
__device__ __forceinline__ float wave_max(float v) {
#pragma unroll
    for (int o = 1; o < 64; o <<= 1) v = fmaxf(v, __shfl_xor(v, o));
    return v;
}

namespace pg8 {
#define PG8_LAS __attribute__((address_space(3)))
typedef unsigned short bf16_t;
typedef short bf16x8 __attribute__((ext_vector_type(8)));
typedef float f32x4 __attribute__((ext_vector_type(4)));
typedef unsigned u32x4 __attribute__((ext_vector_type(4)));
constexpr int BM = 256, BK = 64, HALF = 128, HTB = HALF * BK * 2  , STAGE_BYTES = 8 * HTB, NXCD = 8, WGM = 8;

__host__ __device__ __forceinline__ int lds_byte(int r, int c) { const int st = (r >> 4) * 2 + (c >> 5), rr = r & 15, cc = c & 31, ob = rr * 64 + cc * 2; return st * 1024 + (ob ^ (((ob >> 9) & 1) << 5)); }
__host__ __device__ __forceinline__ void stage_rc(int b, int& R, int& C) { const int st = b / 1024, sb = b % 1024, swz = sb ^ (((sb >> 9) & 1) << 5); R = (st >> 1) * 16 + swz / 64; C = (st & 1) * 32 + (swz % 64) / 2; }
__host__ __device__ __forceinline__ int perm32(int rho) { const int n = rho >> 4, i = rho & 15; return 8 * (i >> 2) + 4 * n + (i & 3); }

struct Unit { int pm, pn; };
struct Gemm { const bf16_t* A; const bf16_t* Bt; int M, N, K; };

struct StaticOrder {
    int nM, nN, nwg, G, c;
    __host__ __device__ void init(int M, int N, int G_, int c_) { nM = M / BM; nN = N / BM; nwg = nM * nN; G = G_; c = c_; }
    __host__ __device__ bool next(int i, Unit& u) const {
        const long L = (long)i * G + c; if (L >= nwg) return false;
        int wgid = (int)L; { const int q = nwg / NXCD, r = nwg % NXCD, xcd = wgid % NXCD, off = wgid / NXCD; wgid = (xcd < r ? xcd * (q + 1) : r * (q + 1) + (xcd - r) * q) + off; }
        const int nig = WGM * nN, gid = wgid / nig, fm = gid * WGM, gsz = (nM - fm) < WGM ? (nM - fm) : WGM;
        u.pm = fm + ((wgid % nig) % gsz); u.pn = (wgid % nig) / gsz; return true;
    }
    __device__ __forceinline__ void a_ready(const Unit&) const {}
    __device__ __forceinline__ void done(const Unit&) const {}
};


template <int MM, int NN> struct StaticOrderT {
    static constexpr int nM = MM / BM, nN = NN / BM, nwg = nM * nN;
    int G, c;
    __host__ __device__ void init(int G_, int c_) { G = G_; c = c_; }
    __host__ __device__ bool next(int i, Unit& u) const {
        const long L = (long)i * G + c; if (L >= nwg) return false;
        int wgid = (int)L; { constexpr int q = nwg / NXCD, r = nwg % NXCD; const int xcd = wgid % NXCD, off = wgid / NXCD; wgid = (xcd < r ? xcd * (q + 1) : r * (q + 1) + (xcd - r) * q) + off; }
        constexpr int nig = WGM * nN; const int gid = wgid / nig, fm = gid * WGM, gsz = (nM - fm) < WGM ? (nM - fm) : WGM;
        u.pm = fm + ((wgid % nig) % gsz); u.pn = (wgid % nig) / gsz; return true;
    }
    __device__ __forceinline__ void a_ready(const Unit&) const {}
    __device__ __forceinline__ void done(const Unit&) const {}
};
typedef float f32x2 __attribute__((ext_vector_type(2)));
__device__ __forceinline__ unsigned cvt_pk_bf16(float lo, float hi) { unsigned r; asm volatile("v_cvt_pk_bf16_f32 %0, %1, %2" : "=v"(r) : "v"(lo), "v"(hi)); return r; }
__device__ __forceinline__ u32x4 pack8(const f32x4 v0, const f32x4 v1) { u32x4 w; w.x = cvt_pk_bf16(v0[0], v0[1]); w.y = cvt_pk_bf16(v0[2], v0[3]); w.z = cvt_pk_bf16(v1[0], v1[1]); w.w = cvt_pk_bf16(v1[2], v1[3]); return w; }
__device__ __forceinline__ float silu_fast(float x) { return x * __builtin_amdgcn_rcpf(1.f + __expf(-x)); }
struct EpiBf16 {
    static constexpr bool PERM = true, AFTER_DRAIN = false;
    bf16_t* O; int ldc;
    __device__ __forceinline__ void operator()(const f32x4 (&acc)[2][2][4][2], const Unit& u, int wr, int wc, int fr, int fq) const {
        const int row0 = u.pm * BM + wr * 64 + fr, col0 = u.pn * BM + wc * 32 + 8 * fq;
#pragma unroll
        for (int ai = 0; ai < 2; ++ai)
#pragma unroll
            for (int m = 0; m < 4; ++m) { bf16_t* rowp = O + (size_t)(row0 + ai * HALF + m * 16) * ldc + col0;
#pragma unroll
                for (int bj = 0; bj < 2; ++bj) *(u32x4*)(rowp + bj * HALF) = pack8(acc[ai][bj][m][0], acc[ai][bj][m][1]); }
    }
};

__device__ __forceinline__ void row_stats8(const float* MUR, int row0, float (&mu)[2][4], float (&rs)[2][4]) {
#pragma unroll
    for (int ai = 0; ai < 2; ++ai)
#pragma unroll
        for (int m = 0; m < 4; ++m) { const f32x2 t = *(const f32x2*)(MUR + 2 * (size_t)(row0 + ai * HALF + m * 16)); mu[ai][m] = t.x; rs[ai][m] = t.y; }
}
struct EpiBf16LN {
    static constexpr bool PERM = true, AFTER_DRAIN = false;
    bf16_t* O; int ldc; const float* MUR; const float* cs; const float* cb;
    __device__ __forceinline__ void operator()(const f32x4 (&acc)[2][2][4][2], const Unit& u, int wr, int wc, int fr, int fq) const {
        const int row0 = u.pm * BM + wr * 64 + fr, col0 = u.pn * BM + wc * 32 + 8 * fq;
        float mu[2][4], rs[2][4]; row_stats8(MUR, row0, mu, rs);
#pragma unroll
        for (int bj = 0; bj < 2; ++bj) { const f32x4 s0 = *(const f32x4*)(cs + col0 + bj * HALF), s1 = *(const f32x4*)(cs + col0 + bj * HALF + 4), b0 = *(const f32x4*)(cb + col0 + bj * HALF), b1 = *(const f32x4*)(cb + col0 + bj * HALF + 4);
#pragma unroll
            for (int ai = 0; ai < 2; ++ai)
#pragma unroll
                for (int m = 0; m < 4; ++m) { const f32x4 v0 = (acc[ai][bj][m][0] - s0 * mu[ai][m]) * rs[ai][m] + b0, v1 = (acc[ai][bj][m][1] - s1 * mu[ai][m]) * rs[ai][m] + b1;
                    *(u32x4*)(O + (size_t)(row0 + ai * HALF + m * 16) * ldc + col0 + bj * HALF) = pack8(v0, v1); } }
    }
};
struct EpiInLN {
    static constexpr bool PERM = true, AFTER_DRAIN = false;
    bf16_t* O; const float* MUR; const float* cs; const float* cb; static constexpr int ldc = 2560;
    __device__ __forceinline__ void operator()(const f32x4 (&acc)[2][2][4][2], const Unit& u, int wr, int wc, int fr, int fq) const {
        const int row0 = u.pm * BM + wr * 64 + fr, col0 = u.pn * BM + wc * 32 + 8 * fq;
        float mu[2][4], rs[2][4]; row_stats8(MUR, row0, mu, rs);
        if (u.pn >= 4) {
#pragma unroll
            for (int bj = 0; bj < 2; ++bj) { const f32x4 s0 = *(const f32x4*)(cs + col0 + bj * HALF), s1 = *(const f32x4*)(cs + col0 + bj * HALF + 4), b0 = *(const f32x4*)(cb + col0 + bj * HALF), b1 = *(const f32x4*)(cb + col0 + bj * HALF + 4);
#pragma unroll
                for (int ai = 0; ai < 2; ++ai)
#pragma unroll
                    for (int m = 0; m < 4; ++m) { const f32x4 v0 = (acc[ai][bj][m][0] - s0 * mu[ai][m]) * rs[ai][m] + b0, v1 = (acc[ai][bj][m][1] - s1 * mu[ai][m]) * rs[ai][m] + b1;
                        *(u32x4*)(O + (size_t)(row0 + ai * HALF + m * 16) * ldc + col0 + bj * HALF) = pack8(v0, v1); } }
        } else {
            const int ucol = u.pn * HALF + wc * 32 + 8 * fq;
            const f32x4 sa0 = *(const f32x4*)(cs + col0), sa1 = *(const f32x4*)(cs + col0 + 4), ba0 = *(const f32x4*)(cb + col0), ba1 = *(const f32x4*)(cb + col0 + 4);
            const f32x4 sg0 = *(const f32x4*)(cs + col0 + HALF), sg1 = *(const f32x4*)(cs + col0 + HALF + 4), bg0 = *(const f32x4*)(cb + col0 + HALF), bg1 = *(const f32x4*)(cb + col0 + HALF + 4);
#pragma unroll
            for (int ai = 0; ai < 2; ++ai)
#pragma unroll
                for (int m = 0; m < 4; ++m) {
                    const f32x4 a0 = (acc[ai][0][m][0] - sa0 * mu[ai][m]) * rs[ai][m] + ba0, a1 = (acc[ai][0][m][1] - sa1 * mu[ai][m]) * rs[ai][m] + ba1;
                    const f32x4 g0 = (acc[ai][1][m][0] - sg0 * mu[ai][m]) * rs[ai][m] + bg0, g1 = (acc[ai][1][m][1] - sg1 * mu[ai][m]) * rs[ai][m] + bg1;
                    f32x4 u0, u1;
#pragma unroll
                    for (int j = 0; j < 4; ++j) { u0[j] = a0[j] * __builtin_amdgcn_rcpf(1.f + __expf(-g0[j])); u1[j] = a1[j] * __builtin_amdgcn_rcpf(1.f + __expf(-g1[j])); }
                    *(u32x4*)(O + (size_t)(row0 + ai * HALF + m * 16) * ldc + ucol) = pack8(u0, u1); }
        }
    }
};
struct EpiSwigluLN {
    static constexpr bool PERM = true, AFTER_DRAIN = false;
    bf16_t* O; const float* MUR; const float* cs; const float* cb; static constexpr int ldc = 2816;
    __device__ __forceinline__ void operator()(const f32x4 (&acc)[2][2][4][2], const Unit& u, int wr, int wc, int fr, int fq) const {
        const int row0 = u.pm * BM + wr * 64 + fr, wrow = u.pn * BM + wc * 32 + 8 * fq, col0 = u.pn * HALF + wc * 32 + 8 * fq;
        float mu[2][4], rs[2][4]; row_stats8(MUR, row0, mu, rs);
        const f32x4 sg0 = *(const f32x4*)(cs + wrow), sg1 = *(const f32x4*)(cs + wrow + 4), bg0 = *(const f32x4*)(cb + wrow), bg1 = *(const f32x4*)(cb + wrow + 4);
        const f32x4 su0 = *(const f32x4*)(cs + wrow + HALF), su1 = *(const f32x4*)(cs + wrow + HALF + 4), bu0 = *(const f32x4*)(cb + wrow + HALF), bu1 = *(const f32x4*)(cb + wrow + HALF + 4);
#pragma unroll
        for (int ai = 0; ai < 2; ++ai)
#pragma unroll
            for (int m = 0; m < 4; ++m) {
                const f32x4 g0 = (acc[ai][0][m][0] - sg0 * mu[ai][m]) * rs[ai][m] + bg0, g1 = (acc[ai][0][m][1] - sg1 * mu[ai][m]) * rs[ai][m] + bg1;
                const f32x4 u0 = (acc[ai][1][m][0] - su0 * mu[ai][m]) * rs[ai][m] + bu0, u1 = (acc[ai][1][m][1] - su1 * mu[ai][m]) * rs[ai][m] + bu1;
                f32x4 a0, a1;
#pragma unroll
                for (int j = 0; j < 4; ++j) { a0[j] = silu_fast(g0[j]) * u0[j]; a1[j] = silu_fast(g1[j]) * u1[j]; }
                *(u32x4*)(O + (size_t)(row0 + ai * HALF + m * 16) * ldc + col0) = pack8(a0, a1); }
    }
};
struct EpiResLN {
    static constexpr bool PERM = false, AFTER_DRAIN = false;
    const float* Xin; float* Yout; bf16_t* YB; float* MUR; const float* gp; const float* bp; unsigned long long* slots; unsigned* cnt; float alpha; PG8_LAS unsigned char* lds;
    __device__ __forceinline__ void operator()(f32x4 (&acc)[2][2][4][2], const Unit& u, int wr, int wc, int fr, int fq) const {
        typedef unsigned u32x2 __attribute__((ext_vector_type(2)));
        const int row0 = u.pm * BM + wr * 64 + fr, col0 = u.pn * BM + wc * 32 + 4 * fq;
#pragma unroll
        for (int ai = 0; ai < 2; ++ai) {
            float mu[4], rs[4];
#pragma unroll
            for (int m = 0; m < 4; ++m) { const f32x2 t = *(const f32x2*)(MUR + 2 * (size_t)(row0 + ai * HALF + m * 16)); mu[m] = t.x; rs[m] = t.y; }
#pragma unroll
            for (int bj = 0; bj < 2; ++bj)
#pragma unroll
                for (int n = 0; n < 2; ++n) { const f32x4 g4 = *(const f32x4*)(gp + col0 + bj * HALF + n * 16), b4 = *(const f32x4*)(bp + col0 + bj * HALF + n * 16);
                    u32x2 told[4];
                    if (!Xin) {
#pragma unroll
                        for (int m = 0; m < 4; ++m) told[m] = *(const u32x2*)(YB + (size_t)(row0 + ai * HALF + m * 16) * 1024 + col0 + bj * HALF + n * 16);
                    }
#pragma unroll
                    for (int m = 0; m < 4; ++m) { const size_t off = (size_t)(row0 + ai * HALF + m * 16) * 1024 + col0 + bj * HALF + n * 16;
                        f32x4 yo;
                        if (Xin) yo = *(const f32x4*)(Xin + off);
                        else { const u32x2 t = told[m]; yo = (f32x4){__uint_as_float(t.x << 16), __uint_as_float(t.x & 0xffff0000u), __uint_as_float(t.y << 16), __uint_as_float(t.y & 0xffff0000u)}; }
                        const f32x4 yn = ((yo - mu[m]) * rs[m] * g4 + b4) * alpha + acc[ai][bj][m][n];
                        acc[ai][bj][m][n] = yn; if (Yout) *(f32x4*)(Yout + off) = yn;
                        u32x2 w; w.x = cvt_pk_bf16(yn[0], yn[1]); w.y = cvt_pk_bf16(yn[2], yn[3]); *(u32x2*)(YB + off) = w; } } }
        PG8_LAS f32x2* P = (PG8_LAS f32x2*)(lds + 131072);
#pragma unroll
        for (int ai = 0; ai < 2; ++ai)
#pragma unroll
            for (int m = 0; m < 4; ++m) {
                float s = 0.f;
#pragma unroll
                for (int bj = 0; bj < 2; ++bj)
#pragma unroll
                    for (int n = 0; n < 2; ++n) { const f32x4 x = acc[ai][bj][m][n]; s += (x[0] + x[1]) + (x[2] + x[3]); }
                s += __shfl_xor(s, 16); s += __shfl_xor(s, 32);
                const float mw = s * (1.0f / 64.0f); float q = 0.f;
#pragma unroll
                for (int bj = 0; bj < 2; ++bj)
#pragma unroll
                    for (int n = 0; n < 2; ++n) { const f32x4 d = acc[ai][bj][m][n] - mw; q += (d[0] * d[0] + d[1] * d[1]) + (d[2] * d[2] + d[3] * d[3]); }
                q += __shfl_xor(q, 16); q += __shfl_xor(q, 32);
                if (fq == 0) P[(ai * HALF + wr * 64 + m * 16 + fr) * 4 + wc] = (f32x2){mw, q};
            }
        asm volatile("s_waitcnt lgkmcnt(0)" ::: "memory"); __builtin_amdgcn_s_barrier(); asm volatile("" ::: "memory");
        const int wid = wr * 4 + wc, lane = fq * 16 + fr, row = wid * 32 + (lane & 31);
        if (lane < 32) {
            const f32x2 a = P[row * 4 + 0], b = P[row * 4 + 1], c = P[row * 4 + 2], d = P[row * 4 + 3];
            const float mt = (a.x + b.x + c.x + d.x) * 0.25f;
            const float da = a.x - mt, db = b.x - mt, dc = c.x - mt, dd = d.x - mt;
            const float m2 = (a.y + b.y) + (c.y + d.y) + 64.0f * ((da * da + db * db) + (dc * dc + dd * dd));
            __hip_atomic_store(slots + ((size_t)(u.pm * BM + row) * 4 + u.pn), ((unsigned long long)__float_as_uint(m2) << 32) | __float_as_uint(mt), __ATOMIC_RELAXED, __HIP_MEMORY_SCOPE_AGENT);
        }
        asm volatile("s_waitcnt vmcnt(0)" ::: "memory");
        unsigned old = 0u;
        if (lane == 0) old = __hip_atomic_fetch_add(cnt + u.pm, 1u, __ATOMIC_RELAXED, __HIP_MEMORY_SCOPE_AGENT);
        old = (unsigned)__builtin_amdgcn_readfirstlane((int)old);
        if (old == 31u) {
#pragma unroll
            for (int rr = 0; rr < 4; ++rr) { const int r = lane * 4 + rr; const unsigned long long* sl = slots + (size_t)(u.pm * BM + r) * 4; float mt[4], m2[4], ms = 0.f;
#pragma unroll
                for (int t = 0; t < 4; ++t) { const unsigned long long w = __hip_atomic_load(sl + t, __ATOMIC_RELAXED, __HIP_MEMORY_SCOPE_AGENT); mt[t] = __uint_as_float((unsigned)w); m2[t] = __uint_as_float((unsigned)(w >> 32)); ms += mt[t]; }
                const float mean = ms * 0.25f; float q = 0.f;
#pragma unroll
                for (int t = 0; t < 4; ++t) { const float dm = mt[t] - mean; q += m2[t] + 256.0f * dm * dm; }
                *(f32x2*)(MUR + 2 * (size_t)(u.pm * BM + r)) = (f32x2){mean, 1.0f / sqrtf(q * (1.0f / 1024.0f) + 1e-5f)}; }
        }
    }
};

template <class Epi, class Sched, bool ALIGN_EPI, bool SP2, int KC>
__device__ __forceinline__ void gemm_phase(PG8_LAS unsigned char* lds, const Gemm g, const Sched& S, const Epi& E, const int tid) {
    const int wid = __builtin_amdgcn_readfirstlane(tid >> 6), lane = tid & 63, wr = wid >> 2, wc = wid & 3, fr = lane & 15, fq = lane >> 4;
    constexpr int K = KC, nt = K / BK;
    unsigned voffA[2], voffB[2];
#pragma unroll
    for (int i = 0; i < 2; ++i) { int R, C; stage_rc(tid * 16 + i * 8192, R, C); const int Rb = Epi::PERM ? ((R & ~31) + perm32(R & 31)) : R;
        voffA[i] = (unsigned)(R * K + C) * 2u; voffB[i] = (unsigned)(Rb * K + C) * 2u; }
    const size_t kstep = (size_t)(BK * 2);
    const size_t hstep = (size_t)HALF * K * 2;
    const size_t tstep = 2 * hstep;
    const unsigned ldsw = (unsigned)wid * 1024u;
    const int aoff = lds_byte(wr * 64 + fr, fq * 8), boff = lds_byte(wc * 32 + fr, fq * 8);
#define PG8_SA(b, h) (((b) * 2 + (h)) * HTB)
#define PG8_SB(b, h) ((4 + (b) * 2 + (h)) * HTB)
#define PG8_STAGE(bufoff, gbase, voff) do { _Pragma("unroll") for (int _i = 0; _i < 2; ++_i) \
        __builtin_amdgcn_global_load_lds((const unsigned*)((const char*)(gbase) + (voff)[_i]), (PG8_LAS unsigned*)(lds + (bufoff) + ldsw + _i * 8192), 16, 0, 0); } while (0)
#define PG8_LDA(dst, b, h) do { _Pragma("unroll") for (int m = 0; m < 4; ++m) _Pragma("unroll") for (int k = 0; k < 2; ++k) dst[m][k] = *(const PG8_LAS bf16x8*)(lds + PG8_SA(b, h) + aoff + m * 2048 + k * 1024); } while (0)
#define PG8_LDB(dst, b, h) do { _Pragma("unroll") for (int n = 0; n < 2; ++n) _Pragma("unroll") for (int k = 0; k < 2; ++k) dst[n][k] = *(const PG8_LAS bf16x8*)(lds + PG8_SB(b, h) + boff + n * 2048 + k * 1024); } while (0)
#define PG8_MMA(ai, bj, At, Bt) do { __builtin_amdgcn_s_setprio(1); _Pragma("unroll") for (int m = 0; m < 4; ++m) _Pragma("unroll") for (int n = 0; n < 2; ++n) _Pragma("unroll") for (int k = 0; k < 2; ++k) \
        acc[ai][bj][m][n] = __builtin_amdgcn_mfma_f32_16x16x32_bf16(Bt[n][k], At[m][k], acc[ai][bj][m][n], 0, 0, 0); __builtin_amdgcn_s_setprio(0); } while (0)
#define PG8_WAIT_V(n) asm volatile("s_waitcnt vmcnt(" #n ")" ::: "memory")
#define PG8_WAIT_L(n) asm volatile("s_waitcnt lgkmcnt(" #n ")" ::: "memory")
#define PG8_BAR __builtin_amdgcn_s_barrier()
#define PG8_SCHED __builtin_amdgcn_sched_barrier(0)
    Unit cur, nxt; int ui = 0;
    if (!S.next(0, cur)) return;
    f32x4 acc[2][2][4][2];
#pragma unroll
    for (int a = 0; a < 2; ++a)
#pragma unroll
        for (int b = 0; b < 2; ++b)
#pragma unroll
            for (int m = 0; m < 4; ++m)
#pragma unroll
                for (int n = 0; n < 2; ++n) acc[a][b][m][n] = (f32x4){0.f, 0.f, 0.f, 0.f};
    bf16x8 At[4][2], B0[2][2], B1[2][2];
    const char* cA = (const char*)g.A + (size_t)cur.pm * tstep; const char* cB = (const char*)g.Bt + (size_t)cur.pn * tstep;
    S.a_ready(cur);
    if constexpr (SP2) {
        PG8_STAGE(PG8_SB(0, 0), cB, voffB); PG8_STAGE(PG8_SB(0, 1), cB + hstep, voffB); PG8_STAGE(PG8_SA(0, 0), cA, voffA); PG8_STAGE(PG8_SA(0, 1), cA + hstep, voffA);
        if (wr == 1) PG8_BAR;
        PG8_WAIT_V(2); PG8_BAR;
        PG8_STAGE(PG8_SB(1, 0), cB + kstep, voffB); PG8_STAGE(PG8_SA(1, 0), cA + kstep, voffA); PG8_STAGE(PG8_SB(1, 1), cB + hstep + kstep, voffB);
        PG8_WAIT_V(6); PG8_BAR;
    } else {
        PG8_STAGE(PG8_SB(0, 0), cB, voffB); PG8_STAGE(PG8_SA(0, 0), cA, voffA); PG8_STAGE(PG8_SB(0, 1), cB + hstep, voffB); PG8_STAGE(PG8_SA(0, 1), cA + hstep, voffA);
        if (wr == 1) PG8_BAR;
        PG8_WAIT_V(4); PG8_BAR;
        PG8_STAGE(PG8_SB(1, 0), cB + kstep, voffB); PG8_STAGE(PG8_SA(1, 0), cA + kstep, voffA); PG8_STAGE(PG8_SB(1, 1), cB + hstep + kstep, voffB);
        PG8_WAIT_V(6); PG8_BAR;
    }
    for (;;) {
        const bool has_next = S.next(ui + 1, nxt);
        const char* nA = has_next ? (const char*)g.A + (size_t)nxt.pm * tstep : cA; const char* nB = has_next ? (const char*)g.Bt + (size_t)nxt.pn * tstep : cB;
        for (int t = 0; t < nt; t += 2) {
            const bool last = (t == nt - 2);
            const char* a1 = cA + (size_t)(t + 1) * kstep;
            const char* a2 = last ? nA : cA + (size_t)(t + 2) * kstep; const char* b2 = last ? nB : cB + (size_t)(t + 2) * kstep;
            const char* a3 = a2 + kstep; const char* b3 = b2 + kstep;
            if (last && has_next) S.a_ready(nxt);
            if constexpr (SP2) {
            PG8_LDB(B0, 0, 0); PG8_LDB(B1, 0, 1); PG8_SCHED; PG8_LDA(At, 0, 0); PG8_STAGE(PG8_SA(1, 1), a1 + hstep, voffA);
            PG8_WAIT_V(8); PG8_WAIT_L(0); PG8_BAR; PG8_MMA(0, 0, At, B0); PG8_MMA(0, 1, At, B1); PG8_BAR; PG8_SCHED;
            PG8_LDA(At, 0, 1); PG8_STAGE(PG8_SB(0, 0), b2, voffB); PG8_STAGE(PG8_SB(0, 1), b2 + hstep, voffB); PG8_STAGE(PG8_SA(0, 0), a2, voffA);
            PG8_WAIT_V(8); PG8_WAIT_L(0); PG8_BAR; PG8_MMA(1, 0, At, B0); PG8_MMA(1, 1, At, B1); PG8_BAR; PG8_SCHED;
            PG8_LDB(B0, 1, 0); PG8_LDB(B1, 1, 1); PG8_SCHED; PG8_LDA(At, 1, 0); PG8_STAGE(PG8_SA(0, 1), a2 + hstep, voffA);
            PG8_WAIT_V(8); PG8_WAIT_L(0); PG8_BAR; PG8_MMA(0, 0, At, B0); PG8_MMA(0, 1, At, B1); PG8_BAR; PG8_SCHED;
            PG8_LDA(At, 1, 1); PG8_STAGE(PG8_SB(1, 0), b3, voffB); PG8_STAGE(PG8_SB(1, 1), b3 + hstep, voffB); PG8_STAGE(PG8_SA(1, 0), a3, voffA);
            PG8_WAIT_V(8); PG8_WAIT_L(0); PG8_BAR; PG8_MMA(1, 0, At, B0); PG8_MMA(1, 1, At, B1); PG8_BAR; PG8_SCHED;
            } else {
            PG8_LDB(B0, 0, 0); PG8_SCHED; PG8_LDA(At, 0, 0); PG8_STAGE(PG8_SA(1, 1), a1 + hstep, voffA);
            PG8_WAIT_L(8); PG8_BAR; PG8_WAIT_L(0); PG8_MMA(0, 0, At, B0); PG8_BAR; PG8_SCHED;
            PG8_LDB(B1, 0, 1); PG8_STAGE(PG8_SB(0, 0), b2, voffB);
            PG8_BAR; PG8_WAIT_L(0); PG8_MMA(0, 1, At, B1); PG8_BAR;
            PG8_LDA(At, 0, 1); PG8_STAGE(PG8_SA(0, 0), a2, voffA);
            PG8_BAR; PG8_WAIT_L(0); PG8_MMA(1, 0, At, B0); PG8_BAR; PG8_SCHED;
            PG8_STAGE(PG8_SB(0, 1), b2 + hstep, voffB);
            PG8_WAIT_V(6); PG8_BAR; PG8_MMA(1, 1, At, B1); PG8_BAR;
            PG8_LDB(B0, 1, 0); PG8_SCHED; PG8_LDA(At, 1, 0); PG8_STAGE(PG8_SA(0, 1), a2 + hstep, voffA);
            PG8_WAIT_L(8); PG8_BAR; PG8_WAIT_L(0); PG8_MMA(0, 0, At, B0); PG8_BAR; PG8_SCHED;
            PG8_LDB(B1, 1, 1); PG8_STAGE(PG8_SB(1, 0), b3, voffB);
            PG8_BAR; PG8_WAIT_L(0); PG8_MMA(0, 1, At, B1); PG8_BAR;
            PG8_LDA(At, 1, 1); PG8_STAGE(PG8_SA(1, 0), a3, voffA);
            PG8_BAR; PG8_WAIT_L(0); PG8_MMA(1, 0, At, B0); PG8_BAR; PG8_SCHED;
            PG8_STAGE(PG8_SB(1, 1), b3 + hstep, voffB);
            PG8_WAIT_V(6); PG8_BAR; PG8_MMA(1, 1, At, B1); PG8_BAR;
            }
        }
        if constexpr (ALIGN_EPI) { if (wr == 0) PG8_BAR; }
        if constexpr (!Epi::AFTER_DRAIN) { E(acc, cur, wr, wc, fr, fq); S.done(cur); }
        if (!has_next) break;
#pragma unroll
        for (int a = 0; a < 2; ++a)
#pragma unroll
            for (int b = 0; b < 2; ++b)
#pragma unroll
                for (int m = 0; m < 4; ++m)
#pragma unroll
                    for (int n = 0; n < 2; ++n) acc[a][b][m][n] = (f32x4){0.f, 0.f, 0.f, 0.f};
        cur = nxt; cA = nA; cB = nB; ++ui;
        if constexpr (ALIGN_EPI) { if (wr == 1) PG8_BAR; }
    }
    PG8_WAIT_V(0);
    if constexpr (!ALIGN_EPI) { if (wr == 0) PG8_BAR; }
    PG8_BAR;
    if constexpr (Epi::AFTER_DRAIN) { E.fused(acc, cur, wr, wc, fr, fq, lds, wid, lane); S.done(cur); }
#undef PG8_SA
#undef PG8_SB
#undef PG8_STAGE
#undef PG8_LDA
#undef PG8_LDB
#undef PG8_MMA
#undef PG8_WAIT_V
#undef PG8_WAIT_L
#undef PG8_BAR
#undef PG8_SCHED
}
}
namespace cg = cooperative_groups;
#define LAS __attribute__((address_space(3)))
#define LDS_WAIT() asm volatile("s_waitcnt lgkmcnt(0)" ::: "memory")
constexpr int NWAVES = 8, LDS_BYTES = 147456;
constexpr size_t WT_XK = 0, WT_XV = (size_t)4096 * 1024, WT_L0 = (size_t)2 * 4096 * 1024, WT_LSTRIDE = 14680064;
constexpr size_t WO_IN = 0, WO_MIX = 2883584, WO_XQ = WO_MIX + 1048576, WO_XO = WO_XQ + 1048576, WO_FF1 = WO_XO + 1048576, WO_FF2 = WO_FF1 + 5767168;
static_assert(WO_FF2 + 2883584 == WT_LSTRIDE && (WT_L0 + 4 * WT_LSTRIDE) * 2 == 128 * MiB, "weight map");
constexpr int I_IN = 16 * 81, I_SQ = 512, I_XKV = 1024, I_FF1 = 16 * 176, I_FF2 = 44 * 32, I_LAYER = I_IN + 3 * I_SQ + I_XKV + I_FF1 + I_FF2;

struct Args { const float* in[24]; float* out; unsigned char* ws; int ph_lo, ph_hi, sub, pad; };

__device__ __forceinline__ unsigned pk2(float lo, float hi) { return (unsigned)f2bf(lo) | ((unsigned)f2bf(hi) << 16); }
__device__ __forceinline__ void cvt_item(const float* W, int K, int N, int k0, int n0, bf16_t* dst, LAS float* scr, int lane) {
#pragma unroll
    for (int i = 0; i < 32; ++i) { const int kk = 2 * i + (lane >> 5), n = n0 + (lane & 31); scr[kk * 33 + (lane & 31)] = n < N ? W[(size_t)(k0 + kk) * N + n] : 0.f; }
    LDS_WAIT(); asm volatile("" ::: "memory");
    const int c = lane & 7;
#pragma unroll
    for (int j = 0; j < 4; ++j) { const int n = (lane >> 3) + 8 * j; const LAS float* s = scr + (8 * c) * 33 + n;
        u32x4 o; o.x = pk2(s[0 * 33], s[1 * 33]); o.y = pk2(s[2 * 33], s[3 * 33]); o.z = pk2(s[4 * 33], s[5 * 33]); o.w = pk2(s[6 * 33], s[7 * 33]);
        *(u32x4*)(dst + (size_t)n * K + k0 + 8 * c) = o; }
    LDS_WAIT(); asm volatile("" ::: "memory");
}
__device__ __forceinline__ void ln_row(const float* in, float* outf, bf16_t* outb, const float* g, const float* b, int lane) {
    const f32x4* xr = (const f32x4*)in + lane;
    f32x4 v[4]; float s = 0.f;
#pragma unroll
    for (int j = 0; j < 4; ++j) { v[j] = xr[64 * j]; s += (v[j].x + v[j].y) + (v[j].z + v[j].w); }
    const float mean = wave_sum(s) * (1.f / D); float s2 = 0.f;
#pragma unroll
    for (int j = 0; j < 4; ++j) { v[j] = v[j] - mean; s2 += (v[j].x * v[j].x + v[j].y * v[j].y) + (v[j].z * v[j].z + v[j].w * v[j].w); }
    const float rstd = rsqrtf(wave_sum(s2) * (1.f / D) + LN_EPS);
#pragma unroll
    for (int j = 0; j < 4; ++j) {
        const int c = (64 * j + lane) * 4;
        const f32x4 o = v[j] * rstd * *(const f32x4*)(g + c) + *(const f32x4*)(b + c);
        *((f32x4*)outf + 64 * j + lane) = o;
        *(unsigned long long*)(outb + c) = (unsigned long long)pk2(o.x, o.y) | ((unsigned long long)pk2(o.z, o.w) << 32);
    }
}


__device__ __forceinline__ void cvt_item_ln(const float* W, int K, int N, int k0, int n0, bf16_t* dst, LAS float* scr, int lane, const float* g, const float* b, float* csp, float* cbp) {
    float cs = 0.f, cb = 0.f;
#pragma unroll
    for (int i = 0; i < 32; ++i) { const int kk = 2 * i + (lane >> 5), n = n0 + (lane & 31); const float w = n < N ? W[(size_t)(k0 + kk) * N + n] : 0.f; const float wg = w * g[k0 + kk];
        scr[kk * 33 + (lane & 31)] = wg; cs += bf2f(f2bf(wg)); cb += b[k0 + kk] * w; }
    cs += __shfl_xor(cs, 32); cb += __shfl_xor(cb, 32);
    if (lane < 32) { csp[lane] = cs; cbp[lane] = cb; }
    LDS_WAIT(); asm volatile("" ::: "memory");
    const int c = lane & 7;
#pragma unroll
    for (int j = 0; j < 4; ++j) { const int n = (lane >> 3) + 8 * j; const LAS float* s = scr + (8 * c) * 33 + n;
        u32x4 o; o.x = pk2(s[0 * 33], s[1 * 33]); o.y = pk2(s[2 * 33], s[3 * 33]); o.z = pk2(s[4 * 33], s[5 * 33]); o.w = pk2(s[6 * 33], s[7 * 33]);
        *(u32x4*)(dst + (size_t)n * K + k0 + 8 * c) = o; }
    LDS_WAIT(); asm volatile("" ::: "memory");
}
template <int NR> __device__ __forceinline__ void x_rows(const float* x, bf16_t* YB, float* MUR, int m0, int stride, int lane) {
    f32x4 v[NR][4];
#pragma unroll
    for (int r = 0; r < NR; ++r)
#pragma unroll
        for (int j = 0; j < 4; ++j) v[r][j] = *((const f32x4*)(x + (size_t)(m0 + r * stride) * D) + 64 * j + lane);
#pragma unroll
    for (int r = 0; r < NR; ++r) { const size_t m = (size_t)(m0 + r * stride); float s = 0.f;
#pragma unroll
        for (int j = 0; j < 4; ++j) { s += (v[r][j].x + v[r][j].y) + (v[r][j].z + v[r][j].w);
            *(unsigned long long*)(YB + m * D + (64 * j + lane) * 4) = (unsigned long long)pk2(v[r][j].x, v[r][j].y) | ((unsigned long long)pk2(v[r][j].z, v[r][j].w) << 32); }
        const float mean = wave_sum(s) * (1.f / D); float s2 = 0.f;
#pragma unroll
        for (int j = 0; j < 4; ++j) { const f32x4 d = v[r][j] - mean; s2 += (d.x * d.x + d.y * d.y) + (d.z * d.z + d.w * d.w); }
        const float rstd = rsqrtf(wave_sum(s2) * (1.f / D) + LN_EPS);
        if (lane == 0) { MUR[2 * m] = mean; MUR[2 * m + 1] = rstd; } }
}
__device__ __forceinline__ void ln_row_f32(float* io, const float* g, const float* b, int lane) {
    f32x4* xr = (f32x4*)io + lane;
    f32x4 v[4]; float s = 0.f;
#pragma unroll
    for (int j = 0; j < 4; ++j) { v[j] = xr[64 * j]; s += (v[j].x + v[j].y) + (v[j].z + v[j].w); }
    const float mean = wave_sum(s) * (1.f / D); float s2 = 0.f;
#pragma unroll
    for (int j = 0; j < 4; ++j) { v[j] = v[j] - mean; s2 += (v[j].x * v[j].x + v[j].y * v[j].y) + (v[j].z * v[j].z + v[j].w * v[j].w); }
    const float rstd = rsqrtf(wave_sum(s2) * (1.f / D) + LN_EPS);
#pragma unroll
    for (int j = 0; j < 4; ++j) { const int c = (64 * j + lane) * 4; xr[64 * j] = v[j] * rstd * *(const f32x4*)(g + c) + *(const f32x4*)(b + c); }
}

__device__ __forceinline__ void alow_rows(const bf16_t* YB, const bf16_t* Wal, const float* MUR, const float* cs, const float* cb, bf16_t* ALOW, int gw, int NGW, int lane) {
    typedef short bf16x8_t __attribute__((ext_vector_type(8)));
    typedef unsigned u32x2_t __attribute__((ext_vector_type(2)));
    const int i = lane & 15, kg = lane >> 4;
    for (int rb = gw; rb < M / 16; rb += NGW) {
        const bf16_t* ap = YB + (size_t)(rb * 16 + i) * 1024 + 8 * kg; const bf16_t* wp = Wal + (size_t)i * 1024 + 8 * kg;
        f32x4 acc0 = (f32x4){0.f, 0.f, 0.f, 0.f}, acc1 = acc0;
#pragma unroll
        for (int s0 = 0; s0 < 32; s0 += 8) { bf16x8_t af[8], wf[8];
#pragma unroll
            for (int s = 0; s < 8; ++s) { af[s] = *(const bf16x8_t*)(ap + 32 * (s0 + s)); wf[s] = *(const bf16x8_t*)(wp + 32 * (s0 + s)); }
#pragma unroll
            for (int s = 0; s < 8; s += 2) { acc0 = __builtin_amdgcn_mfma_f32_16x16x32_bf16(wf[s], af[s], acc0, 0, 0, 0); acc1 = __builtin_amdgcn_mfma_f32_16x16x32_bf16(wf[s + 1], af[s + 1], acc1, 0, 0, 0); } }
        const float mu = MUR[2 * (size_t)(rb * 16 + i)], rs = MUR[2 * (size_t)(rb * 16 + i) + 1];
        const f32x4 c4 = *(const f32x4*)(cs + 4 * kg), b4 = *(const f32x4*)(cb + 4 * kg);
        const f32x4 z = ((acc0 + acc1) - c4 * mu) * rs + b4;
        u32x2_t w; w.x = pk2(z[0], z[1]); w.y = pk2(z[2], z[3]);
        *(u32x2_t*)(ALOW + (size_t)(rb * 16 + i) * 16 + 4 * kg) = w;
    }
}
#define XB_TMO      128
#define XB_XCNT(j)  (256  + 64 * (j))
#define XB_XSUB(j)  (1280 + 64 * (j))
#define XB_XGEN(j)  (2304 + 64 * (j))
#define XB_TOP      3328
#define XB_TOPGEN   3392
#define XCD_BAR_WORDS 3456
#define XB_SPIN_CAP (1u << 18)

__device__ __forceinline__ unsigned xb_ld(unsigned* p)              { return __hip_atomic_load(p, __ATOMIC_RELAXED, __HIP_MEMORY_SCOPE_AGENT); }
__device__ __forceinline__ unsigned xb_add(unsigned* p, unsigned v) { return __hip_atomic_fetch_add(p, v, __ATOMIC_RELAXED, __HIP_MEMORY_SCOPE_AGENT); }
__device__ __forceinline__ unsigned xb_xcc_id() { return (unsigned)__builtin_amdgcn_s_getreg((3 << 11) | 20) & 0xFu; }
#define XB_SPIN(cond, bar) do { unsigned _sp = 0; while (cond) { __builtin_amdgcn_s_sleep(1); \
    if ((++_sp & 255u) == 0u) { if (xb_ld(&(bar)[XB_TMO])) break; if (_sp > XB_SPIN_CAP) { atomicAdd(&(bar)[XB_TMO], 1u); break; } } } } while (0)

struct XcdBarrier {
    unsigned* bar; unsigned x;
    volatile LAS unsigned* st;
};

__device__ __forceinline__ XcdBarrier xcd_barrier_post(unsigned* bar, volatile LAS unsigned* st) {
    XcdBarrier b; b.bar = bar; b.x = xb_xcc_id(); b.st = st;
    if (threadIdx.x == 0) (void)xb_add(&bar[XB_XCNT(b.x)], 1u);
    return b;
}
__device__ __forceinline__ void xcd_barrier_complete(unsigned* bar, unsigned x, unsigned& nloc, unsigned& nx) {
    const unsigned G = gridDim.x * gridDim.y * gridDim.z;
    unsigned sum, cnt, mine, sp = 0u;
    for (;;) {
        sum = 0u; cnt = 0u; mine = 0u;
#pragma unroll
        for (unsigned j = 0; j < 16; ++j) { const unsigned c = xb_ld(&bar[XB_XCNT(j)]); sum += c; cnt += (c > 0u) ? 1u : 0u; mine = (j == x) ? c : mine; }
        if (sum == G) break;
        __builtin_amdgcn_s_sleep(1);
        if ((++sp & 255u) == 0u) { if (xb_ld(&bar[XB_TMO])) break; if (sp > XB_SPIN_CAP) { atomicAdd(&bar[XB_TMO], 1u); break; } }
    }
    nloc = mine > 0u ? mine : 1u; nx = cnt > 0u ? cnt : 1u;
}

__device__ __forceinline__ void xcd_barrier(const XcdBarrier& b) {
    asm volatile("s_waitcnt vmcnt(0)" ::: "memory");
    __syncthreads();
    if (threadIdx.x == 0) {
        unsigned* bar = b.bar;
        __builtin_amdgcn_s_waitcnt(0);
        unsigned nloc = b.st[0], nx = b.st[1];
        if (nloc == 0u) { xcd_barrier_complete(bar, b.x, nloc, nx); b.st[0] = nloc; b.st[1] = nx; }
        const unsigned old = xb_add(&bar[XB_XSUB(b.x)], 1u);
        const unsigned gen = old / nloc;
        if (old + 1u == (gen + 1u) * nloc) {
            __builtin_amdgcn_fence(__ATOMIC_RELEASE, "agent");
            asm volatile("s_waitcnt vmcnt(0)" ::: "memory");
            const unsigned og = xb_add(&bar[XB_TOP], 1u);
            const unsigned tg = og / nx;
            if (og + 1u == (tg + 1u) * nx) xb_add(&bar[XB_TOPGEN], 1u);
            else XB_SPIN(xb_ld(&bar[XB_TOPGEN]) == tg, bar);
            __builtin_amdgcn_fence(__ATOMIC_ACQUIRE, "agent");
            xb_add(&bar[XB_XGEN(b.x)], 1u);
            asm volatile("s_waitcnt vmcnt(0)" ::: "memory");
        } else {
            XB_SPIN(xb_ld(&bar[XB_XGEN(b.x)]) == gen, bar);
            __builtin_amdgcn_fence(__ATOMIC_ACQUIRE, "agent");
            asm volatile("s_waitcnt vmcnt(0)" ::: "memory");
        }
    }
    __syncthreads();
}

template <bool REL, bool ACQ> __device__ __forceinline__ void xcd_barrier_v(const XcdBarrier& b) {
    asm volatile("s_waitcnt vmcnt(0)" ::: "memory");
    __syncthreads();
    if (threadIdx.x == 0) {
        unsigned* bar = b.bar;
        __builtin_amdgcn_s_waitcnt(0);
        unsigned nloc = b.st[0], nx = b.st[1];
        if (nloc == 0u) { xcd_barrier_complete(bar, b.x, nloc, nx); b.st[0] = nloc; b.st[1] = nx; }
        const unsigned old = xb_add(&bar[XB_XSUB(b.x)], 1u);
        const unsigned gen = old / nloc;
        if (old + 1u == (gen + 1u) * nloc) {
            if (REL) __builtin_amdgcn_fence(__ATOMIC_RELEASE, "agent");
            asm volatile("s_waitcnt vmcnt(0)" ::: "memory");
            const unsigned og = xb_add(&bar[XB_TOP], 1u);
            const unsigned tg = og / nx;
            if (og + 1u == (tg + 1u) * nx) xb_add(&bar[XB_TOPGEN], 1u);
            else XB_SPIN(xb_ld(&bar[XB_TOPGEN]) == tg, bar);
            if (ACQ) __builtin_amdgcn_fence(__ATOMIC_ACQUIRE, "agent");
            xb_add(&bar[XB_XGEN(b.x)], 1u);
            asm volatile("s_waitcnt vmcnt(0)" ::: "memory");
        } else {
            XB_SPIN(xb_ld(&bar[XB_XGEN(b.x)]) == gen, bar);
            if (ACQ) __builtin_amdgcn_fence(__ATOMIC_ACQUIRE, "agent");
            asm volatile("s_waitcnt vmcnt(0)" ::: "memory");
        }
    }
    __syncthreads();
}
typedef short bf16x8_t __attribute__((ext_vector_type(8)));
typedef unsigned u32x2_t __attribute__((ext_vector_type(2)));
__device__ __forceinline__ unsigned cvtpk(float lo, float hi) { unsigned r; asm volatile("v_cvt_pk_bf16_f32 %0, %1, %2" : "=v"(r) : "v"(lo), "v"(hi)); return r; }
__device__ __forceinline__ void att_stage(LAS unsigned char* lds, const bf16_t* src, int pitch, int tid) {
    const int r0 = tid >> 5, ch = tid & 31;
    const bf16_t* g0 = src + (size_t)r0 * pitch + ch * 8;
    LAS unsigned char* l0 = lds + r0 * 512 + ((ch ^ r0) << 4);
    u32x4 v[16];
#pragma unroll
    for (int x = 0; x < 16; ++x) v[x] = *(const u32x4*)(g0 + (size_t)(16 * x) * pitch);
#pragma unroll
    for (int x = 0; x < 16; ++x) *(LAS u32x4*)(l0 + x * 8192) = v[x];
}
template <class Sched> __device__ __forceinline__ void att_phase(LAS unsigned char* lds, const bf16_t* Kl, const bf16_t* Vl, const bf16_t* Qb, bf16_t* Ob, const Sched& S, int tid) {
    pg8::Unit un;
    for (int ui = 0; S.next(ui, un); ++ui) {
        asm volatile("" : "+v"(tid));
        const int lane = tid & 63, wave = __builtin_amdgcn_readfirstlane(tid >> 6), j = lane & 15, kg = lane >> 4;
        const int h = un.pn, pm = un.pm, b = pm >> 5;
        att_stage(lds, Kl + (size_t)(b * 256) * 4096 + h * 256, 4096, tid);
        const bf16_t* qrow = Qb + (size_t)(pm * 256 + 16 * wave + j) * 1024 + h * 256;
        bf16_t* orow = Ob + (size_t)(pm * 256 + 16 * wave + j) * 1024 + h * 256;
        __syncthreads();
        const LAS unsigned char* fbase = lds + j * 512;
        const float cs = 0.0625f * 1.4426950408889634f;
        bf16x8_t pf[2][8]; float inv[2];
#pragma unroll
        for (int hf = 0; hf < 2; ++hf) {
            bf16x8_t qf[8];
#pragma unroll
            for (int s = 0; s < 8; ++s) qf[s] = *(const bf16x8_t*)(qrow + (size_t)hf * 128 * 1024 + 32 * s + 8 * kg);
            f32x4 acc[16];
#pragma unroll
            for (int kb = 0; kb < 16; ++kb) acc[kb] = (f32x4){0.f, 0.f, 0.f, 0.f};
#pragma unroll
            for (int s = 0; s < 8; ++s)
#pragma unroll
                for (int kb = 0; kb < 16; ++kb) { const bf16x8_t af = *(const LAS bf16x8_t*)(fbase + kb * 8192 + (((4 * s + kg) ^ j) << 4));
                    acc[kb] = __builtin_amdgcn_mfma_f32_16x16x32_bf16(af, qf[s], acc[kb], 0, 0, 0); }
            float mx = acc[0][0];
#pragma unroll
            for (int kb = 0; kb < 16; ++kb) mx = fmaxf(fmaxf(mx, fmaxf(acc[kb][0], acc[kb][1])), fmaxf(acc[kb][2], acc[kb][3]));
            mx = fmaxf(mx, __shfl_xor(mx, 16)); mx = fmaxf(mx, __shfl_xor(mx, 32));
            const float mxc = mx * cs; float sum = 0.f;
#pragma unroll
            for (int t = 0; t < 8; ++t) { f32x4 p0, p1;
#pragma unroll
                for (int e = 0; e < 4; ++e) { p0[e] = __builtin_amdgcn_exp2f(acc[2 * t][e] * cs - mxc); p1[e] = __builtin_amdgcn_exp2f(acc[2 * t + 1][e] * cs - mxc); }
                sum += (p0[0] + p0[1]) + (p0[2] + p0[3]) + (p1[0] + p1[1]) + (p1[2] + p1[3]);
                u32x4 w; w.x = cvtpk(p0[0], p0[1]); w.y = cvtpk(p0[2], p0[3]); w.z = cvtpk(p1[0], p1[1]); w.w = cvtpk(p1[2], p1[3]); pf[hf][t] = __builtin_bit_cast(bf16x8_t, w); }
            sum += __shfl_xor(sum, 16); sum += __shfl_xor(sum, 32);
            inv[hf] = 1.f / sum;
            __builtin_amdgcn_sched_barrier(0);
        }
        __syncthreads();
        att_stage(lds, Vl + (size_t)(h * 256) * 1024 + b * 256, 1024, tid);
        __syncthreads();
#pragma unroll
        for (int db = 0; db < 16; ++db) {
            f32x4 o0 = (f32x4){0.f, 0.f, 0.f, 0.f}, o1 = o0;
#pragma unroll
            for (int t = 0; t < 8; ++t) { const bf16x8_t af = *(const LAS bf16x8_t*)(fbase + db * 8192 + (((4 * t + kg) ^ j) << 4));
                o0 = __builtin_amdgcn_mfma_f32_16x16x32_bf16(af, pf[0][t], o0, 0, 0, 0); o1 = __builtin_amdgcn_mfma_f32_16x16x32_bf16(af, pf[1][t], o1, 0, 0, 0); }
            u32x2_t w; w.x = cvtpk(o0[0] * inv[0], o0[1] * inv[0]); w.y = cvtpk(o0[2] * inv[0], o0[3] * inv[0]);
            *(u32x2_t*)(orow + 16 * db + 4 * kg) = w;
            w.x = cvtpk(o1[0] * inv[1], o1[1] * inv[1]); w.y = cvtpk(o1[2] * inv[1], o1[3] * inv[1]);
            *(u32x2_t*)(orow + (size_t)128 * 1024 + 16 * db + 4 * kg) = w;
        }
        __syncthreads();
    }
}

__device__ __forceinline__ void conv_phase(LAS unsigned char* lds, const bf16_t* PROJ, const float* cw, const float* cb, const float* lg, const float* lb, bf16_t* MIXIN, int G, int tid) {
    LAS float* U = (LAS float*)lds;
    for (int u = blockIdx.x; u < M / 32; u += G) {
        asm volatile("" : "+v"(tid));
        const int lane = tid & 63, wave = __builtin_amdgcn_readfirstlane(tid >> 6);
        const int row0 = u * 32, t0 = row0 % SEQ;
        const int c = tid;
        float w[31];
#pragma unroll
        for (int k = 0; k < 31; ++k) w[k] = cw[k * 512 + c];
        const float bias = cb[c];
#pragma unroll
        for (int pass = 0; pass < 8; ++pass) { const int rr = pass * 8 + wave;
            if (rr < 62) { f32x4 o0 = (f32x4){0.f, 0.f, 0.f, 0.f}, o1 = o0;
                if (t0 - 30 + rr >= 0) { const u32x4 a = *(const u32x4*)(PROJ + (size_t)(row0 - 30 + rr) * PROJ_LD + 8 * lane);
                    o0 = (f32x4){__uint_as_float(a[0] << 16), __uint_as_float(a[0] & 0xffff0000u), __uint_as_float(a[1] << 16), __uint_as_float(a[1] & 0xffff0000u)};
                    o1 = (f32x4){__uint_as_float(a[2] << 16), __uint_as_float(a[2] & 0xffff0000u), __uint_as_float(a[3] << 16), __uint_as_float(a[3] & 0xffff0000u)}; }
                *(LAS f32x4*)(U + rr * 512 + 8 * lane) = o0; *(LAS f32x4*)(U + rr * 512 + 8 * lane + 4) = o1; } }
        __syncthreads();
        float y[32];
#pragma unroll
        for (int blk = 0; blk < 4; ++blk) { float win[38];
#pragma unroll
            for (int x = 0; x < 38; ++x) win[x] = U[(8 * blk + x) * 512 + c];
#pragma unroll
            for (int o = 0; o < 8; ++o) { float acc = bias;
#pragma unroll
                for (int k = 0; k < 31; ++k) acc += w[k] * win[o + k];
                y[8 * blk + o] = acc; } }
        __syncthreads();
#pragma unroll
        for (int tt = 0; tt < 32; ++tt) U[tt * 512 + c] = y[tt];
        __syncthreads();
#pragma unroll
        for (int q = 0; q < 4; ++q) { const int tt = 4 * wave + q;
            f32x4 a = *(const LAS f32x4*)(U + tt * 512 + 8 * lane), b = *(const LAS f32x4*)(U + tt * 512 + 8 * lane + 4);
            const float mean = wave_sum((a[0] + a[1]) + (a[2] + a[3]) + (b[0] + b[1]) + (b[2] + b[3])) * (1.f / 512.f);
            a = a - mean; b = b - mean;
            const float var = wave_sum((a[0] * a[0] + a[1] * a[1]) + (a[2] * a[2] + a[3] * a[3]) + (b[0] * b[0] + b[1] * b[1]) + (b[2] * b[2] + b[3] * b[3])) * (1.f / 512.f);
            const float rstd = rsqrtf(var + LN_EPS);
            a = a * rstd * *(const f32x4*)(lg + 8 * lane) + *(const f32x4*)(lb + 8 * lane); b = b * rstd * *(const f32x4*)(lg + 8 * lane + 4) + *(const f32x4*)(lb + 8 * lane + 4);
#pragma unroll
            for (int x = 0; x < 4; ++x) { a[x] = pg8::silu_fast(a[x]); b[x] = pg8::silu_fast(b[x]); }
            *(u32x4*)(MIXIN + (size_t)(row0 + tt) * D + 8 * lane) = pg8::pack8(a, b); }
        __syncthreads();
    }
}

typedef float f32x16_t __attribute__((ext_vector_type(16)));
constexpr int GP = 72;
__device__ __forceinline__ int slot32(int c) { const int w = c & 15; return (c & ~15) + 8 * ((w >> 2) & 1) + (w & 3) + 4 * (w >> 3); }
#define GLA_BAR() do { asm volatile("s_waitcnt lgkmcnt(0)" ::: "memory"); __builtin_amdgcn_s_barrier(); asm volatile("" ::: "memory"); } while (0)
__device__ __forceinline__ void gla_bcum(const u32x4 a0, const u32x4 a1, const float* wa2, const float* ba, int h, int lane, int wave, float (&bc)[8], float (&bl)[8]) {
    float al[16];
#pragma unroll
    for (int x = 0; x < 4; ++x) { al[2 * x] = __uint_as_float(a0[x] << 16); al[2 * x + 1] = __uint_as_float(a0[x] & 0xffff0000u); al[8 + 2 * x] = __uint_as_float(a1[x] << 16); al[8 + 2 * x + 1] = __uint_as_float(a1[x] & 0xffff0000u); }
#pragma unroll
    for (int x = 0; x < 8; ++x) { const int col = h * 64 + 8 * wave + x; float z = ba[col];
#pragma unroll
        for (int i = 0; i < 16; ++i) z += al[i] * wa2[i * 256 + col];
        float la = (fminf(z, 0.f) - __logf(1.f + __expf(-fabsf(z)))) * (1.f / 16.f);
        la += __builtin_bit_cast(float, __builtin_amdgcn_update_dpp(0, __builtin_bit_cast(int, la), 0x111, 0xf, 0xf, true));
        la += __builtin_bit_cast(float, __builtin_amdgcn_update_dpp(0, __builtin_bit_cast(int, la), 0x112, 0xf, 0xf, true));
        la += __builtin_bit_cast(float, __builtin_amdgcn_update_dpp(0, __builtin_bit_cast(int, la), 0x114, 0xf, 0xf, true));
        la += __builtin_bit_cast(float, __builtin_amdgcn_update_dpp(0, __builtin_bit_cast(int, la), 0x118, 0xf, 0xf, true));
        const float t0 = __builtin_bit_cast(float, __builtin_amdgcn_readlane(__builtin_bit_cast(int, la), 15)), t1 = __builtin_bit_cast(float, __builtin_amdgcn_readlane(__builtin_bit_cast(int, la), 31)),
                    t2 = __builtin_bit_cast(float, __builtin_amdgcn_readlane(__builtin_bit_cast(int, la), 47)), t3 = __builtin_bit_cast(float, __builtin_amdgcn_readlane(__builtin_bit_cast(int, la), 63));
        la += (lane >= 48) ? (t0 + t1) + t2 : (lane >= 32) ? t0 + t1 : (lane >= 16) ? t0 : 0.f;
        bc[x] = la; bl[x] = ((t0 + t1) + t2) + t3; }
}
__device__ __forceinline__ void unpack8(const u32x4 v, float (&f)[8]) {
#pragma unroll
    for (int x = 0; x < 4; ++x) { f[2 * x] = __uint_as_float(v[x] << 16); f[2 * x + 1] = __uint_as_float(v[x] & 0xffff0000u); }
}
struct G1In { u32x4 a0, a1, k, v0, v1; };
__device__ __forceinline__ G1In g1_load(const bf16_t* PROJ, const bf16_t* ALOW, int u, int lane, int wave) {
    const int bh = u >> 7, n = u & 127, b = bh >> 2, h = bh & 3, row0 = b * SEQ + n * 64;
    const bf16_t* pr = PROJ + (size_t)(row0 + lane) * PROJ_LD; const bf16_t* al = ALOW + (size_t)(row0 + lane) * 16;
    G1In r; r.a0 = *(const u32x4*)al; r.a1 = *(const u32x4*)(al + 8); r.k = *(const u32x4*)(pr + C_K + h * 64 + 8 * wave);
    r.v0 = *(const u32x4*)(pr + C_V + h * 128 + 8 * wave); r.v1 = *(const u32x4*)(pr + C_V + h * 128 + 64 + 8 * wave); return r;
}
__device__ __forceinline__ void gla_g1_phase(LAS unsigned char* lds, const bf16_t* PROJ, const bf16_t* ALOW, const float* wa2, const float* ba, float* UPD, float* DEC, int G, int tid) {
    LAS bf16_t* KD = (LAS bf16_t*)lds; LAS bf16_t* VT = (LAS bf16_t*)(lds + 18432);
    const int lane = tid & 63, wave = __builtin_amdgcn_readfirstlane(tid >> 6);
    G1In cur; if ((int)blockIdx.x < 2048) cur = g1_load(PROJ, ALOW, blockIdx.x, lane, wave);
    for (int u = blockIdx.x; u < 2048; u += G) {
        G1In nxt; if (u + G < 2048) nxt = g1_load(PROJ, ALOW, u + G, lane, wave);
        const int bh = u >> 7, h = bh & 3;
        float bc[8], bl[8];
        gla_bcum(cur.a0, cur.a1, wa2, ba, h, lane, wave, bc, bl);
        float kf[8]; unpack8(cur.k, kf);
#pragma unroll
        for (int x = 0; x < 8; ++x) KD[(8 * wave + x) * GP + lane] = f2bf(kf[x] * __expf(bl[x] - bc[x]));
        if (lane == 63) {
#pragma unroll
            for (int x = 0; x < 8; ++x) DEC[u * 64 + 8 * wave + x] = __expf(bl[x]); }
#pragma unroll
        for (int pc = 0; pc < 2; ++pc) { const int e0 = 64 * pc + 8 * wave; const u32x4 v = pc ? cur.v1 : cur.v0;
#pragma unroll
            for (int x = 0; x < 4; ++x) { VT[(e0 + 2 * x) * GP + lane] = (bf16_t)(v[x] & 0xffffu); VT[(e0 + 2 * x + 1) * GP + lane] = (bf16_t)(v[x] >> 16); } }
        GLA_BAR();
        const int eb = wave >> 1, dbk = wave & 1, i = lane & 31, kg = lane >> 5;
        f32x16_t acc;
#pragma unroll
        for (int r = 0; r < 16; ++r) acc[r] = 0.f;
#pragma unroll
        for (int s = 0; s < 4; ++s) { const bf16x8_t af = *(const LAS bf16x8_t*)(VT + (32 * eb + i) * GP + 16 * s + 8 * kg), bfr = *(const LAS bf16x8_t*)(KD + (32 * dbk + i) * GP + 16 * s + 8 * kg);
            acc = __builtin_amdgcn_mfma_f32_32x32x16_bf16(af, bfr, acc, 0, 0, 0); }
        float* up = UPD + ((size_t)u * 128 + 32 * eb + 4 * kg) * 64 + 32 * dbk + i;
#pragma unroll
        for (int r = 0; r < 16; ++r) up[((r & 3) + 8 * (r >> 2)) * 64] = acc[r];
        GLA_BAR();
        cur = nxt;
    }
}
__device__ __forceinline__ void gla_g2_phase(const float* UPD, bf16_t* SP, const float* DEC, int G, int tid) {
    for (int g = blockIdx.x * 512 + tid; g < 16 * 8192; g += G * 512) {
        const int bh = g >> 13, ed = g & 8191, d = g & 63;
        const float* p = UPD + (size_t)bh * 128 * 8192 + ed; bf16_t* po = SP + (size_t)bh * 128 * 8192 + ed; const float* dc = DEC + bh * 128 * 64 + d;
        float S = 0.f;
        for (int n0 = 0; n0 < 128; n0 += 16) { float uu[16], dd[16];
#pragma unroll
            for (int x = 0; x < 16; ++x) { uu[x] = p[(size_t)(n0 + x) * 8192]; dd[x] = dc[(n0 + x) * 64]; }
#pragma unroll
            for (int x = 0; x < 16; ++x) { po[(size_t)(n0 + x) * 8192] = f2bf(S); S = dd[x] * S + uu[x]; } }
    }
}
struct G3In { u32x4 a0, a1, q, k, v0, v1; bf16x8_t sp[4]; u32x2_t rr[4]; };
__device__ __forceinline__ G3In g3_load(const bf16_t* PROJ, const bf16_t* ALOW, const bf16_t* SPV, int u, int lane, int wave) {
    const int bh = u >> 7, n = u & 127, b = bh >> 2, h = bh & 3, row0 = b * SEQ + n * 64;
    const int eb = wave >> 1, cb = wave & 1, i = lane & 31, kg = lane >> 5;
    const bf16_t* pr = PROJ + (size_t)(row0 + lane) * PROJ_LD; const bf16_t* al = ALOW + (size_t)(row0 + lane) * 16;
    G3In r; r.a0 = *(const u32x4*)al; r.a1 = *(const u32x4*)(al + 8); r.q = *(const u32x4*)(pr + C_Q + h * 64 + 8 * wave); r.k = *(const u32x4*)(pr + C_K + h * 64 + 8 * wave);
    r.v0 = *(const u32x4*)(pr + C_V + h * 128 + 8 * wave); r.v1 = *(const u32x4*)(pr + C_V + h * 128 + 64 + 8 * wave);
    const bf16_t* sp = SPV + ((size_t)u * 128 + 32 * eb + i) * 64 + 8 * kg;
#pragma unroll
    for (int s = 0; s < 4; ++s) r.sp[s] = *(const bf16x8_t*)(sp + 16 * s);
    const bf16_t* rp = PROJ + (size_t)(row0 + 32 * cb + i) * PROJ_LD + C_R + h * 128 + 32 * eb + 4 * kg;
#pragma unroll
    for (int rg = 0; rg < 4; ++rg) r.rr[rg] = *(const u32x2_t*)(rp + 8 * rg);
    return r;
}
__device__ __forceinline__ void gla_g3_phase(LAS unsigned char* lds, const bf16_t* PROJ, const bf16_t* ALOW, const float* wa2, const float* ba, const float* gn, const bf16_t* UPD, bf16_t* MIXIN, int G, int tid) {
    LAS bf16_t* KE = (LAS bf16_t*)lds; LAS bf16_t* QE = (LAS bf16_t*)(lds + 9216); LAS bf16_t* VT = (LAS bf16_t*)(lds + 18432); LAS float* RED = (LAS float*)(lds + 36864);
    const int lane = tid & 63, wave = __builtin_amdgcn_readfirstlane(tid >> 6);
    const int eb = wave >> 1, cb = wave & 1, i = lane & 31, kg = lane >> 5;
    G3In cur; if ((int)blockIdx.x < 2048) cur = g3_load(PROJ, ALOW, UPD, blockIdx.x, lane, wave);
    for (int u = blockIdx.x; u < 2048; u += G) {
        G3In nxt; if (u + G < 2048) nxt = g3_load(PROJ, ALOW, UPD, u + G, lane, wave);
        const int bh = u >> 7, n = u & 127, b = bh >> 2, h = bh & 3, row0 = b * SEQ + n * 64;
        const size_t row = (size_t)(row0 + 32 * cb + i);
        { float bc[8], bl[8];
          gla_bcum(cur.a0, cur.a1, wa2, ba, h, lane, wave, bc, bl);
          float qf[8], kf[8]; unpack8(cur.q, qf); unpack8(cur.k, kf);
          f32x4 q0, q1, k0, k1;
#pragma unroll
          for (int x = 0; x < 4; ++x) { q0[x] = qf[x] * 0.125f * __expf(bc[x]); q1[x] = qf[4 + x] * 0.125f * __expf(bc[4 + x]); k0[x] = kf[x] * __expf(-bc[x]); k1[x] = kf[4 + x] * __expf(-bc[4 + x]); }
          *(LAS u32x4*)(QE + lane * GP + 8 * wave) = pg8::pack8(q0, q1); *(LAS u32x4*)(KE + lane * GP + 8 * wave) = pg8::pack8(k0, k1);
          const int pcol = slot32(lane);
#pragma unroll
          for (int pc = 0; pc < 2; ++pc) { const int e0 = 64 * pc + 8 * wave; const u32x4 v = pc ? cur.v1 : cur.v0;
#pragma unroll
              for (int x = 0; x < 4; ++x) { VT[(e0 + 2 * x) * GP + pcol] = (bf16_t)(v[x] & 0xffffu); VT[(e0 + 2 * x + 1) * GP + pcol] = (bf16_t)(v[x] >> 16); } } }
        GLA_BAR();
        bf16x8_t qb[4];
#pragma unroll
        for (int s = 0; s < 4; ++s) qb[s] = *(const LAS bf16x8_t*)(QE + (32 * cb + i) * GP + 16 * s + 8 * kg);
        f32x16_t o;
#pragma unroll
        for (int r = 0; r < 16; ++r) o[r] = 0.f;
#pragma unroll
        for (int sb = 0; sb < 2; ++sb) if (sb <= cb) {
            f32x16_t at;
#pragma unroll
            for (int r = 0; r < 16; ++r) at[r] = 0.f;
#pragma unroll
            for (int s = 0; s < 4; ++s) { const bf16x8_t af = *(const LAS bf16x8_t*)(KE + (32 * sb + i) * GP + 16 * s + 8 * kg); at = __builtin_amdgcn_mfma_f32_32x32x16_bf16(af, qb[s], at, 0, 0, 0); }
            if (sb == cb) {
#pragma unroll
                for (int r = 0; r < 16; ++r) if ((r & 3) + 8 * (r >> 2) + 4 * kg > i) at[r] = 0.f; }
#pragma unroll
            for (int sp = 0; sp < 2; ++sp) { u32x4 w; w.x = cvtpk(at[8 * sp + 0], at[8 * sp + 1]); w.y = cvtpk(at[8 * sp + 2], at[8 * sp + 3]); w.z = cvtpk(at[8 * sp + 4], at[8 * sp + 5]); w.w = cvtpk(at[8 * sp + 6], at[8 * sp + 7]);
                const bf16x8_t af = *(const LAS bf16x8_t*)(VT + (32 * eb + i) * GP + 32 * sb + 16 * sp + 8 * kg);
                o = __builtin_amdgcn_mfma_f32_32x32x16_bf16(af, __builtin_bit_cast(bf16x8_t, w), o, 0, 0, 0); }
        }
#pragma unroll
        for (int s = 0; s < 4; ++s) o = __builtin_amdgcn_mfma_f32_32x32x16_bf16(cur.sp[s], qb[s], o, 0, 0, 0);
        float ss = 0.f;
#pragma unroll
        for (int r = 0; r < 16; ++r) ss += o[r] * o[r];
        ss += __shfl_xor(ss, 32);
        if (kg == 0) RED[eb * 64 + 32 * cb + i] = ss;
        GLA_BAR();
        const float tot = (RED[32 * cb + i] + RED[64 + 32 * cb + i]) + (RED[128 + 32 * cb + i] + RED[192 + 32 * cb + i]);
        const float rstd = rsqrtf(tot * (1.f / 128.f) + LN_EPS);
#pragma unroll
        for (int rg = 0; rg < 4; ++rg) { const int e = 32 * eb + 8 * rg + 4 * kg;
            const f32x4 g4 = *(const f32x4*)(gn + e); const u32x2_t rr = cur.rr[rg];
            const float r0 = __uint_as_float(rr.x << 16), r1 = __uint_as_float(rr.x & 0xffff0000u), r2 = __uint_as_float(rr.y << 16), r3 = __uint_as_float(rr.y & 0xffff0000u);
            u32x2_t w; w.x = cvtpk(o[4 * rg] * rstd * g4[0] * pg8::silu_fast(r0), o[4 * rg + 1] * rstd * g4[1] * pg8::silu_fast(r1));
            w.y = cvtpk(o[4 * rg + 2] * rstd * g4[2] * pg8::silu_fast(r2), o[4 * rg + 3] * rstd * g4[3] * pg8::silu_fast(r3));
            *(u32x2_t*)(MIXIN + row * D + 512 + h * 128 + e) = w; }
        GLA_BAR();
        cur = nxt;
    }
}

#ifndef PROBE_MASK
#define PROBE_MASK 0
#endif
#ifndef ONE_LAUNCH
#define ONE_LAUNCH 1
#endif
constexpr int NPL = 9, NPH = 2 + NPL * DEPTH + 1;
enum { PK_IN = 0, PK_CG1, PK_G2, PK_G3, PK_MIX, PK_Q, PK_XO, PK_FF1, PK_FF2 };
constexpr int CSN = 9472, CS_IN = 0, CS_Q = 2816, CS_FF1 = 3840;

__global__ void __launch_bounds__(NWAVES * 64) mega(Args a) {
    extern __shared__ __attribute__((aligned(16))) unsigned char lds_raw[];
    LAS unsigned char* lds = (LAS unsigned char*)lds_raw;
    const int wave = __builtin_amdgcn_readfirstlane(threadIdx.x >> 6);
    const int G = gridDim.x, gw = blockIdx.x * NWAVES + wave, NGW = G * NWAVES;
    unsigned char* ws = a.ws;
#define INP(k) ({ int k_ = (k); asm volatile("" : "+s"(k_)); a.in[k_]; })
    float* Y = a.out;
    bf16_t* WT = (bf16_t*)(ws + WS_WT); bf16_t* YB = (bf16_t*)(ws + WS_HB); bf16_t* PROJ = (bf16_t*)(ws + WS_PROJ); bf16_t* ALOW = (bf16_t*)(ws + WS_ALOW);
    bf16_t* MIXIN = (bf16_t*)(ws + WS_MIXIN); bf16_t* Qb = (bf16_t*)(ws + WS_Q); bf16_t* ACT = (bf16_t*)(ws + WS_ACT);
    bf16_t* Kb = (bf16_t*)(ws + WS_K); bf16_t* Vt = (bf16_t*)(ws + WS_VT); bf16_t* MEMB = (bf16_t*)(ws + WS_MEMB); bf16_t* MEMP = (bf16_t*)(ws + WS_MEMP);
    float* UPD = (float*)(ws + WS_UPD); float* DEC = (float*)(ws + WS_DEC);
    float* CSP = (float*)(ws + WS_CSP); float* CS = (float*)(ws + WS_CS); float* MUR = (float*)(ws + WS_MUR);
    unsigned long long* SLOTS = (unsigned long long*)(ws + WS_SLOTS); unsigned* CNT = (unsigned*)(ws + WS_CNT);

    volatile LAS unsigned* bst = (volatile LAS unsigned*)(lds + 143360);
    if (threadIdx.x == 0) { bst[0] = 0u; bst[1] = 0u; }
    __syncthreads();
    XcdBarrier xbar; xbar.bar = (unsigned*)(ws + WS_BAR); xbar.x = 0; xbar.st = bst;
    if (a.ph_hi - a.ph_lo > 1) xbar = xcd_barrier_post((unsigned*)(ws + WS_BAR), bst);
    for (int p = a.ph_lo; p < a.ph_hi; ++p) {
      const int pkind = (p < 2 || p == NPH - 1) ? -1 : (p - 2) % NPL;
      int nrep = 1;
      if ((a.sub & 4) && (pkind == PK_IN || pkind == PK_Q || pkind == PK_FF1)) nrep = 2;
      if ((a.sub & (8 | 8192)) && pkind == PK_CG1) nrep = 2;
      if ((a.sub & 16384) && pkind == PK_G3) nrep = 2;
      if ((a.sub & 64) && p < 2) nrep = 2;
      for (int rep = 0; rep < nrep; ++rep) {
        const bool dummy = rep + 1 < nrep;
        int tid; asm volatile("v_mbcnt_lo_u32_b32 %0, -1, 0\n\tv_mbcnt_hi_u32_b32 %0, -1, %0\n\tv_lshl_or_b32 %0, %1, 6, %0" : "=&v"(tid) : "s"(wave));
        const int lane = tid & 63;
        if (p == 0) {
            LAS float* scr = (LAS float*)(lds + wave * 16384);
            if (blockIdx.x == 0) { CNT[tid] = 0u; CNT[512 + tid] = 0u; CNT[1024 + tid] = 0u; }
            for (int it = gw; it < DEPTH * I_LAYER; it += NGW) {
                const int l = it / I_LAYER; int r = it % I_LAYER;
                bf16_t* WL = WT + WT_L0 + (size_t)l * WT_LSTRIDE;
                float* cspl = CSP + (size_t)l * 2 * 16 * CSN;
                if (r < I_IN) { const int kb = r / 81, n0 = 32 * (r % 81); const float* gg = l == 0 ? INP(2) : INP(22) + (l - 1) * D; const float* bb = l == 0 ? INP(3) : INP(23) + (l - 1) * D;
                    const int drow = n0 < 512 ? 256 * (n0 / 128) + n0 % 128 : n0 < 1024 ? 256 * ((n0 - 512) / 128) + 128 + (n0 - 512) % 128 : n0;
                    cvt_item_ln(INP(4) + (size_t)l * 1024 * IN_COLS, 1024, IN_COLS, 64 * kb, n0, WL + WO_IN + (size_t)drow * 1024, scr, lane, gg, bb, cspl + kb * CSN + CS_IN + drow, cspl + (16 + kb) * CSN + CS_IN + drow); continue; } r -= I_IN;
                if (r < I_SQ) { const int kb = r / 32, nb = r % 32; cvt_item(INP(12) + (size_t)l * 1024 * 1024, 1024, 1024, 64 * kb, 32 * nb, WL + WO_MIX + (size_t)(32 * nb) * 1024, scr, lane); continue; } r -= I_SQ;
                if (r < I_SQ) { const int kb = r / 32, nb = r % 32;
                    cvt_item_ln(INP(15) + (size_t)l * 1024 * 1024, 1024, 1024, 64 * kb, 32 * nb, WL + WO_XQ + (size_t)(32 * nb) * 1024, scr, lane, INP(13) + l * D, INP(14) + l * D, cspl + kb * CSN + CS_Q + 32 * nb, cspl + (16 + kb) * CSN + CS_Q + 32 * nb); continue; } r -= I_SQ;
                if (r < I_SQ) { const int kb = r / 32, nb = r % 32; cvt_item(INP(17) + (size_t)l * 1024 * 1024, 1024, 1024, 64 * kb, 32 * nb, WL + WO_XO + (size_t)(32 * nb) * 1024, scr, lane); continue; } r -= I_SQ;
                if (r < I_XKV) { const int kb = r / 64, n0 = 32 * (r % 64);
                    bf16_t* dst = n0 < 1024 ? WT + WT_XK + (size_t)(l * 1024 + n0) * 1024 : WT + WT_XV + (size_t)(l * 1024 + n0 - 1024) * 1024;
                    cvt_item(INP(16) + (size_t)l * 1024 * 2048, 1024, 2048, 64 * kb, n0, dst, scr, lane); continue; } r -= I_XKV;
                if (r < I_FF1) { const int kb = r / 176, n0 = 32 * (r % 176);
                    const int drow = n0 < D_FF ? 256 * (n0 / 128) + n0 % 128 : 256 * ((n0 - D_FF) / 128) + 128 + (n0 - D_FF) % 128;
                    cvt_item_ln(INP(20) + (size_t)l * 1024 * 2 * D_FF, 1024, 2 * D_FF, 64 * kb, n0, WL + WO_FF1 + (size_t)drow * 1024, scr, lane, INP(18) + l * D, INP(19) + l * D, cspl + kb * CSN + CS_FF1 + drow, cspl + (16 + kb) * CSN + CS_FF1 + drow); continue; } r -= I_FF1;
                { const int kb = r / 32, nb = r % 32; cvt_item(INP(21) + (size_t)l * D_FF * 1024, D_FF, 1024, 64 * kb, 32 * nb, WL + WO_FF2 + (size_t)(32 * nb) * D_FF, scr, lane); }
            }
            for (int i = blockIdx.x * 512 + tid; i < 1024 * 1024; i += G * 512) {
                const int row = i >> 10, c = i & 1023, b = row >> 8, key = row & 255; const bf16_t v = f2bf(INP(1)[i]);
                MEMB[i] = v; MEMP[(size_t)(b * 256 + slot_of_key(key)) * 1024 + c] = v; }
            { const float* xin = INP(0); int m = gw;
              for (; m + 3 * NGW < M; m += 4 * NGW) x_rows<4>(xin, YB, MUR, m, NGW, lane);
              for (; m < M; m += NGW) x_rows<1>(xin, YB, MUR, m, NGW, lane); }
        } else if (p == 1) {
            for (int i = blockIdx.x * 512 + tid; i < DEPTH * 2 * CSN; i += G * 512) { const int lc = i / CSN, c = i % CSN; const float* pp = CSP + (size_t)lc * 16 * CSN + c; float s = 0.f;
#pragma unroll
                for (int kb = 0; kb < 16; ++kb) s += pp[kb * CSN];
                CS[i] = s; }
            const int half = G / 2;
            if ((int)blockIdx.x < half) { pg8::Gemm g{MEMB, WT + WT_XK, 1024, 4096, 1024}; pg8::StaticOrderT<1024, 4096> S; S.init(half, (int)blockIdx.x);
                pg8::EpiBf16 E{Kb, 4096}; pg8::gemm_phase<pg8::EpiBf16, pg8::StaticOrderT<1024, 4096>, true, true, 1024>(lds, g, S, E, tid); }
            else { pg8::Gemm g{WT + WT_XV, MEMP, 4096, 1024, 1024}; pg8::StaticOrderT<4096, 1024> S; S.init(G - half, (int)blockIdx.x - half);
                pg8::EpiBf16 E{Vt, 1024}; pg8::gemm_phase<pg8::EpiBf16, pg8::StaticOrderT<4096, 1024>, true, true, 1024>(lds, g, S, E, tid); }
        } else if (p == NPH - 1) {
            const float* gg = INP(22) + (DEPTH - 1) * D; const float* bb = INP(23) + (DEPTH - 1) * D;
            for (int m = gw; m < M; m += NGW) ln_row_f32(Y + (size_t)m * D, gg, bb, lane);
        } else {
            const int l = (p - 2) / NPL, kind = (p - 2) % NPL;
            const bf16_t* WL = WT + WT_L0 + (size_t)l * WT_LSTRIDE;
            const float* csl = CS + (size_t)l * 2 * CSN; const float* cbl = csl + CSN;
            if (kind == PK_IN) { pg8::Gemm g{YB, WL + WO_IN, M, 2560, 1024}; pg8::StaticOrderT<M, 2560> S; S.init(G, (int)blockIdx.x);
                pg8::EpiInLN E{PROJ, MUR, csl + CS_IN, cbl + CS_IN}; pg8::gemm_phase<pg8::EpiInLN, pg8::StaticOrderT<M, 2560>, true, true, 1024>(lds, g, S, E, tid);
                alow_rows(YB, WL + WO_IN + (size_t)2560 * 1024, MUR, csl + CS_IN + 2560, cbl + CS_IN + 2560, ALOW, gw, NGW, lane); }
            else if (kind == PK_CG1) {
                if ((a.sub & 1) && !(dummy && (a.sub & 8192))) conv_phase(lds, PROJ, INP(7) + l * 31 * 512, INP(8) + l * 512, INP(9) + l * 512, INP(10) + l * 512, MIXIN, G, tid);
                if ((a.sub & 2) && !(dummy && (a.sub & 8))) gla_g1_phase(lds, PROJ, ALOW, INP(5) + l * 16 * 256, INP(6) + l * 256, UPD, DEC, G, tid); }
            else if (kind == PK_G2) { gla_g2_phase(UPD, (bf16_t*)a.out, DEC, G, tid); }
            else if (kind == PK_G3) { gla_g3_phase(lds, PROJ, ALOW, INP(5) + l * 16 * 256, INP(6) + l * 256, INP(11) + l * 128, (const bf16_t*)a.out, MIXIN, G, tid); }
            else if (kind == PK_MIX || kind == PK_XO) {
                const bool mix = kind == PK_MIX;
                pg8::Gemm g{mix ? MIXIN : Qb, WL + (mix ? WO_MIX : WO_XO), M, 1024, 1024}; pg8::StaticOrderT<M, 1024> S; S.init(G, (int)blockIdx.x);
                const float* gp = mix ? (l == 0 ? INP(2) : INP(22) + (l - 1) * D) : INP(13) + l * D; const float* bp = mix ? (l == 0 ? INP(3) : INP(23) + (l - 1) * D) : INP(14) + l * D;
                pg8::EpiResLN E{(mix && l == 0) ? INP(0) : nullptr, nullptr, YB, MUR, gp, bp, SLOTS, CNT + (3 * l + (mix ? 0 : 1)) * 128, ALPHA, lds};
                pg8::gemm_phase<pg8::EpiResLN, pg8::StaticOrderT<M, 1024>, true, true, 1024>(lds, g, S, E, tid); }
            else if (kind == PK_Q) { pg8::Gemm g{YB, WL + WO_XQ, M, 1024, 1024}; pg8::StaticOrderT<M, 1024> S; S.init(G, (int)blockIdx.x);
                pg8::EpiBf16LN E{Qb, 1024, MUR, csl + CS_Q, cbl + CS_Q}; pg8::gemm_phase<pg8::EpiBf16LN, pg8::StaticOrderT<M, 1024>, true, true, 1024>(lds, g, S, E, tid);
                asm volatile("s_waitcnt vmcnt(0)" ::: "memory"); __syncthreads();
                att_phase(lds, Kb + l * 1024, Vt + (size_t)l * 1024 * 1024, Qb, Qb, S, tid); }
            else if (kind == PK_FF1) { pg8::Gemm g{YB, WL + WO_FF1, M, 2 * D_FF, 1024}; pg8::StaticOrderT<M, 2 * D_FF> S; S.init(G, (int)blockIdx.x);
                pg8::EpiSwigluLN E{ACT, MUR, csl + CS_FF1, cbl + CS_FF1}; pg8::gemm_phase<pg8::EpiSwigluLN, pg8::StaticOrderT<M, 2 * D_FF>, true, true, 1024>(lds, g, S, E, tid); }
            else { pg8::Gemm g{ACT, WL + WO_FF2, M, 1024, D_FF}; pg8::StaticOrderT<M, 1024> S; S.init(G, (int)blockIdx.x);
                pg8::EpiResLN E{nullptr, l == DEPTH - 1 ? Y : nullptr, YB, MUR, INP(18) + l * D, INP(19) + l * D, SLOTS, CNT + (3 * l + 2) * 128, ALPHA, lds};
                pg8::gemm_phase<pg8::EpiResLN, pg8::StaticOrderT<M, 1024>, true, true, D_FF>(lds, g, S, E, tid); }
        }
      }
        if (p + 1 < a.ph_hi) { if (p == 0) cg::this_grid().sync(); else xcd_barrier(xbar); if (a.sub & 256) xcd_barrier(xbar); if (a.sub & 512) xcd_barrier_v<false, false>(xbar); }
    }
}

#undef INP
extern "C" void kernel_launch(void* const* d_in, const int* in_sizes, int n_in, void* d_out, int out_size, void* d_ws, size_t ws_size, hipStream_t stream) {
    if (n_in != 24 || out_size != M * D || ws_size < WS_END) { fprintf(stderr, "kernel_launch: unexpected shapes (n_in %d out %d ws %zu)\n", n_in, out_size, ws_size); return; }
    static int grid = 0;
    if (grid == 0) {
        int dev = 0, cus = 0, per_cu = 0;
        (void)hipGetDevice(&dev); (void)hipDeviceGetAttribute(&cus, hipDeviceAttributeMultiprocessorCount, dev);
        if (hipFuncSetAttribute((const void*)mega, hipFuncAttributeMaxDynamicSharedMemorySize, LDS_BYTES) != hipSuccess) { fprintf(stderr, "kernel_launch: hipFuncSetAttribute failed\n"); grid = -1; return; }
        if (hipOccupancyMaxActiveBlocksPerMultiprocessor(&per_cu, (const void*)mega, NWAVES * 64, LDS_BYTES) != hipSuccess || per_cu < 1) { fprintf(stderr, "kernel_launch: occupancy query says %d\n", per_cu); per_cu = 1; }
        (void)hipGetLastError();
        grid = cus;
    }
    if (grid < 0) return;
    Args a{};
    for (int i = 0; i < 24; ++i) a.in[i] = (const float*)d_in[i];
    a.out = (float*)d_out; a.ws = (unsigned char*)d_ws;
#if ONE_LAUNCH
    if (hipMemsetAsync((char*)d_ws + WS_BAR, 0, 16384, stream) != hipSuccess) { fprintf(stderr, "kernel_launch: memset of the barrier words failed\n"); return; }
    a.ph_lo = 0; a.ph_hi = NPH; a.sub = 3 | PROBE_MASK;
    void* kargs[] = {&a};
    hipError_t e = hipLaunchCooperativeKernel((const void*)mega, dim3(grid), dim3(NWAVES * 64), kargs, LDS_BYTES, stream);
    if (e != hipSuccess) fprintf(stderr, "kernel_launch: cooperative launch failed: %s\n", hipGetErrorString(e));
#else
    for (int p = 0; p < NPH; ++p) { a.ph_lo = p; a.ph_hi = p + 1; a.sub = 3; hipLaunchKernelGGL(mega, dim3(grid), dim3(NWAVES * 64), LDS_BYTES, stream, a); }
#endif
}
```
